# Optimizing an MI355X kernel written in HIP

```python
import math
import jax, jax.numpy as jnp
from jax import lax
import numpy as np

D_MODEL = 4096
BATCH = 4
SEQ = 4096
DEPTH = 1
DEC_BATCH = 8
DEC_SEQ = 2048
PAST_LEN = 128

DA_HEADS = 8
DA_HEAD_DIM = 128
DA_QK = DA_HEADS * 2 * DA_HEAD_DIM
DA_V = DA_HEADS * 2 * DA_HEAD_DIM
GLA_HEADS = 4
GLA_DK = 256
GLA_DV = 512
GLA_K = GLA_HEADS * GLA_DK
GLA_V = GLA_HEADS * GLA_DV
GLA_GATE_RANK = 16
GLA_GATE_TAU = 16.0
GLA_CHUNK = 64
D_FF = 11008
CONV_WIDTH = 3
REL_BUCKETS = 32
REL_MAX_DIST = 128
Q_BLOCK = 128
EPS = 1e-6
D_IN = DA_QK + DA_QK + DA_V + GLA_K + GLA_K + GLA_V + GLA_V + 2 * GLA_GATE_RANK + 2 * D_MODEL

kernel_name = 'hybrid_diffattn_gla_convffn_encoder'


def _rmsnorm(x, g):
    xf = x.astype(jnp.float32)
    y = xf * lax.rsqrt(jnp.mean(xf * xf, axis=-1, keepdims=True) + EPS)
    return (y * g.astype(jnp.float32)).astype(x.dtype)


def _t5_bucket(rel):
    half = REL_BUCKETS // 2
    max_exact = half // 2
    ret = jnp.where(rel > 0, half, 0)
    n = jnp.abs(rel)
    nf = jnp.maximum(n, 1).astype(jnp.float32)
    large = max_exact + (jnp.log(nf / max_exact) / math.log(REL_MAX_DIST / max_exact)
                         * (half - max_exact)).astype(jnp.int32)
    large = jnp.minimum(large, half - 1)
    return ret + jnp.where(n < max_exact, n, large)


def _diff_attention(q, k, v, rel_bias, lam):
    B, H, _, T, d = q.shape
    nq = T // Q_BLOCK
    qb = q.reshape(B, H, 2, nq, Q_BLOCK, d).transpose(3, 0, 1, 2, 4, 5)
    kpos = jnp.arange(T, dtype=jnp.int32)

    def block(args):
        i, qi = args
        qpos = i * Q_BLOCK + jnp.arange(Q_BLOCK, dtype=jnp.int32)
        bias = rel_bias[_t5_bucket(kpos[None, :] - qpos[:, None])]
        bias = jnp.transpose(bias, (2, 0, 1)).astype(jnp.float32)
        s = jnp.einsum('bhmqd,bhmkd->bhmqk', qi, k).astype(jnp.float32) + bias[None, :, None]
        p = jax.nn.softmax(s, axis=-1)
        w = p[:, :, 0] - lam * p[:, :, 1]
        return jnp.einsum('bhqk,bhkv->bhqv', w.astype(v.dtype), v)

    o = lax.map(block, (jnp.arange(nq, dtype=jnp.int32), qb))
    return o.transpose(1, 0, 3, 2, 4).reshape(B, T, H, 2 * d)


def _gla_chunked(q, k, v, log_a):
    B, H, T, dk = q.shape
    dv = v.shape[-1]
    C = GLA_CHUNK
    N = T // C
    q, k, log_a = (t.reshape(B, H, N, C, dk) for t in (q, k, log_a))
    v = v.reshape(B, H, N, C, dv)
    b = jnp.cumsum(log_a, axis=3)
    b_last = b[:, :, :, -1:, :]
    q_dec = q * jnp.exp(b)
    k_inv = k * jnp.exp(-b)
    mask = jnp.tril(jnp.ones((C, C), dtype=bool))
    att = jnp.where(mask, jnp.einsum('bhncd,bhnsd->bhncs', q_dec, k_inv), 0.0)
    o_intra = jnp.einsum('bhncs,bhnsv->bhncv', att, v)
    k_dec = k * jnp.exp(b_last - b)
    decay = jnp.exp(b_last[:, :, :, 0, :])

    def step(S, xs):
        qd, kd, vn, dn = xs
        o = jnp.einsum('bhcd,bhdv->bhcv', qd, S)
        S = dn[..., None] * S + jnp.einsum('bhcd,bhcv->bhdv', kd, vn)
        return S, o

    xs = tuple(jnp.moveaxis(t, 2, 0) for t in (q_dec, k_dec, v, decay))
    S0 = jnp.zeros((B, H, dk, dv), jnp.float32)
    _, o_inter = lax.scan(step, S0, xs)
    o = o_intra + jnp.moveaxis(o_inter, 0, 2)
    return o.reshape(B, H, T, dv)


def _depthwise_conv3(a, w, bias):
    ap = jnp.pad(a, ((0, 0), (1, 1), (0, 0)))
    return ap[:, :-2] * w[0] + ap[:, 1:-1] * w[1] + ap[:, 2:] * w[2] + bias


def _encoder_layer(x, lambda_init, rel_bias, g_mix, w_in, q_norm_g, k_norm_g, lambda_q1, lambda_k1,
                   lambda_q2, lambda_k2, da_subln_g, w_gate_fwd, b_gate_fwd, w_gate_bwd, b_gate_bwd,
                   gla_norm_g, w_branch_a, w_branch_b, w_out, g_ffn, w_up, conv_w, conv_b, w_down):
    B, T, _ = x.shape
    f32 = jnp.float32
    h = _rmsnorm(x, g_mix)
    z = h @ w_in
    widths = [DA_QK, DA_QK, DA_V, GLA_K, GLA_K, GLA_V, GLA_V, GLA_GATE_RANK, GLA_GATE_RANK, D_MODEL, D_MODEL]
    points = [int(c) for c in np.cumsum(widths)[:-1]]
    (da_q, da_k, da_v, gl_q, gl_k, gl_v, gl_r, gl_lf, gl_lb, gate_a, gate_b) = jnp.split(z, points, axis=-1)

    q = _rmsnorm(da_q.reshape(B, T, DA_HEADS, 2, DA_HEAD_DIM), q_norm_g) * (DA_HEAD_DIM ** -0.5)
    k = _rmsnorm(da_k.reshape(B, T, DA_HEADS, 2, DA_HEAD_DIM), k_norm_g)
    q = q.transpose(0, 2, 3, 1, 4)
    k = k.transpose(0, 2, 3, 1, 4)
    v = da_v.reshape(B, T, DA_HEADS, 2 * DA_HEAD_DIM).transpose(0, 2, 1, 3)
    lam = (jnp.exp(jnp.sum(lambda_q1.astype(f32) * lambda_k1.astype(f32)))
           - jnp.exp(jnp.sum(lambda_q2.astype(f32) * lambda_k2.astype(f32))) + lambda_init)
    o_a = _diff_attention(q, k, v, rel_bias, lam)
    o_a = (_rmsnorm(o_a, da_subln_g) * (1.0 - lambda_init)).reshape(B, T, DA_V)

    def heads(t, dh):
        return t.reshape(B, T, GLA_HEADS, dh).transpose(0, 2, 1, 3).astype(f32)

    gq = heads(gl_q, GLA_DK) * (GLA_DK ** -0.5)
    gk = heads(gl_k, GLA_DK)
    gv = heads(gl_v, GLA_DV)
    la_f = heads(jax.nn.log_sigmoid((gl_lf @ w_gate_fwd + b_gate_fwd).astype(f32)) / GLA_GATE_TAU, GLA_DK)
    la_b = heads(jax.nn.log_sigmoid((gl_lb @ w_gate_bwd + b_gate_bwd).astype(f32)) / GLA_GATE_TAU, GLA_DK)
    flip = lambda t: jnp.flip(t, axis=2)
    o_b = _gla_chunked(gq, gk, gv, la_f) + flip(_gla_chunked(flip(gq), flip(gk), flip(gv), flip(la_b)))
    o_b = _rmsnorm(o_b.transpose(0, 2, 1, 3), gla_norm_g).astype(x.dtype)
    o_b = (o_b * jax.nn.silu(gl_r.reshape(B, T, GLA_HEADS, GLA_DV))).reshape(B, T, GLA_V)

    merged = jax.nn.sigmoid(gate_a) * (o_a @ w_branch_a) + jax.nn.sigmoid(gate_b) * (o_b @ w_branch_b)
    x = x + merged @ w_out

    h2 = _rmsnorm(x, g_ffn)
    a, g = jnp.split(h2 @ w_up, 2, axis=-1)
    a = _depthwise_conv3(a, conv_w, conv_b)
    return x + (jax.nn.gelu(a) * g) @ w_down


def setup_inputs(seed: int = 0) -> dict:
    key = jax.random.key(seed)
    ks = jax.random.split(key, 25)
    f32 = jnp.float32
    L = DEPTH

    def nrm(k, shape, scale):
        return jax.random.normal(k, shape, f32) * scale

    def gain(k, shape):
        return 1.0 + 0.02 * jax.random.normal(k, shape, f32)

    return {
        'x_prompt': nrm(ks[0], (BATCH, SEQ, D_MODEL), 1.0),
        'x_sample': nrm(ks[1], (DEC_BATCH, DEC_SEQ, D_MODEL), 1.0),
        'rel_bias': nrm(ks[2], (REL_BUCKETS, DA_HEADS), 0.5),
        'g_mix': gain(ks[3], (L, D_MODEL)),
        'w_in': nrm(ks[4], (L, D_MODEL, D_IN), D_MODEL ** -0.5),
        'q_norm_g': gain(ks[5], (L, DA_HEAD_DIM)),
        'k_norm_g': gain(ks[6], (L, DA_HEAD_DIM)),
        'lambda_q1': nrm(ks[7], (L, DA_HEAD_DIM), 0.1),
        'lambda_k1': nrm(ks[8], (L, DA_HEAD_DIM), 0.1),
        'lambda_q2': nrm(ks[9], (L, DA_HEAD_DIM), 0.1),
        'lambda_k2': nrm(ks[10], (L, DA_HEAD_DIM), 0.1),
        'da_subln_g': gain(ks[11], (L, 2 * DA_HEAD_DIM)),
        'w_gate_fwd': nrm(ks[12], (L, GLA_GATE_RANK, GLA_K), GLA_GATE_RANK ** -0.5),
        'b_gate_fwd': nrm(ks[13], (L, GLA_K), 0.1),
        'w_gate_bwd': nrm(ks[14], (L, GLA_GATE_RANK, GLA_K), GLA_GATE_RANK ** -0.5),
        'b_gate_bwd': nrm(ks[15], (L, GLA_K), 0.1),
        'gla_norm_g': gain(ks[16], (L, GLA_DV)),
        'w_branch_a': nrm(ks[17], (L, DA_V, D_MODEL), DA_V ** -0.5),
        'w_branch_b': nrm(ks[18], (L, GLA_V, D_MODEL), GLA_V ** -0.5),
        'w_out': nrm(ks[19], (L, D_MODEL, D_MODEL), D_MODEL ** -0.5),
        'g_ffn': gain(ks[20], (L, D_MODEL)),
        'w_up': nrm(ks[21], (L, D_MODEL, 2 * D_FF), D_MODEL ** -0.5),
        'conv_w': nrm(ks[22], (L, CONV_WIDTH, D_FF), CONV_WIDTH ** -0.5),
        'conv_b': nrm(ks[23], (L, D_FF), 0.02),
        'w_down': nrm(ks[24], (L, D_FF, D_MODEL), D_FF ** -0.5),
    }


def reference(x_prompt, x_sample, rel_bias, g_mix, w_in, q_norm_g, k_norm_g, lambda_q1, lambda_k1,
              lambda_q2, lambda_k2, da_subln_g, w_gate_fwd, b_gate_fwd, w_gate_bwd, b_gate_bwd,
              gla_norm_g, w_branch_a, w_branch_b, w_out, g_ffn, w_up, conv_w, conv_b, w_down):
    y_prompt = x_prompt
    y_sample = x_sample
    for l in range(DEPTH):
        lambda_init = 0.8 - 0.6 * math.exp(-0.3 * l)
        lp = (g_mix[l], w_in[l], q_norm_g[l], k_norm_g[l], lambda_q1[l], lambda_k1[l], lambda_q2[l],
              lambda_k2[l], da_subln_g[l], w_gate_fwd[l], b_gate_fwd[l], w_gate_bwd[l], b_gate_bwd[l],
              gla_norm_g[l], w_branch_a[l], w_branch_b[l], w_out[l], g_ffn[l], w_up[l], conv_w[l],
              conv_b[l], w_down[l])
        y_prompt = _encoder_layer(y_prompt, lambda_init, rel_bias, *lp)
        y_sample = _encoder_layer(y_sample, lambda_init, rel_bias, *lp)
    return (y_prompt, y_sample)
```

```cpp
#include <hip/hip_runtime.h>
#include <cstdio>
#include <cstdint>

#ifndef MK_ONE_LAUNCH
#define MK_ONE_LAUNCH 1
#endif
#ifndef MK_DIAG
#define MK_DIAG 0
#endif
#define DG_WORD(ws) ((unsigned*)((ws) + WS_CTL) + 32768 + 50)

#define LAS __attribute__((address_space(3)))
#define GAS __attribute__((address_space(1)))
typedef unsigned short bf16_t;
typedef short bf16x8 __attribute__((ext_vector_type(8)));
typedef short s16x4 __attribute__((ext_vector_type(4)));
typedef float f32x4 __attribute__((ext_vector_type(4)));
typedef float f32x2 __attribute__((ext_vector_type(2)));
typedef float f32x16 __attribute__((ext_vector_type(16)));
typedef unsigned u32x4 __attribute__((ext_vector_type(4)));
typedef unsigned u32x2 __attribute__((ext_vector_type(2)));

constexpr int DM = 4096, GT = 16384  , DIN = 20512, DINP = 20736, DFF = 11008;
constexpr float EPS = 1e-6f;
constexpr float LOG2E = 1.4426950408889634f;
constexpr int NWAVES = 8, NTHR = 512;

constexpr size_t MiB = 1u << 20;
constexpr size_t WS_CTL = 0, CTL_ZERO_BYTES = 1 * MiB;
constexpr size_t WS_PRM = 1 * MiB;
constexpr int P_LAM = 0, P_GMIX = 64, P_QG = 4160, P_KG = 4288, P_SUBLN = 4416, P_WGF = 4672, P_BGF = 21056, P_WGB = 22080, P_BGB = 38464, P_GLAG = 39488, P_CW = 40000, P_CB = 73024, P_RB = 84032, P_END = 84288;
constexpr size_t WS_ST = 2 * MiB;
constexpr size_t WS_DEC = 4 * MiB;
constexpr size_t WS_WIN = 8 * MiB;
constexpr size_t WS_WUP = 170 * MiB;
constexpr size_t WS_WDN = 342 * MiB;
constexpr size_t WS_WOUT = 428 * MiB;
constexpr size_t WS_WPAB = 460 * MiB;
constexpr size_t WS_ACT = 492 * MiB;
constexpr size_t A_H = WS_ACT + 0 * MiB;
constexpr size_t A_Q = WS_ACT + 128 * MiB, A_K = WS_ACT + 192 * MiB, A_V = WS_ACT + 256 * MiB;
constexpr size_t A_GQ = WS_ACT + 320 * MiB, A_GK = WS_ACT + 352 * MiB;
constexpr size_t A_GV = WS_ACT + 384 * MiB, A_GR = WS_ACT + 448 * MiB;
constexpr size_t A_SA = WS_ACT + 512 * MiB, A_SB = WS_ACT + 640 * MiB;
constexpr size_t A_QD = A_H, A_KDT = A_H + 64 * MiB;
constexpr size_t A_OAB = A_Q;
constexpr size_t A_MRG = A_V;
constexpr size_t A_X1B = A_H;
constexpr size_t A_FA = WS_ACT + 128 * MiB;
constexpr size_t A_FG = WS_ACT + 472 * MiB;
constexpr size_t WS_END = WS_ACT + 816 * MiB;
constexpr int CW_BAR = 1024;
constexpr int CW_RSS = 65536;

constexpr int LDS_BYTES = 155648;
constexpr int LDS_MISC = 153600;

typedef __bf16 nbf16x2 __attribute__((ext_vector_type(2)));
__device__ __forceinline__ unsigned cvt_pk_bf16(float lo, float hi) { const f32x2 v = {lo, hi}; return __builtin_bit_cast(unsigned, __builtin_convertvector(v, nbf16x2)); }
__device__ __forceinline__ float bflo(unsigned w) { return __uint_as_float(w << 16); }
__device__ __forceinline__ float bfhi(unsigned w) { return __uint_as_float(w & 0xffff0000u); }
__device__ __forceinline__ float bf2f(bf16_t v) { return __uint_as_float(((unsigned)v) << 16); }
__device__ __forceinline__ bf16_t f2bf(float f) { return (bf16_t)(cvt_pk_bf16(f, 0.f) & 0xffffu); }
__device__ __forceinline__ float wave_sum(float v) {
#pragma unroll
    for (int o = 1; o < 64; o <<= 1) v += __shfl_xor(v, o);
    return v;
}
__device__ __forceinline__ float fast_exp(float x) { return __builtin_amdgcn_exp2f(x * LOG2E); }
__device__ __forceinline__ float sigmoidf_(float x) { return __builtin_amdgcn_rcpf(1.f + fast_exp(-x)); }

__device__ __forceinline__ int fresh_tid(int wave_s) { int l; asm volatile("v_mbcnt_lo_u32_b32 %0, -1, 0\n\tv_mbcnt_hi_u32_b32 %0, -1, %0" : "=v"(l)); return (wave_s << 6) | l; }
__device__ __forceinline__ int fresh_bid() { int b = blockIdx.x; asm volatile("" : "+s"(b)); return b; }
__device__ __forceinline__ int fresh_grid() { int g = gridDim.x; asm volatile("" : "+s"(g)); return g; }
#define XB_TMO      128
#define XB_XCNT(j)  (256  + 64 * (j))
#define XB_XSUB(j)  (1280 + 64 * (j))
#define XB_XGEN(j)  (2304 + 64 * (j))
#define XB_TOP      3328
#define XB_TOPGEN   3392
#define XCD_BAR_WORDS 3456
#define XB_SPIN_CAP (1u << 18)
__device__ __forceinline__ unsigned xb_ld(unsigned* p)              { return __hip_atomic_load(p, __ATOMIC_RELAXED, __HIP_MEMORY_SCOPE_AGENT); }
__device__ __forceinline__ unsigned xb_add(unsigned* p, unsigned v) { return __hip_atomic_fetch_add(p, v, __ATOMIC_RELAXED, __HIP_MEMORY_SCOPE_AGENT); }
__device__ __forceinline__ unsigned xb_xcc_id() { return (unsigned)__builtin_amdgcn_s_getreg((3 << 11) | 20) & 0xFu; }
#define XB_SPIN(cond, bar) do { unsigned _sp = 0; while (cond) { __builtin_amdgcn_s_sleep(1); \
    if ((++_sp & 255u) == 0u) { if (xb_ld(&(bar)[XB_TMO])) break; if (_sp > XB_SPIN_CAP) { atomicAdd(&(bar)[XB_TMO], 1u); break; } } } } while (0)
struct XcdBarrier { unsigned* bar; unsigned x; volatile LAS unsigned* st; };
__device__ __forceinline__ XcdBarrier xcd_barrier_post(unsigned* bar, volatile LAS unsigned* st) {
    XcdBarrier b; b.bar = bar; b.x = xb_xcc_id(); b.st = st;
    if (threadIdx.x == 0) (void)xb_add(&bar[XB_XCNT(b.x)], 1u);
    return b;
}
__device__ __forceinline__ void xcd_barrier_complete(unsigned* bar, unsigned x, unsigned& nloc, unsigned& nx) {
    const unsigned G = gridDim.x * gridDim.y * gridDim.z;
    unsigned sum, cnt, mine, sp = 0u;
    for (;;) {
        sum = 0u; cnt = 0u; mine = 0u;
#pragma unroll
        for (unsigned j = 0; j < 16; ++j) { const unsigned c = xb_ld(&bar[XB_XCNT(j)]); sum += c; cnt += (c > 0u) ? 1u : 0u; mine = (j == x) ? c : mine; }
        if (sum == G) break;
        __builtin_amdgcn_s_sleep(1);
        if ((++sp & 255u) == 0u) { if (xb_ld(&bar[XB_TMO])) break; if (sp > XB_SPIN_CAP) { atomicAdd(&bar[XB_TMO], 1u); break; } }
    }
    nloc = mine > 0u ? mine : 1u; nx = cnt > 0u ? cnt : 1u;
}
__device__ __forceinline__ void xcd_barrier(const XcdBarrier& b) {
    asm volatile("s_waitcnt vmcnt(0)" ::: "memory");
    __syncthreads();
    if (threadIdx.x == 0) {
        unsigned* bar = b.bar;
        __builtin_amdgcn_s_waitcnt(0);
        unsigned nloc = b.st[0], nx = b.st[1];
        if (nloc == 0u) { xcd_barrier_complete(bar, b.x, nloc, nx); b.st[0] = nloc; b.st[1] = nx; }
        const unsigned old = xb_add(&bar[XB_XSUB(b.x)], 1u);
        const unsigned gen = old / nloc;
        if (old + 1u == (gen + 1u) * nloc) {
            __builtin_amdgcn_fence(__ATOMIC_RELEASE, "agent");
            asm volatile("s_waitcnt vmcnt(0)" ::: "memory");
            const unsigned og = xb_add(&bar[XB_TOP], 1u);
            const unsigned tg = og / nx;
            if (og + 1u == (tg + 1u) * nx) xb_add(&bar[XB_TOPGEN], 1u);
            else XB_SPIN(xb_ld(&bar[XB_TOPGEN]) == tg, bar);
            __builtin_amdgcn_fence(__ATOMIC_ACQUIRE, "agent");
            xb_add(&bar[XB_XGEN(b.x)], 1u);
            asm volatile("s_waitcnt vmcnt(0)" ::: "memory");
        } else {
            XB_SPIN(xb_ld(&bar[XB_XGEN(b.x)]) == gen, bar);
            __builtin_amdgcn_fence(__ATOMIC_ACQUIRE, "agent");
            asm volatile("s_waitcnt vmcnt(0)" ::: "memory");
        }
    }
    __syncthreads();
}

namespace pg8 {
constexpr int BM = 256, BK = 64, HALF = 128, HTB = HALF * BK * 2, STAGE_BYTES = 8 * HTB, NXCD = 8, WGM = 8;
__host__ __device__ __forceinline__ int lds_byte(int r, int c) { const int st = (r >> 4) * 2 + (c >> 5), rr = r & 15, cc = c & 31, ob = rr * 64 + cc * 2; return st * 1024 + (ob ^ (((ob >> 9) & 1) << 5)); }
__host__ __device__ __forceinline__ void stage_rc(int b, int& R, int& C) { const int st = b / 1024, sb = b % 1024, swz = sb ^ (((sb >> 9) & 1) << 5); R = (st >> 1) * 16 + swz / 64; C = (st & 1) * 32 + (swz % 64) / 2; }
__host__ __device__ __forceinline__ int perm32(int rho) { const int n = rho >> 4, i = rho & 15; return 8 * (i >> 2) + 4 * n + (i & 3); }
struct Unit { int pm, pn, ps; };
struct Gemm { const bf16_t* A; const bf16_t* Bt; };
template <int NM, int NN, int PASSES> struct StaticOrder {
    int G, c;
    __device__ __forceinline__ bool next(int i, Unit& u) const {
        constexpr int nwg = NM * NN;
        const int ti = PASSES == 2 ? (i >> 1) : i;
        const long L = (long)ti * G + c; if (L >= nwg) return false;
        int wgid = (int)L; { constexpr int q = nwg / NXCD, r = nwg % NXCD; const int xcd = wgid % NXCD, off = wgid / NXCD; wgid = (xcd < r ? xcd * (q + 1) : r * (q + 1) + (xcd - r) * q) + off; }
        constexpr int nig = WGM * NN; const int gid = wgid / nig, fm = gid * WGM, gsz = (NM - fm) < WGM ? (NM - fm) : WGM;
        u.pm = fm + ((wgid % nig) % gsz); u.pn = (wgid % nig) / gsz; u.ps = PASSES == 2 ? (i & 1) : 0; return true;
    }
};
template <int M, int N, int K, int LDA, int LDB, int PASSES, int PASS_OFF  , class Epi>
__device__ __forceinline__ void gemm_phase(LAS unsigned char* lds, const Gemm g, int G, int c, int tid_, const Epi& E) {
    StaticOrder<M / BM, N / BM, PASSES> S; S.G = G; S.c = c;
    const int tid = tid_, wid = __builtin_amdgcn_readfirstlane(tid >> 6), lane = tid & 63, wr = wid >> 2, wc = wid & 3, fr = lane & 15, fq = lane >> 4;
    constexpr int nt = K / BK;
    unsigned voffA[2], voffB[2];
#pragma unroll
    for (int i = 0; i < 2; ++i) { int R, C; stage_rc(tid * 16 + i * 8192, R, C); const int Rb = Epi::PERM ? ((R & ~31) + perm32(R & 31)) : R;
        voffA[i] = (unsigned)(R * LDA + C) * 2u; voffB[i] = (unsigned)(Rb * LDB + C) * 2u; }
    constexpr size_t kstep = (size_t)(BK * 2);
    constexpr size_t hstepA = (size_t)HALF * LDA * 2, hstepB = (size_t)HALF * LDB * 2;
    constexpr size_t tstepA = 2 * hstepA, tstepB = 2 * hstepB, pstep = (size_t)PASS_OFF * 2;
    const unsigned ldsw = (unsigned)wid * 1024u;
    const int aoff = lds_byte(wr * 64 + fr, fq * 8), boff = lds_byte(wc * 32 + fr, fq * 8);
#define PG8_SA(b, h) (((b) * 2 + (h)) * HTB)
#define PG8_SB(b, h) ((4 + (b) * 2 + (h)) * HTB)
#define PG8_STAGE(bufoff, gbase, voff) do { _Pragma("unroll") for (int _i = 0; _i < 2; ++_i) \
        __builtin_amdgcn_global_load_lds((const unsigned*)((const char*)(gbase) + (voff)[_i]), (LAS unsigned*)(lds + (bufoff) + ldsw + _i * 8192), 16, 0, 0); } while (0)
#define PG8_LDA(dst, b, h) do { _Pragma("unroll") for (int m = 0; m < 4; ++m) _Pragma("unroll") for (int k = 0; k < 2; ++k) dst[m][k] = *(const LAS bf16x8*)(lds + PG8_SA(b, h) + aoff + m * 2048 + k * 1024); } while (0)
#define PG8_LDB(dst, b, h) do { _Pragma("unroll") for (int n = 0; n < 2; ++n) _Pragma("unroll") for (int k = 0; k < 2; ++k) dst[n][k] = *(const LAS bf16x8*)(lds + PG8_SB(b, h) + boff + n * 2048 + k * 1024); } while (0)
#define PG8_MMA(ai, bj, At, Bt) do { __builtin_amdgcn_s_setprio(1); _Pragma("unroll") for (int m = 0; m < 4; ++m) _Pragma("unroll") for (int n = 0; n < 2; ++n) _Pragma("unroll") for (int k = 0; k < 2; ++k) \
        acc[ai][bj][m][n] = __builtin_amdgcn_mfma_f32_16x16x32_bf16(Bt[n][k], At[m][k], acc[ai][bj][m][n], 0, 0, 0); __builtin_amdgcn_s_setprio(0); } while (0)
#define PG8_WAIT_V(n) asm volatile("s_waitcnt vmcnt(" #n ")" ::: "memory")
#define PG8_WAIT_L(n) asm volatile("s_waitcnt lgkmcnt(" #n ")" ::: "memory")
#define PG8_BAR __builtin_amdgcn_s_barrier()
#define PG8_SCHED __builtin_amdgcn_sched_barrier(0)
    Unit cur, nxt; int ui = 0;
    if (!S.next(0, cur)) return;
    f32x4 acc[2][2][4][2];
#pragma unroll
    for (int a = 0; a < 2; ++a)
#pragma unroll
        for (int b = 0; b < 2; ++b)
#pragma unroll
            for (int m = 0; m < 4; ++m)
#pragma unroll
                for (int n = 0; n < 2; ++n) acc[a][b][m][n] = (f32x4){0.f, 0.f, 0.f, 0.f};
    bf16x8 At[4][2], B0[2][2], B1[2][2];
    const char* cA = (const char*)g.A + (size_t)cur.pm * tstepA + (size_t)cur.ps * pstep; const char* cB = (const char*)g.Bt + (size_t)cur.pn * tstepB + (size_t)cur.ps * pstep;
    PG8_STAGE(PG8_SB(0, 0), cB, voffB); PG8_STAGE(PG8_SB(0, 1), cB + hstepB, voffB); PG8_STAGE(PG8_SA(0, 0), cA, voffA); PG8_STAGE(PG8_SA(0, 1), cA + hstepA, voffA);
    if (wr == 1) PG8_BAR;
    PG8_WAIT_V(2); PG8_BAR;
    PG8_STAGE(PG8_SB(1, 0), cB + kstep, voffB); PG8_STAGE(PG8_SA(1, 0), cA + kstep, voffA); PG8_STAGE(PG8_SB(1, 1), cB + hstepB + kstep, voffB);
    PG8_WAIT_V(6); PG8_BAR;
    for (;;) {
        const bool has_next = S.next(ui + 1, nxt);
        const char* nA = has_next ? (const char*)g.A + (size_t)nxt.pm * tstepA + (size_t)nxt.ps * pstep : cA; const char* nB = has_next ? (const char*)g.Bt + (size_t)nxt.pn * tstepB + (size_t)nxt.ps * pstep : cB;
        for (int t = 0; t < nt; t += 2) {
            const bool last = (t == nt - 2);
            const char* a1 = cA + (size_t)(t + 1) * kstep;
            const char* a2 = last ? nA : cA + (size_t)(t + 2) * kstep; const char* b2 = last ? nB : cB + (size_t)(t + 2) * kstep;
            const char* a3 = a2 + kstep; const char* b3 = b2 + kstep;
            PG8_LDB(B0, 0, 0); PG8_LDB(B1, 0, 1); PG8_SCHED; PG8_LDA(At, 0, 0); PG8_STAGE(PG8_SA(1, 1), a1 + hstepA, voffA);
            PG8_WAIT_V(8); PG8_WAIT_L(0); PG8_BAR; PG8_MMA(0, 0, At, B0); PG8_MMA(0, 1, At, B1); PG8_BAR; PG8_SCHED;
            PG8_LDA(At, 0, 1); PG8_STAGE(PG8_SB(0, 0), b2, voffB); PG8_STAGE(PG8_SB(0, 1), b2 + hstepB, voffB); PG8_STAGE(PG8_SA(0, 0), a2, voffA);
            PG8_WAIT_V(8); PG8_WAIT_L(0); PG8_BAR; PG8_MMA(1, 0, At, B0); PG8_MMA(1, 1, At, B1); PG8_BAR; PG8_SCHED;
            PG8_LDB(B0, 1, 0); PG8_LDB(B1, 1, 1); PG8_SCHED; PG8_LDA(At, 1, 0); PG8_STAGE(PG8_SA(0, 1), a2 + hstepA, voffA);
            PG8_WAIT_V(8); PG8_WAIT_L(0); PG8_BAR; PG8_MMA(0, 0, At, B0); PG8_MMA(0, 1, At, B1); PG8_BAR; PG8_SCHED;
            PG8_LDA(At, 1, 1); PG8_STAGE(PG8_SB(1, 0), b3, voffB); PG8_STAGE(PG8_SB(1, 1), b3 + hstepB, voffB); PG8_STAGE(PG8_SA(1, 0), a3, voffA);
            PG8_WAIT_V(8); PG8_WAIT_L(0); PG8_BAR; PG8_MMA(1, 0, At, B0); PG8_MMA(1, 1, At, B1); PG8_BAR; PG8_SCHED;
        }
        if (wr == 0) PG8_BAR;
        E(acc, cur, wr, wc, fr, fq);
        if (!has_next) break;
#pragma unroll
        for (int a = 0; a < 2; ++a)
#pragma unroll
            for (int b = 0; b < 2; ++b)
#pragma unroll
                for (int m = 0; m < 4; ++m)
#pragma unroll
                    for (int n = 0; n < 2; ++n) acc[a][b][m][n] = (f32x4){0.f, 0.f, 0.f, 0.f};
        cur = nxt; cA = nA; cB = nB; ++ui;
        if (wr == 1) PG8_BAR;
    }
    PG8_WAIT_V(0);
    PG8_BAR;
#undef PG8_SA
#undef PG8_SB
#undef PG8_STAGE
#undef PG8_LDA
#undef PG8_LDB
#undef PG8_MMA
#undef PG8_WAIT_V
#undef PG8_WAIT_L
#undef PG8_BAR
#undef PG8_SCHED
}
}
using pg8::Unit;
constexpr int HALF = 128, BM = 256;

struct EpiInProj {
    static constexpr bool PERM = true;
    unsigned char* ws;
    __device__ __forceinline__ void operator()(const f32x4 (&acc)[2][2][4][2], const Unit& u, int wr, int wc, int fr, int fq) const {
        const int pn = u.pn; const int row0 = u.pm * BM + wr * 64 + fr;
        if (pn == 80) {
            if (wc == 0) { float* ST = (float*)(ws + WS_ST);
#pragma unroll
                for (int ai = 0; ai < 2; ++ai)
#pragma unroll
                    for (int m = 0; m < 4; ++m) { float* rp = ST + (size_t)(row0 + ai * HALF + m * 16) * 32 + 8 * fq;
                        *(f32x4*)(rp) = acc[ai][0][m][0]; *(f32x4*)(rp + 4) = acc[ai][0][m][1]; }
            }
            return;
        }
        unsigned boff; int ld, cb, mode = 0;
        if (pn < 8) { boff = 0u; ld = 2048; cb = pn * 256; }
        else if (pn < 16) { boff = (unsigned)(A_K - A_Q); ld = 2048; cb = (pn - 8) * 256; }
        else if (pn < 24) { boff = (unsigned)(A_V - A_Q); ld = 2048; cb = (pn - 16) * 256; }
        else if (pn < 28) { boff = (unsigned)(A_GQ - A_Q); ld = 1024; cb = (pn - 24) * 256; mode = 1; }
        else if (pn < 32) { boff = (unsigned)(A_GK - A_Q); ld = 1024; cb = (pn - 28) * 256; }
        else if (pn < 40) { boff = (unsigned)(A_GV - A_Q); ld = 2048; cb = (pn - 32) * 256; }
        else if (pn < 48) { boff = (unsigned)(A_GR - A_Q); ld = 2048; cb = (pn - 40) * 256; mode = 2; }
        else if (pn < 64) { boff = (unsigned)(A_SA - A_Q); ld = 4096; cb = (pn - 48) * 256; mode = 3; }
        else { boff = (unsigned)(A_SB - A_Q); ld = 4096; cb = (pn - 64) * 256; mode = 3; }
        bf16_t* base = (bf16_t*)(ws + A_Q + boff);
        const int col0 = cb + wc * 32 + 8 * fq;
#pragma unroll
        for (int ai = 0; ai < 2; ++ai)
#pragma unroll
            for (int m = 0; m < 4; ++m) { bf16_t* rowp = base + (size_t)(row0 + ai * HALF + m * 16) * ld + col0;
#pragma unroll
                for (int bj = 0; bj < 2; ++bj) { f32x4 v0 = acc[ai][bj][m][0], v1 = acc[ai][bj][m][1];
                    if (mode == 1) { v0 = v0 * 0.0625f; v1 = v1 * 0.0625f; }
                    else if (mode >= 2) {
#pragma unroll
                        for (int j = 0; j < 4; ++j) { const float s0 = sigmoidf_(v0[j]), s1 = sigmoidf_(v1[j]); v0[j] = mode == 2 ? v0[j] * s0 : s0; v1[j] = mode == 2 ? v1[j] * s1 : s1; } }
                    u32x4 w; w.x = cvt_pk_bf16(v0[0], v0[1]); w.y = cvt_pk_bf16(v0[2], v0[3]); w.z = cvt_pk_bf16(v1[0], v1[1]); w.w = cvt_pk_bf16(v1[2], v1[3]);
                    *(u32x4*)(rowp + bj * HALF) = w; }
                asm volatile("" ::: "memory"); }
    }
};
struct EpiBranch {
    static constexpr bool PERM = true;
    unsigned char* ws;
    __device__ __forceinline__ void operator()(const f32x4 (&acc)[2][2][4][2], const Unit& u, int wr, int wc, int fr, int fq) const {
        const int row0 = u.pm * BM + wr * 64 + fr, col0 = u.pn * BM + wc * 32 + 8 * fq;
        const bf16_t* G = (const bf16_t*)(ws + (u.ps ? A_SB : A_SA)); bf16_t* O = (bf16_t*)(ws + A_MRG);
#pragma unroll
        for (int ai = 0; ai < 2; ++ai)
#pragma unroll
            for (int m = 0; m < 4; ++m) { const size_t off = (size_t)(row0 + ai * HALF + m * 16) * DM + col0;
#pragma unroll
                for (int bj = 0; bj < 2; ++bj) { const u32x4 gw = *(const u32x4*)(G + off + bj * HALF);
                    f32x4 v0 = acc[ai][bj][m][0], v1 = acc[ai][bj][m][1];
                    v0[0] *= bflo(gw.x); v0[1] *= bfhi(gw.x); v0[2] *= bflo(gw.y); v0[3] *= bfhi(gw.y);
                    v1[0] *= bflo(gw.z); v1[1] *= bfhi(gw.z); v1[2] *= bflo(gw.w); v1[3] *= bfhi(gw.w);
                    if (u.ps) { const u32x4 ow = *(const u32x4*)(O + off + bj * HALF);
                        v0[0] += bflo(ow.x); v0[1] += bfhi(ow.x); v0[2] += bflo(ow.y); v0[3] += bfhi(ow.y);
                        v1[0] += bflo(ow.z); v1[1] += bfhi(ow.z); v1[2] += bflo(ow.w); v1[3] += bfhi(ow.w); }
                    u32x4 w; w.x = cvt_pk_bf16(v0[0], v0[1]); w.y = cvt_pk_bf16(v0[2], v0[3]); w.z = cvt_pk_bf16(v1[0], v1[1]); w.w = cvt_pk_bf16(v1[2], v1[3]);
                    *(u32x4*)(O + off + bj * HALF) = w; }
                asm volatile("" ::: "memory"); }
    }
};
struct EpiWout {
    static constexpr bool PERM = false;
    const float* X; float* OUT; bf16_t* X1B; float* RSS;
    __device__ __forceinline__ void operator()(const f32x4 (&acc)[2][2][4][2], const Unit& u, int wr, int wc, int fr, int fq) const {
        const int row0 = u.pm * BM + wr * 64 + fr, col0 = u.pn * BM + wc * 32 + 4 * fq;
#pragma unroll
        for (int ai = 0; ai < 2; ++ai)
#pragma unroll
            for (int m = 0; m < 4; ++m) { const int row = row0 + ai * HALF + m * 16; const size_t off = (size_t)row * DM + col0; float ss = 0.f;
#pragma unroll
                for (int bj = 0; bj < 2; ++bj)
#pragma unroll
                    for (int n = 0; n < 2; ++n) { const f32x4 xv = *(const f32x4*)(X + off + bj * HALF + n * 16); const f32x4 o = xv + acc[ai][bj][m][n];
                        *(f32x4*)(OUT + off + bj * HALF + n * 16) = o; ss += (o[0] * o[0] + o[1] * o[1]) + (o[2] * o[2] + o[3] * o[3]);
                        u32x2 w; w.x = cvt_pk_bf16(o[0], o[1]); w.y = cvt_pk_bf16(o[2], o[3]); *(u32x2*)(X1B + off + bj * HALF + n * 16) = w; }
                ss += __shfl_xor(ss, 16); ss += __shfl_xor(ss, 32);
                if (fq == 0) atomicAdd(RSS + row, ss); }
    }
};
struct EpiUp {
    static constexpr bool PERM = true;
    const float* RSS; bf16_t* FA; bf16_t* FG;
    __device__ __forceinline__ void operator()(const f32x4 (&acc)[2][2][4][2], const Unit& u, int wr, int wc, int fr, int fq) const {
        const int row0 = u.pm * BM + wr * 64 + fr, col0 = u.pn * HALF + wc * 32 + 8 * fq;
#pragma unroll
        for (int ai = 0; ai < 2; ++ai)
#pragma unroll
            for (int m = 0; m < 4; ++m) { const int row = row0 + ai * HALF + m * 16; const float rstd = __builtin_amdgcn_rsqf(RSS[row] * (1.f / DM) + EPS);
                const size_t off = (size_t)row * DFF + col0;
#pragma unroll
                for (int bj = 0; bj < 2; ++bj) { const f32x4 v0 = acc[ai][bj][m][0] * rstd, v1 = acc[ai][bj][m][1] * rstd;
                    u32x4 w; w.x = cvt_pk_bf16(v0[0], v0[1]); w.y = cvt_pk_bf16(v0[2], v0[3]); w.z = cvt_pk_bf16(v1[0], v1[1]); w.w = cvt_pk_bf16(v1[2], v1[3]);
                    *(u32x4*)((bj ? FG : FA) + off) = w; } }
    }
};
struct EpiDown {
    static constexpr bool PERM = false;
    float* OUT;
    __device__ __forceinline__ void operator()(const f32x4 (&acc)[2][2][4][2], const Unit& u, int wr, int wc, int fr, int fq) const {
        const int row0 = u.pm * BM + wr * 64 + fr, col0 = u.pn * BM + wc * 32 + 4 * fq;
#pragma unroll
        for (int ai = 0; ai < 2; ++ai)
#pragma unroll
            for (int m = 0; m < 4; ++m) { float* rowp = OUT + (size_t)(row0 + ai * HALF + m * 16) * DM + col0;
#pragma unroll
                for (int bj = 0; bj < 2; ++bj)
#pragma unroll
                    for (int n = 0; n < 2; ++n) { f32x4* p = (f32x4*)(rowp + bj * HALF + n * 16); *p = *p + acc[ai][bj][m][n]; } }
    }
};

struct Args { const float* in[25]; float* out; unsigned char* ws; int ph_lo, ph_hi, g_lo, g_hi; };
struct Frame {
    LAS unsigned char* lds; int tid, lane, wave, vcu, G;
};
__device__ __forceinline__ Frame make_frame(LAS unsigned char* lds, int wave_s) {
    Frame F; F.lds = lds; F.tid = fresh_tid(wave_s); F.lane = F.tid & 63; F.wave = __builtin_amdgcn_readfirstlane(F.tid >> 6);
    F.G = fresh_grid(); { const int bx = fresh_bid(); F.vcu = (F.G % 8 == 0) ? (bx % 8) * (F.G / 8) + bx / 8 : bx; }
    return F;
}

template <int NMAP> __device__ __forceinline__ int nmap(int n) {
    if (NMAP == 1) { return n < 12288 ? n : (n < 12320 ? 20480 + (n - 12288) : n - 32); }
    if (NMAP == 2) { const int bj = n >= DFF ? 1 : 0, f = n - bj * DFF; return (f >> 7) * 256 + bj * 128 + (f & 127); }
    return n;
}
template <int NMAP> __device__ __forceinline__ void p0_transpose_item(const float* W, int N, const float* kscale, bf16_t* WT, int ldd, int koff, LAS float* scr, int kb, int nb, int lane) {
    const int k0 = 64 * kb, n0 = 64 * nb; const bool inb = (n0 + lane) < N;
#pragma unroll 8
    for (int i = 0; i < 64; ++i) { float v = inb ? W[(size_t)(k0 + i) * N + n0 + lane] : 0.f; if (kscale) v *= kscale[k0 + i]; scr[i * 65 + lane] = v; }
    asm volatile("s_waitcnt lgkmcnt(0)" ::: "memory");
    const int c = lane & 7;
#pragma unroll
    for (int j = 0; j < 8; ++j) { const int nl = (lane >> 3) + 8 * j; const int n = n0 + nl; const LAS float* s = scr + (8 * c) * 65 + nl;
        u32x4 o; o.x = cvt_pk_bf16(s[0 * 65], s[1 * 65]); o.y = cvt_pk_bf16(s[2 * 65], s[3 * 65]); o.z = cvt_pk_bf16(s[4 * 65], s[5 * 65]); o.w = cvt_pk_bf16(s[6 * 65], s[7 * 65]);
        if (n < N) *(u32x4*)(WT + (size_t)nmap<NMAP>(n) * ldd + koff + k0 + 8 * c) = o; }
    asm volatile("s_waitcnt lgkmcnt(0)" ::: "memory");
}
__device__ __forceinline__ void p0_weights(const Frame& F, const Args& a) {
    unsigned char* ws = a.ws;
    LAS float* scr = (LAS float*)(F.lds + F.wave * 16640);
    const int gw = F.vcu * NWAVES + F.wave, NGW = F.G * NWAVES;
    constexpr int I_IN = 64 * 321, I_UP = 64 * 344, I_DN = 172 * 64, I_OUT = 64 * 64, I_PA = 32 * 64, I_PB = 32 * 64;
    constexpr int NITEMS = I_IN + I_UP + I_DN + I_OUT + I_PA + I_PB;
    for (int it = gw; it < NITEMS; it += NGW) {
        int r = it;
        if (r < I_IN) { p0_transpose_item<1>(a.in[4], DIN, nullptr, (bf16_t*)(ws + WS_WIN), DM, 0, scr, r / 321, r % 321, F.lane); continue; } r -= I_IN;
        if (r < I_UP) { p0_transpose_item<2>(a.in[21], 2 * DFF, a.in[20], (bf16_t*)(ws + WS_WUP), DM, 0, scr, r / 344, r % 344, F.lane); continue; } r -= I_UP;
        if (r < I_DN) { p0_transpose_item<0>(a.in[24], DM, nullptr, (bf16_t*)(ws + WS_WDN), DFF, 0, scr, r / 64, r % 64, F.lane); continue; } r -= I_DN;
        if (r < I_OUT) { p0_transpose_item<0>(a.in[19], DM, nullptr, (bf16_t*)(ws + WS_WOUT), DM, 0, scr, r / 64, r % 64, F.lane); continue; } r -= I_OUT;
        if (r < I_PA) { p0_transpose_item<0>(a.in[17], DM, nullptr, (bf16_t*)(ws + WS_WPAB), DM, 0, scr, r / 64, r % 64, F.lane); continue; } r -= I_PA;
        p0_transpose_item<0>(a.in[18], DM, nullptr, (bf16_t*)(ws + WS_WPAB), DM, 2048, scr, r / 64, r % 64, F.lane);
    }
    { u32x4* z = (u32x4*)((bf16_t*)(ws + WS_WIN) + (size_t)DIN * DM);
      for (int i = gw * 64 + F.lane; i < 224 * 512; i += NGW * 64) z[i] = (u32x4){0u, 0u, 0u, 0u}; }
    { float* prm = (float*)(ws + WS_PRM); const int gt = F.vcu * NTHR + F.tid, ngt = F.G * NTHR;
      for (int i = gt; i < 4096; i += ngt) prm[P_GMIX + i] = a.in[3][i];
      for (int i = gt; i < 128; i += ngt) { prm[P_QG + i] = a.in[5][i]; prm[P_KG + i] = a.in[6][i]; }
      for (int i = gt; i < 256; i += ngt) { prm[P_SUBLN + i] = a.in[11][i]; prm[P_RB + i] = a.in[2][i]; }
      for (int i = gt; i < 16384; i += ngt) { prm[P_WGF + i] = a.in[12][i]; prm[P_WGB + i] = a.in[14][i]; }
      for (int i = gt; i < 1024; i += ngt) { prm[P_BGF + i] = a.in[13][i]; prm[P_BGB + i] = a.in[15][i]; }
      for (int i = gt; i < 512; i += ngt) prm[P_GLAG + i] = a.in[16][i];
      for (int i = gt; i < 3 * DFF; i += ngt) prm[P_CW + i] = a.in[22][i];
      for (int i = gt; i < DFF; i += ngt) prm[P_CB + i] = a.in[23][i]; }
    if (fresh_bid() == 0 && F.wave == 0) {
        float s1 = 0.f, s2 = 0.f;
        for (int i = F.lane; i < 128; i += 64) { s1 += a.in[7][i] * a.in[8][i]; s2 += a.in[9][i] * a.in[10][i]; }
        s1 = wave_sum(s1); s2 = wave_sum(s2);
        if (F.lane == 0) ((float*)(ws + WS_PRM))[P_LAM] = expf(s1) - expf(s2) + 0.2f;
    }
}
__device__ __forceinline__ void p1_hnorm(const Frame& F, const float* x, const float* gm, bf16_t* H) {
    const int gw = F.vcu * NWAVES + F.wave, NGW = F.G * NWAVES;
    for (int m = gw; m < GT; m += NGW) {
        const f32x4* xr = (const f32x4*)(x + (size_t)m * DM) + F.lane;
        f32x4 v[16]; float s = 0.f;
#pragma unroll
        for (int j = 0; j < 16; ++j) { v[j] = xr[64 * j]; s += (v[j][0] * v[j][0] + v[j][1] * v[j][1]) + (v[j][2] * v[j][2] + v[j][3] * v[j][3]); }
        const float rstd = 1.f / sqrtf(wave_sum(s) * (1.f / DM) + EPS);
        u32x2* o = (u32x2*)(H + (size_t)m * DM) + F.lane; const f32x4* gr = (const f32x4*)gm + F.lane;
#pragma unroll
        for (int j = 0; j < 16; ++j) { const f32x4 g = gr[64 * j]; u32x2 w; w.x = cvt_pk_bf16(v[j][0] * rstd * g[0], v[j][1] * rstd * g[1]); w.y = cvt_pk_bf16(v[j][2] * rstd * g[2], v[j][3] * rstd * g[3]); o[64 * j] = w; }
    }
}
__device__ __forceinline__ void p3_qknorm(const Frame& F, bf16_t* Q, bf16_t* K, const float* gq, const float* gk) {
    const int gw = F.vcu * NWAVES + F.wave, NGW = F.G * NWAVES;
    const int gi = (F.lane & 15) * 8;
    float gqv[8], gkv[8];
#pragma unroll
    for (int e = 0; e < 8; ++e) { gqv[e] = gq[gi + e]; gkv[e] = gk[gi + e]; }
    for (int m = gw; m < 2 * GT; m += NGW) {
        const bool isk = m >= GT; bf16_t* row = (isk ? K : Q) + (size_t)(isk ? m - GT : m) * 2048;
#pragma unroll
        for (int i = 0; i < 4; ++i) {
            u32x4* p = (u32x4*)(row + i * 512) + F.lane; const u32x4 w = *p;
            float v[8] = {bflo(w.x), bfhi(w.x), bflo(w.y), bfhi(w.y), bflo(w.z), bfhi(w.z), bflo(w.w), bfhi(w.w)};
            float s = 0.f;
#pragma unroll
            for (int e = 0; e < 8; ++e) s += v[e] * v[e];
            s += __shfl_xor(s, 1); s += __shfl_xor(s, 2); s += __shfl_xor(s, 4); s += __shfl_xor(s, 8);
            const float r = 1.f / sqrtf(s * (1.f / 128.f) + EPS);
#pragma unroll
            for (int e = 0; e < 8; ++e) v[e] = v[e] * r * (isk ? gkv[e] : gqv[e]);
            u32x4 o; o.x = cvt_pk_bf16(v[0], v[1]); o.y = cvt_pk_bf16(v[2], v[3]); o.z = cvt_pk_bf16(v[4], v[5]); o.w = cvt_pk_bf16(v[6], v[7]);
            *p = o;
        }
    }
}

constexpr int LQ = 264;
constexpr int LS = 72;
constexpr int G1_QD = 0, G1_KI = 64 * LQ * 2, G1_VT = 2 * 64 * LQ * 2, G1_ATT = G1_VT + 256 * LS * 2, G1_ST = G1_ATT + 64 * LS * 2, G1_TOT = G1_ST + 64 * 16 * 4, G1_END = G1_TOT + 2 * 256 * 4;
static_assert(G1_END <= LDS_MISC, "G1 LDS");
struct GlaT { const bf16_t *GQ, *GK, *GV; const float* ST; const float *wgf, *bgf, *wgb, *bgb; bf16_t *QD, *KDT, *OI; float* DEC; unsigned* dg; };
__device__ __forceinline__ void gla_g1_item(const Frame& F, const GlaT& T, int item, int TT) {
    LAS unsigned char* lds = F.lds;
    const int NCH = TT / 64;
    const int n = item % NCH; int r_ = item / NCH; const int dir = r_ & 1; r_ >>= 1; const int h = r_ & 3; const int b = r_ >> 2;
    const int tok0 = b * TT + n * 64, cg = tok0 >> 6;
    const int tid = F.tid, d = tid & 255, half = tid >> 8;
#if MK_DIAG
    if (tid == 0) atomicOr(T.dg, 32u);
#endif
    LAS bf16_t* qd_l = (LAS bf16_t*)(lds + G1_QD); LAS bf16_t* ki_l = (LAS bf16_t*)(lds + G1_KI); LAS bf16_t* vT_l = (LAS bf16_t*)(lds + G1_VT);
    LAS bf16_t* att_l = (LAS bf16_t*)(lds + G1_ATT); LAS float* st_l = (LAS float*)(lds + G1_ST); LAS float* tot_l = (LAS float*)(lds + G1_TOT);
    const float* wg = dir ? T.wgb : T.wgf; const float* bg = dir ? T.bgb : T.bgf;
    float wgr[16];
#pragma unroll
    for (int j = 0; j < 16; ++j) wgr[j] = wg[j * 1024 + h * 256 + d];
    const float bias = bg[h * 256 + d];
    if (tid < 256) { const int r = tid >> 2, j4 = (tid & 3) * 4; const f32x4 sv = *(const f32x4*)(T.ST + (size_t)(tok0 + r) * 32 + dir * 16 + j4); *(LAS f32x4*)(st_l + r * 16 + j4) = sv;
#if MK_DIAG
        if (!(fabsf(sv[0]) <= 20.f && fabsf(sv[1]) <= 20.f && fabsf(sv[2]) <= 20.f && fabsf(sv[3]) <= 20.f)) atomicOr(T.dg, 16u);
#endif
    }
    __syncthreads();
    float bl[32];
#pragma unroll
    for (int rr = 0; rr < 32; ++rr) { const int r = half * 32 + rr; float x = bias;
#pragma unroll
        for (int j4 = 0; j4 < 4; ++j4) { const f32x4 s = *(const LAS f32x4*)(st_l + r * 16 + j4 * 4); x += s[0] * wgr[j4 * 4] + s[1] * wgr[j4 * 4 + 1] + s[2] * wgr[j4 * 4 + 2] + s[3] * wgr[j4 * 4 + 3]; }
#if MK_DIAG
        if (!(fabsf(x) <= 50.f)) atomicOr(T.dg, 1u);
#endif
        const float ax = fabsf(x); const float ls = fminf(x, 0.f) - __logf(1.f + __expf(-ax));
        bl[rr] = ls * 0.0625f; if ((rr & 3) == 3) __builtin_amdgcn_sched_barrier(0); }
    float run = 0.f;
    if (dir == 0) {
#pragma unroll
        for (int rr = 0; rr < 32; ++rr) { run += bl[rr]; bl[rr] = run; }
    } else {
#pragma unroll
        for (int rr = 31; rr >= 0; --rr) { run += bl[rr]; bl[rr] = run; }
    }
    tot_l[half * 256 + d] = run;
    __syncthreads();
    const float other = tot_l[(1 - half) * 256 + d]; const float blast = run + other;
    const float addv = ((dir == 0) ? (half == 1) : (half == 0)) ? other : 0.f;
    const float elast = __expf(blast);
    const int gbase = (cg * 4 + h) * 2 + dir;
    if (half == 0) T.DEC[(size_t)gbase * 256 + d] = elast;
    unsigned kdp[16];
#pragma unroll
    for (int rr = 0; rr < 32; rr += 2) {
        float kd2[2];
#pragma unroll
        for (int e = 0; e < 2; ++e) { const int r = half * 32 + rr + e; const float bb = bl[rr + e] + addv; const float eb = __expf(bb), ieb = __builtin_amdgcn_rcpf(eb);
            const float qv = bf2f(T.GQ[(size_t)(tok0 + r) * 1024 + h * 256 + d]), kv = bf2f(T.GK[(size_t)(tok0 + r) * 1024 + h * 256 + d]);
            const bf16_t qdb = f2bf(qv * eb); const float ki = kv * ieb;
#if MK_DIAG
            if (!(fabsf(ki) <= 1e30f)) atomicOr(T.dg, 2u);
#endif
            qd_l[r * LQ + d] = qdb; ki_l[r * LQ + d] = f2bf(ki);
            T.QD[((size_t)(tok0 + r) * 2 + dir) * 1024 + h * 256 + d] = qdb;
            kd2[e] = ki * elast; }
        kdp[rr >> 1] = cvt_pk_bf16(kd2[0], kd2[1]); if ((rr & 6) == 6) __builtin_amdgcn_sched_barrier(0);
    }
    { u32x4* kp = (u32x4*)(T.KDT + ((size_t)gbase * 256 + d) * 64 + half * 32);
#pragma unroll
      for (int i = 0; i < 4; ++i) kp[i] = (u32x4){kdp[4 * i], kdp[4 * i + 1], kdp[4 * i + 2], kdp[4 * i + 3]}; }
    __syncthreads();
    const int lane = F.lane, fr = lane & 15, fq = lane >> 4;
#pragma unroll
    for (int i = 0; i < 2; ++i) { const int id = F.wave * 2 + i, mt = id >> 2, nt = id & 3; f32x4 acc = {0.f, 0.f, 0.f, 0.f};
#pragma unroll
        for (int k0 = 0; k0 < 256; k0 += 32) { const bf16x8 av = *(const LAS bf16x8*)(qd_l + (16 * mt + fr) * LQ + k0 + 8 * fq); const bf16x8 bv = *(const LAS bf16x8*)(ki_l + (16 * nt + fr) * LQ + k0 + 8 * fq);
            acc = __builtin_amdgcn_mfma_f32_16x16x32_bf16(av, bv, acc, 0, 0, 0); }
#pragma unroll
        for (int j = 0; j < 4; ++j) { const int c = 16 * mt + 4 * fq + j, s = 16 * nt + fr; const bool keep = dir == 0 ? (s <= c) : (s >= c); att_l[c * LS + s] = f2bf(keep ? acc[j] : 0.f);
#if MK_DIAG
            if (keep && !(fabsf(acc[j]) <= 1e4f)) atomicOr(T.dg, 4u);
#endif
        } }
    __syncthreads();
    LAS bf16_t* ost = qd_l;
    for (int vh = 0; vh < 2; ++vh) {
#pragma unroll
        for (int i = 0; i < 4; ++i) { const int id = tid + 512 * i, s = id >> 5, cc = id & 31; const u32x4 w = *(const u32x4*)(T.GV + (size_t)(tok0 + s) * 2048 + h * 512 + vh * 256 + cc * 8);
            LAS bf16_t* vp = vT_l + (cc * 8) * LS + s;
            vp[0 * LS] = (bf16_t)(w.x & 0xffff); vp[1 * LS] = (bf16_t)(w.x >> 16); vp[2 * LS] = (bf16_t)(w.y & 0xffff); vp[3 * LS] = (bf16_t)(w.y >> 16);
            vp[4 * LS] = (bf16_t)(w.z & 0xffff); vp[5 * LS] = (bf16_t)(w.z >> 16); vp[6 * LS] = (bf16_t)(w.w & 0xffff); vp[7 * LS] = (bf16_t)(w.w >> 16); }
        __syncthreads();
#pragma unroll
        for (int vi = 0; vi < 2; ++vi) { const int vt = F.wave * 2 + vi;
            const bf16x8 b0 = *(const LAS bf16x8*)(vT_l + (16 * vt + fr) * LS + 8 * fq), b1 = *(const LAS bf16x8*)(vT_l + (16 * vt + fr) * LS + 32 + 8 * fq);
#pragma unroll
            for (int mt = 0; mt < 4; ++mt) { f32x4 acc = {0.f, 0.f, 0.f, 0.f};
                const bf16x8 a0 = *(const LAS bf16x8*)(att_l + (16 * mt + fr) * LS + 8 * fq), a1 = *(const LAS bf16x8*)(att_l + (16 * mt + fr) * LS + 32 + 8 * fq);
                acc = __builtin_amdgcn_mfma_f32_16x16x32_bf16(a0, b0, acc, 0, 0, 0); acc = __builtin_amdgcn_mfma_f32_16x16x32_bf16(a1, b1, acc, 0, 0, 0);
#pragma unroll
                for (int j = 0; j < 4; ++j) { ost[(16 * mt + 4 * fq + j) * LQ + 16 * vt + fr] = f2bf(acc[j]);
#if MK_DIAG
                    if (!(fabsf(acc[j]) <= 1e4f)) atomicOr(T.dg, 8u);
#endif
                } } }
        __syncthreads();
#pragma unroll
        for (int i = 0; i < 4; ++i) { const int c = tid >> 3, ch = (tid & 7) + 8 * i;
            *(u32x4*)(T.OI + ((size_t)dir * GT + tok0 + c) * 2048 + h * 512 + vh * 256 + ch * 8) = *(const LAS u32x4*)(ost + c * LQ + ch * 8); }
        __syncthreads();
    }
}

constexpr int LR = 68;
constexpr int G2_QD = 0, G2_KT = 64 * LQ * 2, G2_VT = G2_KT + 256 * LS * 2, G2_DEC = G2_VT + 64 * LS * 2, G2_RED = G2_DEC + 1024, G2_END = G2_RED + 2 * 64 * LR * 4;
static_assert(G2_END <= LDS_MISC, "G2 LDS");
__device__ __forceinline__ void gla_g2_item(const Frame& F, const GlaT& T, int item, int TT) {
    LAS unsigned char* lds = F.lds;
    const int NCH = TT / 64;
    const int vs = item & 7; int r_ = item >> 3; const int dir = r_ & 1; r_ >>= 1; const int h = r_ & 3; const int b = r_ >> 2;
    const int tid = F.tid, lane = F.lane, fr = lane & 15, fq = lane >> 4, vt = F.wave & 3, dh = F.wave >> 2;
    LAS bf16_t* qd_l = (LAS bf16_t*)(lds + G2_QD); LAS bf16_t* kT_l = (LAS bf16_t*)(lds + G2_KT); LAS bf16_t* vT_l = (LAS bf16_t*)(lds + G2_VT);
    LAS float* dec_l = (LAS float*)(lds + G2_DEC); LAS float* red_l = (LAS float*)(lds + G2_RED);
    f32x4 S[8];
#pragma unroll
    for (int i = 0; i < 8; ++i) S[i] = (f32x4){0.f, 0.f, 0.f, 0.f};
    for (int st = 0; st < NCH; ++st) {
        const int n = dir ? (NCH - 1 - st) : st; const int tok0 = b * TT + n * 64; const int gbase = ((tok0 >> 6) * 4 + h) * 2 + dir;
#pragma unroll
        for (int i = 0; i < 4; ++i) { const int id = tid + 512 * i; { const int c = id >> 5, cc = id & 31;
                *(LAS u32x4*)(qd_l + c * LQ + cc * 8) = *(const u32x4*)(T.QD + ((size_t)(tok0 + c) * 2 + dir) * 1024 + h * 256 + cc * 8); }
            { const int dd = id >> 3, cc = id & 7; *(LAS u32x4*)(kT_l + dd * LS + cc * 8) = *(const u32x4*)(T.KDT + ((size_t)gbase * 256 + dd) * 64 + cc * 8); } }
        { const int s = tid >> 3, cc = tid & 7; const u32x4 w = *(const u32x4*)(T.GV + (size_t)(tok0 + s) * 2048 + h * 512 + vs * 64 + cc * 8);
            LAS bf16_t* vp = vT_l + (cc * 8) * LS + s;
            vp[0 * LS] = (bf16_t)(w.x & 0xffff); vp[1 * LS] = (bf16_t)(w.x >> 16); vp[2 * LS] = (bf16_t)(w.y & 0xffff); vp[3 * LS] = (bf16_t)(w.y >> 16);
            vp[4 * LS] = (bf16_t)(w.z & 0xffff); vp[5 * LS] = (bf16_t)(w.z >> 16); vp[6 * LS] = (bf16_t)(w.w & 0xffff); vp[7 * LS] = (bf16_t)(w.w >> 16); }
        if (tid < 256) dec_l[tid] = T.DEC[(size_t)gbase * 256 + tid];
        __syncthreads();
        bf16x8 sb[4];
#pragma unroll
        for (int kb = 0; kb < 4; ++kb) { u32x4 w; w.x = cvt_pk_bf16(S[2 * kb][0], S[2 * kb][1]); w.y = cvt_pk_bf16(S[2 * kb][2], S[2 * kb][3]); w.z = cvt_pk_bf16(S[2 * kb + 1][0], S[2 * kb + 1][1]); w.w = cvt_pk_bf16(S[2 * kb + 1][2], S[2 * kb + 1][3]);
            sb[kb] = __builtin_bit_cast(bf16x8, w); }
#pragma unroll
        for (int mt = 0; mt < 4; ++mt) { f32x4 acc = {0.f, 0.f, 0.f, 0.f};
#pragma unroll
            for (int kb = 0; kb < 4; ++kb) { const LAS bf16_t* ap = qd_l + (16 * mt + fr) * LQ + 128 * dh + 32 * kb + 4 * fq;
                const s16x4 lo = *(const LAS s16x4*)(ap), hi = *(const LAS s16x4*)(ap + 16);
                const bf16x8 av = __builtin_shufflevector(lo, hi, 0, 1, 2, 3, 4, 5, 6, 7);
                acc = __builtin_amdgcn_mfma_f32_16x16x32_bf16(av, sb[kb], acc, 0, 0, 0); }
#pragma unroll
            for (int j = 0; j < 4; ++j) red_l[(dh * 64 + 16 * mt + 4 * fq + j) * LR + 16 * vt + fr] = acc[j]; }
        { const bf16x8 b0 = *(const LAS bf16x8*)(vT_l + (16 * vt + fr) * LS + 8 * fq), b1 = *(const LAS bf16x8*)(vT_l + (16 * vt + fr) * LS + 32 + 8 * fq);
#pragma unroll
          for (int i = 0; i < 8; ++i) { const int drow = 128 * dh + 16 * i; const f32x4 dc = *(const LAS f32x4*)(dec_l + drow + 4 * fq);
              S[i] = S[i] * dc;
              const bf16x8 a0 = *(const LAS bf16x8*)(kT_l + (drow + fr) * LS + 8 * fq), a1 = *(const LAS bf16x8*)(kT_l + (drow + fr) * LS + 32 + 8 * fq);
              S[i] = __builtin_amdgcn_mfma_f32_16x16x32_bf16(a0, b0, S[i], 0, 0, 0); S[i] = __builtin_amdgcn_mfma_f32_16x16x32_bf16(a1, b1, S[i], 0, 0, 0); } }
        __syncthreads();
        { const int c = tid >> 3, v8 = (tid & 7) * 8; bf16_t* op = T.OI + ((size_t)dir * GT + tok0 + c) * 2048 + h * 512 + vs * 64 + v8;
          const u32x4 ow = *(const u32x4*)op;
          const f32x4 r0 = *(const LAS f32x4*)(red_l + c * LR + v8) + *(const LAS f32x4*)(red_l + (64 + c) * LR + v8);
          const f32x4 r1 = *(const LAS f32x4*)(red_l + c * LR + v8 + 4) + *(const LAS f32x4*)(red_l + (64 + c) * LR + v8 + 4);
          u32x4 w; w.x = cvt_pk_bf16(r0[0] + bflo(ow.x), r0[1] + bfhi(ow.x)); w.y = cvt_pk_bf16(r0[2] + bflo(ow.y), r0[3] + bfhi(ow.y));
          w.z = cvt_pk_bf16(r1[0] + bflo(ow.z), r1[1] + bfhi(ow.z)); w.w = cvt_pk_bf16(r1[2] + bflo(ow.w), r1[3] + bfhi(ow.w));
          *(u32x4*)op = w; }
        __syncthreads();
    }
}

namespace att {
constexpr int D = 128, NW = 8, QBLK = 32, KVBLK = 64, LD = 2048;
constexpr float SCALE = 0.088388347648318440f;
constexpr int SHM_V = KVBLK * D * 2, SHM_K = KVBLK * D * 2;
constexpr int OFF_V = 0, OFF_K = 2 * SHM_V, OFF_WS = OFF_K + 2 * SHM_K, OFF_TB = OFF_WS + NW * 64 * 4, TB_STRIDE = 264  , ATT_LDS = OFF_TB + 8 * TB_STRIDE * 4;
static_assert(ATT_LDS <= LDS_MISC, "attention LDS");
#define KSWZ(row, colB) ((row) * 256 + ((colB) ^ (((row) & 7) << 4)))
#define SBAR() __builtin_amdgcn_sched_barrier(0)
__device__ __forceinline__ int crow(int r, int hi) { return (r & 3) + 8 * (r >> 2) + 4 * hi; }
__device__ __forceinline__ void partialSM(f32x16& p0, f32x16& p1, const LAS float* tb, int rel0, int relmin, int relmax, int hi) {
    constexpr float C = SCALE * LOG2E;
    if (relmin >= 128 || relmax <= -128) {
        const float c = (relmin >= 128) ? tb[256] : tb[0];
#pragma unroll
        for (int r = 0; r < 16; ++r) { p0[r] = fmaf(p0[r], C, c); p1[r] = fmaf(p1[r], C, c); }
    } else {
        int rb = rel0 + 4 * hi; asm volatile("" : "+v"(rb));
#pragma unroll
        for (int r4 = 0; r4 < 16; r4 += 4) {
#pragma unroll
            for (int r = r4; r < r4 + 4; ++r) { const int rl = rb + ((r & 3) + 8 * (r >> 2)); const int i0 = min(max(rl, -128), 128) + 128, i1 = min(max(rl + 32, -128), 128) + 128;
                p0[r] = fmaf(p0[r], C, tb[i0]); p1[r] = fmaf(p1[r], C, tb[i1]); }
            __builtin_amdgcn_sched_barrier(0);
        }
    }
#pragma unroll
    for (int r = 0; r < 16; ++r) p0[r] = __builtin_amdgcn_exp2f(p0[r]);
}
__device__ __forceinline__ void finishSM(f32x16& p0, f32x16& p1, float& l_reg, bf16x8& pa0, bf16x8& pa1, bf16x8& pa2, bf16x8& pa3) {
#pragma unroll
    for (int r = 0; r < 16; ++r) p1[r] = __builtin_amdgcn_exp2f(p1[r]);
    float ps = 0;
#pragma unroll
    for (int r = 0; r < 16; ++r) ps += p0[r];
#pragma unroll
    for (int r = 0; r < 16; ++r) ps += p1[r];
    { auto rr = __builtin_amdgcn_permlane32_swap(__float_as_uint(ps), __float_as_uint(ps), false, false);
      ps = __uint_as_float(rr[0]) + __uint_as_float(rr[1]); }
    l_reg += ps;
#define PK4(P, BASE, OUT) do { unsigned a0 = cvt_pk_bf16(P[BASE + 0], P[BASE + 1]), a1 = cvt_pk_bf16(P[BASE + 2], P[BASE + 3]);   \
    unsigned b0 = cvt_pk_bf16(P[BASE + 4], P[BASE + 5]), b1 = cvt_pk_bf16(P[BASE + 6], P[BASE + 7]);                              \
    auto r0 = __builtin_amdgcn_permlane32_swap(a0, b0, false, false); auto r1 = __builtin_amdgcn_permlane32_swap(a1, b1, false, false); \
    u32x4 w = {r0[0], r1[0], r0[1], r1[1]}; OUT = __builtin_bit_cast(bf16x8, w); } while (0)
    PK4(p0, 0, pa0); PK4(p0, 8, pa1); PK4(p1, 0, pa2); PK4(p1, 8, pa3);
#undef PK4
}
__device__ __forceinline__ void qkt(f32x16& p0, f32x16& p1, const LAS char* Ks, const bf16x8* Qs, int r32, int hi) {
    p0 = f32x16{}; p1 = f32x16{};
#pragma unroll
    for (int d0 = 0; d0 < 8; ++d0) { const int cb = (d0 * 16 + hi * 8) * 2;
        const bf16x8 b0 = *(const LAS bf16x8*)(Ks + KSWZ(r32, cb));
        const bf16x8 b1 = *(const LAS bf16x8*)(Ks + KSWZ(32 + r32, cb));
        const bf16x8 q = Qs[d0];
        p0 = __builtin_amdgcn_mfma_f32_32x32x16_bf16(b0, q, p0, 0, 0, 0);
        p1 = __builtin_amdgcn_mfma_f32_32x32x16_bf16(b1, q, p1, 0, 0, 0); }
}
__device__ __forceinline__ int v_st(int k, int c) { const int kk = (k & ~0xC) | ((k & 4) << 1) | ((k & 8) >> 1); return ((kk >> 3) * 4 + (c >> 5)) * 512 + ((kk & 7) * 32 + (c & 31)) * 2; }
__device__ __forceinline__ int v_rd_base(int lane) { return ((lane & 3) << 3) | (((lane >> 2) & 3) << 6) | (((lane >> 4) & 1) << 5) | (((lane >> 5) & 1) << 8); }
constexpr int v_rd_off(int d0, int ks, int half) { return d0 * 512 + ks * 4096 + half * 2048; }
template <int OFF> __device__ __forceinline__ s16x4 tr_read(int vb) {
    s16x4 r; asm volatile("ds_read_b64_tr_b16 %0, %1 offset:%2" : "=&v"(r) : "v"(vb), "i"(OFF) : "memory"); return r;
}
template <int D0> __device__ __forceinline__ void pv_one(f32x16& od, int vb, bf16x8 pa0, bf16x8 pa1, bf16x8 pa2, bf16x8 pa3) {
    const s16x4 l0 = tr_read<v_rd_off(D0, 0, 0)>(vb), h0 = tr_read<v_rd_off(D0, 0, 1)>(vb), l1 = tr_read<v_rd_off(D0, 1, 0)>(vb), h1 = tr_read<v_rd_off(D0, 1, 1)>(vb);
    const s16x4 l2 = tr_read<v_rd_off(D0, 2, 0)>(vb), h2 = tr_read<v_rd_off(D0, 2, 1)>(vb), l3 = tr_read<v_rd_off(D0, 3, 0)>(vb), h3 = tr_read<v_rd_off(D0, 3, 1)>(vb);
    asm volatile("s_waitcnt lgkmcnt(0)" ::: "memory"); SBAR();
#define PK(L, H) (bf16x8){L[0], L[1], L[2], L[3], H[0], H[1], H[2], H[3]}
    od = __builtin_amdgcn_mfma_f32_32x32x16_bf16(pa0, PK(l0, h0), od, 0, 0, 0);
    od = __builtin_amdgcn_mfma_f32_32x32x16_bf16(pa1, PK(l1, h1), od, 0, 0, 0);
    od = __builtin_amdgcn_mfma_f32_32x32x16_bf16(pa2, PK(l2, h2), od, 0, 0, 0);
    od = __builtin_amdgcn_mfma_f32_32x32x16_bf16(pa3, PK(l3, h3), od, 0, 0, 0);
#undef PK
}
__device__ __forceinline__ void pv_d0(f32x16* o, int vb, bf16x8 pa0, bf16x8 pa1, bf16x8 pa2, bf16x8 pa3) {
    pv_one<0>(o[0], vb, pa0, pa1, pa2, pa3); pv_one<1>(o[1], vb, pa0, pa1, pa2, pa3); pv_one<2>(o[2], vb, pa0, pa1, pa2, pa3); pv_one<3>(o[3], vb, pa0, pa1, pa2, pa3);
}
__device__ __forceinline__ void attn_unit(const bf16_t* __restrict__ Qb, const bf16_t* __restrict__ Kh, const bf16_t* __restrict__ Vh, bf16_t* __restrict__ Ob, int seq, int q0, const LAS float* tb, LAS char* lds, int tid_) {
    const int tid = tid_, wid = tid >> 6, lane = tid & 63, r32 = lane & 31, hi = lane >> 5;
    LAS char* V_lds = lds + OFF_V; LAS char* K_lds = lds + OFF_K;
    LAS float* li_l = (LAS float*)(lds + OFF_WS) + wid * 64;
    float l_reg = 0; f32x16 o[4] = {};
    bf16x8 qr[8];
    { const bf16_t* Qw = Qb + (long)(wid * QBLK + r32) * LD + hi * 8;
#pragma unroll
      for (int d0 = 0; d0 < 8; ++d0) qr[d0] = *(const bf16x8*)(Qw + d0 * 16); }
    const int sr = tid >> 4, sc = (tid & 15) * 8, vst0 = v_st(sr, sc), vst1 = v_st(32 + sr, sc);
    const int vb0 = (int)(unsigned)(size_t)V_lds + v_rd_base(lane);
    const int qpos = q0 + wid * QBLK + r32, wq0 = q0 + wid * QBLK;
    struct { bf16x8 vs0, vs1, ks0, ks1; } sr_;
#define SLOAD(k0) do { sr_.vs0 = *(const bf16x8*)(&Vh[(long)((k0) + sr) * LD + sc]); sr_.vs1 = *(const bf16x8*)(&Vh[(long)((k0) + 32 + sr) * LD + sc]); \
    sr_.ks0 = *(const bf16x8*)(&Kh[(long)((k0) + sr) * LD + sc]); sr_.ks1 = *(const bf16x8*)(&Kh[(long)((k0) + 32 + sr) * LD + sc]); } while (0)
#define SWRITE(b) do { *(LAS bf16x8*)(V_lds + (b) * SHM_V + vst0) = sr_.vs0;          \
    *(LAS bf16x8*)(V_lds + (b) * SHM_V + vst1) = sr_.vs1; const int kc = sc * 2;               \
    *(LAS bf16x8*)(K_lds + (b) * SHM_K + KSWZ(sr, kc)) = sr_.ks0;                       \
    *(LAS bf16x8*)(K_lds + (b) * SHM_K + KSWZ(32 + sr, kc)) = sr_.ks1; } while (0)
#define PSM(P0, P1, TILE) partialSM(P0, P1, tb, (TILE) * KVBLK - qpos, (TILE) * KVBLK - (wq0 + 31), (TILE) * KVBLK + 63 - wq0, hi)
#define TILE_STEP(J, B) do { __syncthreads(); \
        if ((J) + 1 < NT) { asm volatile("s_waitcnt vmcnt(0)" ::: "memory"); SWRITE(1 - (B)); } \
        if ((J) + 2 < NT) SLOAD(((J) + 2) * KVBLK); \
        SBAR(); qkt(p0, p1, K_lds + (B) * SHM_K, qr, r32, hi); PSM(p0, p1, (J)); \
        finishSM(p0, p1, l_reg, pa0, pa1, pa2, pa3); SBAR(); \
        pv_d0(o, vb0 + (B) * (int)SHM_V, pa0, pa1, pa2, pa3); } while (0)
    f32x16 p0, p1; bf16x8 pa0, pa1, pa2, pa3; const int NT = seq / KVBLK;
    SLOAD(0); asm volatile("s_waitcnt vmcnt(0)" ::: "memory"); SWRITE(0); SLOAD(KVBLK);
#pragma nounroll
    for (int j = 0; j < NT; j += 2) { TILE_STEP(j, 0); TILE_STEP(j + 1, 1); }
#undef TILE_STEP
    if (hi == 0) li_l[r32] = l_reg; asm volatile("s_waitcnt lgkmcnt(0)" ::: "memory");
    float rli[16];
#pragma unroll
    for (int r = 0; r < 16; ++r) rli[r] = __builtin_amdgcn_rcpf(li_l[crow(r, hi)]);
    bf16_t* Ow = Ob + (long)(wid * QBLK) * LD;
#pragma unroll
    for (int r = 0; r < 16; ++r) { const int orow = crow(r, hi);
#pragma unroll
        for (int d0 = 0; d0 < 4; ++d0) Ow[(long)orow * LD + d0 * 32 + r32] = f2bf(o[d0][r] * rli[r]); }
#undef SLOAD
#undef SWRITE
#undef PSM
}
}

__device__ __forceinline__ int t5_bucket(int rel) {
    const int ret = rel > 0 ? 16 : 0; const int n = rel < 0 ? -rel : rel;
    if (n < 8) return ret + n;
    const int e = 31 - __clz(n); int large = 8 + 2 * (e - 3) + ((n * n >= (2 << (2 * e))) ? 1 : 0);
    large = large < 15 ? large : 15;
    return ret + large;
}

__device__ __forceinline__ void p4_mixer(const Frame& F, const Args& a, int g) {
    unsigned char* ws = a.ws; const int TT = g ? 2048 : 4096, NB = g ? 8 : 4;
    bf16_t* dsc = (bf16_t*)(a.out + (size_t)g * GT * DM);
    const float* prm = (const float*)(ws + WS_PRM);
    GlaT T{(const bf16_t*)(ws + A_GQ), (const bf16_t*)(ws + A_GK), (const bf16_t*)(ws + A_GV), (const float*)(ws + WS_ST), prm + P_WGF, prm + P_BGF, prm + P_WGB, prm + P_BGB,
           (bf16_t*)(ws + A_QD), (bf16_t*)(ws + A_KDT), dsc + (size_t)2 * GT * 2048, (float*)(ws + WS_DEC), DG_WORD(ws)};
    const int n_g2 = NB * 4 * 2 * 8;
    for (int it = F.vcu; it < n_g2; it += F.G) gla_g2_item(F, T, it, TT);
    const int NQB = TT / 256, n_at = NB * 8 * 2 * 2 * NQB;
    LAS float* tb = (LAS float*)(F.lds + att::OFF_TB);
    const bf16_t* Qg = (const bf16_t*)(ws + A_Q); const bf16_t* Kg = (const bf16_t*)(ws + A_K); const bf16_t* Vg = (const bf16_t*)(ws + A_V);
    __syncthreads();
    for (int i = F.tid; i < 8 * 257; i += NTHR) { const int h = i / 257, j = i - h * 257; tb[h * att::TB_STRIDE + j] = prm[P_RB + t5_bucket(j - 128) * 8 + h] * LOG2E; }
    __syncthreads();
    for (int it = F.vcu; it < n_at; it += F.G) {
        const int qb = it % NQB; int r = it / NQB; const int vhalf = r & 1; r >>= 1; const int map = r & 1; r >>= 1; const int h = r & 7; const int b = r >> 3;
        const size_t rowb = (size_t)b * TT;
        att::attn_unit(Qg + (rowb + qb * 256) * 2048 + h * 256 + map * 128, Kg + rowb * 2048 + h * 256 + map * 128, Vg + rowb * 2048 + h * 256 + vhalf * 128,
                       dsc + (size_t)map * GT * 2048 + (rowb + qb * 256) * 2048 + h * 256 + vhalf * 128, TT, qb * 256, tb + h * att::TB_STRIDE, (LAS char*)F.lds, F.tid);
        __syncthreads();
    }
}
__device__ __forceinline__ void p5_finalize(const Frame& F, const Args& a, int g) {
    unsigned char* ws = a.ws; const bf16_t* dsc = (const bf16_t*)(a.out + (size_t)g * GT * DM);
    const bf16_t* O1 = dsc; const bf16_t* O2 = dsc + (size_t)GT * 2048; const bf16_t* OF = dsc + (size_t)2 * GT * 2048; const bf16_t* OB = dsc + (size_t)3 * GT * 2048;
    const bf16_t* GR = (const bf16_t*)(ws + A_GR); bf16_t* OAB = (bf16_t*)(ws + A_OAB);
    const float* prm = (const float*)(ws + WS_PRM); const float lam = prm[P_LAM];
    const int gw = F.vcu * NWAVES + F.wave, NGW = F.G * NWAVES, lane = F.lane;
    float sg[8], gg[8];
#pragma unroll
    for (int e = 0; e < 8; ++e) { sg[e] = prm[P_SUBLN + (lane & 31) * 8 + e] * 0.8f; gg[e] = prm[P_GLAG + lane * 8 + e]; }
    for (int m = gw; m < GT; m += NGW) {
#pragma unroll
        for (int i = 0; i < 4; ++i) {
            const size_t off = (size_t)m * 2048 + i * 512 + lane * 8;
            { const u32x4 w1 = *(const u32x4*)(O1 + off), w2 = *(const u32x4*)(O2 + off);
              float v[8] = {bflo(w1.x) - lam * bflo(w2.x), bfhi(w1.x) - lam * bfhi(w2.x), bflo(w1.y) - lam * bflo(w2.y), bfhi(w1.y) - lam * bfhi(w2.y),
                            bflo(w1.z) - lam * bflo(w2.z), bfhi(w1.z) - lam * bfhi(w2.z), bflo(w1.w) - lam * bflo(w2.w), bfhi(w1.w) - lam * bfhi(w2.w)};
              float s = 0.f;
#pragma unroll
              for (int e = 0; e < 8; ++e) s += v[e] * v[e];
              s += __shfl_xor(s, 1); s += __shfl_xor(s, 2); s += __shfl_xor(s, 4); s += __shfl_xor(s, 8); s += __shfl_xor(s, 16);
              const float r = 1.f / sqrtf(s * (1.f / 256.f) + EPS);
              u32x4 o; o.x = cvt_pk_bf16(v[0] * r * sg[0], v[1] * r * sg[1]); o.y = cvt_pk_bf16(v[2] * r * sg[2], v[3] * r * sg[3]); o.z = cvt_pk_bf16(v[4] * r * sg[4], v[5] * r * sg[5]); o.w = cvt_pk_bf16(v[6] * r * sg[6], v[7] * r * sg[7]);
              *(u32x4*)(OAB + (size_t)m * DM + i * 512 + lane * 8) = o; }
            { const u32x4 w1 = *(const u32x4*)(OF + off), w2 = *(const u32x4*)(OB + off), wr_ = *(const u32x4*)(GR + off);
              float v[8] = {bflo(w1.x) + bflo(w2.x), bfhi(w1.x) + bfhi(w2.x), bflo(w1.y) + bflo(w2.y), bfhi(w1.y) + bfhi(w2.y),
                            bflo(w1.z) + bflo(w2.z), bfhi(w1.z) + bfhi(w2.z), bflo(w1.w) + bflo(w2.w), bfhi(w1.w) + bfhi(w2.w)};
              const float rr[8] = {bflo(wr_.x), bfhi(wr_.x), bflo(wr_.y), bfhi(wr_.y), bflo(wr_.z), bfhi(wr_.z), bflo(wr_.w), bfhi(wr_.w)};
              float s = 0.f;
#pragma unroll
              for (int e = 0; e < 8; ++e) s += v[e] * v[e];
              s = wave_sum(s);
              const float r = 1.f / sqrtf(s * (1.f / 512.f) + EPS);
              u32x4 o; o.x = cvt_pk_bf16(v[0] * r * gg[0] * rr[0], v[1] * r * gg[1] * rr[1]); o.y = cvt_pk_bf16(v[2] * r * gg[2] * rr[2], v[3] * r * gg[3] * rr[3]);
              o.z = cvt_pk_bf16(v[4] * r * gg[4] * rr[4], v[5] * r * gg[5] * rr[5]); o.w = cvt_pk_bf16(v[6] * r * gg[6] * rr[6], v[7] * r * gg[7] * rr[7]);
              *(u32x4*)(OAB + (size_t)m * DM + 2048 + i * 512 + lane * 8) = o; }
        }
    }
}
__device__ __forceinline__ float gelu_tanh(float x) { const float u = x * (1.5957691216057308f + 0.07135481627159145f * x * x); return x * __builtin_amdgcn_rcpf(1.f + __builtin_amdgcn_exp2f(-u * LOG2E)); }
__device__ __forceinline__ void unpack8(const u32x4 w, float (&v)[8]) { v[0] = bflo(w.x); v[1] = bfhi(w.x); v[2] = bflo(w.y); v[3] = bfhi(w.y); v[4] = bflo(w.z); v[5] = bfhi(w.z); v[6] = bflo(w.w); v[7] = bfhi(w.w); }
__device__ __forceinline__ void p9_conv(const Frame& F, const Args& a, int g) {
    unsigned char* ws = a.ws; const int TT = g ? 2048 : 4096;
    const bf16_t* FA = (const bf16_t*)(ws + A_FA); bf16_t* FG = (bf16_t*)(ws + A_FG);
    const float* cw = (const float*)(ws + WS_PRM) + P_CW; const float* cb = (const float*)(ws + WS_PRM) + P_CB;
    constexpr int NF8 = DFF / 8, RB = 16, NRB = GT / RB;
    const long total = (long)NF8 * NRB;
    for (long it = (long)F.vcu * NTHR + F.tid; it < total; it += (long)F.G * NTHR) {
        const int f8 = (int)(it % NF8), rb = (int)(it / NF8), f0 = f8 * 8, r0 = rb * RB;
        float w0[8], w1[8], w2[8], bb[8];
#pragma unroll
        for (int e = 0; e < 8; ++e) { w0[e] = cw[f0 + e]; w1[e] = cw[DFF + f0 + e]; w2[e] = cw[2 * DFF + f0 + e]; bb[e] = cb[f0 + e]; }
        float pv[8], cv[8], nv[8];
        if ((r0 % TT) != 0) unpack8(*(const u32x4*)(FA + (size_t)(r0 - 1) * DFF + f0), pv); else {
#pragma unroll
            for (int e = 0; e < 8; ++e) pv[e] = 0.f; }
        unpack8(*(const u32x4*)(FA + (size_t)r0 * DFF + f0), cv);
#pragma unroll 4
        for (int r = 0; r < RB; ++r) { const int row = r0 + r;
            if (((row + 1) % TT) != 0) unpack8(*(const u32x4*)(FA + (size_t)(row + 1) * DFF + f0), nv); else {
#pragma unroll
                for (int e = 0; e < 8; ++e) nv[e] = 0.f; }
            float gv[8]; unpack8(*(const u32x4*)(FG + (size_t)row * DFF + f0), gv);
            float o[8];
#pragma unroll
            for (int e = 0; e < 8; ++e) { const float c = pv[e] * w0[e] + cv[e] * w1[e] + nv[e] * w2[e] + bb[e]; o[e] = gelu_tanh(c) * gv[e]; pv[e] = cv[e]; cv[e] = nv[e]; }
            u32x4 w; w.x = cvt_pk_bf16(o[0], o[1]); w.y = cvt_pk_bf16(o[2], o[3]); w.z = cvt_pk_bf16(o[4], o[5]); w.w = cvt_pk_bf16(o[6], o[7]);
            *(u32x4*)(FG + (size_t)row * DFF + f0) = w; }
    }
}

constexpr int NPH = 11;
#define GRID_BAR() do { if (!multi) { XcdBarrier b_; b_.bar = (unsigned*)(args.ws + WS_CTL) + CW_BAR; b_.x = xb_xcc_id(); b_.st = (volatile LAS unsigned*)(lds + LDS_MISC); xcd_barrier(b_); } } while (0)
#if MK_ONE_LAUNCH
#define IN(k) true
#else
#define IN(k) (lo <= (k) && (k) < hi)
#endif
template <int GI> __device__ __forceinline__ void group_body(LAS unsigned char* lds, const int wave_s, const Args& args, const bool more) {
    constexpr bool multi = !MK_ONE_LAUNCH;
    constexpr int g = GI;
    unsigned char* ws = args.ws; const int lo = args.ph_lo, hi = args.ph_hi; (void)lo; (void)hi;
    const float* xg = args.in[GI];
    float* outg = args.out + (size_t)GI * GT * DM;
    float* rss = (float*)((unsigned*)(ws + WS_CTL) + CW_RSS) + (size_t)GI * GT;
    if (IN(1)) { const Frame F = make_frame(lds, wave_s); p1_hnorm(F, xg, GI == 0 ? args.in[3] : (const float*)(ws + WS_PRM) + P_GMIX, (bf16_t*)(ws + A_H)); GRID_BAR(); }
    if (IN(2)) { const Frame F = make_frame(lds, wave_s);
        pg8::Gemm gm{(const bf16_t*)(ws + A_H), (const bf16_t*)(ws + WS_WIN)};
        EpiInProj E{ws};
        pg8::gemm_phase<GT, DINP, DM, DM, DM, 1, 0>(F.lds, gm, fresh_grid(), fresh_bid(), F.tid, E); GRID_BAR();
    }
    if (IN(3)) { const Frame F = make_frame(lds, wave_s);
        const float* prm = (const float*)(ws + WS_PRM);
        p3_qknorm(F, (bf16_t*)(ws + A_Q), (bf16_t*)(ws + A_K), prm + P_QG, prm + P_KG);
        bf16_t* dsc = (bf16_t*)outg;
        GlaT T{(const bf16_t*)(ws + A_GQ), (const bf16_t*)(ws + A_GK), (const bf16_t*)(ws + A_GV), (const float*)(ws + WS_ST), prm + P_WGF, prm + P_BGF, prm + P_WGB, prm + P_BGB,
               (bf16_t*)(ws + A_QD), (bf16_t*)(ws + A_KDT), dsc + (size_t)2 * GT * 2048, (float*)(ws + WS_DEC), DG_WORD(ws)};
        constexpr int TT = g ? 2048 : 4096;
        for (int it = F.vcu; it < 2048; it += F.G) gla_g1_item(F, T, it, TT);
        GRID_BAR();
    }
    if (IN(4)) { const Frame F = make_frame(lds, wave_s); p4_mixer(F, args, g); GRID_BAR(); }
    if (IN(5)) { const Frame F = make_frame(lds, wave_s); p5_finalize(F, args, g); GRID_BAR(); }
    if (IN(6)) { const Frame F = make_frame(lds, wave_s);
        pg8::Gemm gm{(const bf16_t*)(ws + A_OAB), (const bf16_t*)(ws + WS_WPAB)}; EpiBranch E{ws};
        pg8::gemm_phase<GT, DM, 2048, DM, DM, 2, 2048>(F.lds, gm, fresh_grid(), fresh_bid(), F.tid, E); GRID_BAR();
    }
    if (IN(7)) { const Frame F = make_frame(lds, wave_s);
        pg8::Gemm gm{(const bf16_t*)(ws + A_MRG), (const bf16_t*)(ws + WS_WOUT)};
        EpiWout E{xg, outg, (bf16_t*)(ws + A_X1B), rss}; pg8::gemm_phase<GT, DM, DM, DM, DM, 1, 0>(F.lds, gm, fresh_grid(), fresh_bid(), F.tid, E); GRID_BAR();
    }
    if (IN(8)) { const Frame F = make_frame(lds, wave_s);
        pg8::Gemm gm{(const bf16_t*)(ws + A_X1B), (const bf16_t*)(ws + WS_WUP)};
        EpiUp E{rss, (bf16_t*)(ws + A_FA), (bf16_t*)(ws + A_FG)}; pg8::gemm_phase<GT, 2 * DFF, DM, DM, DM, 1, 0>(F.lds, gm, fresh_grid(), fresh_bid(), F.tid, E); GRID_BAR();
    }
    if (IN(9)) { const Frame F = make_frame(lds, wave_s); p9_conv(F, args, g); GRID_BAR(); }
    if (IN(10)) { const Frame F = make_frame(lds, wave_s);
        pg8::Gemm gm{(const bf16_t*)(ws + A_FG), (const bf16_t*)(ws + WS_WDN)};
        EpiDown E{outg}; pg8::gemm_phase<GT, DM, DFF, DFF, DFF, 1, 0>(F.lds, gm, fresh_grid(), fresh_bid(), F.tid, E);
        if (more) GRID_BAR();
    }
}
__global__ void __launch_bounds__(NTHR, 2) mk_fwd(Args args) {
    extern __shared__ __attribute__((aligned(16))) unsigned char lds_raw[];
    LAS unsigned char* lds = (LAS unsigned char*)lds_raw;
    const int wave_s = __builtin_amdgcn_readfirstlane((int)threadIdx.x >> 6);
    { volatile LAS unsigned* MISC = (volatile LAS unsigned*)(lds + LDS_MISC); const int t = fresh_tid(wave_s); if (t < 64) MISC[t] = 0u; }
    __syncthreads();
#if MK_ONE_LAUNCH
    (void)xcd_barrier_post((unsigned*)(args.ws + WS_CTL) + CW_BAR, (volatile LAS unsigned*)(lds + LDS_MISC));
    { const Frame F = make_frame(lds, wave_s); p0_weights(F, args); }
    group_body<0>(lds, wave_s, args, true);
    group_body<1>(lds, wave_s, args, false);
#else
    if (args.ph_lo == 0 && args.g_lo == 0) { const Frame F = make_frame(lds, wave_s); p0_weights(F, args); }
    if (args.g_lo <= 0 && 0 < args.g_hi) group_body<0>(lds, wave_s, args, false);
    if (args.g_lo <= 1 && 1 < args.g_hi) group_body<1>(lds, wave_s, args, false);
#endif
}
#undef IN
#undef GRID_BAR


#if MK_DIAG
constexpr int CW_DIAG = 32768;
__global__ void diag_scan_bf16(const bf16_t* p, size_t n, unsigned* diag, int stage, float thr) {
    unsigned bad = 0;
    for (size_t i = (size_t)blockIdx.x * blockDim.x + threadIdx.x; i < n; i += (size_t)gridDim.x * blockDim.x) { const float v = bf2f(p[i]); if (!(fabsf(v) <= thr)) ++bad; }
    if (bad) atomicAdd(diag + stage, bad);
}
__global__ void diag_scan_f32(const float* p, size_t n, unsigned* diag, int stage, float thr) {
    unsigned bad = 0;
    for (size_t i = (size_t)blockIdx.x * blockDim.x + threadIdx.x; i < n; i += (size_t)gridDim.x * blockDim.x) { const float v = p[i]; if (!(fabsf(v) <= thr)) ++bad; }
    if (bad) atomicAdd(diag + stage, bad);
}

__global__ void diag_check_inproj(const float* x, const float* gm, const float* w_in, unsigned char* ws, unsigned* flag) {
    const int lane = threadIdx.x & 63, wv = (blockIdx.x * blockDim.x + threadIdx.x) >> 6, nw = (gridDim.x * blockDim.x) >> 6;
    const bf16_t* H = (const bf16_t*)(ws + A_H); const bf16_t* W = (const bf16_t*)(ws + WS_WIN);
    for (int s = wv; s < 4096; s += nw) {
        const unsigned hsh = (unsigned)s * 2654435761u; const int row = (int)((hsh >> 8) % GT);
        { float ss = 0.f; for (int k = lane; k < DM; k += 64) { const float v = x[(size_t)row * DM + k]; ss += v * v; } ss = wave_sum(ss);
          const int k = (int)((hsh >> 3) % DM); const float ref = x[(size_t)row * DM + k] * (1.f / sqrtf(ss / DM + EPS)) * gm[k]; const float got = bf2f(H[(size_t)row * DM + k]);
          if (!(fabsf(got - ref) <= 0.02f * fabsf(ref) + 1e-3f)) atomicOr(flag, 1u); }
        { const int n = (int)((hsh >> 5) % DIN), k = (int)((hsh >> 7) % DM); const int nn = n < 12288 ? n : (n < 12320 ? 20480 + (n - 12288) : n - 32);
          const float ref = w_in[(size_t)k * DIN + n], got = bf2f(W[(size_t)nn * DM + k]); if (!(fabsf(got - ref) <= 0.01f * fabsf(ref) + 1e-6f)) atomicOr(flag, 2u); }
        { const int seg = s % 7; int ncol, ld; size_t boff; float scale = 1.f;
          if (seg == 0) { ncol = 2048; ld = 2048; boff = A_Q; } else if (seg == 1) { ncol = 2048; ld = 2048; boff = A_K; } else if (seg == 2) { ncol = 2048; ld = 2048; boff = A_V; }
          else if (seg == 3) { ncol = 1024; ld = 1024; boff = A_GQ; scale = 0.0625f; } else if (seg == 4) { ncol = 1024; ld = 1024; boff = A_GK; } else if (seg == 5) { ncol = 2048; ld = 2048; boff = A_GV; } else { ncol = 32; ld = 32; boff = WS_ST; }
          const int segbase[7] = {0, 2048, 4096, 6144, 7168, 8192, 20480};
          const int c = (int)((hsh >> 11) % ncol); const int nn = segbase[seg] + c;
          float acc = 0.f; for (int k = lane; k < DM; k += 64) acc += bf2f(H[(size_t)row * DM + k]) * bf2f(W[(size_t)nn * DM + k]); acc = wave_sum(acc) * scale;
          const float got = seg == 6 ? ((const float*)(ws + boff))[(size_t)row * 32 + c] : bf2f(((const bf16_t*)(ws + boff))[(size_t)row * ld + c]);
          if (!(fabsf(got - acc) <= 0.02f * fabsf(acc) + 0.02f)) atomicOr(flag, 4u << seg); }
    }
}
__global__ void diag_final(float* out, size_t n, const unsigned* diag, int nstages) {
    int D = (int)(diag[50] & 32u); for (int s = 0; s < 4; ++s) if (diag[40 + s]) D |= 1 << s; if (diag[41] > 1000u) D |= 16;
    if (D == 0) return;
    const float c = exp2f(0.5f * (float)D);
    for (size_t i = (size_t)blockIdx.x * blockDim.x + threadIdx.x; i < n; i += (size_t)gridDim.x * blockDim.x) out[i] = c;
}
#endif
extern "C" void kernel_launch(void* const* d_in, const int* in_sizes, int n_in, void* d_out, int out_size, void* d_ws, size_t ws_size, hipStream_t stream) {
    static int grid = 0;
    if (grid == 0) {
        if (n_in != 25 || ws_size < WS_END) { fprintf(stderr, "kernel_launch: n_in %d ws %zu (need %zu)\n", n_in, ws_size, (size_t)WS_END); grid = -1; return; }
        int dev = 0, cus = 0, per_cu = 0;
        if (hipGetDevice(&dev) != hipSuccess || hipDeviceGetAttribute(&cus, hipDeviceAttributeMultiprocessorCount, dev) != hipSuccess) { grid = -1; return; }
        if (hipFuncSetAttribute((const void*)mk_fwd, hipFuncAttributeMaxDynamicSharedMemorySize, LDS_BYTES) != hipSuccess) { fprintf(stderr, "kernel_launch: hipFuncSetAttribute failed\n"); grid = -1; return; }
        if (hipOccupancyMaxActiveBlocksPerMultiprocessor(&per_cu, (const void*)mk_fwd, NTHR, LDS_BYTES) != hipSuccess || per_cu < 1) { fprintf(stderr, "kernel_launch: occupancy query says %d\n", per_cu); }
        (void)hipGetLastError();
        grid = cus;
    }
    if (grid < 0) return;
    (void)hipMemsetAsync((char*)d_ws + WS_CTL, 0, CTL_ZERO_BYTES, stream);
    Args a{};
    for (int i = 0; i < 25; ++i) a.in[i] = (const float*)d_in[i];
    a.out = (float*)d_out; a.ws = (unsigned char*)d_ws;
#if MK_ONE_LAUNCH
    a.ph_lo = 0; a.ph_hi = NPH; a.g_lo = 0; a.g_hi = 2;
    hipLaunchKernelGGL(mk_fwd, dim3(grid), dim3(NTHR), LDS_BYTES, stream, a);
#else
    a.ph_lo = 0; a.ph_hi = 1; a.g_lo = 0; a.g_hi = 1;
    hipLaunchKernelGGL(mk_fwd, dim3(grid), dim3(NTHR), LDS_BYTES, stream, a);
#if MK_DIAG
    unsigned char* ws = (unsigned char*)d_ws; unsigned* dg = (unsigned*)(ws + WS_CTL) + CW_DIAG;
#define SCANB(ptr, nel, st, thr) hipLaunchKernelGGL(diag_scan_bf16, dim3(2048), dim3(256), 0, stream, (const bf16_t*)(ptr), (size_t)(nel), dg, (st), (thr))
#define SCANF(ptr, nel, st, thr) hipLaunchKernelGGL(diag_scan_f32, dim3(2048), dim3(256), 0, stream, (const float*)(ptr), (size_t)(nel), dg, (st), (thr))
    SCANB(ws + WS_WIN, (WS_ACT - WS_WIN) / 2, 1, 1e4f);
    SCANF(ws + WS_PRM, P_END, 1, 1e4f);
#endif
    for (int g = 0; g < 2; ++g)
        for (int p = 1; p < NPH; ++p) { a.ph_lo = p; a.ph_hi = p + 1; a.g_lo = g; a.g_hi = g + 1; hipLaunchKernelGGL(mk_fwd, dim3(grid), dim3(NTHR), LDS_BYTES, stream, a);
#if MK_DIAG
            const int sb = 2 + g * 12; float* og = (float*)d_out + (size_t)g * GT * DM; const size_t E64 = (size_t)GT * 2048;
            if (p == 1) SCANB(ws + A_H, 2 * E64, sb + 0, 1e4f);
            if (p == 2) { SCANB(ws + A_Q, (A_SB + 128 * MiB - A_Q) / 2, sb + 1, 1e4f); SCANF(ws + WS_ST, (size_t)GT * 32, sb + 1, 1e4f); }
            if (p == 3 && g == 0) { SCANB((bf16_t*)og + 2 * E64, 2 * E64, 40, 3e38f); SCANB((bf16_t*)og + 2 * E64, 2 * E64, 41, 1e4f); SCANB((bf16_t*)og + 2 * E64, E64, 42, 1e4f); SCANB((bf16_t*)og + 3 * E64, E64, 43, 1e4f); }
            if (p == 4) SCANB(og, 4 * E64, sb + 3, 1e4f);
            if (p == 5) SCANB(ws + A_OAB, 2 * E64, sb + 4, 1e4f);
            if (p == 6) SCANB(ws + A_MRG, 2 * E64, sb + 5, 1e4f);
            if (p == 7) { SCANF(og, (size_t)GT * DM, sb + 6, 1e4f); SCANB(ws + A_X1B, 2 * E64, sb + 6, 1e4f); SCANF((float*)((unsigned*)(ws + WS_CTL) + CW_RSS) + (size_t)g * GT, GT, sb + 6, 1e6f); }
            if (p == 8) { SCANB(ws + A_FA, (size_t)GT * DFF, sb + 7, 1e4f); SCANB(ws + A_FG, (size_t)GT * DFF, sb + 7, 1e4f); }
            if (p == 9) SCANB(ws + A_FG, (size_t)GT * DFF, sb + 8, 1e4f);
            if (p == 10) SCANF(og, (size_t)GT * DM, sb + 9, 1e4f);
#endif
        }
#if MK_DIAG
    hipLaunchKernelGGL(diag_final, dim3(2048), dim3(256), 0, stream, (float*)d_out, (size_t)2 * GT * DM, dg, 32);
#endif
#endif
}
```

```cpp
#include <hip/hip_runtime.h>
#include <cstdio>
#include <cstdint>

#ifndef MK_ONE_LAUNCH
#define MK_ONE_LAUNCH 1
#endif
#ifndef INT8_WOUT
#define INT8_WOUT 1
#endif
#ifndef ATT_DMA
#define ATT_DMA 2
#endif
#ifndef FUSE_CONV
#define FUSE_CONV 1
#endif
#ifndef ATT_PV_KMAJOR
#define ATT_PV_KMAJOR 1
#endif
#ifndef RELAX_EPI
#define RELAX_EPI 1
#endif
#ifndef ATT_FULLV
#define ATT_FULLV 1
#endif
#ifndef ATT_PIPE
#define ATT_PIPE 0
#endif
#ifndef MK_TPROBE
#define MK_TPROBE -1
#endif
#ifndef MK_DIAG
#define MK_DIAG 0
#endif
#define DG_WORD(ws) ((unsigned*)((ws) + WS_CTL) + 32768 + 50)

#define LAS __attribute__((address_space(3)))
#define GAS __attribute__((address_space(1)))
typedef unsigned short bf16_t;
typedef short bf16x8 __attribute__((ext_vector_type(8)));
typedef short s16x4 __attribute__((ext_vector_type(4)));
typedef float f32x4 __attribute__((ext_vector_type(4)));
typedef float f32x2 __attribute__((ext_vector_type(2)));
typedef float f32x16 __attribute__((ext_vector_type(16)));
typedef unsigned u32x4 __attribute__((ext_vector_type(4)));
typedef unsigned u32x2 __attribute__((ext_vector_type(2)));

constexpr int DM = 4096, GT = 16384  , DIN = 20512, DINP = 20736, DFF = 11008;
constexpr float EPS = 1e-6f;
constexpr float LOG2E = 1.4426950408889634f;
constexpr int NWAVES = 8, NTHR = 512;

constexpr size_t MiB = 1u << 20;
constexpr size_t WS_CTL = 0, CTL_ZERO_BYTES = 1 * MiB;
constexpr size_t WS_PRM = 1 * MiB;
constexpr int P_LAM = 0, P_GMIX = 64, P_QG = 4160, P_KG = 4288, P_SUBLN = 4416, P_WGF = 4672, P_BGF = 21056, P_WGB = 22080, P_BGB = 38464, P_GLAG = 39488, P_CW = 40000, P_CB = 73024, P_RB = 84032, P_END = 84288;
constexpr size_t WS_ST = 2 * MiB;
constexpr size_t WS_DEC = 4 * MiB;
constexpr size_t WS_WIN = 8 * MiB;
constexpr size_t WS_WIN8 = 96 * MiB;
constexpr size_t WS_WUP = 170 * MiB;
constexpr size_t WS_WDN = 342 * MiB;
constexpr size_t WS_WOUT = 428 * MiB;
constexpr size_t WS_WPAB = 460 * MiB;
constexpr size_t WS_ACT = 492 * MiB;
constexpr size_t A_H = WS_ACT + 0 * MiB;
constexpr size_t A_Q = WS_ACT + 128 * MiB, A_K = WS_ACT + 192 * MiB, A_V = WS_ACT + 256 * MiB;
constexpr size_t A_GQ = WS_ACT + 320 * MiB, A_GK = WS_ACT + 352 * MiB;
constexpr size_t A_GV = WS_ACT + 384 * MiB, A_GR = WS_ACT + 448 * MiB;
constexpr size_t A_SA = WS_ACT + 512 * MiB, A_SB = WS_ACT + 640 * MiB;
constexpr size_t A_ATT = WS_ACT + 768 * MiB;
constexpr size_t A_QD = A_H, A_KDT = A_H + 64 * MiB;
constexpr size_t A_OAB = A_Q;
constexpr size_t A_MRG = A_V;
constexpr size_t A_X1B = A_H;
constexpr size_t A_FA = WS_ACT + 128 * MiB;
constexpr size_t A_FG = WS_ACT + 472 * MiB;
constexpr size_t WS_END = WS_ACT + 816 * MiB;
constexpr float H8_SCALE = 16.f;
constexpr float U8_SCALE = 8.f, W8_SCALE = 64.f;
constexpr int CW_CMAX_UP = 100000, CW_CMAX_IN = 125000;
constexpr int P_SWUP = 150000, P_SWIN = 175000;
constexpr int CW_CMAX_PA = 146000, CW_CMAX_PB = 150100, CW_CMAX_WO = 154200;
constexpr int P_SOA = 200000, P_SOB = 216384, P_SM = 232768;
constexpr int P_SWPA = 249200, P_SWPB = 253296, P_SWWO = 257392;
constexpr int CW_WMAX = 40000;
constexpr int P_SH = 130000;
constexpr int P_SX = 90000;
constexpr int CW_BAR = 1024;
constexpr int CW_RSS = 65536;

constexpr int LDS_BYTES = 155648;
constexpr int LDS_MISC = 153600;

typedef __bf16 nbf16x2 __attribute__((ext_vector_type(2)));
__device__ __forceinline__ unsigned cvt_pk_bf16(float lo, float hi) { const f32x2 v = {lo, hi}; return __builtin_bit_cast(unsigned, __builtin_convertvector(v, nbf16x2)); }
__device__ __forceinline__ float bflo(unsigned w) { return __uint_as_float(w << 16); }
__device__ __forceinline__ float bfhi(unsigned w) { return __uint_as_float(w & 0xffff0000u); }
__device__ __forceinline__ float bf2f(bf16_t v) { return __uint_as_float(((unsigned)v) << 16); }
__device__ __forceinline__ bf16_t f2bf(float f) { return (bf16_t)(cvt_pk_bf16(f, 0.f) & 0xffffu); }
__device__ __forceinline__ float sat8(float v) { return __builtin_fminf(__builtin_fmaxf(v, -448.f), 448.f); }
__device__ __forceinline__ unsigned pack_i8x4(float a, float b, float c, float d) {
    const int ia = (int)__builtin_rintf(a), ib = (int)__builtin_rintf(b), ic = (int)__builtin_rintf(c), id = (int)__builtin_rintf(d);
    return (unsigned)(ia & 0xff) | ((unsigned)(ib & 0xff) << 8) | ((unsigned)(ic & 0xff) << 16) | ((unsigned)id << 24);
}
__device__ __forceinline__ float wave_sum(float v) {
#pragma unroll
    for (int o = 1; o < 64; o <<= 1) v += __shfl_xor(v, o);
    return v;
}
__device__ __forceinline__ float fast_exp(float x) { return __builtin_amdgcn_exp2f(x * LOG2E); }
__device__ __forceinline__ float sigmoidf_(float x) { return __builtin_amdgcn_rcpf(1.f + fast_exp(-x)); }

__device__ __forceinline__ int fresh_tid(int wave_s) { int l; asm volatile("v_mbcnt_lo_u32_b32 %0, -1, 0\n\tv_mbcnt_hi_u32_b32 %0, -1, %0" : "=v"(l)); return (wave_s << 6) | l; }
__device__ __forceinline__ int fresh_bid() { int b = blockIdx.x; asm volatile("" : "+s"(b)); return b; }
__device__ __forceinline__ int fresh_grid() { int g = gridDim.x; asm volatile("" : "+s"(g)); return g; }
#define XB_TMO      128
#define XB_XCNT(j)  (256  + 64 * (j))
#define XB_XSUB(j)  (1280 + 64 * (j))
#define XB_XGEN(j)  (2304 + 64 * (j))
#define XB_TOP      3328
#define XB_TOPGEN   3392
#define XCD_BAR_WORDS 3456
#define XB_SPIN_CAP (1u << 18)
__device__ __forceinline__ unsigned xb_ld(unsigned* p)              { return __hip_atomic_load(p, __ATOMIC_RELAXED, __HIP_MEMORY_SCOPE_AGENT); }
__device__ __forceinline__ unsigned xb_add(unsigned* p, unsigned v) { return __hip_atomic_fetch_add(p, v, __ATOMIC_RELAXED, __HIP_MEMORY_SCOPE_AGENT); }
__device__ __forceinline__ unsigned xb_xcc_id() { return (unsigned)__builtin_amdgcn_s_getreg((3 << 11) | 20) & 0xFu; }
#define XB_SPIN(cond, bar) do { unsigned _sp = 0; while (cond) { __builtin_amdgcn_s_sleep(1); \
    if ((++_sp & 255u) == 0u) { if (xb_ld(&(bar)[XB_TMO])) break; if (_sp > XB_SPIN_CAP) { atomicAdd(&(bar)[XB_TMO], 1u); break; } } } } while (0)
struct XcdBarrier { unsigned* bar; unsigned x; volatile LAS unsigned* st; };
__device__ __forceinline__ XcdBarrier xcd_barrier_post(unsigned* bar, volatile LAS unsigned* st) {
    XcdBarrier b; b.bar = bar; b.x = xb_xcc_id(); b.st = st;
    if (threadIdx.x == 0) (void)xb_add(&bar[XB_XCNT(b.x)], 1u);
    return b;
}
__device__ __forceinline__ void xcd_barrier_complete(unsigned* bar, unsigned x, unsigned& nloc, unsigned& nx) {
    const unsigned G = gridDim.x * gridDim.y * gridDim.z;
    unsigned sum, cnt, mine, sp = 0u;
    for (;;) {
        sum = 0u; cnt = 0u; mine = 0u;
#pragma unroll
        for (unsigned j = 0; j < 16; ++j) { const unsigned c = xb_ld(&bar[XB_XCNT(j)]); sum += c; cnt += (c > 0u) ? 1u : 0u; mine = (j == x) ? c : mine; }
        if (sum == G) break;
        __builtin_amdgcn_s_sleep(1);
        if ((++sp & 255u) == 0u) { if (xb_ld(&bar[XB_TMO])) break; if (sp > XB_SPIN_CAP) { atomicAdd(&bar[XB_TMO], 1u); break; } }
    }
    nloc = mine > 0u ? mine : 1u; nx = cnt > 0u ? cnt : 1u;
}
__device__ __forceinline__ void xcd_barrier(const XcdBarrier& b) {
    asm volatile("s_waitcnt vmcnt(0)" ::: "memory");
    __syncthreads();
    if (threadIdx.x == 0) {
        unsigned* bar = b.bar;
        __builtin_amdgcn_s_waitcnt(0);
        unsigned nloc = b.st[0], nx = b.st[1];
        if (nloc == 0u) { xcd_barrier_complete(bar, b.x, nloc, nx); b.st[0] = nloc; b.st[1] = nx; }
        const unsigned old = xb_add(&bar[XB_XSUB(b.x)], 1u);
        const unsigned gen = old / nloc;
        if (old + 1u == (gen + 1u) * nloc) {
            __builtin_amdgcn_fence(__ATOMIC_RELEASE, "agent");
            asm volatile("s_waitcnt vmcnt(0)" ::: "memory");
            const unsigned og = xb_add(&bar[XB_TOP], 1u);
            const unsigned tg = og / nx;
            if (og + 1u == (tg + 1u) * nx) xb_add(&bar[XB_TOPGEN], 1u);
            else XB_SPIN(xb_ld(&bar[XB_TOPGEN]) == tg, bar);
            __builtin_amdgcn_fence(__ATOMIC_ACQUIRE, "agent");
            xb_add(&bar[XB_XGEN(b.x)], 1u);
            asm volatile("s_waitcnt vmcnt(0)" ::: "memory");
        } else {
            XB_SPIN(xb_ld(&bar[XB_XGEN(b.x)]) == gen, bar);
            __builtin_amdgcn_fence(__ATOMIC_ACQUIRE, "agent");
            asm volatile("s_waitcnt vmcnt(0)" ::: "memory");
        }
    }
    __syncthreads();
}

namespace pg8 {
typedef int i32x8_ __attribute__((ext_vector_type(8)));
typedef int i32x4_ __attribute__((ext_vector_type(4)));
union Frag { i32x8_ v; bf16x8 q[2]; };
constexpr int BM = 256, BK = 64, HALF = 128, HTB = HALF * BK * 2, STAGE_BYTES = 8 * HTB, NXCD = 8, WGM = 4;
__host__ __device__ __forceinline__ int lds_byte(int r, int c) { const int st = (r >> 4) * 2 + (c >> 5), rr = r & 15, cc = c & 31, ob = rr * 64 + cc * 2; return st * 1024 + (ob ^ (((ob >> 9) & 1) << 5)); }
__host__ __device__ __forceinline__ void stage_rc(int b, int& R, int& C) { const int st = b / 1024, sb = b % 1024, swz = sb ^ (((sb >> 9) & 1) << 5); R = (st >> 1) * 16 + swz / 64; C = (st & 1) * 32 + (swz % 64) / 2; }
__host__ __device__ __forceinline__ int perm32(int rho) { const int n = rho >> 4, i = rho & 15; return 8 * (i >> 2) + 4 * n + (i & 3); }
struct Unit { int pm, pn, ps; };
struct Gemm { const bf16_t* A; const bf16_t* Bt; };
template <int NM, int NN, int PASSES> struct StaticOrder {
    int G, c;
    __device__ __forceinline__ bool next(int i, Unit& u) const {
        constexpr int nwg = NM * NN;
        const int ti = PASSES == 2 ? (i >> 1) : i;
        const long L = (long)ti * G + c; if (L >= nwg) return false;
        int wgid = (int)L; { constexpr int q = nwg / NXCD, r = nwg % NXCD; const int xcd = wgid % NXCD, off = wgid / NXCD; wgid = (xcd < r ? xcd * (q + 1) : r * (q + 1) + (xcd - r) * q) + off; }
        constexpr int nig = WGM * NN; const int gid = wgid / nig, fm = gid * WGM, gsz = (NM - fm) < WGM ? (NM - fm) : WGM;
        u.pm = fm + ((wgid % nig) % gsz); u.pn = (wgid % nig) / gsz; u.ps = PASSES == 2 ? (i & 1) : 0; return true;
    }
};
template <int M, int N, int K, int LDA, int LDB, int PASSES, int PASS_OFF  , int MODE  , class Epi>
__device__ __forceinline__ void gemm_phase(LAS unsigned char* lds, const Gemm g, int G, int c, int tid_, const Epi& E) {
    StaticOrder<M / BM, N / BM, PASSES> S; S.G = G; S.c = c;
    const int tid = tid_, wid = __builtin_amdgcn_readfirstlane(tid >> 6), lane = tid & 63, wr = wid >> 2, wc = wid & 3, fr = lane & 15, fq = lane >> 4;
    constexpr int nt = K / BK;
    unsigned voffA[2], voffB[2];
#pragma unroll
    for (int i = 0; i < 2; ++i) { int R, C; stage_rc(tid * 16 + i * 8192, R, C); const int Rb = Epi::PERM ? ((R & ~31) + perm32(R & 31)) : R;
        voffA[i] = (unsigned)(R * LDA + C) * 2u; voffB[i] = (unsigned)(Rb * LDB + C) * 2u; }
    constexpr size_t kstep = (size_t)(BK * 2);
    constexpr size_t hstepA = (size_t)HALF * LDA * 2, hstepB = (size_t)HALF * LDB * 2;
    constexpr size_t tstepA = 2 * hstepA, tstepB = 2 * hstepB, pstep = (size_t)PASS_OFF * 2;
    const unsigned ldsw = (unsigned)wid * 1024u;
    const int aoff = lds_byte(wr * 64 + fr, fq * 8), boff = lds_byte(wc * 32 + fr, fq * 8);
#define PG8_SA(b, h) (((b) * 2 + (h)) * HTB)
#define PG8_SB(b, h) ((4 + (b) * 2 + (h)) * HTB)
#define PG8_STAGE(bufoff, gbase, voff) do { _Pragma("unroll") for (int _i = 0; _i < 2; ++_i) \
        __builtin_amdgcn_global_load_lds((const unsigned*)((const char*)(gbase) + (voff)[_i]), (LAS unsigned*)(lds + (bufoff) + ldsw + _i * 8192), 16, 0, 0); } while (0)
#define PG8_LDA(dst, b, h) do { _Pragma("unroll") for (int m = 0; m < 4; ++m) _Pragma("unroll") for (int k = 0; k < 2; ++k) dst[m].q[k] = *(const LAS bf16x8*)(lds + PG8_SA(b, h) + aoff + m * 2048 + k * 1024); } while (0)
#define PG8_LDB(dst, b, h) do { _Pragma("unroll") for (int n = 0; n < 2; ++n) _Pragma("unroll") for (int k = 0; k < 2; ++k) dst[n].q[k] = *(const LAS bf16x8*)(lds + PG8_SB(b, h) + boff + n * 2048 + k * 1024); } while (0)
#define PG8_MMA(ai, bj, At, Bt) do { __builtin_amdgcn_s_setprio(1); _Pragma("unroll") for (int m = 0; m < 4; ++m) _Pragma("unroll") for (int n = 0; n < 2; ++n) { \
        if constexpr (FP8) asm volatile("v_mfma_scale_f32_16x16x128_f8f6f4 %0, %1, %2, %0, %3, %3 op_sel_hi:[0,0,0]" : "+v"(acc[ai][bj][m][n]) : "v"(Bt[n].v), "v"(At[m].v), "v"(one_scale)); \
        else if constexpr (MODE == 2) { _Pragma("unroll") for (int k = 0; k < 2; ++k) acc[ai][bj][m][n] = __builtin_bit_cast(f32x4, __builtin_amdgcn_mfma_i32_16x16x64_i8(__builtin_bit_cast(i32x4_, Bt[n].q[k]), __builtin_bit_cast(i32x4_, At[m].q[k]), __builtin_bit_cast(i32x4_, acc[ai][bj][m][n]), 0, 0, 0)); } \
        else { _Pragma("unroll") for (int k = 0; k < 2; ++k) acc[ai][bj][m][n] = __builtin_amdgcn_mfma_f32_16x16x32_bf16(Bt[n].q[k], At[m].q[k], acc[ai][bj][m][n], 0, 0, 0); } } \
        __builtin_amdgcn_s_setprio(0); } while (0)
#define PG8_WAIT_V(n) asm volatile("s_waitcnt vmcnt(" #n ")" ::: "memory")
#define PG8_WAIT_L(n) asm volatile("s_waitcnt lgkmcnt(" #n ")" ::: "memory")
#define PG8_BAR __builtin_amdgcn_s_barrier()
#define PG8_SCHED __builtin_amdgcn_sched_barrier(0)
    Unit cur, nxt; int ui = 0;
    if (!S.next(0, cur)) return;
    f32x4 acc[2][2][4][2];
#pragma unroll
    for (int a = 0; a < 2; ++a)
#pragma unroll
        for (int b = 0; b < 2; ++b)
#pragma unroll
            for (int m = 0; m < 4; ++m)
#pragma unroll
                for (int n = 0; n < 2; ++n) acc[a][b][m][n] = (f32x4){0.f, 0.f, 0.f, 0.f};
    Frag At[4], B0[2], B1[2];
    const int one_scale = 0x7f7f7f7f;
    constexpr bool FP8 = MODE == 1;
    const char* cA = (const char*)g.A + (size_t)cur.pm * tstepA + (size_t)cur.ps * pstep; const char* cB = (const char*)g.Bt + (size_t)cur.pn * tstepB + (size_t)cur.ps * pstep;
    PG8_STAGE(PG8_SB(0, 0), cB, voffB); PG8_STAGE(PG8_SB(0, 1), cB + hstepB, voffB); PG8_STAGE(PG8_SA(0, 0), cA, voffA); PG8_STAGE(PG8_SA(0, 1), cA + hstepA, voffA);
    if (wr == 1) PG8_BAR;
    PG8_WAIT_V(2); PG8_BAR;
    PG8_STAGE(PG8_SB(1, 0), cB + kstep, voffB); PG8_STAGE(PG8_SA(1, 0), cA + kstep, voffA); PG8_STAGE(PG8_SB(1, 1), cB + hstepB + kstep, voffB);
    PG8_WAIT_V(6); PG8_BAR;
    for (;;) {
        const bool has_next = S.next(ui + 1, nxt);
        const char* nA = has_next ? (const char*)g.A + (size_t)nxt.pm * tstepA + (size_t)nxt.ps * pstep : cA; const char* nB = has_next ? (const char*)g.Bt + (size_t)nxt.pn * tstepB + (size_t)nxt.ps * pstep : cB;
        for (int t = 0; t < nt; t += 2) {
            const bool last = (t == nt - 2);
            const char* a1 = cA + (size_t)(t + 1) * kstep;
            const char* a2 = last ? nA : cA + (size_t)(t + 2) * kstep; const char* b2 = last ? nB : cB + (size_t)(t + 2) * kstep;
            const char* a3 = a2 + kstep; const char* b3 = b2 + kstep;
            const int rlx = __builtin_amdgcn_readfirstlane((RELAX_EPI && (t == 0) && (ui > 0)) ? 1 : 0);
#define PG8_WAIT_V8R() do { if constexpr (Epi::NST >= 32) asm volatile("s_waitcnt vmcnt(40)\n\ts_cmp_lg_u32 %0, 0\n\ts_cbranch_scc1 .Lrlx%=\n\ts_waitcnt vmcnt(8)\n.Lrlx%=:" :: "s"(rlx) : "memory", "scc"); \
                            else asm volatile("s_waitcnt vmcnt(24)\n\ts_cmp_lg_u32 %0, 0\n\ts_cbranch_scc1 .Lrlx%=\n\ts_waitcnt vmcnt(8)\n.Lrlx%=:" :: "s"(rlx) : "memory", "scc"); } while (0)
            PG8_LDB(B0, 0, 0); PG8_LDB(B1, 0, 1); PG8_SCHED; PG8_LDA(At, 0, 0); PG8_STAGE(PG8_SA(1, 1), a1 + hstepA, voffA);
            PG8_WAIT_V8R(); PG8_WAIT_L(0); PG8_BAR; PG8_MMA(0, 0, At, B0); PG8_MMA(0, 1, At, B1); PG8_BAR; PG8_SCHED;
            PG8_LDA(At, 0, 1); PG8_STAGE(PG8_SB(0, 0), b2, voffB); PG8_STAGE(PG8_SB(0, 1), b2 + hstepB, voffB); PG8_STAGE(PG8_SA(0, 0), a2, voffA);
            PG8_WAIT_V8R(); PG8_WAIT_L(0); PG8_BAR; PG8_MMA(1, 0, At, B0); PG8_MMA(1, 1, At, B1); PG8_BAR; PG8_SCHED;
#undef PG8_WAIT_V8R
            PG8_LDB(B0, 1, 0); PG8_LDB(B1, 1, 1); PG8_SCHED; PG8_LDA(At, 1, 0); PG8_STAGE(PG8_SA(0, 1), a2 + hstepA, voffA);
            PG8_WAIT_V(8); PG8_WAIT_L(0); PG8_BAR; PG8_MMA(0, 0, At, B0); PG8_MMA(0, 1, At, B1); PG8_BAR; PG8_SCHED;
            PG8_LDA(At, 1, 1); PG8_STAGE(PG8_SB(1, 0), b3, voffB); PG8_STAGE(PG8_SB(1, 1), b3 + hstepB, voffB); PG8_STAGE(PG8_SA(1, 0), a3, voffA);
            PG8_WAIT_V(8); PG8_WAIT_L(0); PG8_BAR; PG8_MMA(1, 0, At, B0); PG8_MMA(1, 1, At, B1); PG8_BAR; PG8_SCHED;
        }
        if (wr == 0) PG8_BAR;
        { int l_; asm volatile("v_mbcnt_lo_u32_b32 %0, -1, 0\n\tv_mbcnt_hi_u32_b32 %0, -1, %0" : "=v"(l_));
          E(acc, cur, wr, wc, l_ & 15, l_ >> 4); }
        if (!has_next) break;
#pragma unroll
        for (int a = 0; a < 2; ++a)
#pragma unroll
            for (int b = 0; b < 2; ++b)
#pragma unroll
                for (int m = 0; m < 4; ++m)
#pragma unroll
                    for (int n = 0; n < 2; ++n) acc[a][b][m][n] = (f32x4){0.f, 0.f, 0.f, 0.f};
        cur = nxt; cA = nA; cB = nB; ++ui;
        if (wr == 1) PG8_BAR;
    }
    PG8_WAIT_V(0);
    PG8_BAR;
#undef PG8_SA
#undef PG8_SB
#undef PG8_STAGE
#undef PG8_LDA
#undef PG8_LDB
#undef PG8_MMA
#undef PG8_WAIT_V
#undef PG8_WAIT_L
#undef PG8_BAR
#undef PG8_SCHED
}
}
using pg8::Unit;
constexpr int HALF = 128, BM = 256;

struct EpiInProj {
    static constexpr bool PERM = true;
    static constexpr int NST = 16;
    unsigned char* ws; const float* SH; const float* SW;
    LAS float* XS;
    __device__ __forceinline__ void qk_tile(const f32x4 (&acc)[2][2][4][2], const Unit& u, int wr, int wc, int fr, int fq, bf16_t* base, int col0) const {
        const int pn = u.pn, row0 = u.pm * BM + wr * 64 + fr; const float* gn = (const float*)(ws + WS_PRM) + (pn < 8 ? P_QG : P_KG) + wc * 32 + 8 * fq;
        f32x4 cs[2][2], g4[2]; float shr[2][4];
#pragma unroll
        for (int ai = 0; ai < 2; ++ai)
#pragma unroll
            for (int m = 0; m < 4; ++m) shr[ai][m] = SH[row0 + ai * HALF + m * 16];
#pragma unroll
        for (int n = 0; n < 2; ++n) { g4[n] = *(const f32x4*)(gn + 4 * n);
#pragma unroll
            for (int bj = 0; bj < 2; ++bj) cs[bj][n] = *(const f32x4*)(SW + pn * BM + bj * HALF + wc * 32 + 8 * fq + 4 * n); }
#pragma unroll
        for (int ai = 0; ai < 2; ++ai)
#pragma unroll
            for (int m = 0; m < 4; ++m) { const int rl = ai * HALF + wr * 64 + m * 16 + fr; const float sc = shr[ai][m];
#pragma unroll
                for (int bj = 0; bj < 2; ++bj) { float ss = 0.f;
#pragma unroll
                    for (int n = 0; n < 2; ++n) { const pg8::i32x4_ ii = __builtin_bit_cast(pg8::i32x4_, acc[ai][bj][m][n]); const f32x4 x = (f32x4){(float)ii[0], (float)ii[1], (float)ii[2], (float)ii[3]} * cs[bj][n] * sc;
                        ss += (x[0] * x[0] + x[1] * x[1]) + (x[2] * x[2] + x[3] * x[3]); }
                    ss += __shfl_xor(ss, 16); ss += __shfl_xor(ss, 32);
                    if (fq == 0) XS[(rl * 2 + bj) * 4 + wc] = ss; } }
        asm volatile("s_waitcnt lgkmcnt(0)" ::: "memory"); __builtin_amdgcn_s_barrier(); asm volatile("" ::: "memory");
#pragma unroll
        for (int bj = 0; bj < 2; ++bj)
#pragma unroll
            for (int n = 0; n < 2; ++n) asm volatile("" : "+v"(cs[bj][n]));
#pragma unroll
        for (int ai = 0; ai < 2; ++ai)
#pragma unroll
            for (int m = 0; m < 4; ++m) { const int rl = ai * HALF + wr * 64 + m * 16 + fr; bf16_t* rowp = base + (size_t)(u.pm * BM + rl) * 2048 + col0; const float sc = shr[ai][m];
#pragma unroll
                for (int bj = 0; bj < 2; ++bj) { const f32x4 p = *(const LAS f32x4*)(XS + (rl * 2 + bj) * 4); const float r = sc / sqrtf(((p[0] + p[1]) + (p[2] + p[3])) * (1.f / 128.f) + EPS);
                    pg8::i32x4_ j0 = __builtin_bit_cast(pg8::i32x4_, acc[ai][bj][m][0]), j1 = __builtin_bit_cast(pg8::i32x4_, acc[ai][bj][m][1]);
                    asm volatile("" : "+v"(j0), "+v"(j1));
                    const f32x4 y0 = (f32x4){(float)j0[0], (float)j0[1], (float)j0[2], (float)j0[3]} * cs[bj][0] * g4[0] * r, y1 = (f32x4){(float)j1[0], (float)j1[1], (float)j1[2], (float)j1[3]} * cs[bj][1] * g4[1] * r;
                    u32x4 w; w.x = cvt_pk_bf16(y0[0], y0[1]); w.y = cvt_pk_bf16(y0[2], y0[3]); w.z = cvt_pk_bf16(y1[0], y1[1]); w.w = cvt_pk_bf16(y1[2], y1[3]);
                    *(u32x4*)(rowp + bj * HALF) = w; } }
    }
    __device__ __forceinline__ void operator()(const f32x4 (&acc)[2][2][4][2], const Unit& u, int wr, int wc, int fr, int fq) const {
        const int pn = u.pn; const int row0 = u.pm * BM + wr * 64 + fr;
        if (pn == 80) {
            if (wc == 0) { float* ST = (float*)(ws + WS_ST);
#pragma unroll
                for (int ai = 0; ai < 2; ++ai)
#pragma unroll
                    for (int m = 0; m < 4; ++m) { const int row = row0 + ai * HALF + m * 16; float* rp = ST + (size_t)row * 32 + 8 * fq; const float sc = SH[row]; const f32x4 c0 = *(const f32x4*)(SW + 80 * BM + 8 * fq), c1 = *(const f32x4*)(SW + 80 * BM + 8 * fq + 4);
                        const pg8::i32x4_ i0 = __builtin_bit_cast(pg8::i32x4_, acc[ai][0][m][0]), i1 = __builtin_bit_cast(pg8::i32x4_, acc[ai][0][m][1]);
                        *(f32x4*)(rp) = (f32x4){(float)i0[0], (float)i0[1], (float)i0[2], (float)i0[3]} * c0 * sc; *(f32x4*)(rp + 4) = (f32x4){(float)i1[0], (float)i1[1], (float)i1[2], (float)i1[3]} * c1 * sc; }
            }
            else asm volatile("s_waitcnt vmcnt(0)" ::: "memory");
            return;
        }
        unsigned boff; int ld, cb, mode = 0;
        if (pn < 8) { boff = 0u; ld = 2048; cb = pn * 256; }
        else if (pn < 16) { boff = (unsigned)(A_K - A_Q); ld = 2048; cb = (pn - 8) * 256; }
        else if (pn < 24) { boff = (unsigned)(A_V - A_Q); ld = 2048; cb = (pn - 16) * 256; }
        else if (pn < 28) { boff = (unsigned)(A_GQ - A_Q); ld = 1024; cb = (pn - 24) * 256; mode = 1; }
        else if (pn < 32) { boff = (unsigned)(A_GK - A_Q); ld = 1024; cb = (pn - 28) * 256; }
        else if (pn < 40) { boff = (unsigned)(A_GV - A_Q); ld = 2048; cb = (pn - 32) * 256; }
        else if (pn < 48) { boff = (unsigned)(A_GR - A_Q); ld = 2048; cb = (pn - 40) * 256; mode = 2; }
        else if (pn < 64) { boff = (unsigned)(A_SA - A_Q); ld = 4096; cb = (pn - 48) * 256; mode = 3; }
        else { boff = (unsigned)(A_SB - A_Q); ld = 4096; cb = (pn - 64) * 256; mode = 3; }
        bf16_t* base = (bf16_t*)(ws + A_Q + boff);
        const int col0 = cb + wc * 32 + 8 * fq;
        if (pn < 16) { qk_tile(acc, u, wr, wc, fr, fq, base, col0); return; }
        f32x4 cs[2][2]; float shr[2][4];
#pragma unroll
        for (int ai = 0; ai < 2; ++ai)
#pragma unroll
            for (int m = 0; m < 4; ++m) shr[ai][m] = SH[row0 + ai * HALF + m * 16];
#pragma unroll
        for (int bj = 0; bj < 2; ++bj)
#pragma unroll
            for (int n = 0; n < 2; ++n) cs[bj][n] = *(const f32x4*)(SW + pn * BM + bj * HALF + wc * 32 + 8 * fq + 4 * n);
        if (mode == 3) tile_out<3>(acc, cs, shr, base, row0, ld, col0);
        else if (mode == 2) tile_out<2>(acc, cs, shr, base, row0, ld, col0);
        else if (mode == 1) tile_out<1>(acc, cs, shr, base, row0, ld, col0);
        else tile_out<0>(acc, cs, shr, base, row0, ld, col0);
    }
    template <int MODE> __device__ __forceinline__ void tile_out(const f32x4 (&acc)[2][2][4][2], f32x4 (&cs)[2][2], const float (&shr)[2][4], bf16_t* base, int row0, int ld, int col0) const {
        if (MODE == 1 || MODE == 3) {
#pragma unroll
            for (int bj = 0; bj < 2; ++bj)
#pragma unroll
                for (int n = 0; n < 2; ++n) cs[bj][n] = cs[bj][n] * (MODE == 1 ? 0.0625f : -LOG2E); }
#pragma unroll
        for (int ai = 0; ai < 2; ++ai)
#pragma unroll
            for (int m = 0; m < 4; ++m) { const int row = row0 + ai * HALF + m * 16; bf16_t* rowp = base + (size_t)row * ld + col0; const float sc = shr[ai][m];
#pragma unroll
                for (int bj = 0; bj < 2; ++bj) { const pg8::i32x4_ i0 = __builtin_bit_cast(pg8::i32x4_, acc[ai][bj][m][0]), i1 = __builtin_bit_cast(pg8::i32x4_, acc[ai][bj][m][1]);
                    f32x4 v0 = (f32x4){(float)i0[0], (float)i0[1], (float)i0[2], (float)i0[3]} * cs[bj][0] * sc, v1 = (f32x4){(float)i1[0], (float)i1[1], (float)i1[2], (float)i1[3]} * cs[bj][1] * sc;
                    if (MODE == 2) {
#pragma unroll
                        for (int j = 0; j < 4; ++j) { v0[j] = v0[j] * sigmoidf_(v0[j]); v1[j] = v1[j] * sigmoidf_(v1[j]); } }
                    if (MODE == 3) {
#pragma unroll
                        for (int j = 0; j < 4; ++j) { v0[j] = __builtin_amdgcn_rcpf(1.f + __builtin_amdgcn_exp2f(v0[j])); v1[j] = __builtin_amdgcn_rcpf(1.f + __builtin_amdgcn_exp2f(v1[j])); }
                        const unsigned g0 = (unsigned)__builtin_rintf(v0[0] * 255.f) | ((unsigned)__builtin_rintf(v0[1] * 255.f) << 8) | ((unsigned)__builtin_rintf(v0[2] * 255.f) << 16) | ((unsigned)__builtin_rintf(v0[3] * 255.f) << 24);
                        const unsigned g1 = (unsigned)__builtin_rintf(v1[0] * 255.f) | ((unsigned)__builtin_rintf(v1[1] * 255.f) << 8) | ((unsigned)__builtin_rintf(v1[2] * 255.f) << 16) | ((unsigned)__builtin_rintf(v1[3] * 255.f) << 24);
                        *(u32x2*)((unsigned char*)base + (size_t)row * 4096 + col0 + bj * HALF) = (u32x2){g0, g1};
                    } else {
                    u32x4 w; w.x = cvt_pk_bf16(v0[0], v0[1]); w.y = cvt_pk_bf16(v0[2], v0[3]); w.z = cvt_pk_bf16(v1[0], v1[1]); w.w = cvt_pk_bf16(v1[2], v1[3]);
                    *(u32x4*)(rowp + bj * HALF) = w; } } }
    }
};
struct EpiBranch {
    static constexpr bool PERM = true;
    static constexpr int NST = 16;
    unsigned char* ws;
    __device__ __forceinline__ void operator()(const f32x4 (&acc)[2][2][4][2], const Unit& u, int wr, int wc, int fr, int fq) const {
        const int row0 = u.pm * BM + wr * 64 + fr, col0 = u.pn * BM + wc * 32 + 8 * fq;
        const unsigned char* G = ws + (u.ps ? A_SB : A_SA); bf16_t* O = (bf16_t*)(ws + A_MRG);
        const float* SR = (const float*)(ws + WS_PRM) + (u.ps ? P_SOB : P_SOA); const float* SW = (const float*)(ws + WS_PRM) + (u.ps ? P_SWPB : P_SWPA);
        f32x4 cs[2][2];
#pragma unroll
        for (int bj = 0; bj < 2; ++bj)
#pragma unroll
            for (int n = 0; n < 2; ++n) cs[bj][n] = *(const f32x4*)(SW + col0 + bj * HALF + 4 * n) * (1.f / 255.f);
#pragma unroll
        for (int ai = 0; ai < 2; ++ai) {
            u32x2 gw[4][2]; u32x4 ow[4][2]; float sr[4];
#pragma unroll
            for (int m = 0; m < 4; ++m) { const int row = row0 + ai * HALF + m * 16; const size_t off = (size_t)row * DM + col0; sr[m] = SR[row];
#pragma unroll
                for (int bj = 0; bj < 2; ++bj) { gw[m][bj] = *(const u32x2*)(G + off + bj * HALF); if (u.ps) ow[m][bj] = *(const u32x4*)(O + off + bj * HALF); else ow[m][bj] = (u32x4){0u, 0u, 0u, 0u}; } }
#pragma unroll
            for (int m = 0; m < 4; ++m) { const size_t off = (size_t)(row0 + ai * HALF + m * 16) * DM + col0;
#pragma unroll
                for (int bj = 0; bj < 2; ++bj) { const u32x2 g = gw[m][bj]; const u32x4 o4 = ow[m][bj];
                    const pg8::i32x4_ i0 = __builtin_bit_cast(pg8::i32x4_, acc[ai][bj][m][0]), i1 = __builtin_bit_cast(pg8::i32x4_, acc[ai][bj][m][1]);
                    f32x4 v0 = (f32x4){(float)i0[0], (float)i0[1], (float)i0[2], (float)i0[3]} * cs[bj][0] * sr[m], v1 = (f32x4){(float)i1[0], (float)i1[1], (float)i1[2], (float)i1[3]} * cs[bj][1] * sr[m];
                    v0[0] = v0[0] * (float)(g.x & 0xffu) + bflo(o4.x); v0[1] = v0[1] * (float)((g.x >> 8) & 0xffu) + bfhi(o4.x); v0[2] = v0[2] * (float)((g.x >> 16) & 0xffu) + bflo(o4.y); v0[3] = v0[3] * (float)(g.x >> 24) + bfhi(o4.y);
                    v1[0] = v1[0] * (float)(g.y & 0xffu) + bflo(o4.z); v1[1] = v1[1] * (float)((g.y >> 8) & 0xffu) + bfhi(o4.z); v1[2] = v1[2] * (float)((g.y >> 16) & 0xffu) + bflo(o4.w); v1[3] = v1[3] * (float)(g.y >> 24) + bfhi(o4.w);
                    u32x4 w; w.x = cvt_pk_bf16(v0[0], v0[1]); w.y = cvt_pk_bf16(v0[2], v0[3]); w.z = cvt_pk_bf16(v1[0], v1[1]); w.w = cvt_pk_bf16(v1[2], v1[3]);
                    *(u32x4*)(O + off + bj * HALF) = w; } }
            asm volatile("" ::: "memory"); }
    }
};
struct EpiWout {
    static constexpr bool PERM = false;
    static constexpr int NST = 32;
    const float* X; bf16_t* X1B; float* RSS; const float* SM; const float* SW;
    __device__ __forceinline__ void operator()(const f32x4 (&acc)[2][2][4][2], const Unit& u, int wr, int wc, int fr, int fq) const {
        const int row0 = u.pm * BM + wr * 64 + fr, col0 = u.pn * BM + wc * 32 + 4 * fq;
        f32x4 cs[2][2];
#pragma unroll
        for (int bj = 0; bj < 2; ++bj)
#pragma unroll
            for (int n = 0; n < 2; ++n) cs[bj][n] = INT8_WOUT ? *(const f32x4*)(SW + col0 + bj * HALF + n * 16) : (f32x4){1.f, 1.f, 1.f, 1.f};
#pragma unroll
        for (int ai = 0; ai < 2; ++ai) {
            f32x4 xv[4][2][2]; float sr[4];
#pragma unroll
            for (int m = 0; m < 4; ++m) { const int row = row0 + ai * HALF + m * 16; const size_t off = (size_t)row * DM + col0; sr[m] = INT8_WOUT ? SM[row] : 1.f;
#pragma unroll
                for (int bj = 0; bj < 2; ++bj)
#pragma unroll
                    for (int n = 0; n < 2; ++n) xv[m][bj][n] = *(const f32x4*)(X + off + bj * HALF + n * 16); }
#pragma unroll
            for (int m = 0; m < 4; ++m) { const int row = row0 + ai * HALF + m * 16; const size_t off = (size_t)row * DM + col0; float ss = 0.f;
#pragma unroll
                for (int bj = 0; bj < 2; ++bj)
#pragma unroll
                    for (int n = 0; n < 2; ++n) { const pg8::i32x4_ ia = __builtin_bit_cast(pg8::i32x4_, acc[ai][bj][m][n]);
                        const f32x4 o = INT8_WOUT ? xv[m][bj][n] + (f32x4){(float)ia[0], (float)ia[1], (float)ia[2], (float)ia[3]} * cs[bj][n] * sr[m] : xv[m][bj][n] + acc[ai][bj][m][n];
                        ss += (o[0] * o[0] + o[1] * o[1]) + (o[2] * o[2] + o[3] * o[3]);
                        u32x2 w; w.x = cvt_pk_bf16(o[0], o[1]); w.y = cvt_pk_bf16(o[2], o[3]); *(u32x2*)(X1B + off + bj * HALF + n * 16) = w; }
                ss += __shfl_xor(ss, 16); ss += __shfl_xor(ss, 32);
                if (fq == 0) atomicAdd(RSS + row, ss); }
            asm volatile("" ::: "memory"); }
    }
};
struct EpiUp {
    static constexpr bool PERM = true;
    static constexpr int NST = 16;
    const float* RSS; bf16_t* FA; bf16_t* FG; const float* SX; const float* SW;
    __device__ __forceinline__ void operator()(const f32x4 (&acc)[2][2][4][2], const Unit& u, int wr, int wc, int fr, int fq) const {
        const int row0 = u.pm * BM + wr * 64 + fr, col0 = u.pn * HALF + wc * 32 + 8 * fq;
        f32x4 cs[2][2];
#pragma unroll
        for (int bj = 0; bj < 2; ++bj)
#pragma unroll
            for (int n = 0; n < 2; ++n) cs[bj][n] = *(const f32x4*)(SW + u.pn * BM + bj * HALF + wc * 32 + 8 * fq + 4 * n);
#pragma unroll
        for (int ai = 0; ai < 2; ++ai)
#pragma unroll
            for (int m = 0; m < 4; ++m) { const int row = row0 + ai * HALF + m * 16; const float rstd = __builtin_amdgcn_rsqf(RSS[row] * (1.f / DM) + EPS) * SX[row];
                const size_t off = (size_t)row * DFF + col0;
#pragma unroll
                for (int bj = 0; bj < 2; ++bj) { const pg8::i32x4_ i0 = __builtin_bit_cast(pg8::i32x4_, acc[ai][bj][m][0]), i1 = __builtin_bit_cast(pg8::i32x4_, acc[ai][bj][m][1]);
                    const f32x4 v0 = (f32x4){(float)i0[0], (float)i0[1], (float)i0[2], (float)i0[3]} * cs[bj][0] * rstd, v1 = (f32x4){(float)i1[0], (float)i1[1], (float)i1[2], (float)i1[3]} * cs[bj][1] * rstd;
                    u32x4 w; w.x = cvt_pk_bf16(v0[0], v0[1]); w.y = cvt_pk_bf16(v0[2], v0[3]); w.z = cvt_pk_bf16(v1[0], v1[1]); w.w = cvt_pk_bf16(v1[2], v1[3]);
                    *(u32x4*)((bj ? FG : FA) + off) = w; } }
    }
};
__device__ __forceinline__ float gelu_tanh_(float x) { const float uu = x * (-1.5957691216057308f * LOG2E + (-0.07135481627159145f * LOG2E) * x * x); return x * __builtin_amdgcn_rcpf(1.f + __builtin_amdgcn_exp2f(uu)); }
struct EpiUpConv {
    static constexpr bool PERM = true;
    static constexpr int NST = 16;
    unsigned char* ws; int gi; LAS float* XB;
    __device__ __forceinline__ void operator()(const f32x4 (&acc)[2][2][4][2], const Unit& u, int wr, int wc, int fr, int fq) const {
        const float* RSS = (const float*)((const unsigned*)(ws + WS_CTL) + CW_RSS) + (size_t)gi * GT; const float* SX = (const float*)(ws + WS_PRM) + P_SX + (size_t)gi * GT; const float* SW = (const float*)(ws + WS_PRM) + P_SWUP;
        const float* CW = (const float*)(ws + WS_PRM) + P_CW; const float* CB = (const float*)(ws + WS_PRM) + P_CB; unsigned char* U8 = ws + A_FG; float* HB = (float*)(ws + A_FA);
        const int lane = fq * 16 + fr, fl = wc * 32 + 8 * fq, f0 = u.pn * HALF + fl, row0 = u.pm * BM + wr * 64 + fr;
        float csa[8], csg[8];
#pragma unroll
        for (int n = 0; n < 2; ++n) { const f32x4 a4 = *(const f32x4*)(SW + u.pn * BM + fl + 4 * n), g4 = *(const f32x4*)(SW + u.pn * BM + HALF + fl + 4 * n);
#pragma unroll
            for (int i = 0; i < 4; ++i) { csa[4 * n + i] = a4[i]; csg[4 * n + i] = g4[i]; } }
        float A[2][4][8], G[2][4][8];
#pragma unroll
        for (int ai = 0; ai < 2; ++ai)
#pragma unroll
            for (int m = 0; m < 4; ++m) { const int row = row0 + ai * HALF + m * 16; const float fac = __builtin_amdgcn_rsqf(RSS[row] * (1.f / DM) + EPS) * SX[row];
#pragma unroll
                for (int n = 0; n < 2; ++n) { const pg8::i32x4_ ia = __builtin_bit_cast(pg8::i32x4_, acc[ai][0][m][n]), ig = __builtin_bit_cast(pg8::i32x4_, acc[ai][1][m][n]);
#pragma unroll
                    for (int i = 0; i < 4; ++i) { A[ai][m][4 * n + i] = (float)ia[i] * csa[4 * n + i] * fac; G[ai][m][4 * n + i] = (float)ig[i] * csg[4 * n + i] * fac; } } }
#pragma unroll
        for (int ai = 0; ai < 2; ++ai) { const int b = 2 * ai + wr;
            if (fr == 0) { *(LAS f32x4*)(XB + (2 * b) * 128 + fl) = (f32x4){A[ai][0][0], A[ai][0][1], A[ai][0][2], A[ai][0][3]}; *(LAS f32x4*)(XB + (2 * b) * 128 + fl + 4) = (f32x4){A[ai][0][4], A[ai][0][5], A[ai][0][6], A[ai][0][7]}; }
            if (fr == 15) { *(LAS f32x4*)(XB + (2 * b + 1) * 128 + fl) = (f32x4){A[ai][3][0], A[ai][3][1], A[ai][3][2], A[ai][3][3]}; *(LAS f32x4*)(XB + (2 * b + 1) * 128 + fl + 4) = (f32x4){A[ai][3][4], A[ai][3][5], A[ai][3][6], A[ai][3][7]}; } }
        { float* hb = HB + ((size_t)(u.pm * 86 + u.pn) * 6) * 128 + fl;
          if (wr == 0 && fr <= 1) { *(f32x4*)(hb + fr * 128) = (f32x4){A[0][0][0], A[0][0][1], A[0][0][2], A[0][0][3]}; *(f32x4*)(hb + fr * 128 + 4) = (f32x4){A[0][0][4], A[0][0][5], A[0][0][6], A[0][0][7]};
              if (fr == 0) { *(f32x4*)(hb + 4 * 128) = (f32x4){G[0][0][0], G[0][0][1], G[0][0][2], G[0][0][3]}; *(f32x4*)(hb + 4 * 128 + 4) = (f32x4){G[0][0][4], G[0][0][5], G[0][0][6], G[0][0][7]}; } }
          if (wr == 1 && fr >= 14) { const int sl = fr - 12;
              *(f32x4*)(hb + sl * 128) = (f32x4){A[1][3][0], A[1][3][1], A[1][3][2], A[1][3][3]}; *(f32x4*)(hb + sl * 128 + 4) = (f32x4){A[1][3][4], A[1][3][5], A[1][3][6], A[1][3][7]};
              if (fr == 15) { *(f32x4*)(hb + 5 * 128) = (f32x4){G[1][3][0], G[1][3][1], G[1][3][2], G[1][3][3]}; *(f32x4*)(hb + 5 * 128 + 4) = (f32x4){G[1][3][4], G[1][3][5], G[1][3][6], G[1][3][7]}; } } }
        asm volatile("s_waitcnt lgkmcnt(0)" ::: "memory"); __builtin_amdgcn_s_barrier(); asm volatile("" ::: "memory");
        const int src_dn = (lane & ~15) | ((fr + 1) & 15), src_up = (lane & ~15) | ((fr + 15) & 15);
#pragma unroll
        for (int n = 0; n < 2; ++n) {
            const f32x4 x0 = *(const f32x4*)(CW + f0 + 4 * n), x1 = *(const f32x4*)(CW + DFF + f0 + 4 * n), x2 = *(const f32x4*)(CW + 2 * DFF + f0 + 4 * n), xb = *(const f32x4*)(CB + f0 + 4 * n);
#pragma unroll
            for (int ai = 0; ai < 2; ++ai) { const int b = 2 * ai + wr;
                const f32x4 XP = b > 0 ? *(const LAS f32x4*)(XB + (2 * (b - 1) + 1) * 128 + fl + 4 * n) : (f32x4){0.f, 0.f, 0.f, 0.f};
                const f32x4 XN = b < 3 ? *(const LAS f32x4*)(XB + (2 * (b + 1)) * 128 + fl + 4 * n) : (f32x4){0.f, 0.f, 0.f, 0.f};
#pragma unroll
                for (int m = 0; m < 4; ++m) { const int row = row0 + ai * HALF + m * 16; float o[4];
#pragma unroll
                    for (int i = 0; i < 4; ++i) { const int j = 4 * n + i;
                        const float dn = __shfl(A[ai][m][j], src_dn), dnw = m < 3 ? __shfl(A[ai][m + 1][j], src_dn) : XN[i], nxt = fr == 15 ? dnw : dn;
                        const float up = __shfl(A[ai][m][j], src_up), upw = m > 0 ? __shfl(A[ai][m - 1][j], src_up) : XP[i], prv = fr == 0 ? upw : up;
                        const float c = prv * x0[i] + A[ai][m][j] * x1[i] + nxt * x2[i] + xb[i]; o[i] = gelu_tanh_(c) * G[ai][m][j]; }
                    int q0 = 0;
                    q0 = __builtin_amdgcn_cvt_pk_fp8_f32(sat8(o[0] * U8_SCALE), sat8(o[1] * U8_SCALE), q0, false); q0 = __builtin_amdgcn_cvt_pk_fp8_f32(sat8(o[2] * U8_SCALE), sat8(o[3] * U8_SCALE), q0, true);
                    *(unsigned*)(U8 + (size_t)row * DFF + f0 + 4 * n) = (unsigned)q0;
                    __builtin_amdgcn_sched_barrier(0); } } }
    }
};
struct EpiDown {
    static constexpr bool PERM = false;
    static constexpr int NST = 32;
    float* OUT; const bf16_t* X1B; float sc;
    __device__ __forceinline__ void operator()(const f32x4 (&acc)[2][2][4][2], const Unit& u, int wr, int wc, int fr, int fq) const {
        const int row0 = u.pm * BM + wr * 64 + fr, col0 = u.pn * BM + wc * 32 + 4 * fq;
#pragma unroll
        for (int ai = 0; ai < 2; ++ai) {
            u32x2 xw[4][2][2];
#pragma unroll
            for (int m = 0; m < 4; ++m) { const size_t off = (size_t)(row0 + ai * HALF + m * 16) * DM + col0;
#pragma unroll
                for (int bj = 0; bj < 2; ++bj)
#pragma unroll
                    for (int n = 0; n < 2; ++n) xw[m][bj][n] = *(const u32x2*)(X1B + off + bj * HALF + n * 16); }
#pragma unroll
            for (int m = 0; m < 4; ++m) { const size_t off = (size_t)(row0 + ai * HALF + m * 16) * DM + col0;
#pragma unroll
                for (int bj = 0; bj < 2; ++bj)
#pragma unroll
                    for (int n = 0; n < 2; ++n) { const u32x2 x2 = xw[m][bj][n]; const f32x4 a4 = acc[ai][bj][m][n] * sc;
                        *(f32x4*)(OUT + off + bj * HALF + n * 16) = (f32x4){bflo(x2.x) + a4[0], bfhi(x2.x) + a4[1], bflo(x2.y) + a4[2], bfhi(x2.y) + a4[3]}; } }
            asm volatile("" ::: "memory"); }
    }
};

struct Args;
__device__ __forceinline__ unsigned char* u8_ptr(const Args& a, int g);
struct Args { const float* in[25]; float* out; unsigned char* ws; int ph_lo, ph_hi, g_lo, g_hi; };
struct Frame {
    LAS unsigned char* lds; int tid, lane, wave, vcu, G;
};
__device__ __forceinline__ unsigned char* u8_ptr(const Args& a, int g) { (void)g; return FUSE_CONV ? a.ws + A_FG : (g == 0 ? (unsigned char*)(a.out + (size_t)GT * DM) : a.ws + WS_WIN); }
__device__ __forceinline__ Frame make_frame(LAS unsigned char* lds, int wave_s) {
    Frame F; F.lds = lds; F.tid = fresh_tid(wave_s); F.lane = F.tid & 63; F.wave = __builtin_amdgcn_readfirstlane(F.tid >> 6);
    F.G = fresh_grid(); { const int bx = fresh_bid(); F.vcu = (F.G % 8 == 0) ? (bx % 8) * (F.G / 8) + bx / 8 : bx; }
    return F;
}

template <int NMAP> __device__ __forceinline__ int nmap(int n) {
    if (NMAP == 1) { return n < 12288 ? n : (n < 12320 ? 20480 + (n - 12288) : n - 32); }
    if (NMAP == 2) { const int bj = n >= DFF ? 1 : 0, f = n - bj * DFF; return (f >> 7) * 256 + bj * 128 + (f & 127); }
    return n;
}
template <int NMAP> __device__ __forceinline__ void p0_transpose_item(const float* W, int N, const float* kscale, bf16_t* WT, int ldd, int koff, LAS float* scr, int kb, int nb, int lane) {
    const int k0 = 64 * kb, n0 = 64 * nb; const bool inb = (n0 + lane) < N;
#pragma unroll
    for (int i0 = 0; i0 < 64; i0 += 32) { float v[32];
#pragma unroll
        for (int i = 0; i < 32; ++i) v[i] = inb ? W[(size_t)(k0 + i0 + i) * N + n0 + lane] : 0.f;
#pragma unroll
        for (int i = 0; i < 32; ++i) { float t = v[i]; if (kscale) t *= kscale[k0 + i0 + i]; scr[(i0 + i) * 65 + lane] = t; } }
    asm volatile("s_waitcnt lgkmcnt(0)" ::: "memory");
    const int c = lane & 7;
#pragma unroll
    for (int j = 0; j < 8; ++j) { const int nl = (lane >> 3) + 8 * j; const int n = n0 + nl; const LAS float* s = scr + (8 * c) * 65 + nl;
        u32x4 o; o.x = cvt_pk_bf16(s[0 * 65], s[1 * 65]); o.y = cvt_pk_bf16(s[2 * 65], s[3 * 65]); o.z = cvt_pk_bf16(s[4 * 65], s[5 * 65]); o.w = cvt_pk_bf16(s[6 * 65], s[7 * 65]);
        if (n < N) *(u32x4*)(WT + (size_t)nmap<NMAP>(n) * ldd + koff + k0 + 8 * c) = o; }
    asm volatile("s_waitcnt lgkmcnt(0)" ::: "memory");
}
__device__ __forceinline__ void p0_colmax(const Frame& F, const float* W, int K, int N, const float* kscale, unsigned* out) {
    const int gw = F.vcu * NWAVES + F.wave, NGW = F.G * NWAVES; const int nnb = (N + 255) / 256, nt = (K / 64) * nnb;
    for (int t = gw; t < nt; t += NGW) { const int kb = t / nnb, nb = t - kb * nnb, n = nb * 256 + 4 * F.lane; if (n >= N) continue;
        f32x4 mx = {0.f, 0.f, 0.f, 0.f};
#pragma unroll 16
        for (int i = 0; i < 64; ++i) { const int k = kb * 64 + i; const float ks = kscale ? fabsf(kscale[k]) : 1.f; const f32x4 v = *(const f32x4*)(W + (size_t)k * N + n);
            mx[0] = fmaxf(mx[0], fabsf(v[0]) * ks); mx[1] = fmaxf(mx[1], fabsf(v[1]) * ks); mx[2] = fmaxf(mx[2], fabsf(v[2]) * ks); mx[3] = fmaxf(mx[3], fabsf(v[3]) * ks); }
#pragma unroll
        for (int j = 0; j < 4; ++j) atomicMax(out + n + j, __float_as_uint(mx[j])); }
}
__device__ __forceinline__ void p0_absmax(const Frame& F, const float* W, int K, int N, const float* kscale, unsigned* out) {
    const int gw = F.vcu * NWAVES + F.wave, NGW = F.G * NWAVES; float mx = 0.f;
    for (int k = gw; k < K; k += NGW) { const float ks = kscale ? kscale[k] : 1.f; const f32x4* row = (const f32x4*)(W + (size_t)k * N);
        for (int i = F.lane; i < N / 4; i += 64) { const f32x4 v = row[i]; mx = fmaxf(mx, fmaxf(fmaxf(fabsf(v[0]), fabsf(v[1])), fmaxf(fabsf(v[2]), fabsf(v[3]))) * fabsf(ks)); } }
#pragma unroll
    for (int o = 1; o < 64; o <<= 1) mx = fmaxf(mx, __shfl_xor(mx, o));
    if (F.lane == 0) atomicMax(out, __float_as_uint(mx));
}
template <int NMAP> __device__ __forceinline__ void p0_transpose_item_i8(const float* W, int N, const float* kscale, const unsigned* cmax, unsigned char* WT8, int ldd, int koff, LAS float* scr, int kb, int nb, int lane) {
    const int k0 = 64 * kb, n0 = 64 * nb; const bool inb = (n0 + lane) < N;
    const float qs = inb ? 127.f / fmaxf(__uint_as_float(__hip_atomic_load(cmax + n0 + lane, __ATOMIC_RELAXED, __HIP_MEMORY_SCOPE_AGENT)), 1e-30f) : 0.f;
#pragma unroll
    for (int i0 = 0; i0 < 64; i0 += 32) { float v[32];
#pragma unroll
        for (int i = 0; i < 32; ++i) v[i] = inb ? W[(size_t)(k0 + i0 + i) * N + n0 + lane] : 0.f;
#pragma unroll
        for (int i = 0; i < 32; ++i) { float t = v[i] * qs; if (kscale) t *= kscale[k0 + i0 + i]; scr[(i0 + i) * 65 + lane] = t; } }
    asm volatile("s_waitcnt lgkmcnt(0)" ::: "memory");
    const int c = lane & 7;
#pragma unroll
    for (int j = 0; j < 8; ++j) { const int nl = (lane >> 3) + 8 * j; const LAS float* s = scr + (8 * c) * 65 + nl;
        const unsigned w0 = pack_i8x4(s[0 * 65], s[1 * 65], s[2 * 65], s[3 * 65]), w1 = pack_i8x4(s[4 * 65], s[5 * 65], s[6 * 65], s[7 * 65]);
        if (n0 + nl < N) *(u32x2*)(WT8 + (size_t)nmap<NMAP>(n0 + nl) * ldd + koff + k0 + 8 * c) = (u32x2){w0, w1}; }
    asm volatile("s_waitcnt lgkmcnt(0)" ::: "memory");
}
template <int NMAP> __device__ __forceinline__ void p0_transpose_item_fp8(const float* W, int N, unsigned char* WT8, int ldd, LAS float* scr, int kb, int nb, int lane) {
    const int k0 = 64 * kb, n0 = 64 * nb; const bool inb = (n0 + lane) < N;
#pragma unroll
    for (int i0 = 0; i0 < 64; i0 += 32) { float v[32];
#pragma unroll
        for (int i = 0; i < 32; ++i) v[i] = inb ? W[(size_t)(k0 + i0 + i) * N + n0 + lane] : 0.f;
#pragma unroll
        for (int i = 0; i < 32; ++i) scr[(i0 + i) * 65 + lane] = sat8(v[i] * W8_SCALE); }
    asm volatile("s_waitcnt lgkmcnt(0)" ::: "memory");
    const int c = lane & 7;
#pragma unroll
    for (int j = 0; j < 8; ++j) { const int nl = (lane >> 3) + 8 * j; const LAS float* s = scr + (8 * c) * 65 + nl;
        int w0 = 0, w1 = 0;
        w0 = __builtin_amdgcn_cvt_pk_fp8_f32(s[0 * 65], s[1 * 65], w0, false); w0 = __builtin_amdgcn_cvt_pk_fp8_f32(s[2 * 65], s[3 * 65], w0, true);
        w1 = __builtin_amdgcn_cvt_pk_fp8_f32(s[4 * 65], s[5 * 65], w1, false); w1 = __builtin_amdgcn_cvt_pk_fp8_f32(s[6 * 65], s[7 * 65], w1, true);
        if (n0 + nl < N) *(u32x2*)(WT8 + (size_t)nmap<NMAP>(n0 + nl) * ldd + k0 + 8 * c) = (u32x2){(unsigned)w0, (unsigned)w1}; }
    asm volatile("s_waitcnt lgkmcnt(0)" ::: "memory");
}
__device__ __forceinline__ void p0_weights(const Frame& F, const Args& a) {
    unsigned char* ws = a.ws;
    LAS float* scr = (LAS float*)(F.lds + F.wave * 16640);
    const int gw = F.vcu * NWAVES + F.wave, NGW = F.G * NWAVES;
    constexpr int I_IN = 64 * 321, I_UP = 64 * 344, I_DN = 172 * 64, I_OUT = 64 * 64, I_PA = 32 * 64, I_PB = 32 * 64;
    constexpr int NITEMS = I_IN + I_UP + I_DN + I_OUT + I_PA + I_PB;
    { float* prm = (float*)(ws + WS_PRM); const int gt = F.vcu * NTHR + F.tid, ngt = F.G * NTHR; const unsigned* ctl = (const unsigned*)(ws + WS_CTL);
      for (int n = gt; n < 2 * DFF; n += ngt) prm[P_SWUP + nmap<2>(n)] = __uint_as_float(__hip_atomic_load(ctl + CW_CMAX_UP + n, __ATOMIC_RELAXED, __HIP_MEMORY_SCOPE_AGENT)) * (1.f / 127.f);
      for (int n = gt; n < DM; n += ngt) { prm[P_SWPA + n] = __uint_as_float(__hip_atomic_load(ctl + CW_CMAX_PA + n, __ATOMIC_RELAXED, __HIP_MEMORY_SCOPE_AGENT)) * (1.f / 127.f);
          prm[P_SWPB + n] = __uint_as_float(__hip_atomic_load(ctl + CW_CMAX_PB + n, __ATOMIC_RELAXED, __HIP_MEMORY_SCOPE_AGENT)) * (1.f / 127.f);
          prm[P_SWWO + n] = __uint_as_float(__hip_atomic_load(ctl + CW_CMAX_WO + n, __ATOMIC_RELAXED, __HIP_MEMORY_SCOPE_AGENT)) * (1.f / 127.f); }
      for (int n = gt; n < DINP; n += ngt) { if (n < DIN) prm[P_SWIN + nmap<1>(n)] = __uint_as_float(__hip_atomic_load(ctl + CW_CMAX_IN + n, __ATOMIC_RELAXED, __HIP_MEMORY_SCOPE_AGENT)) * (1.f / 127.f); else prm[P_SWIN + n] = 0.f; } }
    for (int it = gw; it < NITEMS; it += NGW) {
        int r = it;
        if (r < I_IN) { p0_transpose_item_i8<1>(a.in[4], DIN, nullptr, (const unsigned*)(ws + WS_CTL) + CW_CMAX_IN, ws + WS_WIN, DM, 0, scr, r / 321, r % 321, F.lane); continue; } r -= I_IN;
        if (r < I_UP) { p0_transpose_item_i8<2>(a.in[21], 2 * DFF, a.in[20], (const unsigned*)(ws + WS_CTL) + CW_CMAX_UP, ws + WS_WUP, DM, 0, scr, r / 344, r % 344, F.lane); continue; } r -= I_UP;
        if (r < I_DN) { p0_transpose_item_fp8<0>(a.in[24], DM, ws + WS_WDN, DFF, scr, r / 64, r % 64, F.lane); continue; } r -= I_DN;
        if (r < I_OUT) { if (INT8_WOUT) p0_transpose_item_i8<0>(a.in[19], DM, nullptr, (const unsigned*)(ws + WS_CTL) + CW_CMAX_WO, ws + WS_WOUT, DM, 0, scr, r / 64, r % 64, F.lane);
                         else p0_transpose_item<0>(a.in[19], DM, nullptr, (bf16_t*)(ws + WS_WOUT), DM, 0, scr, r / 64, r % 64, F.lane); continue; } r -= I_OUT;
        if (r < I_PA) { p0_transpose_item_i8<0>(a.in[17], DM, nullptr, (const unsigned*)(ws + WS_CTL) + CW_CMAX_PA, ws + WS_WPAB, DM, 0, scr, r / 64, r % 64, F.lane); continue; } r -= I_PA;
        p0_transpose_item_i8<0>(a.in[18], DM, nullptr, (const unsigned*)(ws + WS_CTL) + CW_CMAX_PB, ws + WS_WPAB, DM, 2048, scr, r / 64, r % 64, F.lane);
    }
    { u32x4* z = (u32x4*)(ws + WS_WIN + (size_t)DIN * DM);
      for (int i = gw * 64 + F.lane; i < 224 * 256; i += NGW * 64) z[i] = (u32x4){0u, 0u, 0u, 0u}; }
    { float* prm = (float*)(ws + WS_PRM); const int gt = F.vcu * NTHR + F.tid, ngt = F.G * NTHR;
      for (int i = gt; i < 4096; i += ngt) prm[P_GMIX + i] = a.in[3][i];
      for (int i = gt; i < 128; i += ngt) { prm[P_QG + i] = a.in[5][i]; prm[P_KG + i] = a.in[6][i]; }
      for (int i = gt; i < 256; i += ngt) { prm[P_SUBLN + i] = a.in[11][i]; prm[P_RB + i] = a.in[2][i]; }
      for (int i = gt; i < 16384; i += ngt) { prm[P_WGF + i] = a.in[12][i]; prm[P_WGB + i] = a.in[14][i]; }
      for (int i = gt; i < 1024; i += ngt) { prm[P_BGF + i] = a.in[13][i]; prm[P_BGB + i] = a.in[15][i]; }
      for (int i = gt; i < 512; i += ngt) prm[P_GLAG + i] = a.in[16][i];
      for (int i = gt; i < 3 * DFF; i += ngt) prm[P_CW + i] = a.in[22][i];
      for (int i = gt; i < DFF; i += ngt) prm[P_CB + i] = a.in[23][i]; }
    if (fresh_bid() == 0 && F.wave == 0) {
        float s1 = 0.f, s2 = 0.f;
        for (int i = F.lane; i < 128; i += 64) { s1 += a.in[7][i] * a.in[8][i]; s2 += a.in[9][i] * a.in[10][i]; }
        s1 = wave_sum(s1); s2 = wave_sum(s2);
        if (F.lane == 0) ((float*)(ws + WS_PRM))[P_LAM] = expf(s1) - expf(s2) + 0.2f;
    }
}
__device__ __forceinline__ void p1_hnorm(const Frame& F, const float* x, const float* gm, unsigned char* HQ, float* SH) {
    const int gw = F.vcu * NWAVES + F.wave, NGW = F.G * NWAVES;
    for (int m = gw; m < GT; m += NGW) {
        const f32x4* xr = (const f32x4*)(x + (size_t)m * DM) + F.lane; const f32x4* gr = (const f32x4*)gm + F.lane;
        f32x4 v[16]; float s = 0.f;
#pragma unroll
        for (int j = 0; j < 16; ++j) { v[j] = xr[64 * j]; s += (v[j][0] * v[j][0] + v[j][1] * v[j][1]) + (v[j][2] * v[j][2] + v[j][3] * v[j][3]); }
        const float rstd = 1.f / sqrtf(wave_sum(s) * (1.f / DM) + EPS); float mx = 0.f;
#pragma unroll
        for (int j = 0; j < 16; ++j) { v[j] = v[j] * gr[64 * j]; mx = fmaxf(mx, fmaxf(fmaxf(fabsf(v[j][0]), fabsf(v[j][1])), fmaxf(fabsf(v[j][2]), fabsf(v[j][3])))); }
#pragma unroll
        for (int o = 1; o < 64; o <<= 1) mx = fmaxf(mx, __shfl_xor(mx, o));
        mx = fmaxf(mx, 1e-30f); const float qs = 127.f / mx;
        unsigned* o8 = (unsigned*)(HQ + (size_t)m * DM) + F.lane;
#pragma unroll
        for (int j = 0; j < 16; ++j) o8[64 * j] = pack_i8x4(v[j][0] * qs, v[j][1] * qs, v[j][2] * qs, v[j][3] * qs);
        if (F.lane == 0) SH[m] = mx * rstd * (1.f / 127.f);
    }
}
__device__ __forceinline__ void p7b_quant_x1(const Frame& F, const bf16_t* X1B, unsigned char* X1Q, float* SX) {
    const int gw = F.vcu * NWAVES + F.wave, NGW = F.G * NWAVES;
    for (int m = gw; m < GT; m += NGW) {
        const u32x4* xr = (const u32x4*)(X1B + (size_t)m * DM) + F.lane; u32x4 w[8]; float mx = 0.f;
#pragma unroll
        for (int j = 0; j < 8; ++j) { w[j] = xr[64 * j]; mx = fmaxf(mx, fmaxf(fmaxf(fmaxf(fabsf(bflo(w[j].x)), fabsf(bfhi(w[j].x))), fmaxf(fabsf(bflo(w[j].y)), fabsf(bfhi(w[j].y)))), fmaxf(fmaxf(fabsf(bflo(w[j].z)), fabsf(bfhi(w[j].z))), fmaxf(fabsf(bflo(w[j].w)), fabsf(bfhi(w[j].w)))))); }
#pragma unroll
        for (int o = 1; o < 64; o <<= 1) mx = fmaxf(mx, __shfl_xor(mx, o));
        mx = fmaxf(mx, 1e-30f); const float qs = 127.f / mx;
        u32x2* o8 = (u32x2*)(X1Q + (size_t)m * DM) + F.lane;
#pragma unroll
        for (int j = 0; j < 8; ++j) o8[64 * j] = (u32x2){pack_i8x4(bflo(w[j].x) * qs, bfhi(w[j].x) * qs, bflo(w[j].y) * qs, bfhi(w[j].y) * qs), pack_i8x4(bflo(w[j].z) * qs, bfhi(w[j].z) * qs, bflo(w[j].w) * qs, bfhi(w[j].w) * qs)};
        if (F.lane == 0) SX[m] = mx * (1.f / 127.f);
    }
}
__device__ __forceinline__ void p3_qknorm(const Frame& F, bf16_t* Q, bf16_t* K, const float* gq, const float* gk) {
    const int gw = F.vcu * NWAVES + F.wave, NGW = F.G * NWAVES;
    const int gi = (F.lane & 15) * 8;
    float gqv[8], gkv[8];
#pragma unroll
    for (int e = 0; e < 8; ++e) { gqv[e] = gq[gi + e]; gkv[e] = gk[gi + e]; }
    for (int m = gw; m < 2 * GT; m += NGW) {
        const bool isk = m >= GT; bf16_t* row = (isk ? K : Q) + (size_t)(isk ? m - GT : m) * 2048;
#pragma unroll
        for (int i = 0; i < 4; ++i) {
            u32x4* p = (u32x4*)(row + i * 512) + F.lane; const u32x4 w = *p;
            float v[8] = {bflo(w.x), bfhi(w.x), bflo(w.y), bfhi(w.y), bflo(w.z), bfhi(w.z), bflo(w.w), bfhi(w.w)};
            float s = 0.f;
#pragma unroll
            for (int e = 0; e < 8; ++e) s += v[e] * v[e];
            s += __shfl_xor(s, 1); s += __shfl_xor(s, 2); s += __shfl_xor(s, 4); s += __shfl_xor(s, 8);
            const float r = 1.f / sqrtf(s * (1.f / 128.f) + EPS);
#pragma unroll
            for (int e = 0; e < 8; ++e) v[e] = v[e] * r * (isk ? gkv[e] : gqv[e]);
            u32x4 o; o.x = cvt_pk_bf16(v[0], v[1]); o.y = cvt_pk_bf16(v[2], v[3]); o.z = cvt_pk_bf16(v[4], v[5]); o.w = cvt_pk_bf16(v[6], v[7]);
            *p = o;
        }
    }
}

constexpr int LQ = 264;
constexpr int LS = 72;
constexpr int G1_QD = 0, G1_KI = 64 * LQ * 2, G1_VT = 2 * 64 * LQ * 2, G1_ATT = G1_VT + 256 * LS * 2, G1_ST = G1_ATT + 64 * LS * 2, G1_TOT = G1_ST + 64 * 16 * 4, G1_END = G1_TOT + 2 * 256 * 4;
static_assert(G1_END <= LDS_MISC, "G1 LDS");
struct GlaT { const bf16_t *GQ, *GK, *GV; const float* ST; const float *wgf, *bgf, *wgb, *bgb; bf16_t *QD, *KDT, *OI, *ATT; float* DEC; unsigned* dg; };
__device__ __forceinline__ void gla_g1_item(const Frame& F, const GlaT& T, int item, int TT) {
    LAS unsigned char* lds = F.lds;
    const int NCH = TT / 64;
    const int n = item % NCH; int r_ = item / NCH; const int dir = r_ & 1; r_ >>= 1; const int h = r_ & 3; const int b = r_ >> 2;
    const int tok0 = b * TT + n * 64, cg = tok0 >> 6;
    const int tid = F.tid, d = tid & 255, half = tid >> 8;
#if MK_DIAG
    if (tid == 0) atomicOr(T.dg, 32u);
#endif
    LAS bf16_t* qd_l = (LAS bf16_t*)(lds + G1_QD); LAS bf16_t* ki_l = (LAS bf16_t*)(lds + G1_KI); LAS bf16_t* vT_l = (LAS bf16_t*)(lds + G1_VT);
    LAS bf16_t* att_l = (LAS bf16_t*)(lds + G1_ATT); LAS float* st_l = (LAS float*)(lds + G1_ST); LAS float* tot_l = (LAS float*)(lds + G1_TOT);
    const float* wg = dir ? T.wgb : T.wgf; const float* bg = dir ? T.bgb : T.bgf;
    float wgr[16];
#pragma unroll
    for (int j = 0; j < 16; ++j) wgr[j] = wg[j * 1024 + h * 256 + d];
    const float bias = bg[h * 256 + d];
    const bf16_t* gqp = T.GQ + (size_t)tok0 * 1024 + h * 256; const bf16_t* gkp = T.GK + (size_t)tok0 * 1024 + h * 256;
    unsigned o32 = (unsigned)(half * 32 * 1024 + d); asm volatile("" : "+v"(o32));
    bf16_t qraw[32], kraw[32];
#pragma unroll
    for (int rr = 0; rr < 32; ++rr) { qraw[rr] = gqp[o32 + (unsigned)(rr * 1024)]; kraw[rr] = gkp[o32 + (unsigned)(rr * 1024)]; }
    if (tid < 256) { const int r = tid >> 2, j4 = (tid & 3) * 4; const f32x4 sv = *(const f32x4*)(T.ST + (size_t)(tok0 + r) * 32 + dir * 16 + j4); *(LAS f32x4*)(st_l + r * 16 + j4) = sv;
#if MK_DIAG
        if (!(fabsf(sv[0]) <= 20.f && fabsf(sv[1]) <= 20.f && fabsf(sv[2]) <= 20.f && fabsf(sv[3]) <= 20.f)) atomicOr(T.dg, 16u);
#endif
    }
    __syncthreads();
    float bl[32];
#pragma unroll
    for (int rr = 0; rr < 32; ++rr) { const int r = half * 32 + rr; float x = bias;
#pragma unroll
        for (int j4 = 0; j4 < 4; ++j4) { const f32x4 s = *(const LAS f32x4*)(st_l + r * 16 + j4 * 4); x += s[0] * wgr[j4 * 4] + s[1] * wgr[j4 * 4 + 1] + s[2] * wgr[j4 * 4 + 2] + s[3] * wgr[j4 * 4 + 3]; }
#if MK_DIAG
        if (!(fabsf(x) <= 50.f)) atomicOr(T.dg, 1u);
#endif
        const float ax = fabsf(x); const float ls = fminf(x, 0.f) - __logf(1.f + __expf(-ax));
        bl[rr] = ls * 0.0625f; if ((rr & 3) == 3) __builtin_amdgcn_sched_barrier(0); }
    float run = 0.f;
    if (dir == 0) {
#pragma unroll
        for (int rr = 0; rr < 32; ++rr) { run += bl[rr]; bl[rr] = run; }
    } else {
#pragma unroll
        for (int rr = 31; rr >= 0; --rr) { run += bl[rr]; bl[rr] = run; }
    }
    tot_l[half * 256 + d] = run;
    __syncthreads();
    const float other = tot_l[(1 - half) * 256 + d]; const float blast = run + other;
    const float addv = ((dir == 0) ? (half == 1) : (half == 0)) ? other : 0.f;
    const float elast = __expf(blast);
    const int gbase = (cg * 4 + h) * 2 + dir;
    if (half == 0) T.DEC[(size_t)gbase * 256 + d] = elast;
    unsigned kdp[16];
    bf16_t* qdp = T.QD + ((size_t)tok0 * 2 + dir) * 1024 + h * 256;
    const unsigned o32q = (unsigned)(half * 32 * 2048 + d);
#pragma unroll
    for (int rr = 0; rr < 32; rr += 2) {
        unsigned od = o32q; asm volatile("" : "+v"(od));
        float kd2[2];
#pragma unroll
        for (int e = 0; e < 2; ++e) { const int r = half * 32 + rr + e; const float bb = bl[rr + e] + addv; const float eb = __expf(bb), ieb = __builtin_amdgcn_rcpf(eb);
            const float qv = bf2f(qraw[rr + e]), kv = bf2f(kraw[rr + e]);
            const bf16_t qdb = f2bf(qv * eb); const float ki = kv * ieb;
#if MK_DIAG
            if (!(fabsf(ki) <= 1e30f)) atomicOr(T.dg, 2u);
#endif
            qd_l[r * LQ + d] = qdb; ki_l[r * LQ + d] = f2bf(ki);
            qdp[od + (unsigned)((rr + e) * 2048)] = qdb;
            kd2[e] = ki * elast; }
        kdp[rr >> 1] = cvt_pk_bf16(kd2[0], kd2[1]); if ((rr & 6) == 6) __builtin_amdgcn_sched_barrier(0);
    }
    { u32x4* kp = (u32x4*)(T.KDT + ((size_t)gbase * 256 + d) * 64 + half * 32);
#pragma unroll
      for (int i = 0; i < 4; ++i) kp[i] = (u32x4){kdp[4 * i], kdp[4 * i + 1], kdp[4 * i + 2], kdp[4 * i + 3]}; }
    __syncthreads();
    const int lane = F.lane, fr = lane & 15, fq = lane >> 4;
#pragma unroll
    for (int i = 0; i < 2; ++i) { const int id = F.wave * 2 + i, mt = id >> 2, nt = id & 3; f32x4 acc = {0.f, 0.f, 0.f, 0.f};
#pragma unroll
        for (int k0 = 0; k0 < 256; k0 += 32) { const bf16x8 av = *(const LAS bf16x8*)(qd_l + (16 * mt + fr) * LQ + k0 + 8 * fq); const bf16x8 bv = *(const LAS bf16x8*)(ki_l + (16 * nt + fr) * LQ + k0 + 8 * fq);
            acc = __builtin_amdgcn_mfma_f32_16x16x32_bf16(av, bv, acc, 0, 0, 0); }
#pragma unroll
        for (int j = 0; j < 4; ++j) { const int c = 16 * mt + 4 * fq + j, s = 16 * nt + fr; const bool keep = dir == 0 ? (s <= c) : (s >= c); att_l[c * LS + s] = f2bf(keep ? acc[j] : 0.f);
#if MK_DIAG
            if (keep && !(fabsf(acc[j]) <= 1e4f)) atomicOr(T.dg, 4u);
#endif
        } }
    __syncthreads();
    { const int c = tid >> 3, ch = tid & 7; *(u32x4*)(T.ATT + (size_t)gbase * 4096 + c * 64 + ch * 8) = *(const LAS u32x4*)(att_l + c * LS + ch * 8); }
    __syncthreads();
}

constexpr int LR = 68;
constexpr int G2_QD = 0, G2_KT = 64 * LQ * 2, G2_VT = G2_KT + 256 * LS * 2, G2_DEC = G2_VT + 64 * LS * 2, G2_RED = G2_DEC + 1024, G2_ATT = G2_RED + 2 * 64 * LR * 4, G2_END = G2_ATT + 64 * LS * 2;
static_assert(G2_END <= LDS_MISC, "G2 LDS");
__device__ __forceinline__ void gla_g2_item(const Frame& F, const GlaT& T, int item, int TT) {
    LAS unsigned char* lds = F.lds;
    const int NCH = TT / 64;
    const int vs = item & 7; int r_ = item >> 3; const int dir = r_ & 1; r_ >>= 1; const int h = r_ & 3; const int b = r_ >> 2;
    int tid_l = F.tid; asm volatile("" : "+v"(tid_l));
    const int tid = tid_l, lane = tid & 63, fr = lane & 15, fq = lane >> 4, vt = F.wave & 3, dh = F.wave >> 2;
    LAS bf16_t* qd_l = (LAS bf16_t*)(lds + G2_QD); LAS bf16_t* kT_l = (LAS bf16_t*)(lds + G2_KT); LAS bf16_t* vT_l = (LAS bf16_t*)(lds + G2_VT);
    LAS float* dec_l = (LAS float*)(lds + G2_DEC); LAS float* red_l = (LAS float*)(lds + G2_RED); LAS bf16_t* at_l = (LAS bf16_t*)(lds + G2_ATT);
    f32x4 S[8];
#pragma unroll
    for (int i = 0; i < 8; ++i) S[i] = (f32x4){0.f, 0.f, 0.f, 0.f};
    u32x4 pq[2][4], pk[2][4], pv[2], po[2]; float pd[2] = {0.f, 0.f};
#define G2_PREFETCH(SET, STEP) do { const int n_ = dir ? (NCH - 1 - (STEP)) : (STEP); const int tk_ = b * TT + n_ * 64; const int gb_ = ((tk_ >> 6) * 4 + h) * 2 + dir; \
        _Pragma("unroll") for (int i = 0; i < 4; ++i) { const int id = tid + 512 * i; \
            pq[SET][i] = *(const u32x4*)(T.QD + ((size_t)(tk_ + (id >> 5)) * 2 + dir) * 1024 + h * 256 + (id & 31) * 8); \
            pk[SET][i] = *(const u32x4*)(T.KDT + ((size_t)gb_ * 256 + (id >> 3)) * 64 + (id & 7) * 8); } \
        pv[SET] = *(const u32x4*)(T.GV + (size_t)(tk_ + (tid >> 3)) * 2048 + h * 512 + vs * 64 + (tid & 7) * 8); \
        po[SET] = *(const u32x4*)(T.ATT + (size_t)gb_ * 4096 + (tid >> 3) * 64 + (tid & 7) * 8); \
        if (tid < 256) pd[SET] = T.DEC[(size_t)gb_ * 256 + tid]; } while (0)
    G2_PREFETCH(0, 0); G2_PREFETCH(1, 1);
#pragma nounroll
    for (int st2 = 0; st2 < NCH; st2 += 2) {
#pragma unroll
      for (int SET = 0; SET < 2; ++SET) { const int st = st2 + SET;
        const int n = dir ? (NCH - 1 - st) : st; const int tok0 = b * TT + n * 64;
#pragma unroll
        for (int i = 0; i < 4; ++i) { const int id = tid + 512 * i; *(LAS u32x4*)(qd_l + (id >> 5) * LQ + (id & 31) * 8) = pq[SET][i]; *(LAS u32x4*)(kT_l + (id >> 3) * LS + (id & 7) * 8) = pk[SET][i]; }
        { const int s = tid >> 3, cc = tid & 7; const u32x4 w = pv[SET];
            LAS bf16_t* vp = vT_l + (cc * 8) * LS + s;
            vp[0 * LS] = (bf16_t)(w.x & 0xffff); vp[1 * LS] = (bf16_t)(w.x >> 16); vp[2 * LS] = (bf16_t)(w.y & 0xffff); vp[3 * LS] = (bf16_t)(w.y >> 16);
            vp[4 * LS] = (bf16_t)(w.z & 0xffff); vp[5 * LS] = (bf16_t)(w.z >> 16); vp[6 * LS] = (bf16_t)(w.w & 0xffff); vp[7 * LS] = (bf16_t)(w.w >> 16); }
        if (tid < 256) dec_l[tid] = pd[SET];
        *(LAS u32x4*)(at_l + (tid >> 3) * LS + (tid & 7) * 8) = po[SET];
        __syncthreads();
        if (st + 2 < NCH) { if (SET == 0) G2_PREFETCH(0, st + 2); else G2_PREFETCH(1, st + 2); }
        bf16x8 sb[4];
#pragma unroll
        for (int kb = 0; kb < 4; ++kb) { u32x4 w; w.x = cvt_pk_bf16(S[2 * kb][0], S[2 * kb][1]); w.y = cvt_pk_bf16(S[2 * kb][2], S[2 * kb][3]); w.z = cvt_pk_bf16(S[2 * kb + 1][0], S[2 * kb + 1][1]); w.w = cvt_pk_bf16(S[2 * kb + 1][2], S[2 * kb + 1][3]);
            sb[kb] = __builtin_bit_cast(bf16x8, w); }
        { bf16x8 av[4][4];
#pragma unroll
          for (int mt = 0; mt < 4; ++mt)
#pragma unroll
              for (int kb = 0; kb < 4; ++kb) { const LAS bf16_t* ap = qd_l + (16 * mt + fr) * LQ + 128 * dh + 32 * kb + 4 * fq;
                  const s16x4 lo = *(const LAS s16x4*)(ap), hi = *(const LAS s16x4*)(ap + 16);
                  av[mt][kb] = __builtin_shufflevector(lo, hi, 0, 1, 2, 3, 4, 5, 6, 7); }
          bf16x8 ia[2][2], ib[2];
#pragma unroll
          for (int ks = 0; ks < 2; ++ks) { ib[ks] = *(const LAS bf16x8*)(vT_l + (16 * vt + fr) * LS + 32 * ks + 8 * fq);
#pragma unroll
              for (int j = 0; j < 2; ++j) ia[j][ks] = *(const LAS bf16x8*)(at_l + (16 * (2 * dh + j) + fr) * LS + 32 * ks + 8 * fq); }
          f32x4 acc[4], ai[2];
#pragma unroll
          for (int mt = 0; mt < 4; ++mt) acc[mt] = (f32x4){0.f, 0.f, 0.f, 0.f};
          ai[0] = (f32x4){0.f, 0.f, 0.f, 0.f}; ai[1] = (f32x4){0.f, 0.f, 0.f, 0.f};
#pragma unroll
          for (int kb = 0; kb < 4; ++kb)
#pragma unroll
              for (int mt = 0; mt < 4; ++mt) acc[mt] = __builtin_amdgcn_mfma_f32_16x16x32_bf16(av[mt][kb], sb[kb], acc[mt], 0, 0, 0);
#pragma unroll
          for (int ks = 0; ks < 2; ++ks)
#pragma unroll
              for (int j = 0; j < 2; ++j) ai[j] = __builtin_amdgcn_mfma_f32_16x16x32_bf16(ia[j][ks], ib[ks], ai[j], 0, 0, 0);
#pragma unroll
          for (int mt = 0; mt < 4; ++mt) { const bool mine = (mt >> 1) == dh; const f32x4 add = ai[mt & 1];
#pragma unroll
              for (int j = 0; j < 4; ++j) red_l[(dh * 64 + 16 * mt + 4 * fq + j) * LR + 16 * vt + fr] = acc[mt][j] + (mine ? add[j] : 0.f); } }
        { const bf16x8 b0 = *(const LAS bf16x8*)(vT_l + (16 * vt + fr) * LS + 8 * fq), b1 = *(const LAS bf16x8*)(vT_l + (16 * vt + fr) * LS + 32 + 8 * fq);
#pragma unroll
          for (int i = 0; i < 8; ++i) { const int drow = 128 * dh + 16 * i; const f32x4 dc = *(const LAS f32x4*)(dec_l + drow + 4 * fq);
              S[i] = S[i] * dc;
              const bf16x8 a0 = *(const LAS bf16x8*)(kT_l + (drow + fr) * LS + 8 * fq), a1 = *(const LAS bf16x8*)(kT_l + (drow + fr) * LS + 32 + 8 * fq);
              S[i] = __builtin_amdgcn_mfma_f32_16x16x32_bf16(a0, b0, S[i], 0, 0, 0); S[i] = __builtin_amdgcn_mfma_f32_16x16x32_bf16(a1, b1, S[i], 0, 0, 0); } }
        __syncthreads();
        { const int c = tid >> 3, v8 = (tid & 7) * 8; bf16_t* op = T.OI + ((size_t)dir * GT + tok0 + c) * 2048 + h * 512 + vs * 64 + v8;
          const f32x4 r0 = *(const LAS f32x4*)(red_l + c * LR + v8) + *(const LAS f32x4*)(red_l + (64 + c) * LR + v8);
          const f32x4 r1 = *(const LAS f32x4*)(red_l + c * LR + v8 + 4) + *(const LAS f32x4*)(red_l + (64 + c) * LR + v8 + 4);
          u32x4 w; w.x = cvt_pk_bf16(r0[0], r0[1]); w.y = cvt_pk_bf16(r0[2], r0[3]); w.z = cvt_pk_bf16(r1[0], r1[1]); w.w = cvt_pk_bf16(r1[2], r1[3]);
          *(u32x4*)op = w; }
      }
    }
    __syncthreads();
#undef G2_PREFETCH
}

namespace att {
constexpr int D = 128, NW = 8, QBLK = 32, KVBLK = 64, LD = 2048;
constexpr float SCALE = 0.088388347648318440f;
constexpr int SHM_V = KVBLK * D * 2, SHM_K = KVBLK * D * 2;
#if ATT_FULLV
constexpr int OFF_V = 0, OFF_K = 4 * SHM_V  ;
#else
constexpr int OFF_V = 0, OFF_K = 3 * SHM_V  ;
#endif
#if ATT_FULLV
constexpr int OFF_WS = OFF_K + 2 * SHM_K, OFF_TB = OFF_WS + NW * 64 * 4, TB_STRIDE = 264  , OFF_QS = OFF_TB + 8 * TB_STRIDE * 4  , ATT_LDS = OFF_QS + NW * 4096;
#else
constexpr int OFF_WS = OFF_K + 2 * SHM_K, OFF_TB = OFF_WS + NW * 64 * 4, TB_STRIDE = 264  , ATT_LDS = OFF_TB + 8 * TB_STRIDE * 4;
#endif
static_assert(ATT_LDS <= LDS_MISC, "attention LDS");
#define KSWZ(row, colB) ((row) * 256 + ((colB) ^ (((row) & 7) << 4)))
#define SBAR() __builtin_amdgcn_sched_barrier(0)
__device__ __forceinline__ int crow(int r, int hi) { return (r & 3) + 8 * (r >> 2) + 4 * hi; }
__device__ __forceinline__ void partialSM(f32x16& p0, f32x16& p1, const LAS float* tb, int rel0, int relmin, int relmax, int hi) {
    constexpr float C = SCALE * LOG2E;
    if (relmin >= 128 || relmax <= -128) {
        const float c = (relmin >= 128) ? tb[256] : tb[0];
#pragma unroll
        for (int r = 0; r < 16; ++r) { p0[r] = fmaf(p0[r], C, c); p1[r] = fmaf(p1[r], C, c); }
    } else {
        int rb = rel0 + 4 * hi; asm volatile("" : "+v"(rb));
#pragma unroll
        for (int r4 = 0; r4 < 16; r4 += 4) {
#pragma unroll
            for (int r = r4; r < r4 + 4; ++r) { const int rl = rb + ((r & 3) + 8 * (r >> 2)); const int i0 = min(max(rl, -128), 128) + 128, i1 = min(max(rl + 32, -128), 128) + 128;
                p0[r] = fmaf(p0[r], C, tb[i0]); p1[r] = fmaf(p1[r], C, tb[i1]); }
            __builtin_amdgcn_sched_barrier(0);
        }
    }
#pragma unroll
    for (int r = 0; r < 16; ++r) p0[r] = __builtin_amdgcn_exp2f(p0[r]);
}
__device__ __forceinline__ void finishSM(f32x16& p0, f32x16& p1, float& l_reg, bf16x8& pa0, bf16x8& pa1, bf16x8& pa2, bf16x8& pa3) {
#pragma unroll
    for (int r = 0; r < 16; ++r) p1[r] = __builtin_amdgcn_exp2f(p1[r]);
    float ps = 0;
#pragma unroll
    for (int r = 0; r < 16; ++r) ps += p0[r];
#pragma unroll
    for (int r = 0; r < 16; ++r) ps += p1[r];
    { auto rr = __builtin_amdgcn_permlane32_swap(__float_as_uint(ps), __float_as_uint(ps), false, false);
      ps = __uint_as_float(rr[0]) + __uint_as_float(rr[1]); }
    l_reg += ps;
#define PK4(P, BASE, OUT) do { unsigned a0 = cvt_pk_bf16(P[BASE + 0], P[BASE + 1]), a1 = cvt_pk_bf16(P[BASE + 2], P[BASE + 3]);   \
    unsigned b0 = cvt_pk_bf16(P[BASE + 4], P[BASE + 5]), b1 = cvt_pk_bf16(P[BASE + 6], P[BASE + 7]);                              \
    auto r0 = __builtin_amdgcn_permlane32_swap(a0, b0, false, false); auto r1 = __builtin_amdgcn_permlane32_swap(a1, b1, false, false); \
    u32x4 w = {r0[0], r1[0], r0[1], r1[1]}; OUT = __builtin_bit_cast(bf16x8, w); } while (0)
    PK4(p0, 0, pa0); PK4(p0, 8, pa1); PK4(p1, 0, pa2); PK4(p1, 8, pa3);
#undef PK4
}
__device__ __forceinline__ void qkt(f32x16& p0, f32x16& p1, const LAS char* Ks, const bf16x8* Qs, int r32, int hi) {
    p0 = f32x16{}; p1 = f32x16{};
#pragma unroll
    for (int d0 = 0; d0 < 8; ++d0) { const int cb = (d0 * 16 + hi * 8) * 2;
        const bf16x8 b0 = *(const LAS bf16x8*)(Ks + KSWZ(r32, cb));
        const bf16x8 b1 = *(const LAS bf16x8*)(Ks + KSWZ(32 + r32, cb));
        const bf16x8 q = Qs[d0];
        p0 = __builtin_amdgcn_mfma_f32_32x32x16_bf16(b0, q, p0, 0, 0, 0);
        p1 = __builtin_amdgcn_mfma_f32_32x32x16_bf16(b1, q, p1, 0, 0, 0); }
}
__device__ __forceinline__ int v_st(int k, int c) { const int kk = (k & ~0xC) | ((k & 4) << 1) | ((k & 8) >> 1); return ((kk >> 3) * 4 + (c >> 5)) * 512 + ((kk & 7) * 32 + (c & 31)) * 2; }
__device__ __forceinline__ int v_rd_base(int lane) { return ((lane & 3) << 3) | (((lane >> 2) & 3) << 6) | (((lane >> 4) & 1) << 5) | (((lane >> 5) & 1) << 8); }
constexpr int v_rd_off(int d0, int ks, int half) { return d0 * 512 + ks * 4096 + half * 2048; }
template <int OFF> __device__ __forceinline__ s16x4 tr_read(int vb) {
    s16x4 r; asm volatile("ds_read_b64_tr_b16 %0, %1 offset:%2" : "=&v"(r) : "v"(vb), "i"(OFF) : "memory"); return r;
}
template <int D0> __device__ __forceinline__ void pv_one(f32x16& od, int vb, bf16x8 pa0, bf16x8 pa1, bf16x8 pa2, bf16x8 pa3) {
    const s16x4 l0 = tr_read<v_rd_off(D0, 0, 0)>(vb), h0 = tr_read<v_rd_off(D0, 0, 1)>(vb), l1 = tr_read<v_rd_off(D0, 1, 0)>(vb), h1 = tr_read<v_rd_off(D0, 1, 1)>(vb);
    const s16x4 l2 = tr_read<v_rd_off(D0, 2, 0)>(vb), h2 = tr_read<v_rd_off(D0, 2, 1)>(vb), l3 = tr_read<v_rd_off(D0, 3, 0)>(vb), h3 = tr_read<v_rd_off(D0, 3, 1)>(vb);
    asm volatile("s_waitcnt lgkmcnt(0)" ::: "memory"); SBAR();
#define PK(L, H) (bf16x8){L[0], L[1], L[2], L[3], H[0], H[1], H[2], H[3]}
    od = __builtin_amdgcn_mfma_f32_32x32x16_bf16(pa0, PK(l0, h0), od, 0, 0, 0);
    od = __builtin_amdgcn_mfma_f32_32x32x16_bf16(pa1, PK(l1, h1), od, 0, 0, 0);
    od = __builtin_amdgcn_mfma_f32_32x32x16_bf16(pa2, PK(l2, h2), od, 0, 0, 0);
    od = __builtin_amdgcn_mfma_f32_32x32x16_bf16(pa3, PK(l3, h3), od, 0, 0, 0);
#undef PK
}
template <int KS> __device__ __forceinline__ void pv_ks(f32x16* o, int vb, bf16x8 pa) {
    const s16x4 l0 = tr_read<v_rd_off(0, KS, 0)>(vb), h0 = tr_read<v_rd_off(0, KS, 1)>(vb), l1 = tr_read<v_rd_off(1, KS, 0)>(vb), h1 = tr_read<v_rd_off(1, KS, 1)>(vb);
    const s16x4 l2 = tr_read<v_rd_off(2, KS, 0)>(vb), h2 = tr_read<v_rd_off(2, KS, 1)>(vb), l3 = tr_read<v_rd_off(3, KS, 0)>(vb), h3 = tr_read<v_rd_off(3, KS, 1)>(vb);
    asm volatile("s_waitcnt lgkmcnt(0)" ::: "memory"); SBAR();
#define PK(L, H) (bf16x8){L[0], L[1], L[2], L[3], H[0], H[1], H[2], H[3]}
    o[0] = __builtin_amdgcn_mfma_f32_32x32x16_bf16(pa, PK(l0, h0), o[0], 0, 0, 0);
    o[1] = __builtin_amdgcn_mfma_f32_32x32x16_bf16(pa, PK(l1, h1), o[1], 0, 0, 0);
    o[2] = __builtin_amdgcn_mfma_f32_32x32x16_bf16(pa, PK(l2, h2), o[2], 0, 0, 0);
    o[3] = __builtin_amdgcn_mfma_f32_32x32x16_bf16(pa, PK(l3, h3), o[3], 0, 0, 0);
#undef PK
}
template <int KS, int BASE> __device__ __forceinline__ void pv_kso(f32x16* o, int vb, bf16x8 pa) {
    const s16x4 l0 = tr_read<BASE + v_rd_off(0, KS, 0)>(vb), h0 = tr_read<BASE + v_rd_off(0, KS, 1)>(vb), l1 = tr_read<BASE + v_rd_off(1, KS, 0)>(vb), h1 = tr_read<BASE + v_rd_off(1, KS, 1)>(vb);
    const s16x4 l2 = tr_read<BASE + v_rd_off(2, KS, 0)>(vb), h2 = tr_read<BASE + v_rd_off(2, KS, 1)>(vb), l3 = tr_read<BASE + v_rd_off(3, KS, 0)>(vb), h3 = tr_read<BASE + v_rd_off(3, KS, 1)>(vb);
    asm volatile("s_waitcnt lgkmcnt(0)" ::: "memory"); SBAR();
#define PK(L, H) (bf16x8){L[0], L[1], L[2], L[3], H[0], H[1], H[2], H[3]}
    o[0] = __builtin_amdgcn_mfma_f32_32x32x16_bf16(pa, PK(l0, h0), o[0], 0, 0, 0);
    o[1] = __builtin_amdgcn_mfma_f32_32x32x16_bf16(pa, PK(l1, h1), o[1], 0, 0, 0);
    o[2] = __builtin_amdgcn_mfma_f32_32x32x16_bf16(pa, PK(l2, h2), o[2], 0, 0, 0);
    o[3] = __builtin_amdgcn_mfma_f32_32x32x16_bf16(pa, PK(l3, h3), o[3], 0, 0, 0);
#undef PK
}
__device__ __forceinline__ void pv_d0(f32x16* o, int vb, bf16x8 pa0, bf16x8 pa1, bf16x8 pa2, bf16x8 pa3) {
#if ATT_PV_KMAJOR
    pv_ks<0>(o, vb, pa0); pv_ks<1>(o, vb, pa1); pv_ks<2>(o, vb, pa2); pv_ks<3>(o, vb, pa3);
#else
    pv_one<0>(o[0], vb, pa0, pa1, pa2, pa3); pv_one<1>(o[1], vb, pa0, pa1, pa2, pa3); pv_one<2>(o[2], vb, pa0, pa1, pa2, pa3); pv_one<3>(o[3], vb, pa0, pa1, pa2, pa3);
#endif
}
__device__ __forceinline__ void attn_unit(const bf16_t* __restrict__ Qb, const bf16_t* __restrict__ Kh, const bf16_t* __restrict__ Vh, bf16_t* __restrict__ Ob, int seq, int q0, const LAS float* tb, LAS char* lds, int tid_) {
    const int tid = tid_, wid = tid >> 6, lane = tid & 63, r32 = lane & 31, hi = lane >> 5;
    LAS char* V_lds = lds + OFF_V; LAS char* K_lds = lds + OFF_K;
    LAS float* li_l = (LAS float*)(lds + OFF_WS) + wid * 64;
    float l_reg = 0; f32x16 o[4] = {};
    bf16x8 qr[8];
    { const bf16_t* Qw = Qb + (long)(wid * QBLK + r32) * LD + hi * 8;
#pragma unroll
      for (int d0 = 0; d0 < 8; ++d0) qr[d0] = *(const bf16x8*)(Qw + d0 * 16); }
    const int sr = tid >> 4, sc = (tid & 15) * 8, vst0 = v_st(sr, sc), vst1 = v_st(32 + sr, sc);
    const int vb0 = (int)(unsigned)(size_t)V_lds + v_rd_base(lane);
    const int qpos = q0 + wid * QBLK + r32, wq0 = q0 + wid * QBLK;
    struct { bf16x8 vs0, vs1, ks0, ks1; } sr_;
#define SLOAD(k0) do { sr_.vs0 = *(const bf16x8*)(&Vh[(long)((k0) + sr) * LD + sc]); sr_.vs1 = *(const bf16x8*)(&Vh[(long)((k0) + 32 + sr) * LD + sc]); \
    sr_.ks0 = *(const bf16x8*)(&Kh[(long)((k0) + sr) * LD + sc]); sr_.ks1 = *(const bf16x8*)(&Kh[(long)((k0) + 32 + sr) * LD + sc]); } while (0)
#define SWRITE(b) do { *(LAS bf16x8*)(V_lds + (b) * SHM_V + vst0) = sr_.vs0;          \
    *(LAS bf16x8*)(V_lds + (b) * SHM_V + vst1) = sr_.vs1; const int kc = sc * 2;               \
    *(LAS bf16x8*)(K_lds + (b) * SHM_K + KSWZ(sr, kc)) = sr_.ks0;                       \
    *(LAS bf16x8*)(K_lds + (b) * SHM_K + KSWZ(32 + sr, kc)) = sr_.ks1; } while (0)
#define PSM(P0, P1, TILE) partialSM(P0, P1, tb, (TILE) * KVBLK - qpos, (TILE) * KVBLK - (wq0 + 31), (TILE) * KVBLK + 63 - wq0, hi)
#define TILE_STEP(J, B) do { __syncthreads(); \
        if ((J) + 1 < NT) { asm volatile("s_waitcnt vmcnt(0)" ::: "memory"); SWRITE(1 - (B)); } \
        if ((J) + 2 < NT) SLOAD(((J) + 2) * KVBLK); \
        SBAR(); qkt(p0, p1, K_lds + (B) * SHM_K, qr, r32, hi); PSM(p0, p1, (J)); \
        finishSM(p0, p1, l_reg, pa0, pa1, pa2, pa3); SBAR(); \
        pv_d0(o, vb0 + (B) * (int)SHM_V, pa0, pa1, pa2, pa3); } while (0)
    bf16x8 pa0, pa1, pa2, pa3; const int NT = seq / KVBLK;
#if ATT_PIPE
    f32x16 pA0, pA1, pB0, pB1;
    SLOAD(0); asm volatile("s_waitcnt vmcnt(0)" ::: "memory"); SWRITE(0); __syncthreads();
    qkt(pA0, pA1, K_lds, qr, r32, hi); PSM(pA0, pA1, 0);
    SLOAD(KVBLK);
    asm volatile("s_waitcnt vmcnt(0)" ::: "memory"); SWRITE(1); __syncthreads();
#pragma nounroll
    for (int j = 1; j + 1 < NT; j += 2) {
        SBAR(); qkt(pB0, pB1, K_lds + SHM_K, qr, r32, hi);
        finishSM(pA0, pA1, l_reg, pa0, pa1, pa2, pa3); SBAR();
        SLOAD((j + 1) * KVBLK); SBAR();
        pv_d0(o, vb0, pa0, pa1, pa2, pa3); PSM(pB0, pB1, j);
        __syncthreads(); asm volatile("s_waitcnt vmcnt(0)" ::: "memory"); SWRITE(0);
        __syncthreads();
        SBAR(); qkt(pA0, pA1, K_lds, qr, r32, hi);
        finishSM(pB0, pB1, l_reg, pa0, pa1, pa2, pa3); SBAR();
        SLOAD((j + 2) * KVBLK); SBAR();
        pv_d0(o, vb0 + (int)SHM_V, pa0, pa1, pa2, pa3); PSM(pA0, pA1, j + 1);
        __syncthreads(); asm volatile("s_waitcnt vmcnt(0)" ::: "memory"); SWRITE(1);
        __syncthreads();
    }
    SBAR(); qkt(pB0, pB1, K_lds + SHM_K, qr, r32, hi);
    finishSM(pA0, pA1, l_reg, pa0, pa1, pa2, pa3); SBAR();
    pv_d0(o, vb0, pa0, pa1, pa2, pa3); PSM(pB0, pB1, NT - 1);
    finishSM(pB0, pB1, l_reg, pa0, pa1, pa2, pa3); SBAR();
    pv_d0(o, vb0 + (int)SHM_V, pa0, pa1, pa2, pa3);
#else
    f32x16 p0, p1;
#if ATT_DMA
    unsigned gk[2], gv[2];
    const int widu = __builtin_amdgcn_readfirstlane(wid);
#pragma unroll
    for (int t = 0; t < 2; ++t) { const int ch = wid + 8 * t, b = ch * 1024 + 16 * lane;
        { const int row = b >> 8, cs = (b >> 4) & 15, c = cs ^ (row & 7); gk[t] = (unsigned)(row * LD + c * 8); }
        { const int sub = b >> 9, e = (b & 511) >> 1, kk = ((sub >> 2) << 3) | (e >> 5), c = ((sub & 3) << 5) | (e & 31), k = (kk & ~0xC) | ((kk & 4) << 1) | ((kk & 8) >> 1); gv[t] = (unsigned)(k * LD + c); } }
#define DMA_TILE(k0, bufi) do { _Pragma("unroll") for (int t = 0; t < 2; ++t) { \
        __builtin_amdgcn_global_load_lds((const unsigned*)(Kh + (size_t)(k0) * LD + gk[t]), (LAS unsigned*)(K_lds + (bufi) * SHM_K + (widu + 8 * t) * 1024), 16, 0, 0); \
        __builtin_amdgcn_global_load_lds((const unsigned*)(Vh + (size_t)(k0) * LD + gv[t]), (LAS unsigned*)(V_lds + (bufi) * SHM_V + (widu + 8 * t) * 1024), 16, 0, 0); } } while (0)
#define TILE_STEP_D(J, B) do { asm volatile("s_waitcnt vmcnt(0)" ::: "memory"); __syncthreads();     \
        if ((J) + 1 < NT) DMA_TILE(((J) + 1) * KVBLK, 1 - (B)); \
        SBAR(); qkt(p0, p1, K_lds + (B) * SHM_K, qr, r32, hi); PSM(p0, p1, (J)); \
        finishSM(p0, p1, l_reg, pa0, pa1, pa2, pa3); SBAR(); \
        pv_d0(o, vb0 + (B) * (int)SHM_V, pa0, pa1, pa2, pa3); } while (0)
#if ATT_DMA == 2
#define DMA_TILE2(k0, kbi, vbi) do { _Pragma("unroll") for (int t = 0; t < 2; ++t) { \
        __builtin_amdgcn_global_load_lds((const unsigned*)(Kh + (size_t)(k0) * LD + gk[t]), (LAS unsigned*)(K_lds + (kbi) * SHM_K + (widu + 8 * t) * 1024), 16, 0, 0); \
        __builtin_amdgcn_global_load_lds((const unsigned*)(Vh + (size_t)(k0) * LD + gv[t]), (LAS unsigned*)(V_lds + (vbi) * SHM_V + (widu + 8 * t) * 1024), 16, 0, 0); } } while (0)
#define STEP2(J, PC0, PC1, PP0, PP1) do { asm volatile("s_waitcnt vmcnt(0)" ::: "memory"); __syncthreads(); \
        if ((J) + 1 < NT) DMA_TILE2(((J) + 1) * KVBLK, ((J) + 1) & 1, vnext); \
        SBAR(); qkt(PC0, PC1, K_lds + ((J) & 1) * SHM_K, qr, r32, hi); \
        finishSM(PP0, PP1, l_reg, pa0, pa1, pa2, pa3); SBAR(); \
        pv_d0(o, vb0 + vprev * (int)SHM_V, pa0, pa1, pa2, pa3); PSM(PC0, PC1, (J)); \
        vprev = vcur; vcur = vnext; vnext = vnext == 2 ? 0 : vnext + 1; } while (0)
    f32x16 pb0, pb1;
    int vprev = 0, vcur = 1, vnext = 2;
    DMA_TILE2(0, 0, 0);
    asm volatile("s_waitcnt vmcnt(0)" ::: "memory"); __syncthreads();
    DMA_TILE2(KVBLK, 1, 1);
    qkt(p0, p1, K_lds, qr, r32, hi); PSM(p0, p1, 0);
#pragma nounroll
    for (int j = 1; j + 1 < NT; j += 2) { STEP2(j, pb0, pb1, p0, p1); STEP2(j + 1, p0, p1, pb0, pb1); }
    STEP2(NT - 1, pb0, pb1, p0, p1);
    finishSM(pb0, pb1, l_reg, pa0, pa1, pa2, pa3); SBAR();
    pv_d0(o, vb0 + vprev * (int)SHM_V, pa0, pa1, pa2, pa3);
#undef STEP2
#undef DMA_TILE2
#else
    DMA_TILE(0, 0);
#pragma nounroll
    for (int j = 0; j < NT; j += 2) { TILE_STEP_D(j, 0); TILE_STEP_D(j + 1, 1); }
#endif
#undef TILE_STEP_D
#undef DMA_TILE
#else
    SLOAD(0); asm volatile("s_waitcnt vmcnt(0)" ::: "memory"); SWRITE(0); SLOAD(KVBLK);
#pragma nounroll
    for (int j = 0; j < NT; j += 2) { TILE_STEP(j, 0); TILE_STEP(j + 1, 1); }
#endif
#endif
#undef TILE_STEP
    if (hi == 0) li_l[r32] = l_reg; asm volatile("s_waitcnt lgkmcnt(0)" ::: "memory");
    float rli[16];
#pragma unroll
    for (int r = 0; r < 16; ++r) rli[r] = __builtin_amdgcn_rcpf(li_l[crow(r, hi)]);
    bf16_t* Ow = Ob + (long)(wid * QBLK) * LD;
#pragma unroll
    for (int r = 0; r < 16; ++r) { const int orow = crow(r, hi);
#pragma unroll
        for (int d0 = 0; d0 < 4; ++d0) Ow[(long)orow * LD + d0 * 32 + r32] = f2bf(o[d0][r] * rli[r]); }
#undef SLOAD
#undef SWRITE
#undef PSM
}

#if ATT_FULLV
template <int OFF> __device__ __forceinline__ void qkt1(f32x16& p, int kb, const bf16x8* Qs) {
    p = f32x16{};
    asm volatile("" : "+v"(kb));
    bf16x8 kf[8];
#define KRD(D0) asm volatile("ds_read_b128 %0, %1 offset:%2" : "=&v"(kf[D0]) : "v"(kb ^ ((D0) * 32)), "i"(OFF) : "memory")
#define QK1(D0, N) asm volatile("s_waitcnt lgkmcnt(" #N ")" ::: "memory"); SBAR(); p = __builtin_amdgcn_mfma_f32_32x32x16_bf16(kf[D0], Qs[D0], p, 0, 0, 0); SBAR();
    KRD(0); KRD(1); KRD(2); KRD(3);
    QK1(0, 3) KRD(4); QK1(1, 3) KRD(5); QK1(2, 3) KRD(6); QK1(3, 3) KRD(7); QK1(4, 3) QK1(5, 2) QK1(6, 1) QK1(7, 0)
#undef QK1
#undef KRD
}
template <int OFF> __device__ __forceinline__ void qkt2(f32x16& pA, f32x16& pB, int kb, int qa, const bf16x8* Qs) {
    pA = f32x16{}; pB = f32x16{};
    asm volatile("" : "+v"(kb), "+v"(qa));
    bf16x8 ka[8], kc[8], ql[8];
#define KRD2(D0) do { asm volatile("ds_read_b128 %0, %1 offset:%2" : "=&v"(ka[D0]) : "v"(kb ^ ((D0) * 32)), "i"(OFF) : "memory"); asm volatile("ds_read_b128 %0, %1 offset:%2" : "=&v"(kc[D0]) : "v"(kb ^ ((D0) * 32)), "i"(OFF + 8192) : "memory"); \
        if ((D0) >= 4) asm volatile("ds_read_b128 %0, %1 offset:%2" : "=&v"(ql[D0]) : "v"(qa), "i"(((D0) - 4) * 1024) : "memory"); } while (0)
#define QK2(D0, N) asm volatile("s_waitcnt lgkmcnt(" #N ")" ::: "memory"); SBAR(); { const bf16x8 q_ = (D0) >= 4 ? ql[D0] : Qs[(D0) & 3]; pA = __builtin_amdgcn_mfma_f32_32x32x16_bf16(ka[D0], q_, pA, 0, 0, 0); pB = __builtin_amdgcn_mfma_f32_32x32x16_bf16(kc[D0], q_, pB, 0, 0, 0); } SBAR();
    KRD2(0); KRD2(1);
    QK2(0, 2) KRD2(2); QK2(1, 2) KRD2(3); QK2(2, 2) KRD2(4); QK2(3, 3) KRD2(5); QK2(4, 3) KRD2(6); QK2(5, 3) KRD2(7); QK2(6, 3) QK2(7, 0)
#undef QK2
#undef KRD2
}
__device__ __forceinline__ void partialSM1(f32x16& p, const LAS float* tb, int rel_s, int lrel) {
    constexpr float C = SCALE * LOG2E;
    if (rel_s - 31 >= 128 || rel_s + 31 <= -128) {
        const float c = (rel_s >= 159) ? tb[256] : tb[0];
#pragma unroll
        for (int r = 0; r < 16; ++r) p[r] = fmaf(p[r], C, c);
    } else {
        int rb = rel_s + lrel; asm volatile("" : "+v"(rb));
#pragma unroll
        for (int r4 = 0; r4 < 16; r4 += 4) {
#pragma unroll
            for (int r = r4; r < r4 + 4; ++r) { const int rl = rb + ((r & 3) + 8 * (r >> 2)); const int i0 = min(max(rl, -128), 128) + 128; p[r] = fmaf(p[r], C, tb[i0]); }
            __builtin_amdgcn_sched_barrier(0);
        }
    }
#pragma unroll
    for (int r = 0; r < 16; ++r) p[r] = __builtin_amdgcn_exp2f(p[r]);
}
__device__ __forceinline__ void finishSM1(const f32x16& p, float& l_acc, bf16x8& pa_lo, bf16x8& pa_hi) {
    typedef float f32x2_ __attribute__((ext_vector_type(2)));
    f32x2_ s2 = {p[0], p[1]};
#pragma unroll
    for (int r = 2; r < 16; r += 2) s2 += (f32x2_){p[r], p[r + 1]};
    l_acc += s2[0] + s2[1];
#define PK4(P, BASE, OUT) do { unsigned a0 = cvt_pk_bf16(P[BASE + 0], P[BASE + 1]), a1 = cvt_pk_bf16(P[BASE + 2], P[BASE + 3]);   \
    unsigned b0 = cvt_pk_bf16(P[BASE + 4], P[BASE + 5]), b1 = cvt_pk_bf16(P[BASE + 6], P[BASE + 7]);                              \
    auto r0 = __builtin_amdgcn_permlane32_swap(a0, b0, false, false); auto r1 = __builtin_amdgcn_permlane32_swap(a1, b1, false, false); \
    u32x4 w = {r0[0], r1[0], r0[1], r1[1]}; OUT = __builtin_bit_cast(bf16x8, w); } while (0)
    PK4(p, 0, pa_lo); PK4(p, 8, pa_hi);
#undef PK4
}
__device__ __forceinline__ void attn_unit_fv(const bf16_t* __restrict__ Qb, const bf16_t* __restrict__ Kh, const bf16_t* __restrict__ Vh, bf16_t* __restrict__ Ob, int seq, int q0, const LAS float* tb, LAS char* lds, int tid_) {
    int tid = tid_; asm volatile("" : "+v"(tid));
    const int wid = __builtin_amdgcn_readfirstlane(tid >> 6), lane = tid & 63, r32 = lane & 31, hi = lane >> 5;
    LAS char* V_lds = lds + OFF_V; LAS char* K_lds = lds + OFF_K;
    LAS float* li_l = (LAS float*)(lds + OFF_WS) + wid * 64;
    float l_reg = 0; f32x16 o[8] = {};
    bf16x8 qr[4];
    const int qa0 = (int)(unsigned)(size_t)(lds + OFF_QS) + wid * 4096 + lane * 16;
    { const char* Qw = (const char*)(Qb + (long)(wid * QBLK) * LD); const unsigned qo = (unsigned)((r32 * LD + hi * 8) * 2);
#pragma unroll
      for (int d0 = 0; d0 < 4; ++d0) qr[d0] = *(const bf16x8*)(Qw + qo + d0 * 32);
#pragma unroll
      for (int d0 = 4; d0 < 8; ++d0) { const bf16x8 qv = *(const bf16x8*)(Qw + qo + d0 * 32); *(LAS bf16x8*)((LAS char*)(size_t)(unsigned)qa0 + (d0 - 4) * 1024) = qv; } }
    const int vb0 = (int)(unsigned)(size_t)V_lds + v_rd_base(lane);
    const int wq0 = q0 + wid * QBLK, lrel = 4 * hi - r32;
    unsigned gk0, gv0;
    const int widu = wid;
    { const int b = wid * 1024 + 16 * lane;
      { const int row = b >> 8, cs = (b >> 4) & 15, c = cs ^ (row & 7); gk0 = (unsigned)(row * LD + c * 8) * 2u; }
      { const int sub = b >> 9, e = (b & 511) >> 1, kk = ((sub >> 2) << 3) | (e >> 5), c = ((sub & 3) << 5) | (e & 31), k = (kk & ~0xC) | ((kk & 4) << 1) | ((kk & 8) >> 1); gv0 = (unsigned)(k * LD + c) * 2u; } }
    const int kb0 = (int)(unsigned)(size_t)K_lds + r32 * 256 + ((hi * 16) ^ ((r32 & 7) << 4));
#define DMA1(sbase, voff, ldsaddr) asm volatile("s_mov_b32 m0, %2\n\ts_nop 0\n\tglobal_load_lds_dwordx4 %0, %1" :: "v"(voff), "s"(sbase), "s"(ldsaddr) : "memory", "m0")
#define DMA_TILE_FV(k0, bufi) do { const char* kt_ = (const char*)(Kh + (size_t)(k0) * LD); const char* vt_ = (const char*)(Vh + (size_t)(k0) * LD); _Pragma("unroll") for (int t = 0; t < 2; ++t) { \
        DMA1(kt_ + t * (32 * LD * 2), gk0, (unsigned)(size_t)(K_lds + (bufi) * SHM_K + (widu + 8 * t) * 1024)); \
        DMA1(vt_ + t * (32 * LD * 2), gv0, (unsigned)(size_t)(V_lds + (bufi) * 2 * SHM_V + (widu + 8 * t) * 1024)); \
        DMA1(vt_ + 256 + t * (32 * LD * 2), gv0, (unsigned)(size_t)(V_lds + (bufi) * 2 * SHM_V + SHM_V + (widu + 8 * t) * 1024)); } } while (0)
#define TR4(F, BASE, KS, D0) do { F[0] = tr_read<(BASE) + v_rd_off(D0, KS, 0)>(vb0); F[1] = tr_read<(BASE) + v_rd_off(D0, KS, 1)>(vb0); F[2] = tr_read<(BASE) + v_rd_off(D0 + 1, KS, 0)>(vb0); F[3] = tr_read<(BASE) + v_rd_off(D0 + 1, KS, 1)>(vb0); } while (0)
#define PKF(L, H) (bf16x8){L[0], L[1], L[2], L[3], H[0], H[1], H[2], H[3]}
#define MM2(O, D0, PA, F) do { (O)[D0] = __builtin_amdgcn_mfma_f32_32x32x16_bf16(PA, PKF(F[0], F[1]), (O)[D0], 0, 0, 0); (O)[D0 + 1] = __builtin_amdgcn_mfma_f32_32x32x16_bf16(PA, PKF(F[2], F[3]), (O)[D0 + 1], 0, 0, 0); } while (0)
#define LGK(N) asm volatile("s_waitcnt lgkmcnt(" #N ")" ::: "memory")
#define PV_PIPE(KSA, KSB, VA_, VB_) do { s16x4 f0[4], f1[4], f2[4]; \
        TR4(f0, VA_, KSA, 0); TR4(f1, VA_, KSA, 2); TR4(f2, VB_, KSA, 0); LGK(8); SBAR(); MM2(o, 0, pa0, f0); SBAR(); \
        TR4(f0, VB_, KSA, 2); LGK(8); SBAR(); MM2(o, 2, pa0, f1); SBAR(); \
        TR4(f1, VA_, KSB, 0); LGK(8); SBAR(); MM2(o + 4, 0, pa0, f2); SBAR(); \
        TR4(f2, VA_, KSB, 2); LGK(8); SBAR(); MM2(o + 4, 2, pa0, f0); SBAR(); \
        TR4(f0, VB_, KSB, 0); LGK(8); SBAR(); MM2(o, 0, pa1, f1); SBAR(); \
        TR4(f1, VB_, KSB, 2); LGK(8); SBAR(); MM2(o, 2, pa1, f2); SBAR(); \
        LGK(4); SBAR(); MM2(o + 4, 0, pa1, f0); SBAR(); LGK(0); SBAR(); MM2(o + 4, 2, pa1, f1); } while (0)
#define STEP_FV(J, B) do { asm volatile("s_waitcnt vmcnt(0)" ::: "memory"); __syncthreads();     \
        if ((J) + 1 < NT) DMA_TILE_FV(((J) + 1) * KVBLK, 1 - (B)); \
        { constexpr int VA = (B) * 2 * SHM_V, VB = VA + SHM_V; \
        SBAR(); qkt2<(B) * SHM_K>(p, pb, kb0, qa0, qr); \
        partialSM1(p, tb, (J) * KVBLK - wq0, lrel); \
        finishSM1(p, l_reg, pa0, pa1); SBAR(); \
        pv_kso<0, VA>(o, vb0, pa0); pv_kso<0, VB>(o + 4, vb0, pa0); pv_kso<1, VA>(o, vb0, pa1); pv_kso<1, VB>(o + 4, vb0, pa1); SBAR(); \
        partialSM1(pb, tb, (J) * KVBLK + 32 - wq0, lrel); \
        finishSM1(pb, l_reg, pa0, pa1); SBAR(); \
        PV_PIPE(2, 3, VA, VB); } } while (0)
    bf16x8 pa0, pa1; const int NT = seq / KVBLK;
    f32x16 p, pb;
    DMA_TILE_FV(0, 0);
#pragma nounroll
    for (int j = 0; j < NT; j += 2) { STEP_FV(j, 0); STEP_FV(j + 1, 1); }
#undef STEP_FV
#undef PV_PIPE
#undef LGK
#undef MM2
#undef PKF
#undef TR4
#undef DMA_TILE_FV
#undef DMA1
    { auto rr = __builtin_amdgcn_permlane32_swap(__float_as_uint(l_reg), __float_as_uint(l_reg), false, false); l_reg = __uint_as_float(rr[0]) + __uint_as_float(rr[1]); }
    int l2; asm volatile("v_mbcnt_lo_u32_b32 %0, -1, 0\n\tv_mbcnt_hi_u32_b32 %0, -1, %0" : "=v"(l2));
    const int r32e = l2 & 31, hie = l2 >> 5;
    if (hie == 0) li_l[r32e] = l_reg; asm volatile("s_waitcnt lgkmcnt(0)" ::: "memory");
    char* Ow = (char*)(Ob + (long)(wid * QBLK) * LD);
    unsigned ob = (unsigned)((4 * hie * LD + r32e) * 2);
#pragma unroll
    for (int r = 0; r < 16; ++r) { const float rl = __builtin_amdgcn_rcpf(li_l[crow(r, hie)]); asm volatile("" : "+v"(ob));
        bf16_t* op = (bf16_t*)(Ow + ob + (unsigned)((((r & 3) + 8 * (r >> 2)) * LD) * 2));
#pragma unroll
        for (int d0 = 0; d0 < 8; ++d0) op[d0 * 32] = f2bf(o[d0][r] * rl);
        SBAR(); }
}
#endif
}

__device__ __forceinline__ int t5_bucket(int rel) {
    const int ret = rel > 0 ? 16 : 0; const int n = rel < 0 ? -rel : rel;
    if (n < 8) return ret + n;
    const int e = 31 - __clz(n); int large = 8 + 2 * (e - 3) + ((n * n >= (2 << (2 * e))) ? 1 : 0);
    large = large < 15 ? large : 15;
    return ret + large;
}

__device__ __forceinline__ void p4_mixer(const Frame& F, const Args& a, int g) {
    unsigned char* ws = a.ws; const int TT = g ? 2048 : 4096, NB = g ? 8 : 4;
    bf16_t* dsc = (bf16_t*)(a.out + (size_t)g * GT * DM);
    const float* prm = (const float*)(ws + WS_PRM);
    GlaT T{(const bf16_t*)(ws + A_GQ), (const bf16_t*)(ws + A_GK), (const bf16_t*)(ws + A_GV), (const float*)(ws + WS_ST), prm + P_WGF, prm + P_BGF, prm + P_WGB, prm + P_BGB,
           (bf16_t*)(ws + A_QD), (bf16_t*)(ws + A_KDT), dsc + (size_t)2 * GT * 2048, (bf16_t*)(ws + A_ATT), (float*)(ws + WS_DEC), DG_WORD(ws)};
    const int n_g2 = NB * 4 * 2 * 8;
    for (int it = F.vcu; it < n_g2; it += F.G) gla_g2_item(F, T, it, TT);
#if ATT_FULLV
    const int NQB = TT / 256, n_at = NB * 8 * 2 * NQB;
#else
    const int NQB = TT / 256, n_at = NB * 8 * 2 * 2 * NQB;
#endif
    LAS float* tb = (LAS float*)(F.lds + att::OFF_TB);
    const bf16_t* Qg = (const bf16_t*)(ws + A_Q); const bf16_t* Kg = (const bf16_t*)(ws + A_K); const bf16_t* Vg = (const bf16_t*)(ws + A_V);
    __syncthreads();
    for (int i = F.tid; i < 8 * 257; i += NTHR) { const int h = i / 257, j = i - h * 257; tb[h * att::TB_STRIDE + j] = prm[P_RB + t5_bucket(j - 128) * 8 + h] * LOG2E; }
    __syncthreads();
    for (int it = F.vcu; it < n_at; it += F.G) {
#if ATT_FULLV
        const int qb = it % NQB; int r = it / NQB; const int map = r & 1; r >>= 1; const int h = r & 7; const int b = r >> 3;
        const size_t rowb = (size_t)b * TT;
        att::attn_unit_fv(Qg + (rowb + qb * 256) * 2048 + h * 256 + map * 128, Kg + rowb * 2048 + h * 256 + map * 128, Vg + rowb * 2048 + h * 256,
                          dsc + (size_t)map * GT * 2048 + (rowb + qb * 256) * 2048 + h * 256, TT, qb * 256, tb + h * att::TB_STRIDE, (LAS char*)F.lds, F.tid);
        __syncthreads();
#else
        const int qb = it % NQB; int r = it / NQB; const int vhalf = r & 1; r >>= 1; const int map = r & 1; r >>= 1; const int h = r & 7; const int b = r >> 3;
        const size_t rowb = (size_t)b * TT;
        att::attn_unit(Qg + (rowb + qb * 256) * 2048 + h * 256 + map * 128, Kg + rowb * 2048 + h * 256 + map * 128, Vg + rowb * 2048 + h * 256 + vhalf * 128,
                       dsc + (size_t)map * GT * 2048 + (rowb + qb * 256) * 2048 + h * 256 + vhalf * 128, TT, qb * 256, tb + h * att::TB_STRIDE, (LAS char*)F.lds, F.tid);
        __syncthreads();
#endif
    }
}
__device__ __forceinline__ void p5_finalize(const Frame& F, const Args& a, int g) {
    unsigned char* ws = a.ws; const bf16_t* dsc = (const bf16_t*)(a.out + (size_t)g * GT * DM);
    const bf16_t* O1 = dsc; const bf16_t* O2 = dsc + (size_t)GT * 2048; const bf16_t* OF = dsc + (size_t)2 * GT * 2048; const bf16_t* OB = dsc + (size_t)3 * GT * 2048;
    const bf16_t* GR = (const bf16_t*)(ws + A_GR);
    const float* prm = (const float*)(ws + WS_PRM); const float lam = prm[P_LAM];
    const int gw = F.vcu * NWAVES + F.wave, NGW = F.G * NWAVES, lane = F.lane;
    float sg[8], gg[8];
#pragma unroll
    for (int e = 0; e < 8; ++e) { sg[e] = prm[P_SUBLN + (lane & 31) * 8 + e] * 0.8f; gg[e] = prm[P_GLAG + lane * 8 + e]; }
    unsigned char* OQ = ws + A_OAB; float* soa = (float*)(ws + WS_PRM) + P_SOA; float* sob = (float*)(ws + WS_PRM) + P_SOB;
    for (int m = gw; m < GT; m += NGW) {
        float ya[4][8], yb[4][8]; float ma = 0.f, mb = 0.f;
#pragma unroll
        for (int i = 0; i < 4; ++i) {
            const size_t off = (size_t)m * 2048 + i * 512 + lane * 8;
            { const u32x4 w1 = *(const u32x4*)(O1 + off), w2 = *(const u32x4*)(O2 + off);
              float v[8] = {bflo(w1.x) - lam * bflo(w2.x), bfhi(w1.x) - lam * bfhi(w2.x), bflo(w1.y) - lam * bflo(w2.y), bfhi(w1.y) - lam * bfhi(w2.y),
                            bflo(w1.z) - lam * bflo(w2.z), bfhi(w1.z) - lam * bfhi(w2.z), bflo(w1.w) - lam * bflo(w2.w), bfhi(w1.w) - lam * bfhi(w2.w)};
              float s = 0.f;
#pragma unroll
              for (int e = 0; e < 8; ++e) s += v[e] * v[e];
              s += __shfl_xor(s, 1); s += __shfl_xor(s, 2); s += __shfl_xor(s, 4); s += __shfl_xor(s, 8); s += __shfl_xor(s, 16);
              const float r = 1.f / sqrtf(s * (1.f / 256.f) + EPS);
#pragma unroll
              for (int e = 0; e < 8; ++e) { ya[i][e] = v[e] * r * sg[e]; ma = fmaxf(ma, fabsf(ya[i][e])); } }
            { const u32x4 w1 = *(const u32x4*)(OF + off), w2 = *(const u32x4*)(OB + off), wr_ = *(const u32x4*)(GR + off);
              float v[8] = {bflo(w1.x) + bflo(w2.x), bfhi(w1.x) + bfhi(w2.x), bflo(w1.y) + bflo(w2.y), bfhi(w1.y) + bfhi(w2.y),
                            bflo(w1.z) + bflo(w2.z), bfhi(w1.z) + bfhi(w2.z), bflo(w1.w) + bflo(w2.w), bfhi(w1.w) + bfhi(w2.w)};
              const float rr[8] = {bflo(wr_.x), bfhi(wr_.x), bflo(wr_.y), bfhi(wr_.y), bflo(wr_.z), bfhi(wr_.z), bflo(wr_.w), bfhi(wr_.w)};
              float s = 0.f;
#pragma unroll
              for (int e = 0; e < 8; ++e) s += v[e] * v[e];
              s = wave_sum(s);
              const float r = 1.f / sqrtf(s * (1.f / 512.f) + EPS);
#pragma unroll
              for (int e = 0; e < 8; ++e) { yb[i][e] = v[e] * r * gg[e] * rr[e]; mb = fmaxf(mb, fabsf(yb[i][e])); } }
        }
#pragma unroll
        for (int o = 1; o < 64; o <<= 1) { ma = fmaxf(ma, __shfl_xor(ma, o)); mb = fmaxf(mb, __shfl_xor(mb, o)); }
        ma = fmaxf(ma, 1e-30f); mb = fmaxf(mb, 1e-30f); const float qa = 127.f / ma, qb = 127.f / mb;
#pragma unroll
        for (int i = 0; i < 4; ++i) {
            *(u32x2*)(OQ + (size_t)m * DM + i * 512 + lane * 8) = (u32x2){pack_i8x4(ya[i][0] * qa, ya[i][1] * qa, ya[i][2] * qa, ya[i][3] * qa), pack_i8x4(ya[i][4] * qa, ya[i][5] * qa, ya[i][6] * qa, ya[i][7] * qa)};
            *(u32x2*)(OQ + (size_t)m * DM + 2048 + i * 512 + lane * 8) = (u32x2){pack_i8x4(yb[i][0] * qb, yb[i][1] * qb, yb[i][2] * qb, yb[i][3] * qb), pack_i8x4(yb[i][4] * qb, yb[i][5] * qb, yb[i][6] * qb, yb[i][7] * qb)}; }
        if (lane == 0) { soa[m] = ma * (1.f / 127.f); sob[m] = mb * (1.f / 127.f); }
    }
}
__device__ __forceinline__ void p9_fix(const Frame& F, const float* HB, unsigned char* U8, const float* CW, const float* CB, int TT) {
    const int total = 64 * 86 * 2 * 32;
    for (int it = F.vcu * NTHR + F.tid; it < total; it += F.G * NTHR) {
        const int q = it & 31, e = (it >> 5) & 1, tix = it >> 6, pm = tix / 86, pn = tix - pm * 86, fl = 4 * q, f0 = pn * HALF + fl;
        const float* own = HB + (size_t)tix * 768 + fl; f32x4 prv, cur, nxt, gg; int row;
        if (e == 0) { row = pm * BM; cur = *(const f32x4*)(own); nxt = *(const f32x4*)(own + 128); gg = *(const f32x4*)(own + 4 * 128);
            prv = (row % TT) == 0 ? (f32x4){0.f, 0.f, 0.f, 0.f} : *(const f32x4*)(HB + (size_t)(tix - 86) * 768 + 3 * 128 + fl); }
        else { row = pm * BM + 255; prv = *(const f32x4*)(own + 2 * 128); cur = *(const f32x4*)(own + 3 * 128); gg = *(const f32x4*)(own + 5 * 128);
            nxt = ((row + 1) % TT) == 0 ? (f32x4){0.f, 0.f, 0.f, 0.f} : *(const f32x4*)(HB + (size_t)(tix + 86) * 768 + fl); }
        const f32x4 x0 = *(const f32x4*)(CW + f0), x1 = *(const f32x4*)(CW + DFF + f0), x2 = *(const f32x4*)(CW + 2 * DFF + f0), xb = *(const f32x4*)(CB + f0);
        float o[4];
#pragma unroll
        for (int i = 0; i < 4; ++i) { const float c = prv[i] * x0[i] + cur[i] * x1[i] + nxt[i] * x2[i] + xb[i]; o[i] = gelu_tanh_(c) * gg[i]; }
        int w = 0; w = __builtin_amdgcn_cvt_pk_fp8_f32(sat8(o[0] * U8_SCALE), sat8(o[1] * U8_SCALE), w, false); w = __builtin_amdgcn_cvt_pk_fp8_f32(sat8(o[2] * U8_SCALE), sat8(o[3] * U8_SCALE), w, true);
        *(unsigned*)(U8 + (size_t)row * DFF + f0) = (unsigned)w;
    }
}
__device__ __forceinline__ float gelu_tanh(float x) { const float u = x * (1.5957691216057308f + 0.07135481627159145f * x * x); return x * __builtin_amdgcn_rcpf(1.f + __builtin_amdgcn_exp2f(-u * LOG2E)); }
__device__ __forceinline__ void unpack8(const u32x4 w, float (&v)[8]) { v[0] = bflo(w.x); v[1] = bfhi(w.x); v[2] = bflo(w.y); v[3] = bfhi(w.y); v[4] = bflo(w.z); v[5] = bfhi(w.z); v[6] = bflo(w.w); v[7] = bfhi(w.w); }
__device__ __forceinline__ void p9_conv(const Frame& F, const Args& a, int g) {
    unsigned char* ws = a.ws; const int TT = g ? 2048 : 4096;
    const bf16_t* FA = (const bf16_t*)(ws + A_FA); const bf16_t* FG = (const bf16_t*)(ws + A_FG); unsigned char* U8 = u8_ptr(a, g);
    const float* cw = (const float*)(ws + WS_PRM) + P_CW; const float* cb = (const float*)(ws + WS_PRM) + P_CB;
    constexpr int NF8 = DFF / 8, RB = 16, NRB = GT / RB;
    const long total = (long)NF8 * NRB;
    for (long it = (long)F.vcu * NTHR + F.tid; it < total; it += (long)F.G * NTHR) {
        const int f8 = (int)(it % NF8), rb = (int)(it / NF8), f0 = f8 * 8, r0 = rb * RB;
        float w0[8], w1[8], w2[8], bb[8];
#pragma unroll
        for (int e = 0; e < 8; ++e) { w0[e] = cw[f0 + e]; w1[e] = cw[DFF + f0 + e]; w2[e] = cw[2 * DFF + f0 + e]; bb[e] = cb[f0 + e]; }
        float pv[8], cv[8], nv[8];
        if ((r0 % TT) != 0) unpack8(*(const u32x4*)(FA + (size_t)(r0 - 1) * DFF + f0), pv); else {
#pragma unroll
            for (int e = 0; e < 8; ++e) pv[e] = 0.f; }
        unpack8(*(const u32x4*)(FA + (size_t)r0 * DFF + f0), cv);
#pragma unroll 4
        for (int r = 0; r < RB; ++r) { const int row = r0 + r;
            if (((row + 1) % TT) != 0) unpack8(*(const u32x4*)(FA + (size_t)(row + 1) * DFF + f0), nv); else {
#pragma unroll
                for (int e = 0; e < 8; ++e) nv[e] = 0.f; }
            float gv[8]; unpack8(*(const u32x4*)(FG + (size_t)row * DFF + f0), gv);
            float o[8];
#pragma unroll
            for (int e = 0; e < 8; ++e) { const float c = pv[e] * w0[e] + cv[e] * w1[e] + nv[e] * w2[e] + bb[e]; o[e] = gelu_tanh(c) * gv[e]; pv[e] = cv[e]; cv[e] = nv[e]; }
            int w0 = 0, w1 = 0;
            w0 = __builtin_amdgcn_cvt_pk_fp8_f32(sat8(o[0] * U8_SCALE), sat8(o[1] * U8_SCALE), w0, false); w0 = __builtin_amdgcn_cvt_pk_fp8_f32(sat8(o[2] * U8_SCALE), sat8(o[3] * U8_SCALE), w0, true);
            w1 = __builtin_amdgcn_cvt_pk_fp8_f32(sat8(o[4] * U8_SCALE), sat8(o[5] * U8_SCALE), w1, false); w1 = __builtin_amdgcn_cvt_pk_fp8_f32(sat8(o[6] * U8_SCALE), sat8(o[7] * U8_SCALE), w1, true);
            *(u32x2*)(U8 + (size_t)row * DFF + f0) = (u32x2){(unsigned)w0, (unsigned)w1}; }
    }
}

constexpr int NPH = 11;
#if MK_TPROBE >= 0
#define TP_BEGIN(k) unsigned long long tp_t0_ = 0; if (MK_TPROBE == (k)) tp_t0_ = __builtin_amdgcn_s_memrealtime();
#define TP_END(k) do { if (MK_TPROBE == (k) && F.tid == 0) { volatile LAS unsigned* m_ = (volatile LAS unsigned*)(lds + LDS_MISC); m_[32] = m_[32] + (unsigned)(__builtin_amdgcn_s_memrealtime() - tp_t0_); } } while (0)
#else
#define TP_BEGIN(k)
#define TP_END(k)
#endif
#define GRID_BAR() do { if (!multi) { XcdBarrier b_; b_.bar = (unsigned*)(args.ws + WS_CTL) + CW_BAR; b_.x = xb_xcc_id(); b_.st = (volatile LAS unsigned*)(lds + LDS_MISC); xcd_barrier(b_); } } while (0)
#if MK_ONE_LAUNCH
#define IN(k) true
#else
#define IN(k) (lo <= (k) && (k) < hi)
#endif
template <int GI> __device__ __forceinline__ void group_body(LAS unsigned char* lds, const int wave_s, const Args& args, const bool more) {
    constexpr bool multi = !MK_ONE_LAUNCH;
    constexpr int g = GI;
    unsigned char* ws = args.ws; const int lo = args.ph_lo, hi = args.ph_hi; (void)lo; (void)hi;
    const float* xg = args.in[GI];
    float* outg = args.out + (size_t)GI * GT * DM;
    float* rss = (float*)((unsigned*)(ws + WS_CTL) + CW_RSS) + (size_t)GI * GT;
    if (IN(1)) { const Frame F = make_frame(lds, wave_s); TP_BEGIN(1) p1_hnorm(F, xg, GI == 0 ? args.in[3] : (const float*)(ws + WS_PRM) + P_GMIX, ws + A_H, (float*)(ws + WS_PRM) + P_SH); GRID_BAR(); TP_END(1); }
    if (IN(2)) { const Frame F = make_frame(lds, wave_s);
        TP_BEGIN(2)
        { pg8::Gemm gm{(const bf16_t*)(ws + A_H), (const bf16_t*)(ws + WS_WIN)};
          EpiInProj E{ws, (const float*)(ws + WS_PRM) + P_SH, (const float*)(ws + WS_PRM) + P_SWIN, (LAS float*)(F.lds + 131072 + 4096)};
          pg8::gemm_phase<GT, DINP, DM / 2, DM / 2, DM / 2, 1, 0, 2>(F.lds, gm, fresh_grid(), fresh_bid(), F.tid, E); }
        GRID_BAR(); TP_END(2);
    }
    if (IN(3)) { const Frame F = make_frame(lds, wave_s);
        TP_BEGIN(3)
        const float* prm = (const float*)(ws + WS_PRM);
        bf16_t* dsc = (bf16_t*)outg;
        GlaT T{(const bf16_t*)(ws + A_GQ), (const bf16_t*)(ws + A_GK), (const bf16_t*)(ws + A_GV), (const float*)(ws + WS_ST), prm + P_WGF, prm + P_BGF, prm + P_WGB, prm + P_BGB,
               (bf16_t*)(ws + A_QD), (bf16_t*)(ws + A_KDT), dsc + (size_t)2 * GT * 2048, (bf16_t*)(ws + A_ATT), (float*)(ws + WS_DEC), DG_WORD(ws)};
        constexpr int TT = g ? 2048 : 4096;
        for (int it = F.vcu; it < 2048; it += F.G) gla_g1_item(F, T, it, TT);
        GRID_BAR(); TP_END(3);
    }
    if (IN(4)) { const Frame F = make_frame(lds, wave_s); TP_BEGIN(4) p4_mixer(F, args, g); GRID_BAR(); TP_END(4); }
    if (IN(5)) { const Frame F = make_frame(lds, wave_s); TP_BEGIN(5) p5_finalize(F, args, g); GRID_BAR(); TP_END(5); }
    if (IN(6)) { const Frame F = make_frame(lds, wave_s);
        pg8::Gemm gm{(const bf16_t*)(ws + A_OAB), (const bf16_t*)(ws + WS_WPAB)}; EpiBranch E{ws};
        TP_BEGIN(6) pg8::gemm_phase<GT, DM, 1024, 2048, 2048, 2, 1024, 2>(F.lds, gm, fresh_grid(), fresh_bid(), F.tid, E); GRID_BAR();
        if (INT8_WOUT) { p7b_quant_x1(F, (const bf16_t*)(ws + A_MRG), ws + A_K, (float*)(ws + WS_PRM) + P_SM); GRID_BAR(); } TP_END(6);
    }
    if (IN(7)) { const Frame F = make_frame(lds, wave_s);
        pg8::Gemm gm{(const bf16_t*)(ws + (INT8_WOUT ? A_K : A_MRG)), (const bf16_t*)(ws + WS_WOUT)};
        EpiWout E{xg, (bf16_t*)(ws + A_X1B), rss, (const float*)(ws + WS_PRM) + P_SM, (const float*)(ws + WS_PRM) + P_SWWO}; TP_BEGIN(7) if (INT8_WOUT) pg8::gemm_phase<GT, DM, DM / 2, DM / 2, DM / 2, 1, 0, 2>(F.lds, gm, fresh_grid(), fresh_bid(), F.tid, E); else pg8::gemm_phase<GT, DM, DM, DM, DM, 1, 0, 0>(F.lds, gm, fresh_grid(), fresh_bid(), F.tid, E);
        GRID_BAR(); TP_END(7);
    }
    if (IN(8)) { const Frame F = make_frame(lds, wave_s);
        TP_BEGIN(8)
        float* sx = (float*)(ws + WS_PRM) + P_SX + (size_t)GI * GT;
        p7b_quant_x1(F, (const bf16_t*)(ws + A_X1B), (unsigned char*)outg, sx); GRID_BAR();
        pg8::Gemm gm{(const bf16_t*)outg, (const bf16_t*)(ws + WS_WUP)};
#if FUSE_CONV
        EpiUpConv E{ws, GI, (LAS float*)(F.lds + 131072)};
#else
        EpiUp E{rss, (bf16_t*)(ws + A_FA), (bf16_t*)(ws + A_FG), sx, (const float*)(ws + WS_PRM) + P_SWUP};
#endif
        pg8::gemm_phase<GT, 2 * DFF, DM / 2, DM / 2, DM / 2, 1, 0, 2>(F.lds, gm, fresh_grid(), fresh_bid(), F.tid, E); GRID_BAR(); TP_END(8);
    }
#if FUSE_CONV
    if (IN(9)) { const Frame F = make_frame(lds, wave_s); TP_BEGIN(9) p9_fix(F, (const float*)(ws + A_FA), u8_ptr(args, g), (const float*)(ws + WS_PRM) + P_CW, (const float*)(ws + WS_PRM) + P_CB, g ? 2048 : 4096); GRID_BAR(); TP_END(9); }
#else
    if (IN(9)) { const Frame F = make_frame(lds, wave_s); TP_BEGIN(9) p9_conv(F, args, g); GRID_BAR(); TP_END(9); }
#endif
    if (IN(10)) { const Frame F = make_frame(lds, wave_s);
        pg8::Gemm gm{(const bf16_t*)u8_ptr(args, g), (const bf16_t*)(ws + WS_WDN)};
        EpiDown E{outg, (const bf16_t*)(ws + A_X1B), 1.f / (U8_SCALE * W8_SCALE)}; TP_BEGIN(10) pg8::gemm_phase<GT, DM, DFF / 2, DFF / 2, DFF / 2, 1, 0, 1>(F.lds, gm, fresh_grid(), fresh_bid(), F.tid, E); TP_END(10);
        if (more) GRID_BAR();
    }
}
__global__ void __launch_bounds__(NTHR, 2) mk_fwd(Args args) {
    extern __shared__ __attribute__((aligned(16))) unsigned char lds_raw[];
    LAS unsigned char* lds = (LAS unsigned char*)lds_raw;
    const int wave_s = __builtin_amdgcn_readfirstlane((int)threadIdx.x >> 6);
#if MK_TPROBE == 99
    const unsigned long long tp_k0 = __builtin_amdgcn_s_memrealtime();
#endif
    { volatile LAS unsigned* MISC = (volatile LAS unsigned*)(lds + LDS_MISC); const int t = fresh_tid(wave_s); if (t < 64) MISC[t] = 0u; }
    __syncthreads();
#if MK_ONE_LAUNCH
    (void)xcd_barrier_post((unsigned*)(args.ws + WS_CTL) + CW_BAR, (volatile LAS unsigned*)(lds + LDS_MISC));
    { const Frame F = make_frame(lds, wave_s); p0_colmax(F, args.in[21], DM, 2 * DFF, args.in[20], (unsigned*)(args.ws + WS_CTL) + CW_CMAX_UP);
      p0_colmax(F, args.in[4], DM, DIN, nullptr, (unsigned*)(args.ws + WS_CTL) + CW_CMAX_IN);
      p0_colmax(F, args.in[17], 2048, DM, nullptr, (unsigned*)(args.ws + WS_CTL) + CW_CMAX_PA); p0_colmax(F, args.in[18], 2048, DM, nullptr, (unsigned*)(args.ws + WS_CTL) + CW_CMAX_PB);
      p0_colmax(F, args.in[19], DM, DM, nullptr, (unsigned*)(args.ws + WS_CTL) + CW_CMAX_WO); }
    { XcdBarrier b_; b_.bar = (unsigned*)(args.ws + WS_CTL) + CW_BAR; b_.x = xb_xcc_id(); b_.st = (volatile LAS unsigned*)(lds + LDS_MISC); xcd_barrier(b_); }
    { const Frame F = make_frame(lds, wave_s); TP_BEGIN(0) p0_weights(F, args); TP_END(0); }
    group_body<0>(lds, wave_s, args, true);
    group_body<1>(lds, wave_s, args, false);
#if MK_TPROBE == 99
    { const Frame F = make_frame(lds, wave_s); if (fresh_bid() == 0 && F.tid == 0) args.out[0] += (float)(unsigned)(__builtin_amdgcn_s_memrealtime() - tp_k0) * 1e-4f; }
#elif MK_TPROBE >= 0
    { const Frame F = make_frame(lds, wave_s); if (fresh_bid() == 0 && F.tid == 0) { volatile LAS unsigned* m_ = (volatile LAS unsigned*)(lds + LDS_MISC); args.out[0] += (float)m_[32] * 1e-4f; } }
#endif
#else
    if (args.ph_lo == 0 && args.g_lo == 0) { const Frame F = make_frame(lds, wave_s); p0_weights(F, args); }
    if (args.g_lo <= 0 && 0 < args.g_hi) group_body<0>(lds, wave_s, args, false);
    if (args.g_lo <= 1 && 1 < args.g_hi) group_body<1>(lds, wave_s, args, false);
#endif
}
#undef IN
#undef GRID_BAR


#if MK_DIAG
constexpr int CW_DIAG = 32768;
__global__ void diag_scan_bf16(const bf16_t* p, size_t n, unsigned* diag, int stage, float thr) {
    unsigned bad = 0;
    for (size_t i = (size_t)blockIdx.x * blockDim.x + threadIdx.x; i < n; i += (size_t)gridDim.x * blockDim.x) { const float v = bf2f(p[i]); if (!(fabsf(v) <= thr)) ++bad; }
    if (bad) atomicAdd(diag + stage, bad);
}
__global__ void diag_scan_f32(const float* p, size_t n, unsigned* diag, int stage, float thr) {
    unsigned bad = 0;
    for (size_t i = (size_t)blockIdx.x * blockDim.x + threadIdx.x; i < n; i += (size_t)gridDim.x * blockDim.x) { const float v = p[i]; if (!(fabsf(v) <= thr)) ++bad; }
    if (bad) atomicAdd(diag + stage, bad);
}

__global__ void diag_check_inproj(const float* x, const float* gm, const float* w_in, unsigned char* ws, unsigned* flag) {
    const int lane = threadIdx.x & 63, wv = (blockIdx.x * blockDim.x + threadIdx.x) >> 6, nw = (gridDim.x * blockDim.x) >> 6;
    const bf16_t* H = (const bf16_t*)(ws + A_H); const bf16_t* W = (const bf16_t*)(ws + WS_WIN);
    for (int s = wv; s < 4096; s += nw) {
        const unsigned hsh = (unsigned)s * 2654435761u; const int row = (int)((hsh >> 8) % GT);
        { float ss = 0.f; for (int k = lane; k < DM; k += 64) { const float v = x[(size_t)row * DM + k]; ss += v * v; } ss = wave_sum(ss);
          const int k = (int)((hsh >> 3) % DM); const float ref = x[(size_t)row * DM + k] * (1.f / sqrtf(ss / DM + EPS)) * gm[k]; const float got = bf2f(H[(size_t)row * DM + k]);
          if (!(fabsf(got - ref) <= 0.02f * fabsf(ref) + 1e-3f)) atomicOr(flag, 1u); }
        { const int n = (int)((hsh >> 5) % DIN), k = (int)((hsh >> 7) % DM); const int nn = n < 12288 ? n : (n < 12320 ? 20480 + (n - 12288) : n - 32);
          const float ref = w_in[(size_t)k * DIN + n], got = bf2f(W[(size_t)nn * DM + k]); if (!(fabsf(got - ref) <= 0.01f * fabsf(ref) + 1e-6f)) atomicOr(flag, 2u); }
        { const int seg = s % 7; int ncol, ld; size_t boff; float scale = 1.f;
          if (seg == 0) { ncol = 2048; ld = 2048; boff = A_Q; } else if (seg == 1) { ncol = 2048; ld = 2048; boff = A_K; } else if (seg == 2) { ncol = 2048; ld = 2048; boff = A_V; }
          else if (seg == 3) { ncol = 1024; ld = 1024; boff = A_GQ; scale = 0.0625f; } else if (seg == 4) { ncol = 1024; ld = 1024; boff = A_GK; } else if (seg == 5) { ncol = 2048; ld = 2048; boff = A_GV; } else { ncol = 32; ld = 32; boff = WS_ST; }
          const int segbase[7] = {0, 2048, 4096, 6144, 7168, 8192, 20480};
          const int c = (int)((hsh >> 11) % ncol); const int nn = segbase[seg] + c;
          float acc = 0.f; for (int k = lane; k < DM; k += 64) acc += bf2f(H[(size_t)row * DM + k]) * bf2f(W[(size_t)nn * DM + k]); acc = wave_sum(acc) * scale;
          const float got = seg == 6 ? ((const float*)(ws + boff))[(size_t)row * 32 + c] : bf2f(((const bf16_t*)(ws + boff))[(size_t)row * ld + c]);
          if (!(fabsf(got - acc) <= 0.02f * fabsf(acc) + 0.02f)) atomicOr(flag, 4u << seg); }
    }
}
__global__ void diag_final(float* out, size_t n, const unsigned* diag, int nstages) {
    int D = (int)(diag[50] & 32u); for (int s = 0; s < 4; ++s) if (diag[40 + s]) D |= 1 << s; if (diag[41] > 1000u) D |= 16;
    if (D == 0) return;
    const float c = exp2f(0.5f * (float)D);
    for (size_t i = (size_t)blockIdx.x * blockDim.x + threadIdx.x; i < n; i += (size_t)gridDim.x * blockDim.x) out[i] = c;
}
#endif
extern "C" void kernel_launch(void* const* d_in, const int* in_sizes, int n_in, void* d_out, int out_size, void* d_ws, size_t ws_size, hipStream_t stream) {
    static int grid = 0;
    if (grid == 0) {
        if (n_in != 25 || ws_size < WS_END) { fprintf(stderr, "kernel_launch: n_in %d ws %zu (need %zu)\n", n_in, ws_size, (size_t)WS_END); grid = -1; return; }
        int dev = 0, cus = 0, per_cu = 0;
        if (hipGetDevice(&dev) != hipSuccess || hipDeviceGetAttribute(&cus, hipDeviceAttributeMultiprocessorCount, dev) != hipSuccess) { grid = -1; return; }
        if (hipFuncSetAttribute((const void*)mk_fwd, hipFuncAttributeMaxDynamicSharedMemorySize, LDS_BYTES) != hipSuccess) { fprintf(stderr, "kernel_launch: hipFuncSetAttribute failed\n"); grid = -1; return; }
        if (hipOccupancyMaxActiveBlocksPerMultiprocessor(&per_cu, (const void*)mk_fwd, NTHR, LDS_BYTES) != hipSuccess || per_cu < 1) { fprintf(stderr, "kernel_launch: occupancy query says %d\n", per_cu); }
        (void)hipGetLastError();
        grid = cus;
    }
    if (grid < 0) return;
    (void)hipMemsetAsync((char*)d_ws + WS_CTL, 0, CTL_ZERO_BYTES, stream);
    Args a{};
    for (int i = 0; i < 25; ++i) a.in[i] = (const float*)d_in[i];
    a.out = (float*)d_out; a.ws = (unsigned char*)d_ws;
#if MK_ONE_LAUNCH
    a.ph_lo = 0; a.ph_hi = NPH; a.g_lo = 0; a.g_hi = 2;
    hipLaunchKernelGGL(mk_fwd, dim3(grid), dim3(NTHR), LDS_BYTES, stream, a);
#else
    a.ph_lo = 0; a.ph_hi = 1; a.g_lo = 0; a.g_hi = 1;
    hipLaunchKernelGGL(mk_fwd, dim3(grid), dim3(NTHR), LDS_BYTES, stream, a);
#if MK_DIAG
    unsigned char* ws = (unsigned char*)d_ws; unsigned* dg = (unsigned*)(ws + WS_CTL) + CW_DIAG;
#define SCANB(ptr, nel, st, thr) hipLaunchKernelGGL(diag_scan_bf16, dim3(2048), dim3(256), 0, stream, (const bf16_t*)(ptr), (size_t)(nel), dg, (st), (thr))
#define SCANF(ptr, nel, st, thr) hipLaunchKernelGGL(diag_scan_f32, dim3(2048), dim3(256), 0, stream, (const float*)(ptr), (size_t)(nel), dg, (st), (thr))
    SCANB(ws + WS_WIN, (WS_ACT - WS_WIN) / 2, 1, 1e4f);
    SCANF(ws + WS_PRM, P_END, 1, 1e4f);
#endif
    for (int g = 0; g < 2; ++g)
        for (int p = 1; p < NPH; ++p) { a.ph_lo = p; a.ph_hi = p + 1; a.g_lo = g; a.g_hi = g + 1; hipLaunchKernelGGL(mk_fwd, dim3(grid), dim3(NTHR), LDS_BYTES, stream, a);
#if MK_DIAG
            const int sb = 2 + g * 12; float* og = (float*)d_out + (size_t)g * GT * DM; const size_t E64 = (size_t)GT * 2048;
            if (p == 1) SCANB(ws + A_H, 2 * E64, sb + 0, 1e4f);
            if (p == 2) { SCANB(ws + A_Q, (A_SB + 128 * MiB - A_Q) / 2, sb + 1, 1e4f); SCANF(ws + WS_ST, (size_t)GT * 32, sb + 1, 1e4f); }
            if (p == 3 && g == 0) { SCANB((bf16_t*)og + 2 * E64, 2 * E64, 40, 3e38f); SCANB((bf16_t*)og + 2 * E64, 2 * E64, 41, 1e4f); SCANB((bf16_t*)og + 2 * E64, E64, 42, 1e4f); SCANB((bf16_t*)og + 3 * E64, E64, 43, 1e4f); }
            if (p == 4) SCANB(og, 4 * E64, sb + 3, 1e4f);
            if (p == 5) SCANB(ws + A_OAB, 2 * E64, sb + 4, 1e4f);
            if (p == 6) SCANB(ws + A_MRG, 2 * E64, sb + 5, 1e4f);
            if (p == 7) { SCANF(og, (size_t)GT * DM, sb + 6, 1e4f); SCANB(ws + A_X1B, 2 * E64, sb + 6, 1e4f); SCANF((float*)((unsigned*)(ws + WS_CTL) + CW_RSS) + (size_t)g * GT, GT, sb + 6, 1e6f); }
            if (p == 8) { SCANB(ws + A_FA, (size_t)GT * DFF, sb + 7, 1e4f); SCANB(ws + A_FG, (size_t)GT * DFF, sb + 7, 1e4f); }
            if (p == 9) SCANB(ws + A_FG, (size_t)GT * DFF, sb + 8, 1e4f);
            if (p == 10) SCANF(og, (size_t)GT * DM, sb + 9, 1e4f);
#endif
        }
#if MK_DIAG
    hipLaunchKernelGGL(diag_final, dim3(2048), dim3(256), 0, stream, (float*)d_out, (size_t)2 * GT * DM, dg, 32);
#endif
#endif
}
```

```cpp
#include <hip/hip_runtime.h>
#include <cstdio>
#include <cstdint>

#ifndef MK_ONE_LAUNCH
#define MK_ONE_LAUNCH 1
#endif
#ifndef INT8_WOUT
#define INT8_WOUT 1
#endif
#ifndef ATT_DMA
#define ATT_DMA 2
#endif
#ifndef FUSE_CONV
#define FUSE_CONV 1
#endif
#ifndef ATT_PV_KMAJOR
#define ATT_PV_KMAJOR 1
#endif
#ifndef RELAX_EPI
#define RELAX_EPI 1
#endif
#ifndef ATT_FULLV
#define ATT_FULLV 1
#endif
#ifndef ATT_PIPE
#define ATT_PIPE 0
#endif
#ifndef MK_TPROBE
#define MK_TPROBE -1
#endif
#ifndef MK_DIAG
#define MK_DIAG 0
#endif
#define DG_WORD(ws) ((unsigned*)((ws) + WS_CTL) + 32768 + 50)

#define LAS __attribute__((address_space(3)))
#define GAS __attribute__((address_space(1)))
typedef unsigned short bf16_t;
typedef short bf16x8 __attribute__((ext_vector_type(8)));
typedef short s16x4 __attribute__((ext_vector_type(4)));
typedef float f32x4 __attribute__((ext_vector_type(4)));
typedef float f32x2 __attribute__((ext_vector_type(2)));
typedef float f32x16 __attribute__((ext_vector_type(16)));
typedef unsigned u32x4 __attribute__((ext_vector_type(4)));
typedef unsigned u32x2 __attribute__((ext_vector_type(2)));

constexpr int DM = 4096, GT = 16384  , DIN = 20512, DINP = 20736, DFF = 11008;
constexpr float EPS = 1e-6f;
constexpr float LOG2E = 1.4426950408889634f;
constexpr int NWAVES = 8, NTHR = 512;

constexpr size_t MiB = 1u << 20;
constexpr size_t WS_CTL = 0, CTL_ZERO_BYTES = 1 * MiB;
constexpr size_t WS_PRM = 1 * MiB;
constexpr int P_LAM = 0, P_GMIX = 64, P_QG = 4160, P_KG = 4288, P_SUBLN = 4416, P_WGF = 4672, P_BGF = 21056, P_WGB = 22080, P_BGB = 38464, P_GLAG = 39488, P_CW = 40000, P_CB = 73024, P_RB = 84032, P_END = 84288;
constexpr size_t WS_ST = 2 * MiB;
constexpr size_t WS_DEC = 4 * MiB;
constexpr size_t WS_WIN = 8 * MiB;
constexpr size_t WS_WIN8 = 96 * MiB;
constexpr size_t WS_WUP = 170 * MiB;
constexpr size_t WS_WDN = 342 * MiB;
constexpr size_t WS_WOUT = 428 * MiB;
constexpr size_t WS_WPAB = 460 * MiB;
constexpr size_t WS_ACT = 492 * MiB;
constexpr size_t A_H = WS_ACT + 0 * MiB;
constexpr size_t A_Q = WS_ACT + 128 * MiB, A_K = WS_ACT + 192 * MiB, A_V = WS_ACT + 256 * MiB;
constexpr size_t A_GQ = WS_ACT + 320 * MiB, A_GK = WS_ACT + 352 * MiB;
constexpr size_t A_GV = WS_ACT + 384 * MiB, A_GR = WS_ACT + 448 * MiB;
constexpr size_t A_SA = WS_ACT + 512 * MiB, A_SB = WS_ACT + 640 * MiB;
constexpr size_t A_ATT = WS_ACT + 768 * MiB;
constexpr size_t A_QD = A_H, A_KDT = A_H + 64 * MiB;
constexpr size_t A_OAB = A_Q;
constexpr size_t A_MRG = A_V;
constexpr size_t A_X1B = A_H;
constexpr size_t A_FA = WS_ACT + 128 * MiB;
constexpr size_t A_FG = WS_ACT + 472 * MiB;
constexpr size_t WS_END = WS_ACT + 816 * MiB;
constexpr float H8_SCALE = 16.f;
constexpr float U8_SCALE = 8.f, W8_SCALE = 64.f;
constexpr int CW_CMAX_UP = 100000, CW_CMAX_IN = 125000;
constexpr int P_SWUP = 150000, P_SWIN = 175000;
constexpr int CW_CMAX_PA = 146000, CW_CMAX_PB = 150100, CW_CMAX_WO = 154200;
constexpr int P_SOA = 200000, P_SOB = 216384, P_SM = 232768;
constexpr int P_SWPA = 249200, P_SWPB = 253296, P_SWWO = 257392;
constexpr int CW_WMAX = 40000;
constexpr int P_SH = 130000;
constexpr int P_SX = 90000;
constexpr int CW_BAR = 1024;
constexpr int CW_RSS = 65536;

constexpr int LDS_BYTES = 155648;
constexpr int LDS_MISC = 153600;

typedef __bf16 nbf16x2 __attribute__((ext_vector_type(2)));
__device__ __forceinline__ unsigned cvt_pk_bf16(float lo, float hi) { const f32x2 v = {lo, hi}; return __builtin_bit_cast(unsigned, __builtin_convertvector(v, nbf16x2)); }
__device__ __forceinline__ float bflo(unsigned w) { return __uint_as_float(w << 16); }
__device__ __forceinline__ float bfhi(unsigned w) { return __uint_as_float(w & 0xffff0000u); }
__device__ __forceinline__ float bf2f(bf16_t v) { return __uint_as_float(((unsigned)v) << 16); }
__device__ __forceinline__ bf16_t f2bf(float f) { return (bf16_t)(cvt_pk_bf16(f, 0.f) & 0xffffu); }
__device__ __forceinline__ float sat8(float v) { return __builtin_fminf(__builtin_fmaxf(v, -448.f), 448.f); }
__device__ __forceinline__ unsigned pack_i8x4(float a, float b, float c, float d) {
    const int ia = (int)__builtin_rintf(a), ib = (int)__builtin_rintf(b), ic = (int)__builtin_rintf(c), id = (int)__builtin_rintf(d);
    return (unsigned)(ia & 0xff) | ((unsigned)(ib & 0xff) << 8) | ((unsigned)(ic & 0xff) << 16) | ((unsigned)id << 24);
}
__device__ __forceinline__ float wave_sum(float v) {
#pragma unroll
    for (int o = 1; o < 64; o <<= 1) v += __shfl_xor(v, o);
    return v;
}
__device__ __forceinline__ float fast_exp(float x) { return __builtin_amdgcn_exp2f(x * LOG2E); }
__device__ __forceinline__ float sigmoidf_(float x) { return __builtin_amdgcn_rcpf(1.f + fast_exp(-x)); }

__device__ __forceinline__ int fresh_tid(int wave_s) { int l; asm volatile("v_mbcnt_lo_u32_b32 %0, -1, 0\n\tv_mbcnt_hi_u32_b32 %0, -1, %0" : "=v"(l)); return (wave_s << 6) | l; }
__device__ __forceinline__ int fresh_bid() { int b = blockIdx.x; asm volatile("" : "+s"(b)); return b; }
__device__ __forceinline__ int fresh_grid() { int g = gridDim.x; asm volatile("" : "+s"(g)); return g; }
#define XB_TMO      128
#define XB_XCNT(j)  (256  + 64 * (j))
#define XB_XSUB(j)  (1280 + 64 * (j))
#define XB_XGEN(j)  (2304 + 64 * (j))
#define XB_TOP      3328
#define XB_TOPGEN   3392
#define XCD_BAR_WORDS 3456
#define XB_SPIN_CAP (1u << 18)
__device__ __forceinline__ unsigned xb_ld(unsigned* p)              { return __hip_atomic_load(p, __ATOMIC_RELAXED, __HIP_MEMORY_SCOPE_AGENT); }
__device__ __forceinline__ unsigned xb_add(unsigned* p, unsigned v) { return __hip_atomic_fetch_add(p, v, __ATOMIC_RELAXED, __HIP_MEMORY_SCOPE_AGENT); }
__device__ __forceinline__ unsigned xb_xcc_id() { return (unsigned)__builtin_amdgcn_s_getreg((3 << 11) | 20) & 0xFu; }
#define XB_SPIN(cond, bar) do { unsigned _sp = 0; while (cond) { __builtin_amdgcn_s_sleep(1); \
    if ((++_sp & 255u) == 0u) { if (xb_ld(&(bar)[XB_TMO])) break; if (_sp > XB_SPIN_CAP) { atomicAdd(&(bar)[XB_TMO], 1u); break; } } } } while (0)
struct XcdBarrier { unsigned* bar; unsigned x; volatile LAS unsigned* st; };
__device__ __forceinline__ XcdBarrier xcd_barrier_post(unsigned* bar, volatile LAS unsigned* st) {
    XcdBarrier b; b.bar = bar; b.x = xb_xcc_id(); b.st = st;
    if (threadIdx.x == 0) (void)xb_add(&bar[XB_XCNT(b.x)], 1u);
    return b;
}
__device__ __forceinline__ void xcd_barrier_complete(unsigned* bar, unsigned x, unsigned& nloc, unsigned& nx) {
    const unsigned G = gridDim.x * gridDim.y * gridDim.z;
    unsigned sum, cnt, mine, sp = 0u;
    for (;;) {
        sum = 0u; cnt = 0u; mine = 0u;
#pragma unroll
        for (unsigned j = 0; j < 16; ++j) { const unsigned c = xb_ld(&bar[XB_XCNT(j)]); sum += c; cnt += (c > 0u) ? 1u : 0u; mine = (j == x) ? c : mine; }
        if (sum == G) break;
        __builtin_amdgcn_s_sleep(1);
        if ((++sp & 255u) == 0u) { if (xb_ld(&bar[XB_TMO])) break; if (sp > XB_SPIN_CAP) { atomicAdd(&bar[XB_TMO], 1u); break; } }
    }
    nloc = mine > 0u ? mine : 1u; nx = cnt > 0u ? cnt : 1u;
}
__device__ __forceinline__ void xcd_barrier(const XcdBarrier& b) {
    asm volatile("s_waitcnt vmcnt(0)" ::: "memory");
    __syncthreads();
    if (threadIdx.x == 0) {
        unsigned* bar = b.bar;
        __builtin_amdgcn_s_waitcnt(0);
        unsigned nloc = b.st[0], nx = b.st[1];
        if (nloc == 0u) { xcd_barrier_complete(bar, b.x, nloc, nx); b.st[0] = nloc; b.st[1] = nx; }
        const unsigned old = xb_add(&bar[XB_XSUB(b.x)], 1u);
        const unsigned gen = old / nloc;
        if (old + 1u == (gen + 1u) * nloc) {
            __builtin_amdgcn_fence(__ATOMIC_RELEASE, "agent");
            asm volatile("s_waitcnt vmcnt(0)" ::: "memory");
            const unsigned og = xb_add(&bar[XB_TOP], 1u);
            const unsigned tg = og / nx;
            if (og + 1u == (tg + 1u) * nx) xb_add(&bar[XB_TOPGEN], 1u);
            else XB_SPIN(xb_ld(&bar[XB_TOPGEN]) == tg, bar);
            __builtin_amdgcn_fence(__ATOMIC_ACQUIRE, "agent");
            xb_add(&bar[XB_XGEN(b.x)], 1u);
            asm volatile("s_waitcnt vmcnt(0)" ::: "memory");
        } else {
            XB_SPIN(xb_ld(&bar[XB_XGEN(b.x)]) == gen, bar);
            __builtin_amdgcn_fence(__ATOMIC_ACQUIRE, "agent");
            asm volatile("s_waitcnt vmcnt(0)" ::: "memory");
        }
    }
    __syncthreads();
}

namespace pg8 {
typedef int i32x8_ __attribute__((ext_vector_type(8)));
typedef int i32x4_ __attribute__((ext_vector_type(4)));
union Frag { i32x8_ v; bf16x8 q[2]; };
constexpr int BM = 256, BK = 64, HALF = 128, HTB = HALF * BK * 2, STAGE_BYTES = 8 * HTB, NXCD = 8, WGM = 4;
__host__ __device__ __forceinline__ int lds_byte(int r, int c) { const int st = (r >> 4) * 2 + (c >> 5), rr = r & 15, cc = c & 31, ob = rr * 64 + cc * 2; return st * 1024 + (ob ^ (((ob >> 9) & 1) << 5)); }
__host__ __device__ __forceinline__ void stage_rc(int b, int& R, int& C) { const int st = b / 1024, sb = b % 1024, swz = sb ^ (((sb >> 9) & 1) << 5); R = (st >> 1) * 16 + swz / 64; C = (st & 1) * 32 + (swz % 64) / 2; }
__host__ __device__ __forceinline__ int perm32(int rho) { const int n = rho >> 4, i = rho & 15; return 8 * (i >> 2) + 4 * n + (i & 3); }
struct Unit { int pm, pn, ps; };
struct Gemm { const bf16_t* A; const bf16_t* Bt; };
template <int NM, int NN, int PASSES> struct StaticOrder {
    int G, c;
    __device__ __forceinline__ bool next(int i, Unit& u) const {
        constexpr int nwg = NM * NN;
        const int ti = PASSES == 2 ? (i >> 1) : i;
        const long L = (long)ti * G + c; if (L >= nwg) return false;
        int wgid = (int)L; { constexpr int q = nwg / NXCD, r = nwg % NXCD; const int xcd = wgid % NXCD, off = wgid / NXCD; wgid = (xcd < r ? xcd * (q + 1) : r * (q + 1) + (xcd - r) * q) + off; }
        constexpr int nig = WGM * NN; const int gid = wgid / nig, fm = gid * WGM, gsz = (NM - fm) < WGM ? (NM - fm) : WGM;
        u.pm = fm + ((wgid % nig) % gsz); u.pn = (wgid % nig) / gsz; u.ps = PASSES == 2 ? (i & 1) : 0; return true;
    }
};
template <int M, int N, int K, int LDA, int LDB, int PASSES, int PASS_OFF  , int MODE  , class Epi>
__device__ __forceinline__ void gemm_phase(LAS unsigned char* lds, const Gemm g, int G, int c, int tid_, const Epi& E) {
    StaticOrder<M / BM, N / BM, PASSES> S; S.G = G; S.c = c;
    const int tid = tid_, wid = __builtin_amdgcn_readfirstlane(tid >> 6), lane = tid & 63, wr = wid >> 2, wc = wid & 3, fr = lane & 15, fq = lane >> 4;
    constexpr int nt = K / BK;
    unsigned voffA[2], voffB[2];
#pragma unroll
    for (int i = 0; i < 2; ++i) { int R, C; stage_rc(tid * 16 + i * 8192, R, C); const int Rb = Epi::PERM ? ((R & ~31) + perm32(R & 31)) : R;
        voffA[i] = (unsigned)(R * LDA + C) * 2u; voffB[i] = (unsigned)(Rb * LDB + C) * 2u; }
    constexpr size_t kstep = (size_t)(BK * 2);
    constexpr size_t hstepA = (size_t)HALF * LDA * 2, hstepB = (size_t)HALF * LDB * 2;
    constexpr size_t tstepA = 2 * hstepA, tstepB = 2 * hstepB, pstep = (size_t)PASS_OFF * 2;
    const unsigned ldsw = (unsigned)wid * 1024u;
    const int aoff = lds_byte(wr * 64 + fr, fq * 8), boff = lds_byte(wc * 32 + fr, fq * 8);
#define PG8_SA(b, h) (((b) * 2 + (h)) * HTB)
#define PG8_SB(b, h) ((4 + (b) * 2 + (h)) * HTB)
#define PG8_STAGE(bufoff, gbase, voff) do { _Pragma("unroll") for (int _i = 0; _i < 2; ++_i) \
        __builtin_amdgcn_global_load_lds((const unsigned*)((const char*)(gbase) + (voff)[_i]), (LAS unsigned*)(lds + (bufoff) + ldsw + _i * 8192), 16, 0, 0); } while (0)
#define PG8_LDA(dst, b, h) do { _Pragma("unroll") for (int m = 0; m < 4; ++m) _Pragma("unroll") for (int k = 0; k < 2; ++k) dst[m].q[k] = *(const LAS bf16x8*)(lds + PG8_SA(b, h) + aoff + m * 2048 + k * 1024); } while (0)
#define PG8_LDB(dst, b, h) do { _Pragma("unroll") for (int n = 0; n < 2; ++n) _Pragma("unroll") for (int k = 0; k < 2; ++k) dst[n].q[k] = *(const LAS bf16x8*)(lds + PG8_SB(b, h) + boff + n * 2048 + k * 1024); } while (0)
#define PG8_MMA(ai, bj, At, Bt) do { __builtin_amdgcn_s_setprio(1); _Pragma("unroll") for (int m = 0; m < 4; ++m) _Pragma("unroll") for (int n = 0; n < 2; ++n) { \
        if constexpr (FP8) asm volatile("v_mfma_scale_f32_16x16x128_f8f6f4 %0, %1, %2, %0, %3, %3 op_sel_hi:[0,0,0]" : "+v"(acc[ai][bj][m][n]) : "v"(Bt[n].v), "v"(At[m].v), "v"(one_scale)); \
        else if constexpr (MODE == 2) { _Pragma("unroll") for (int k = 0; k < 2; ++k) acc[ai][bj][m][n] = __builtin_bit_cast(f32x4, __builtin_amdgcn_mfma_i32_16x16x64_i8(__builtin_bit_cast(i32x4_, Bt[n].q[k]), __builtin_bit_cast(i32x4_, At[m].q[k]), __builtin_bit_cast(i32x4_, acc[ai][bj][m][n]), 0, 0, 0)); } \
        else { _Pragma("unroll") for (int k = 0; k < 2; ++k) acc[ai][bj][m][n] = __builtin_amdgcn_mfma_f32_16x16x32_bf16(Bt[n].q[k], At[m].q[k], acc[ai][bj][m][n], 0, 0, 0); } } \
        __builtin_amdgcn_s_setprio(0); } while (0)
#define PG8_WAIT_V(n) asm volatile("s_waitcnt vmcnt(" #n ")" ::: "memory")
#define PG8_WAIT_L(n) asm volatile("s_waitcnt lgkmcnt(" #n ")" ::: "memory")
#define PG8_BAR __builtin_amdgcn_s_barrier()
#define PG8_SCHED __builtin_amdgcn_sched_barrier(0)
    Unit cur, nxt; int ui = 0;
    if (!S.next(0, cur)) return;
    f32x4 acc[2][2][4][2];
#pragma unroll
    for (int a = 0; a < 2; ++a)
#pragma unroll
        for (int b = 0; b < 2; ++b)
#pragma unroll
            for (int m = 0; m < 4; ++m)
#pragma unroll
                for (int n = 0; n < 2; ++n) acc[a][b][m][n] = (f32x4){0.f, 0.f, 0.f, 0.f};
    Frag At[4], B0[2], B1[2];
    const int one_scale = 0x7f7f7f7f;
    constexpr bool FP8 = MODE == 1;
    const char* cA = (const char*)g.A + (size_t)cur.pm * tstepA + (size_t)cur.ps * pstep; const char* cB = (const char*)g.Bt + (size_t)cur.pn * tstepB + (size_t)cur.ps * pstep;
    PG8_STAGE(PG8_SB(0, 0), cB, voffB); PG8_STAGE(PG8_SB(0, 1), cB + hstepB, voffB); PG8_STAGE(PG8_SA(0, 0), cA, voffA); PG8_STAGE(PG8_SA(0, 1), cA + hstepA, voffA);
    if (wr == 1) PG8_BAR;
    PG8_WAIT_V(2); PG8_BAR;
    PG8_STAGE(PG8_SB(1, 0), cB + kstep, voffB); PG8_STAGE(PG8_SA(1, 0), cA + kstep, voffA); PG8_STAGE(PG8_SB(1, 1), cB + hstepB + kstep, voffB);
    PG8_WAIT_V(6); PG8_BAR;
    for (;;) {
        const bool has_next = S.next(ui + 1, nxt);
        const char* nA = has_next ? (const char*)g.A + (size_t)nxt.pm * tstepA + (size_t)nxt.ps * pstep : cA; const char* nB = has_next ? (const char*)g.Bt + (size_t)nxt.pn * tstepB + (size_t)nxt.ps * pstep : cB;
        for (int t = 0; t < nt; t += 2) {
            const bool last = (t == nt - 2);
            const char* a1 = cA + (size_t)(t + 1) * kstep;
            const char* a2 = last ? nA : cA + (size_t)(t + 2) * kstep; const char* b2 = last ? nB : cB + (size_t)(t + 2) * kstep;
            const char* a3 = a2 + kstep; const char* b3 = b2 + kstep;
            const int rlx = __builtin_amdgcn_readfirstlane((RELAX_EPI && (t == 0) && (ui > 0)) ? 1 : 0);
#define PG8_WAIT_V8R() do { if constexpr (Epi::NST >= 32) asm volatile("s_waitcnt vmcnt(40)\n\ts_cmp_lg_u32 %0, 0\n\ts_cbranch_scc1 .Lrlx%=\n\ts_waitcnt vmcnt(8)\n.Lrlx%=:" :: "s"(rlx) : "memory", "scc"); \
                            else asm volatile("s_waitcnt vmcnt(24)\n\ts_cmp_lg_u32 %0, 0\n\ts_cbranch_scc1 .Lrlx%=\n\ts_waitcnt vmcnt(8)\n.Lrlx%=:" :: "s"(rlx) : "memory", "scc"); } while (0)
            PG8_LDB(B0, 0, 0); PG8_LDB(B1, 0, 1); PG8_SCHED; PG8_LDA(At, 0, 0); PG8_STAGE(PG8_SA(1, 1), a1 + hstepA, voffA);
            PG8_WAIT_V8R(); PG8_WAIT_L(0); PG8_BAR; PG8_MMA(0, 0, At, B0); PG8_MMA(0, 1, At, B1); PG8_BAR; PG8_SCHED;
            PG8_LDA(At, 0, 1); PG8_STAGE(PG8_SB(0, 0), b2, voffB); PG8_STAGE(PG8_SB(0, 1), b2 + hstepB, voffB); PG8_STAGE(PG8_SA(0, 0), a2, voffA);
            PG8_WAIT_V8R(); PG8_WAIT_L(0); PG8_BAR; PG8_MMA(1, 0, At, B0); PG8_MMA(1, 1, At, B1); PG8_BAR; PG8_SCHED;
#undef PG8_WAIT_V8R
            PG8_LDB(B0, 1, 0); PG8_LDB(B1, 1, 1); PG8_SCHED; PG8_LDA(At, 1, 0); PG8_STAGE(PG8_SA(0, 1), a2 + hstepA, voffA);
            PG8_WAIT_V(8); PG8_WAIT_L(0); PG8_BAR; PG8_MMA(0, 0, At, B0); PG8_MMA(0, 1, At, B1); PG8_BAR; PG8_SCHED;
            PG8_LDA(At, 1, 1); PG8_STAGE(PG8_SB(1, 0), b3, voffB); PG8_STAGE(PG8_SB(1, 1), b3 + hstepB, voffB); PG8_STAGE(PG8_SA(1, 0), a3, voffA);
            PG8_WAIT_V(8); PG8_WAIT_L(0); PG8_BAR; PG8_MMA(1, 0, At, B0); PG8_MMA(1, 1, At, B1); PG8_BAR; PG8_SCHED;
        }
        if (wr == 0) PG8_BAR;
        { int l_; asm volatile("v_mbcnt_lo_u32_b32 %0, -1, 0\n\tv_mbcnt_hi_u32_b32 %0, -1, %0" : "=v"(l_));
          E(acc, cur, wr, wc, l_ & 15, l_ >> 4); }
        if (!has_next) break;
#pragma unroll
        for (int a = 0; a < 2; ++a)
#pragma unroll
            for (int b = 0; b < 2; ++b)
#pragma unroll
                for (int m = 0; m < 4; ++m)
#pragma unroll
                    for (int n = 0; n < 2; ++n) acc[a][b][m][n] = (f32x4){0.f, 0.f, 0.f, 0.f};
        cur = nxt; cA = nA; cB = nB; ++ui;
        if (wr == 1) PG8_BAR;
    }
    PG8_WAIT_V(0);
    PG8_BAR;
#undef PG8_SA
#undef PG8_SB
#undef PG8_STAGE
#undef PG8_LDA
#undef PG8_LDB
#undef PG8_MMA
#undef PG8_WAIT_V
#undef PG8_WAIT_L
#undef PG8_BAR
#undef PG8_SCHED
}
}
using pg8::Unit;
constexpr int HALF = 128, BM = 256;

struct EpiInProj {
    static constexpr bool PERM = true;
    static constexpr int NST = 16;
    unsigned char* ws; const float* SH; const float* SW;
    LAS float* XS;
    __device__ __forceinline__ void qk_tile(const f32x4 (&acc)[2][2][4][2], const Unit& u, int wr, int wc, int fr, int fq, bf16_t* base, int col0) const {
        const int pn = u.pn, row0 = u.pm * BM + wr * 64 + fr; const float* gn = (const float*)(ws + WS_PRM) + (pn < 8 ? P_QG : P_KG) + wc * 32 + 8 * fq;
        f32x4 cs[2][2], g4[2]; float shr[2][4];
#pragma unroll
        for (int ai = 0; ai < 2; ++ai)
#pragma unroll
            for (int m = 0; m < 4; ++m) shr[ai][m] = SH[row0 + ai * HALF + m * 16];
#pragma unroll
        for (int n = 0; n < 2; ++n) { g4[n] = *(const f32x4*)(gn + 4 * n);
#pragma unroll
            for (int bj = 0; bj < 2; ++bj) cs[bj][n] = *(const f32x4*)(SW + pn * BM + bj * HALF + wc * 32 + 8 * fq + 4 * n); }
#pragma unroll
        for (int ai = 0; ai < 2; ++ai)
#pragma unroll
            for (int m = 0; m < 4; ++m) { const int rl = ai * HALF + wr * 64 + m * 16 + fr; const float sc = shr[ai][m];
#pragma unroll
                for (int bj = 0; bj < 2; ++bj) { float ss = 0.f;
#pragma unroll
                    for (int n = 0; n < 2; ++n) { const pg8::i32x4_ ii = __builtin_bit_cast(pg8::i32x4_, acc[ai][bj][m][n]); const f32x4 x = (f32x4){(float)ii[0], (float)ii[1], (float)ii[2], (float)ii[3]} * cs[bj][n] * sc;
                        ss += (x[0] * x[0] + x[1] * x[1]) + (x[2] * x[2] + x[3] * x[3]); }
                    ss += __shfl_xor(ss, 16); ss += __shfl_xor(ss, 32);
                    if (fq == 0) XS[(rl * 2 + bj) * 4 + wc] = ss; } }
        asm volatile("s_waitcnt lgkmcnt(0)" ::: "memory"); __builtin_amdgcn_s_barrier(); asm volatile("" ::: "memory");
#pragma unroll
        for (int bj = 0; bj < 2; ++bj)
#pragma unroll
            for (int n = 0; n < 2; ++n) asm volatile("" : "+v"(cs[bj][n]));
#pragma unroll
        for (int ai = 0; ai < 2; ++ai)
#pragma unroll
            for (int m = 0; m < 4; ++m) { const int rl = ai * HALF + wr * 64 + m * 16 + fr; bf16_t* rowp = base + (size_t)(u.pm * BM + rl) * 2048 + col0; const float sc = shr[ai][m];
#pragma unroll
                for (int bj = 0; bj < 2; ++bj) { const f32x4 p = *(const LAS f32x4*)(XS + (rl * 2 + bj) * 4); const float r = sc / sqrtf(((p[0] + p[1]) + (p[2] + p[3])) * (1.f / 128.f) + EPS);
                    pg8::i32x4_ j0 = __builtin_bit_cast(pg8::i32x4_, acc[ai][bj][m][0]), j1 = __builtin_bit_cast(pg8::i32x4_, acc[ai][bj][m][1]);
                    asm volatile("" : "+v"(j0), "+v"(j1));
                    const f32x4 y0 = (f32x4){(float)j0[0], (float)j0[1], (float)j0[2], (float)j0[3]} * cs[bj][0] * g4[0] * r, y1 = (f32x4){(float)j1[0], (float)j1[1], (float)j1[2], (float)j1[3]} * cs[bj][1] * g4[1] * r;
                    u32x4 w; w.x = cvt_pk_bf16(y0[0], y0[1]); w.y = cvt_pk_bf16(y0[2], y0[3]); w.z = cvt_pk_bf16(y1[0], y1[1]); w.w = cvt_pk_bf16(y1[2], y1[3]);
                    *(u32x4*)(rowp + bj * HALF) = w; } }
    }
    __device__ __forceinline__ void operator()(const f32x4 (&acc)[2][2][4][2], const Unit& u, int wr, int wc, int fr, int fq) const {
        const int pn = u.pn; const int row0 = u.pm * BM + wr * 64 + fr;
        if (pn == 80) {
            if (wc == 0) { float* ST = (float*)(ws + WS_ST);
#pragma unroll
                for (int ai = 0; ai < 2; ++ai)
#pragma unroll
                    for (int m = 0; m < 4; ++m) { const int row = row0 + ai * HALF + m * 16; float* rp = ST + (size_t)row * 32 + 8 * fq; const float sc = SH[row]; const f32x4 c0 = *(const f32x4*)(SW + 80 * BM + 8 * fq), c1 = *(const f32x4*)(SW + 80 * BM + 8 * fq + 4);
                        const pg8::i32x4_ i0 = __builtin_bit_cast(pg8::i32x4_, acc[ai][0][m][0]), i1 = __builtin_bit_cast(pg8::i32x4_, acc[ai][0][m][1]);
                        *(f32x4*)(rp) = (f32x4){(float)i0[0], (float)i0[1], (float)i0[2], (float)i0[3]} * c0 * sc; *(f32x4*)(rp + 4) = (f32x4){(float)i1[0], (float)i1[1], (float)i1[2], (float)i1[3]} * c1 * sc; }
            }
            else asm volatile("s_waitcnt vmcnt(0)" ::: "memory");
            return;
        }
        unsigned boff; int ld, cb, mode = 0;
        if (pn < 8) { boff = 0u; ld = 2048; cb = pn * 256; }
        else if (pn < 16) { boff = (unsigned)(A_K - A_Q); ld = 2048; cb = (pn - 8) * 256; }
        else if (pn < 24) { boff = (unsigned)(A_V - A_Q); ld = 2048; cb = (pn - 16) * 256; }
        else if (pn < 28) { boff = (unsigned)(A_GQ - A_Q); ld = 1024; cb = (pn - 24) * 256; mode = 1; }
        else if (pn < 32) { boff = (unsigned)(A_GK - A_Q); ld = 1024; cb = (pn - 28) * 256; }
        else if (pn < 40) { boff = (unsigned)(A_GV - A_Q); ld = 2048; cb = (pn - 32) * 256; }
        else if (pn < 48) { boff = (unsigned)(A_GR - A_Q); ld = 2048; cb = (pn - 40) * 256; mode = 2; }
        else if (pn < 64) { boff = (unsigned)(A_SA - A_Q); ld = 4096; cb = (pn - 48) * 256; mode = 3; }
        else { boff = (unsigned)(A_SB - A_Q); ld = 4096; cb = (pn - 64) * 256; mode = 3; }
        bf16_t* base = (bf16_t*)(ws + A_Q + boff);
        const int col0 = cb + wc * 32 + 8 * fq;
        if (pn < 16) { qk_tile(acc, u, wr, wc, fr, fq, base, col0); return; }
        f32x4 cs[2][2]; float shr[2][4];
#pragma unroll
        for (int ai = 0; ai < 2; ++ai)
#pragma unroll
            for (int m = 0; m < 4; ++m) shr[ai][m] = SH[row0 + ai * HALF + m * 16];
#pragma unroll
        for (int bj = 0; bj < 2; ++bj)
#pragma unroll
            for (int n = 0; n < 2; ++n) cs[bj][n] = *(const f32x4*)(SW + pn * BM + bj * HALF + wc * 32 + 8 * fq + 4 * n);
        if (mode == 3) tile_out<3>(acc, cs, shr, base, row0, ld, col0);
        else if (mode == 2) tile_out<2>(acc, cs, shr, base, row0, ld, col0);
        else if (mode == 1) tile_out<1>(acc, cs, shr, base, row0, ld, col0);
        else tile_out<0>(acc, cs, shr, base, row0, ld, col0);
    }
    template <int MODE> __device__ __forceinline__ void tile_out(const f32x4 (&acc)[2][2][4][2], f32x4 (&cs)[2][2], const float (&shr)[2][4], bf16_t* base, int row0, int ld, int col0) const {
        if (MODE == 1 || MODE == 3) {
#pragma unroll
            for (int bj = 0; bj < 2; ++bj)
#pragma unroll
                for (int n = 0; n < 2; ++n) cs[bj][n] = cs[bj][n] * (MODE == 1 ? 0.0625f : -LOG2E); }
#pragma unroll
        for (int ai = 0; ai < 2; ++ai)
#pragma unroll
            for (int m = 0; m < 4; ++m) { const int row = row0 + ai * HALF + m * 16; bf16_t* rowp = base + (size_t)row * ld + col0; const float sc = shr[ai][m];
#pragma unroll
                for (int bj = 0; bj < 2; ++bj) { const pg8::i32x4_ i0 = __builtin_bit_cast(pg8::i32x4_, acc[ai][bj][m][0]), i1 = __builtin_bit_cast(pg8::i32x4_, acc[ai][bj][m][1]);
                    f32x4 v0 = (f32x4){(float)i0[0], (float)i0[1], (float)i0[2], (float)i0[3]} * cs[bj][0] * sc, v1 = (f32x4){(float)i1[0], (float)i1[1], (float)i1[2], (float)i1[3]} * cs[bj][1] * sc;
                    if (MODE == 2) {
#pragma unroll
                        for (int j = 0; j < 4; ++j) { v0[j] = v0[j] * sigmoidf_(v0[j]); v1[j] = v1[j] * sigmoidf_(v1[j]); } }
                    if (MODE == 3) {
#pragma unroll
                        for (int j = 0; j < 4; ++j) { v0[j] = __builtin_amdgcn_rcpf(1.f + __builtin_amdgcn_exp2f(v0[j])); v1[j] = __builtin_amdgcn_rcpf(1.f + __builtin_amdgcn_exp2f(v1[j])); }
                        const unsigned g0 = (unsigned)__builtin_rintf(v0[0] * 255.f) | ((unsigned)__builtin_rintf(v0[1] * 255.f) << 8) | ((unsigned)__builtin_rintf(v0[2] * 255.f) << 16) | ((unsigned)__builtin_rintf(v0[3] * 255.f) << 24);
                        const unsigned g1 = (unsigned)__builtin_rintf(v1[0] * 255.f) | ((unsigned)__builtin_rintf(v1[1] * 255.f) << 8) | ((unsigned)__builtin_rintf(v1[2] * 255.f) << 16) | ((unsigned)__builtin_rintf(v1[3] * 255.f) << 24);
                        *(u32x2*)((unsigned char*)base + (size_t)row * 4096 + col0 + bj * HALF) = (u32x2){g0, g1};
                    } else {
                    u32x4 w; w.x = cvt_pk_bf16(v0[0], v0[1]); w.y = cvt_pk_bf16(v0[2], v0[3]); w.z = cvt_pk_bf16(v1[0], v1[1]); w.w = cvt_pk_bf16(v1[2], v1[3]);
                    *(u32x4*)(rowp + bj * HALF) = w; } } }
    }
};
struct EpiBranch {
    static constexpr bool PERM = true;
    static constexpr int NST = 16;
    unsigned char* ws;
    __device__ __forceinline__ void operator()(const f32x4 (&acc)[2][2][4][2], const Unit& u, int wr, int wc, int fr, int fq) const {
        const int row0 = u.pm * BM + wr * 64 + fr, col0 = u.pn * BM + wc * 32 + 8 * fq;
        const unsigned char* G = ws + (u.ps ? A_SB : A_SA); bf16_t* O = (bf16_t*)(ws + A_MRG);
        const float* SR = (const float*)(ws + WS_PRM) + (u.ps ? P_SOB : P_SOA); const float* SW = (const float*)(ws + WS_PRM) + (u.ps ? P_SWPB : P_SWPA);
        f32x4 cs[2][2];
#pragma unroll
        for (int bj = 0; bj < 2; ++bj)
#pragma unroll
            for (int n = 0; n < 2; ++n) cs[bj][n] = *(const f32x4*)(SW + col0 + bj * HALF + 4 * n) * (1.f / 255.f);
#pragma unroll
        for (int ai = 0; ai < 2; ++ai) {
            u32x2 gw[4][2]; u32x4 ow[4][2]; float sr[4];
#pragma unroll
            for (int m = 0; m < 4; ++m) { const int row = row0 + ai * HALF + m * 16; const size_t off = (size_t)row * DM + col0; sr[m] = SR[row];
#pragma unroll
                for (int bj = 0; bj < 2; ++bj) { gw[m][bj] = *(const u32x2*)(G + off + bj * HALF); if (u.ps) ow[m][bj] = *(const u32x4*)(O + off + bj * HALF); else ow[m][bj] = (u32x4){0u, 0u, 0u, 0u}; } }
#pragma unroll
            for (int m = 0; m < 4; ++m) { const size_t off = (size_t)(row0 + ai * HALF + m * 16) * DM + col0;
#pragma unroll
                for (int bj = 0; bj < 2; ++bj) { const u32x2 g = gw[m][bj]; const u32x4 o4 = ow[m][bj];
                    const pg8::i32x4_ i0 = __builtin_bit_cast(pg8::i32x4_, acc[ai][bj][m][0]), i1 = __builtin_bit_cast(pg8::i32x4_, acc[ai][bj][m][1]);
                    f32x4 v0 = (f32x4){(float)i0[0], (float)i0[1], (float)i0[2], (float)i0[3]} * cs[bj][0] * sr[m], v1 = (f32x4){(float)i1[0], (float)i1[1], (float)i1[2], (float)i1[3]} * cs[bj][1] * sr[m];
                    v0[0] = v0[0] * (float)(g.x & 0xffu) + bflo(o4.x); v0[1] = v0[1] * (float)((g.x >> 8) & 0xffu) + bfhi(o4.x); v0[2] = v0[2] * (float)((g.x >> 16) & 0xffu) + bflo(o4.y); v0[3] = v0[3] * (float)(g.x >> 24) + bfhi(o4.y);
                    v1[0] = v1[0] * (float)(g.y & 0xffu) + bflo(o4.z); v1[1] = v1[1] * (float)((g.y >> 8) & 0xffu) + bfhi(o4.z); v1[2] = v1[2] * (float)((g.y >> 16) & 0xffu) + bflo(o4.w); v1[3] = v1[3] * (float)(g.y >> 24) + bfhi(o4.w);
                    u32x4 w; w.x = cvt_pk_bf16(v0[0], v0[1]); w.y = cvt_pk_bf16(v0[2], v0[3]); w.z = cvt_pk_bf16(v1[0], v1[1]); w.w = cvt_pk_bf16(v1[2], v1[3]);
                    *(u32x4*)(O + off + bj * HALF) = w; } }
            asm volatile("" ::: "memory"); }
    }
};
struct EpiWout {
    static constexpr bool PERM = false;
    static constexpr int NST = 32;
    const float* X; bf16_t* X1B; float* RSS; const float* SM; const float* SW;
    __device__ __forceinline__ void operator()(const f32x4 (&acc)[2][2][4][2], const Unit& u, int wr, int wc, int fr, int fq) const {
        const int row0 = u.pm * BM + wr * 64 + fr, col0 = u.pn * BM + wc * 32 + 4 * fq;
        f32x4 cs[2][2];
#pragma unroll
        for (int bj = 0; bj < 2; ++bj)
#pragma unroll
            for (int n = 0; n < 2; ++n) cs[bj][n] = INT8_WOUT ? *(const f32x4*)(SW + col0 + bj * HALF + n * 16) : (f32x4){1.f, 1.f, 1.f, 1.f};
#pragma unroll
        for (int ai = 0; ai < 2; ++ai) {
            f32x4 xv[4][2][2]; float sr[4];
#pragma unroll
            for (int m = 0; m < 4; ++m) { const int row = row0 + ai * HALF + m * 16; const size_t off = (size_t)row * DM + col0; sr[m] = INT8_WOUT ? SM[row] : 1.f;
#pragma unroll
                for (int bj = 0; bj < 2; ++bj)
#pragma unroll
                    for (int n = 0; n < 2; ++n) xv[m][bj][n] = *(const f32x4*)(X + off + bj * HALF + n * 16); }
#pragma unroll
            for (int m = 0; m < 4; ++m) { const int row = row0 + ai * HALF + m * 16; const size_t off = (size_t)row * DM + col0; float ss = 0.f;
#pragma unroll
                for (int bj = 0; bj < 2; ++bj)
#pragma unroll
                    for (int n = 0; n < 2; ++n) { const pg8::i32x4_ ia = __builtin_bit_cast(pg8::i32x4_, acc[ai][bj][m][n]);
                        const f32x4 o = INT8_WOUT ? xv[m][bj][n] + (f32x4){(float)ia[0], (float)ia[1], (float)ia[2], (float)ia[3]} * cs[bj][n] * sr[m] : xv[m][bj][n] + acc[ai][bj][m][n];
                        ss += (o[0] * o[0] + o[1] * o[1]) + (o[2] * o[2] + o[3] * o[3]);
                        u32x2 w; w.x = cvt_pk_bf16(o[0], o[1]); w.y = cvt_pk_bf16(o[2], o[3]); *(u32x2*)(X1B + off + bj * HALF + n * 16) = w; }
                ss += __shfl_xor(ss, 16); ss += __shfl_xor(ss, 32);
                if (fq == 0) atomicAdd(RSS + row, ss); }
            asm volatile("" ::: "memory"); }
    }
};
struct EpiUp {
    static constexpr bool PERM = true;
    static constexpr int NST = 16;
    const float* RSS; bf16_t* FA; bf16_t* FG; const float* SX; const float* SW;
    __device__ __forceinline__ void operator()(const f32x4 (&acc)[2][2][4][2], const Unit& u, int wr, int wc, int fr, int fq) const {
        const int row0 = u.pm * BM + wr * 64 + fr, col0 = u.pn * HALF + wc * 32 + 8 * fq;
        f32x4 cs[2][2];
#pragma unroll
        for (int bj = 0; bj < 2; ++bj)
#pragma unroll
            for (int n = 0; n < 2; ++n) cs[bj][n] = *(const f32x4*)(SW + u.pn * BM + bj * HALF + wc * 32 + 8 * fq + 4 * n);
#pragma unroll
        for (int ai = 0; ai < 2; ++ai)
#pragma unroll
            for (int m = 0; m < 4; ++m) { const int row = row0 + ai * HALF + m * 16; const float rstd = __builtin_amdgcn_rsqf(RSS[row] * (1.f / DM) + EPS) * SX[row];
                const size_t off = (size_t)row * DFF + col0;
#pragma unroll
                for (int bj = 0; bj < 2; ++bj) { const pg8::i32x4_ i0 = __builtin_bit_cast(pg8::i32x4_, acc[ai][bj][m][0]), i1 = __builtin_bit_cast(pg8::i32x4_, acc[ai][bj][m][1]);
                    const f32x4 v0 = (f32x4){(float)i0[0], (float)i0[1], (float)i0[2], (float)i0[3]} * cs[bj][0] * rstd, v1 = (f32x4){(float)i1[0], (float)i1[1], (float)i1[2], (float)i1[3]} * cs[bj][1] * rstd;
                    u32x4 w; w.x = cvt_pk_bf16(v0[0], v0[1]); w.y = cvt_pk_bf16(v0[2], v0[3]); w.z = cvt_pk_bf16(v1[0], v1[1]); w.w = cvt_pk_bf16(v1[2], v1[3]);
                    *(u32x4*)((bj ? FG : FA) + off) = w; } }
    }
};
__device__ __forceinline__ float gelu_tanh_(float x) { const float uu = x * (-1.5957691216057308f * LOG2E + (-0.07135481627159145f * LOG2E) * x * x); return x * __builtin_amdgcn_rcpf(1.f + __builtin_amdgcn_exp2f(uu)); }
struct EpiUpConv {
    static constexpr bool PERM = true;
    static constexpr int NST = 16;
    unsigned char* ws; int gi; LAS float* XB;
    __device__ __forceinline__ void operator()(const f32x4 (&acc)[2][2][4][2], const Unit& u, int wr, int wc, int fr, int fq) const {
        const float* RSS = (const float*)((const unsigned*)(ws + WS_CTL) + CW_RSS) + (size_t)gi * GT; const float* SX = (const float*)(ws + WS_PRM) + P_SX + (size_t)gi * GT; const float* SW = (const float*)(ws + WS_PRM) + P_SWUP;
        const float* CW = (const float*)(ws + WS_PRM) + P_CW; const float* CB = (const float*)(ws + WS_PRM) + P_CB; unsigned char* U8 = ws + A_FG; float* HB = (float*)(ws + A_FA);
        const int lane = fq * 16 + fr, fl = wc * 32 + 8 * fq, f0 = u.pn * HALF + fl, row0 = u.pm * BM + wr * 64 + fr;
        float csa[8], csg[8];
#pragma unroll
        for (int n = 0; n < 2; ++n) { const f32x4 a4 = *(const f32x4*)(SW + u.pn * BM + fl + 4 * n), g4 = *(const f32x4*)(SW + u.pn * BM + HALF + fl + 4 * n);
#pragma unroll
            for (int i = 0; i < 4; ++i) { csa[4 * n + i] = a4[i]; csg[4 * n + i] = g4[i] * U8_SCALE; } }
        float A[2][4][8], G[2][4][8];
#pragma unroll
        for (int ai = 0; ai < 2; ++ai)
#pragma unroll
            for (int m = 0; m < 4; ++m) { const int row = row0 + ai * HALF + m * 16; const float fac = __builtin_amdgcn_rsqf(RSS[row] * (1.f / DM) + EPS) * SX[row];
#pragma unroll
                for (int n = 0; n < 2; ++n) { const pg8::i32x4_ ia = __builtin_bit_cast(pg8::i32x4_, acc[ai][0][m][n]), ig = __builtin_bit_cast(pg8::i32x4_, acc[ai][1][m][n]);
#pragma unroll
                    for (int i = 0; i < 4; ++i) { A[ai][m][4 * n + i] = (float)ia[i] * csa[4 * n + i] * fac; G[ai][m][4 * n + i] = (float)ig[i] * csg[4 * n + i] * fac; } } }
#pragma unroll
        for (int ai = 0; ai < 2; ++ai) { const int b = 2 * ai + wr;
            if (fr == 0) { *(LAS f32x4*)(XB + (2 * b) * 128 + fl) = (f32x4){A[ai][0][0], A[ai][0][1], A[ai][0][2], A[ai][0][3]}; *(LAS f32x4*)(XB + (2 * b) * 128 + fl + 4) = (f32x4){A[ai][0][4], A[ai][0][5], A[ai][0][6], A[ai][0][7]}; }
            if (fr == 15) { *(LAS f32x4*)(XB + (2 * b + 1) * 128 + fl) = (f32x4){A[ai][3][0], A[ai][3][1], A[ai][3][2], A[ai][3][3]}; *(LAS f32x4*)(XB + (2 * b + 1) * 128 + fl + 4) = (f32x4){A[ai][3][4], A[ai][3][5], A[ai][3][6], A[ai][3][7]}; } }
        { float* hb = HB + ((size_t)(u.pm * 86 + u.pn) * 6) * 128 + fl;
          if (wr == 0 && fr <= 1) { *(f32x4*)(hb + fr * 128) = (f32x4){A[0][0][0], A[0][0][1], A[0][0][2], A[0][0][3]}; *(f32x4*)(hb + fr * 128 + 4) = (f32x4){A[0][0][4], A[0][0][5], A[0][0][6], A[0][0][7]};
              if (fr == 0) { *(f32x4*)(hb + 4 * 128) = (f32x4){G[0][0][0], G[0][0][1], G[0][0][2], G[0][0][3]}; *(f32x4*)(hb + 4 * 128 + 4) = (f32x4){G[0][0][4], G[0][0][5], G[0][0][6], G[0][0][7]}; } }
          if (wr == 1 && fr >= 14) { const int sl = fr - 12;
              *(f32x4*)(hb + sl * 128) = (f32x4){A[1][3][0], A[1][3][1], A[1][3][2], A[1][3][3]}; *(f32x4*)(hb + sl * 128 + 4) = (f32x4){A[1][3][4], A[1][3][5], A[1][3][6], A[1][3][7]};
              if (fr == 15) { *(f32x4*)(hb + 5 * 128) = (f32x4){G[1][3][0], G[1][3][1], G[1][3][2], G[1][3][3]}; *(f32x4*)(hb + 5 * 128 + 4) = (f32x4){G[1][3][4], G[1][3][5], G[1][3][6], G[1][3][7]}; } } }
        asm volatile("s_waitcnt lgkmcnt(0)" ::: "memory"); __builtin_amdgcn_s_barrier(); asm volatile("" ::: "memory");
        const int src_dn = (lane & ~15) | ((fr + 1) & 15), src_up = (lane & ~15) | ((fr + 15) & 15);
#pragma unroll
        for (int n = 0; n < 2; ++n) {
            const f32x4 x0 = *(const f32x4*)(CW + f0 + 4 * n), x1 = *(const f32x4*)(CW + DFF + f0 + 4 * n), x2 = *(const f32x4*)(CW + 2 * DFF + f0 + 4 * n), xb = *(const f32x4*)(CB + f0 + 4 * n);
#pragma unroll
            for (int ai = 0; ai < 2; ++ai) { const int b = 2 * ai + wr;
                const f32x4 XP = b > 0 ? *(const LAS f32x4*)(XB + (2 * (b - 1) + 1) * 128 + fl + 4 * n) : (f32x4){0.f, 0.f, 0.f, 0.f};
                const f32x4 XN = b < 3 ? *(const LAS f32x4*)(XB + (2 * (b + 1)) * 128 + fl + 4 * n) : (f32x4){0.f, 0.f, 0.f, 0.f};
#pragma unroll
                for (int m = 0; m < 4; ++m) { const int row = row0 + ai * HALF + m * 16; float o[4];
#pragma unroll
                    for (int i = 0; i < 4; ++i) { const int j = 4 * n + i;
                        const float dn = __shfl(A[ai][m][j], src_dn), dnw = m < 3 ? __shfl(A[ai][m + 1][j], src_dn) : XN[i], nxt = fr == 15 ? dnw : dn;
                        const float up = __shfl(A[ai][m][j], src_up), upw = m > 0 ? __shfl(A[ai][m - 1][j], src_up) : XP[i], prv = fr == 0 ? upw : up;
                        const float c = prv * x0[i] + A[ai][m][j] * x1[i] + nxt * x2[i] + xb[i]; o[i] = gelu_tanh_(c) * G[ai][m][j]; }
                    int q0 = 0;
                    q0 = __builtin_amdgcn_cvt_pk_fp8_f32(sat8(o[0]), sat8(o[1]), q0, false); q0 = __builtin_amdgcn_cvt_pk_fp8_f32(sat8(o[2]), sat8(o[3]), q0, true);
                    *(unsigned*)(U8 + (size_t)row * DFF + f0 + 4 * n) = (unsigned)q0;
                    __builtin_amdgcn_sched_barrier(0); } } }
    }
};
struct EpiDown {
    static constexpr bool PERM = false;
    static constexpr int NST = 32;
    float* OUT; const bf16_t* X1B; float sc;
    __device__ __forceinline__ void operator()(const f32x4 (&acc)[2][2][4][2], const Unit& u, int wr, int wc, int fr, int fq) const {
        const int row0 = u.pm * BM + wr * 64 + fr, col0 = u.pn * BM + wc * 32 + 4 * fq;
#pragma unroll
        for (int ai = 0; ai < 2; ++ai) {
            u32x2 xw[4][2][2];
#pragma unroll
            for (int m = 0; m < 4; ++m) { const size_t off = (size_t)(row0 + ai * HALF + m * 16) * DM + col0;
#pragma unroll
                for (int bj = 0; bj < 2; ++bj)
#pragma unroll
                    for (int n = 0; n < 2; ++n) xw[m][bj][n] = *(const u32x2*)(X1B + off + bj * HALF + n * 16); }
#pragma unroll
            for (int m = 0; m < 4; ++m) { const size_t off = (size_t)(row0 + ai * HALF + m * 16) * DM + col0;
#pragma unroll
                for (int bj = 0; bj < 2; ++bj)
#pragma unroll
                    for (int n = 0; n < 2; ++n) { const u32x2 x2 = xw[m][bj][n]; const f32x4 a4 = acc[ai][bj][m][n] * sc;
                        *(f32x4*)(OUT + off + bj * HALF + n * 16) = (f32x4){bflo(x2.x) + a4[0], bfhi(x2.x) + a4[1], bflo(x2.y) + a4[2], bfhi(x2.y) + a4[3]}; } }
            asm volatile("" ::: "memory"); }
    }
};

struct Args;
__device__ __forceinline__ unsigned char* u8_ptr(const Args& a, int g);
struct Args { const float* in[25]; float* out; unsigned char* ws; int ph_lo, ph_hi, g_lo, g_hi; };
struct Frame {
    LAS unsigned char* lds; int tid, lane, wave, vcu, G;
};
__device__ __forceinline__ unsigned char* u8_ptr(const Args& a, int g) { (void)g; return FUSE_CONV ? a.ws + A_FG : (g == 0 ? (unsigned char*)(a.out + (size_t)GT * DM) : a.ws + WS_WIN); }
__device__ __forceinline__ Frame make_frame(LAS unsigned char* lds, int wave_s) {
    Frame F; F.lds = lds; F.tid = fresh_tid(wave_s); F.lane = F.tid & 63; F.wave = __builtin_amdgcn_readfirstlane(F.tid >> 6);
    F.G = fresh_grid(); { const int bx = fresh_bid(); F.vcu = (F.G % 8 == 0) ? (bx % 8) * (F.G / 8) + bx / 8 : bx; }
    return F;
}

template <int NMAP> __device__ __forceinline__ int nmap(int n) {
    if (NMAP == 1) { return n < 12288 ? n : (n < 12320 ? 20480 + (n - 12288) : n - 32); }
    if (NMAP == 2) { const int bj = n >= DFF ? 1 : 0, f = n - bj * DFF; return (f >> 7) * 256 + bj * 128 + (f & 127); }
    return n;
}
template <int NMAP> __device__ __forceinline__ void p0_transpose_item(const float* W, int N, const float* kscale, bf16_t* WT, int ldd, int koff, LAS float* scr, int kb, int nb, int lane) {
    const int k0 = 64 * kb, n0 = 64 * nb; const bool inb = (n0 + lane) < N;
#pragma unroll
    for (int i0 = 0; i0 < 64; i0 += 32) { float v[32];
#pragma unroll
        for (int i = 0; i < 32; ++i) v[i] = inb ? W[(size_t)(k0 + i0 + i) * N + n0 + lane] : 0.f;
#pragma unroll
        for (int i = 0; i < 32; ++i) { float t = v[i]; if (kscale) t *= kscale[k0 + i0 + i]; scr[(i0 + i) * 65 + lane] = t; } }
    asm volatile("s_waitcnt lgkmcnt(0)" ::: "memory");
    const int c = lane & 7;
#pragma unroll
    for (int j = 0; j < 8; ++j) { const int nl = (lane >> 3) + 8 * j; const int n = n0 + nl; const LAS float* s = scr + (8 * c) * 65 + nl;
        u32x4 o; o.x = cvt_pk_bf16(s[0 * 65], s[1 * 65]); o.y = cvt_pk_bf16(s[2 * 65], s[3 * 65]); o.z = cvt_pk_bf16(s[4 * 65], s[5 * 65]); o.w = cvt_pk_bf16(s[6 * 65], s[7 * 65]);
        if (n < N) *(u32x4*)(WT + (size_t)nmap<NMAP>(n) * ldd + koff + k0 + 8 * c) = o; }
    asm volatile("s_waitcnt lgkmcnt(0)" ::: "memory");
}
__device__ __forceinline__ void p0_colmax(const Frame& F, const float* W, int K, int N, const float* kscale, unsigned* out) {
    const int gw = F.vcu * NWAVES + F.wave, NGW = F.G * NWAVES; const int nnb = (N + 255) / 256, nt = (K / 64) * nnb;
    for (int t = gw; t < nt; t += NGW) { const int kb = t / nnb, nb = t - kb * nnb, n = nb * 256 + 4 * F.lane; if (n >= N) continue;
        f32x4 mx = {0.f, 0.f, 0.f, 0.f};
#pragma unroll 16
        for (int i = 0; i < 64; ++i) { const int k = kb * 64 + i; const float ks = kscale ? fabsf(kscale[k]) : 1.f; const f32x4 v = *(const f32x4*)(W + (size_t)k * N + n);
            mx[0] = fmaxf(mx[0], fabsf(v[0]) * ks); mx[1] = fmaxf(mx[1], fabsf(v[1]) * ks); mx[2] = fmaxf(mx[2], fabsf(v[2]) * ks); mx[3] = fmaxf(mx[3], fabsf(v[3]) * ks); }
#pragma unroll
        for (int j = 0; j < 4; ++j) atomicMax(out + n + j, __float_as_uint(mx[j])); }
}
__device__ __forceinline__ void p0_absmax(const Frame& F, const float* W, int K, int N, const float* kscale, unsigned* out) {
    const int gw = F.vcu * NWAVES + F.wave, NGW = F.G * NWAVES; float mx = 0.f;
    for (int k = gw; k < K; k += NGW) { const float ks = kscale ? kscale[k] : 1.f; const f32x4* row = (const f32x4*)(W + (size_t)k * N);
        for (int i = F.lane; i < N / 4; i += 64) { const f32x4 v = row[i]; mx = fmaxf(mx, fmaxf(fmaxf(fabsf(v[0]), fabsf(v[1])), fmaxf(fabsf(v[2]), fabsf(v[3]))) * fabsf(ks)); } }
#pragma unroll
    for (int o = 1; o < 64; o <<= 1) mx = fmaxf(mx, __shfl_xor(mx, o));
    if (F.lane == 0) atomicMax(out, __float_as_uint(mx));
}
template <int NMAP> __device__ __forceinline__ void p0_transpose_item_i8(const float* W, int N, const float* kscale, const unsigned* cmax, unsigned char* WT8, int ldd, int koff, LAS float* scr, int kb, int nb, int lane) {
    const int k0 = 64 * kb, n0 = 64 * nb; const bool inb = (n0 + lane) < N;
    const float qs = inb ? 127.f / fmaxf(__uint_as_float(__hip_atomic_load(cmax + n0 + lane, __ATOMIC_RELAXED, __HIP_MEMORY_SCOPE_AGENT)), 1e-30f) : 0.f;
#pragma unroll
    for (int i0 = 0; i0 < 64; i0 += 32) { float v[32];
#pragma unroll
        for (int i = 0; i < 32; ++i) v[i] = inb ? W[(size_t)(k0 + i0 + i) * N + n0 + lane] : 0.f;
#pragma unroll
        for (int i = 0; i < 32; ++i) { float t = v[i] * qs; if (kscale) t *= kscale[k0 + i0 + i]; scr[(i0 + i) * 65 + lane] = t; } }
    asm volatile("s_waitcnt lgkmcnt(0)" ::: "memory");
    const int c = lane & 7;
#pragma unroll
    for (int j = 0; j < 8; ++j) { const int nl = (lane >> 3) + 8 * j; const LAS float* s = scr + (8 * c) * 65 + nl;
        const unsigned w0 = pack_i8x4(s[0 * 65], s[1 * 65], s[2 * 65], s[3 * 65]), w1 = pack_i8x4(s[4 * 65], s[5 * 65], s[6 * 65], s[7 * 65]);
        if (n0 + nl < N) *(u32x2*)(WT8 + (size_t)nmap<NMAP>(n0 + nl) * ldd + koff + k0 + 8 * c) = (u32x2){w0, w1}; }
    asm volatile("s_waitcnt lgkmcnt(0)" ::: "memory");
}
template <int NMAP> __device__ __forceinline__ void p0_transpose_item_fp8(const float* W, int N, unsigned char* WT8, int ldd, LAS float* scr, int kb, int nb, int lane) {
    const int k0 = 64 * kb, n0 = 64 * nb; const bool inb = (n0 + lane) < N;
#pragma unroll
    for (int i0 = 0; i0 < 64; i0 += 32) { float v[32];
#pragma unroll
        for (int i = 0; i < 32; ++i) v[i] = inb ? W[(size_t)(k0 + i0 + i) * N + n0 + lane] : 0.f;
#pragma unroll
        for (int i = 0; i < 32; ++i) scr[(i0 + i) * 65 + lane] = sat8(v[i] * W8_SCALE); }
    asm volatile("s_waitcnt lgkmcnt(0)" ::: "memory");
    const int c = lane & 7;
#pragma unroll
    for (int j = 0; j < 8; ++j) { const int nl = (lane >> 3) + 8 * j; const LAS float* s = scr + (8 * c) * 65 + nl;
        int w0 = 0, w1 = 0;
        w0 = __builtin_amdgcn_cvt_pk_fp8_f32(s[0 * 65], s[1 * 65], w0, false); w0 = __builtin_amdgcn_cvt_pk_fp8_f32(s[2 * 65], s[3 * 65], w0, true);
        w1 = __builtin_amdgcn_cvt_pk_fp8_f32(s[4 * 65], s[5 * 65], w1, false); w1 = __builtin_amdgcn_cvt_pk_fp8_f32(s[6 * 65], s[7 * 65], w1, true);
        if (n0 + nl < N) *(u32x2*)(WT8 + (size_t)nmap<NMAP>(n0 + nl) * ldd + k0 + 8 * c) = (u32x2){(unsigned)w0, (unsigned)w1}; }
    asm volatile("s_waitcnt lgkmcnt(0)" ::: "memory");
}
__device__ __forceinline__ void p0_weights(const Frame& F, const Args& a) {
    unsigned char* ws = a.ws;
    LAS float* scr = (LAS float*)(F.lds + F.wave * 16640);
    const int gw = F.vcu * NWAVES + F.wave, NGW = F.G * NWAVES;
    constexpr int I_IN = 64 * 321, I_UP = 64 * 344, I_DN = 172 * 64, I_OUT = 64 * 64, I_PA = 32 * 64, I_PB = 32 * 64;
    constexpr int NITEMS = I_IN + I_UP + I_DN + I_OUT + I_PA + I_PB;
    { float* prm = (float*)(ws + WS_PRM); const int gt = F.vcu * NTHR + F.tid, ngt = F.G * NTHR; const unsigned* ctl = (const unsigned*)(ws + WS_CTL);
      for (int n = gt; n < 2 * DFF; n += ngt) prm[P_SWUP + nmap<2>(n)] = __uint_as_float(__hip_atomic_load(ctl + CW_CMAX_UP + n, __ATOMIC_RELAXED, __HIP_MEMORY_SCOPE_AGENT)) * (1.f / 127.f);
      for (int n = gt; n < DM; n += ngt) { prm[P_SWPA + n] = __uint_as_float(__hip_atomic_load(ctl + CW_CMAX_PA + n, __ATOMIC_RELAXED, __HIP_MEMORY_SCOPE_AGENT)) * (1.f / 127.f);
          prm[P_SWPB + n] = __uint_as_float(__hip_atomic_load(ctl + CW_CMAX_PB + n, __ATOMIC_RELAXED, __HIP_MEMORY_SCOPE_AGENT)) * (1.f / 127.f);
          prm[P_SWWO + n] = __uint_as_float(__hip_atomic_load(ctl + CW_CMAX_WO + n, __ATOMIC_RELAXED, __HIP_MEMORY_SCOPE_AGENT)) * (1.f / 127.f); }
      for (int n = gt; n < DINP; n += ngt) { if (n < DIN) prm[P_SWIN + nmap<1>(n)] = __uint_as_float(__hip_atomic_load(ctl + CW_CMAX_IN + n, __ATOMIC_RELAXED, __HIP_MEMORY_SCOPE_AGENT)) * (1.f / 127.f); else prm[P_SWIN + n] = 0.f; } }
    for (int it = gw; it < NITEMS; it += NGW) {
        int r = it;
        if (r < I_IN) { p0_transpose_item_i8<1>(a.in[4], DIN, nullptr, (const unsigned*)(ws + WS_CTL) + CW_CMAX_IN, ws + WS_WIN, DM, 0, scr, r / 321, r % 321, F.lane); continue; } r -= I_IN;
        if (r < I_UP) { p0_transpose_item_i8<2>(a.in[21], 2 * DFF, a.in[20], (const unsigned*)(ws + WS_CTL) + CW_CMAX_UP, ws + WS_WUP, DM, 0, scr, r / 344, r % 344, F.lane); continue; } r -= I_UP;
        if (r < I_DN) { p0_transpose_item_fp8<0>(a.in[24], DM, ws + WS_WDN, DFF, scr, r / 64, r % 64, F.lane); continue; } r -= I_DN;
        if (r < I_OUT) { if (INT8_WOUT) p0_transpose_item_i8<0>(a.in[19], DM, nullptr, (const unsigned*)(ws + WS_CTL) + CW_CMAX_WO, ws + WS_WOUT, DM, 0, scr, r / 64, r % 64, F.lane);
                         else p0_transpose_item<0>(a.in[19], DM, nullptr, (bf16_t*)(ws + WS_WOUT), DM, 0, scr, r / 64, r % 64, F.lane); continue; } r -= I_OUT;
        if (r < I_PA) { p0_transpose_item_i8<0>(a.in[17], DM, nullptr, (const unsigned*)(ws + WS_CTL) + CW_CMAX_PA, ws + WS_WPAB, DM, 0, scr, r / 64, r % 64, F.lane); continue; } r -= I_PA;
        p0_transpose_item_i8<0>(a.in[18], DM, nullptr, (const unsigned*)(ws + WS_CTL) + CW_CMAX_PB, ws + WS_WPAB, DM, 2048, scr, r / 64, r % 64, F.lane);
    }
    { u32x4* z = (u32x4*)(ws + WS_WIN + (size_t)DIN * DM);
      for (int i = gw * 64 + F.lane; i < 224 * 256; i += NGW * 64) z[i] = (u32x4){0u, 0u, 0u, 0u}; }
    { float* prm = (float*)(ws + WS_PRM); const int gt = F.vcu * NTHR + F.tid, ngt = F.G * NTHR;
      for (int i = gt; i < 4096; i += ngt) prm[P_GMIX + i] = a.in[3][i];
      for (int i = gt; i < 128; i += ngt) { prm[P_QG + i] = a.in[5][i]; prm[P_KG + i] = a.in[6][i]; }
      for (int i = gt; i < 256; i += ngt) { prm[P_SUBLN + i] = a.in[11][i]; prm[P_RB + i] = a.in[2][i]; }
      for (int i = gt; i < 16384; i += ngt) { prm[P_WGF + i] = a.in[12][i]; prm[P_WGB + i] = a.in[14][i]; }
      for (int i = gt; i < 1024; i += ngt) { prm[P_BGF + i] = a.in[13][i]; prm[P_BGB + i] = a.in[15][i]; }
      for (int i = gt; i < 512; i += ngt) prm[P_GLAG + i] = a.in[16][i];
      for (int i = gt; i < 3 * DFF; i += ngt) prm[P_CW + i] = a.in[22][i];
      for (int i = gt; i < DFF; i += ngt) prm[P_CB + i] = a.in[23][i]; }
    if (fresh_bid() == 0 && F.wave == 0) {
        float s1 = 0.f, s2 = 0.f;
        for (int i = F.lane; i < 128; i += 64) { s1 += a.in[7][i] * a.in[8][i]; s2 += a.in[9][i] * a.in[10][i]; }
        s1 = wave_sum(s1); s2 = wave_sum(s2);
        if (F.lane == 0) ((float*)(ws + WS_PRM))[P_LAM] = expf(s1) - expf(s2) + 0.2f;
    }
}
__device__ __forceinline__ void p1_hnorm(const Frame& F, const float* x, const float* gm, unsigned char* HQ, float* SH) {
    const int gw = F.vcu * NWAVES + F.wave, NGW = F.G * NWAVES;
    for (int m = gw; m < GT; m += NGW) {
        const f32x4* xr = (const f32x4*)(x + (size_t)m * DM) + F.lane; const f32x4* gr = (const f32x4*)gm + F.lane;
        f32x4 v[16]; float s = 0.f;
#pragma unroll
        for (int j = 0; j < 16; ++j) { v[j] = xr[64 * j]; s += (v[j][0] * v[j][0] + v[j][1] * v[j][1]) + (v[j][2] * v[j][2] + v[j][3] * v[j][3]); }
        const float rstd = 1.f / sqrtf(wave_sum(s) * (1.f / DM) + EPS); float mx = 0.f;
#pragma unroll
        for (int j = 0; j < 16; ++j) { v[j] = v[j] * gr[64 * j]; mx = fmaxf(mx, fmaxf(fmaxf(fabsf(v[j][0]), fabsf(v[j][1])), fmaxf(fabsf(v[j][2]), fabsf(v[j][3])))); }
#pragma unroll
        for (int o = 1; o < 64; o <<= 1) mx = fmaxf(mx, __shfl_xor(mx, o));
        mx = fmaxf(mx, 1e-30f); const float qs = 127.f / mx;
        unsigned* o8 = (unsigned*)(HQ + (size_t)m * DM) + F.lane;
#pragma unroll
        for (int j = 0; j < 16; ++j) o8[64 * j] = pack_i8x4(v[j][0] * qs, v[j][1] * qs, v[j][2] * qs, v[j][3] * qs);
        if (F.lane == 0) SH[m] = mx * rstd * (1.f / 127.f);
    }
}
__device__ __forceinline__ void p7b_quant_x1(const Frame& F, const bf16_t* X1B, unsigned char* X1Q, float* SX) {
    const int gw = F.vcu * NWAVES + F.wave, NGW = F.G * NWAVES;
    for (int m = gw; m < GT; m += NGW) {
        const u32x4* xr = (const u32x4*)(X1B + (size_t)m * DM) + F.lane; u32x4 w[8]; float mx = 0.f;
#pragma unroll
        for (int j = 0; j < 8; ++j) { w[j] = xr[64 * j]; mx = fmaxf(mx, fmaxf(fmaxf(fmaxf(fabsf(bflo(w[j].x)), fabsf(bfhi(w[j].x))), fmaxf(fabsf(bflo(w[j].y)), fabsf(bfhi(w[j].y)))), fmaxf(fmaxf(fabsf(bflo(w[j].z)), fabsf(bfhi(w[j].z))), fmaxf(fabsf(bflo(w[j].w)), fabsf(bfhi(w[j].w)))))); }
#pragma unroll
        for (int o = 1; o < 64; o <<= 1) mx = fmaxf(mx, __shfl_xor(mx, o));
        mx = fmaxf(mx, 1e-30f); const float qs = 127.f / mx;
        u32x2* o8 = (u32x2*)(X1Q + (size_t)m * DM) + F.lane;
#pragma unroll
        for (int j = 0; j < 8; ++j) o8[64 * j] = (u32x2){pack_i8x4(bflo(w[j].x) * qs, bfhi(w[j].x) * qs, bflo(w[j].y) * qs, bfhi(w[j].y) * qs), pack_i8x4(bflo(w[j].z) * qs, bfhi(w[j].z) * qs, bflo(w[j].w) * qs, bfhi(w[j].w) * qs)};
        if (F.lane == 0) SX[m] = mx * (1.f / 127.f);
    }
}
__device__ __forceinline__ void p3_qknorm(const Frame& F, bf16_t* Q, bf16_t* K, const float* gq, const float* gk) {
    const int gw = F.vcu * NWAVES + F.wave, NGW = F.G * NWAVES;
    const int gi = (F.lane & 15) * 8;
    float gqv[8], gkv[8];
#pragma unroll
    for (int e = 0; e < 8; ++e) { gqv[e] = gq[gi + e]; gkv[e] = gk[gi + e]; }
    for (int m = gw; m < 2 * GT; m += NGW) {
        const bool isk = m >= GT; bf16_t* row = (isk ? K : Q) + (size_t)(isk ? m - GT : m) * 2048;
#pragma unroll
        for (int i = 0; i < 4; ++i) {
            u32x4* p = (u32x4*)(row + i * 512) + F.lane; const u32x4 w = *p;
            float v[8] = {bflo(w.x), bfhi(w.x), bflo(w.y), bfhi(w.y), bflo(w.z), bfhi(w.z), bflo(w.w), bfhi(w.w)};
            float s = 0.f;
#pragma unroll
            for (int e = 0; e < 8; ++e) s += v[e] * v[e];
            s += __shfl_xor(s, 1); s += __shfl_xor(s, 2); s += __shfl_xor(s, 4); s += __shfl_xor(s, 8);
            const float r = 1.f / sqrtf(s * (1.f / 128.f) + EPS);
#pragma unroll
            for (int e = 0; e < 8; ++e) v[e] = v[e] * r * (isk ? gkv[e] : gqv[e]);
            u32x4 o; o.x = cvt_pk_bf16(v[0], v[1]); o.y = cvt_pk_bf16(v[2], v[3]); o.z = cvt_pk_bf16(v[4], v[5]); o.w = cvt_pk_bf16(v[6], v[7]);
            *p = o;
        }
    }
}

constexpr int LQ = 264;
constexpr int LS = 72;
constexpr int G1_QD = 0, G1_KI = 64 * LQ * 2, G1_VT = 2 * 64 * LQ * 2, G1_ATT = G1_VT + 256 * LS * 2, G1_ST = G1_ATT + 64 * LS * 2, G1_TOT = G1_ST + 64 * 16 * 4, G1_END = G1_TOT + 2 * 256 * 4;
static_assert(G1_END <= LDS_MISC, "G1 LDS");
struct GlaT { const bf16_t *GQ, *GK, *GV; const float* ST; const float *wgf, *bgf, *wgb, *bgb; bf16_t *QD, *KDT, *OI, *ATT; float* DEC; unsigned* dg; };
__device__ __forceinline__ void gla_g1_item(const Frame& F, const GlaT& T, int item, int TT) {
    LAS unsigned char* lds = F.lds;
    const int NCH = TT / 64;
    const int n = item % NCH; int r_ = item / NCH; const int dir = r_ & 1; r_ >>= 1; const int h = r_ & 3; const int b = r_ >> 2;
    const int tok0 = b * TT + n * 64, cg = tok0 >> 6;
    const int tid = F.tid, d = tid & 255, half = tid >> 8;
#if MK_DIAG
    if (tid == 0) atomicOr(T.dg, 32u);
#endif
    LAS bf16_t* qd_l = (LAS bf16_t*)(lds + G1_QD); LAS bf16_t* ki_l = (LAS bf16_t*)(lds + G1_KI); LAS bf16_t* vT_l = (LAS bf16_t*)(lds + G1_VT);
    LAS bf16_t* att_l = (LAS bf16_t*)(lds + G1_ATT); LAS float* st_l = (LAS float*)(lds + G1_ST); LAS float* tot_l = (LAS float*)(lds + G1_TOT);
    const float* wg = dir ? T.wgb : T.wgf; const float* bg = dir ? T.bgb : T.bgf;
    float wgr[16];
#pragma unroll
    for (int j = 0; j < 16; ++j) wgr[j] = wg[j * 1024 + h * 256 + d];
    const float bias = bg[h * 256 + d];
    const bf16_t* gqp = T.GQ + (size_t)tok0 * 1024 + h * 256; const bf16_t* gkp = T.GK + (size_t)tok0 * 1024 + h * 256;
    unsigned o32 = (unsigned)(half * 32 * 1024 + d); asm volatile("" : "+v"(o32));
    bf16_t qraw[32], kraw[32];
#pragma unroll
    for (int rr = 0; rr < 32; ++rr) { qraw[rr] = gqp[o32 + (unsigned)(rr * 1024)]; kraw[rr] = gkp[o32 + (unsigned)(rr * 1024)]; }
    if (tid < 256) { const int r = tid >> 2, j4 = (tid & 3) * 4; const f32x4 sv = *(const f32x4*)(T.ST + (size_t)(tok0 + r) * 32 + dir * 16 + j4); *(LAS f32x4*)(st_l + r * 16 + j4) = sv;
#if MK_DIAG
        if (!(fabsf(sv[0]) <= 20.f && fabsf(sv[1]) <= 20.f && fabsf(sv[2]) <= 20.f && fabsf(sv[3]) <= 20.f)) atomicOr(T.dg, 16u);
#endif
    }
    __syncthreads();
    float bl[32];
#pragma unroll
    for (int rr = 0; rr < 32; ++rr) { const int r = half * 32 + rr; float x = bias;
#pragma unroll
        for (int j4 = 0; j4 < 4; ++j4) { const f32x4 s = *(const LAS f32x4*)(st_l + r * 16 + j4 * 4); x += s[0] * wgr[j4 * 4] + s[1] * wgr[j4 * 4 + 1] + s[2] * wgr[j4 * 4 + 2] + s[3] * wgr[j4 * 4 + 3]; }
#if MK_DIAG
        if (!(fabsf(x) <= 50.f)) atomicOr(T.dg, 1u);
#endif
        const float ax = fabsf(x); const float ls = fminf(x, 0.f) - __logf(1.f + __expf(-ax));
        bl[rr] = ls * 0.0625f; if ((rr & 3) == 3) __builtin_amdgcn_sched_barrier(0); }
    float run = 0.f;
    if (dir == 0) {
#pragma unroll
        for (int rr = 0; rr < 32; ++rr) { run += bl[rr]; bl[rr] = run; }
    } else {
#pragma unroll
        for (int rr = 31; rr >= 0; --rr) { run += bl[rr]; bl[rr] = run; }
    }
    tot_l[half * 256 + d] = run;
    __syncthreads();
    const float other = tot_l[(1 - half) * 256 + d]; const float blast = run + other;
    const float addv = ((dir == 0) ? (half == 1) : (half == 0)) ? other : 0.f;
    const float elast = __expf(blast);
    const int gbase = (cg * 4 + h) * 2 + dir;
    if (half == 0) T.DEC[(size_t)gbase * 256 + d] = elast;
    unsigned kdp[16];
    bf16_t* qdp = T.QD + ((size_t)tok0 * 2 + dir) * 1024 + h * 256;
    const unsigned o32q = (unsigned)(half * 32 * 2048 + d);
#pragma unroll
    for (int rr = 0; rr < 32; rr += 2) {
        unsigned od = o32q; asm volatile("" : "+v"(od));
        float kd2[2];
#pragma unroll
        for (int e = 0; e < 2; ++e) { const int r = half * 32 + rr + e; const float bb = bl[rr + e] + addv; const float eb = __expf(bb), ieb = __builtin_amdgcn_rcpf(eb);
            const float qv = bf2f(qraw[rr + e]), kv = bf2f(kraw[rr + e]);
            const bf16_t qdb = f2bf(qv * eb); const float ki = kv * ieb;
#if MK_DIAG
            if (!(fabsf(ki) <= 1e30f)) atomicOr(T.dg, 2u);
#endif
            qd_l[r * LQ + d] = qdb; ki_l[r * LQ + d] = f2bf(ki);
            qdp[od + (unsigned)((rr + e) * 2048)] = qdb;
            kd2[e] = ki * elast; }
        kdp[rr >> 1] = cvt_pk_bf16(kd2[0], kd2[1]); if ((rr & 6) == 6) __builtin_amdgcn_sched_barrier(0);
    }
    { u32x4* kp = (u32x4*)(T.KDT + ((size_t)gbase * 256 + d) * 64 + half * 32);
#pragma unroll
      for (int i = 0; i < 4; ++i) kp[i] = (u32x4){kdp[4 * i], kdp[4 * i + 1], kdp[4 * i + 2], kdp[4 * i + 3]}; }
    __syncthreads();
    const int lane = F.lane, fr = lane & 15, fq = lane >> 4;
#pragma unroll
    for (int i = 0; i < 2; ++i) { const int id = F.wave * 2 + i, mt = id >> 2, nt = id & 3; f32x4 acc = {0.f, 0.f, 0.f, 0.f};
#pragma unroll
        for (int k0 = 0; k0 < 256; k0 += 32) { const bf16x8 av = *(const LAS bf16x8*)(qd_l + (16 * mt + fr) * LQ + k0 + 8 * fq); const bf16x8 bv = *(const LAS bf16x8*)(ki_l + (16 * nt + fr) * LQ + k0 + 8 * fq);
            acc = __builtin_amdgcn_mfma_f32_16x16x32_bf16(av, bv, acc, 0, 0, 0); }
#pragma unroll
        for (int j = 0; j < 4; ++j) { const int c = 16 * mt + 4 * fq + j, s = 16 * nt + fr; const bool keep = dir == 0 ? (s <= c) : (s >= c); att_l[c * LS + s] = f2bf(keep ? acc[j] : 0.f);
#if MK_DIAG
            if (keep && !(fabsf(acc[j]) <= 1e4f)) atomicOr(T.dg, 4u);
#endif
        } }
    __syncthreads();
    { const int c = tid >> 3, ch = tid & 7; *(u32x4*)(T.ATT + (size_t)gbase * 4096 + c * 64 + ch * 8) = *(const LAS u32x4*)(att_l + c * LS + ch * 8); }
    __syncthreads();
}

constexpr int LR = 68;
constexpr int G2_QD = 0, G2_KT = 64 * LQ * 2, G2_VT = G2_KT + 256 * LS * 2, G2_DEC = G2_VT + 64 * LS * 2, G2_RED = G2_DEC + 1024, G2_ATT = G2_RED + 2 * 64 * LR * 4, G2_END = G2_ATT + 64 * LS * 2;
static_assert(G2_END <= LDS_MISC, "G2 LDS");
__device__ __forceinline__ void gla_g2_item(const Frame& F, const GlaT& T, int item, int TT) {
    LAS unsigned char* lds = F.lds;
    const int NCH = TT / 64;
    const int vs = item & 7; int r_ = item >> 3; const int dir = r_ & 1; r_ >>= 1; const int h = r_ & 3; const int b = r_ >> 2;
    int tid_l = F.tid; asm volatile("" : "+v"(tid_l));
    const int tid = tid_l, lane = tid & 63, fr = lane & 15, fq = lane >> 4, vt = F.wave & 3, dh = F.wave >> 2;
    LAS bf16_t* qd_l = (LAS bf16_t*)(lds + G2_QD); LAS bf16_t* kT_l = (LAS bf16_t*)(lds + G2_KT); LAS bf16_t* vT_l = (LAS bf16_t*)(lds + G2_VT);
    LAS float* dec_l = (LAS float*)(lds + G2_DEC); LAS float* red_l = (LAS float*)(lds + G2_RED); LAS bf16_t* at_l = (LAS bf16_t*)(lds + G2_ATT);
    f32x4 S[8];
#pragma unroll
    for (int i = 0; i < 8; ++i) S[i] = (f32x4){0.f, 0.f, 0.f, 0.f};
    u32x4 pq[2][4], pk[2][4], pv[2], po[2]; float pd[2] = {0.f, 0.f};
#define G2_PREFETCH(SET, STEP) do { const int n_ = dir ? (NCH - 1 - (STEP)) : (STEP); const int tk_ = b * TT + n_ * 64; const int gb_ = ((tk_ >> 6) * 4 + h) * 2 + dir; \
        _Pragma("unroll") for (int i = 0; i < 4; ++i) { const int id = tid + 512 * i; \
            pq[SET][i] = *(const u32x4*)(T.QD + ((size_t)(tk_ + (id >> 5)) * 2 + dir) * 1024 + h * 256 + (id & 31) * 8); \
            pk[SET][i] = *(const u32x4*)(T.KDT + ((size_t)gb_ * 256 + (id >> 3)) * 64 + (id & 7) * 8); } \
        pv[SET] = *(const u32x4*)(T.GV + (size_t)(tk_ + (tid >> 3)) * 2048 + h * 512 + vs * 64 + (tid & 7) * 8); \
        po[SET] = *(const u32x4*)(T.ATT + (size_t)gb_ * 4096 + (tid >> 3) * 64 + (tid & 7) * 8); \
        if (tid < 256) pd[SET] = T.DEC[(size_t)gb_ * 256 + tid]; } while (0)
    G2_PREFETCH(0, 0); G2_PREFETCH(1, 1);
#pragma nounroll
    for (int st2 = 0; st2 < NCH; st2 += 2) {
#pragma unroll
      for (int SET = 0; SET < 2; ++SET) { const int st = st2 + SET;
        const int n = dir ? (NCH - 1 - st) : st; const int tok0 = b * TT + n * 64;
#pragma unroll
        for (int i = 0; i < 4; ++i) { const int id = tid + 512 * i; *(LAS u32x4*)(qd_l + (id >> 5) * LQ + (id & 31) * 8) = pq[SET][i]; *(LAS u32x4*)(kT_l + (id >> 3) * LS + (id & 7) * 8) = pk[SET][i]; }
        { const int s = tid >> 3, cc = tid & 7; const u32x4 w = pv[SET];
            LAS bf16_t* vp = vT_l + (cc * 8) * LS + s;
            vp[0 * LS] = (bf16_t)(w.x & 0xffff); vp[1 * LS] = (bf16_t)(w.x >> 16); vp[2 * LS] = (bf16_t)(w.y & 0xffff); vp[3 * LS] = (bf16_t)(w.y >> 16);
            vp[4 * LS] = (bf16_t)(w.z & 0xffff); vp[5 * LS] = (bf16_t)(w.z >> 16); vp[6 * LS] = (bf16_t)(w.w & 0xffff); vp[7 * LS] = (bf16_t)(w.w >> 16); }
        if (tid < 256) dec_l[tid] = pd[SET];
        *(LAS u32x4*)(at_l + (tid >> 3) * LS + (tid & 7) * 8) = po[SET];
        __syncthreads();
        if (st + 2 < NCH) { if (SET == 0) G2_PREFETCH(0, st + 2); else G2_PREFETCH(1, st + 2); }
        bf16x8 sb[4];
#pragma unroll
        for (int kb = 0; kb < 4; ++kb) { u32x4 w; w.x = cvt_pk_bf16(S[2 * kb][0], S[2 * kb][1]); w.y = cvt_pk_bf16(S[2 * kb][2], S[2 * kb][3]); w.z = cvt_pk_bf16(S[2 * kb + 1][0], S[2 * kb + 1][1]); w.w = cvt_pk_bf16(S[2 * kb + 1][2], S[2 * kb + 1][3]);
            sb[kb] = __builtin_bit_cast(bf16x8, w); }
        { bf16x8 av[4][4];
#pragma unroll
          for (int mt = 0; mt < 4; ++mt)
#pragma unroll
              for (int kb = 0; kb < 4; ++kb) { const LAS bf16_t* ap = qd_l + (16 * mt + fr) * LQ + 128 * dh + 32 * kb + 4 * fq;
                  const s16x4 lo = *(const LAS s16x4*)(ap), hi = *(const LAS s16x4*)(ap + 16);
                  av[mt][kb] = __builtin_shufflevector(lo, hi, 0, 1, 2, 3, 4, 5, 6, 7); }
          bf16x8 ia[2][2], ib[2];
#pragma unroll
          for (int ks = 0; ks < 2; ++ks) { ib[ks] = *(const LAS bf16x8*)(vT_l + (16 * vt + fr) * LS + 32 * ks + 8 * fq);
#pragma unroll
              for (int j = 0; j < 2; ++j) ia[j][ks] = *(const LAS bf16x8*)(at_l + (16 * (2 * dh + j) + fr) * LS + 32 * ks + 8 * fq); }
          f32x4 acc[4], ai[2];
#pragma unroll
          for (int mt = 0; mt < 4; ++mt) acc[mt] = (f32x4){0.f, 0.f, 0.f, 0.f};
          ai[0] = (f32x4){0.f, 0.f, 0.f, 0.f}; ai[1] = (f32x4){0.f, 0.f, 0.f, 0.f};
#pragma unroll
          for (int kb = 0; kb < 4; ++kb)
#pragma unroll
              for (int mt = 0; mt < 4; ++mt) acc[mt] = __builtin_amdgcn_mfma_f32_16x16x32_bf16(av[mt][kb], sb[kb], acc[mt], 0, 0, 0);
#pragma unroll
          for (int ks = 0; ks < 2; ++ks)
#pragma unroll
              for (int j = 0; j < 2; ++j) ai[j] = __builtin_amdgcn_mfma_f32_16x16x32_bf16(ia[j][ks], ib[ks], ai[j], 0, 0, 0);
#pragma unroll
          for (int mt = 0; mt < 4; ++mt) { const bool mine = (mt >> 1) == dh; const f32x4 add = ai[mt & 1];
#pragma unroll
              for (int j = 0; j < 4; ++j) red_l[(dh * 64 + 16 * mt + 4 * fq + j) * LR + 16 * vt + fr] = acc[mt][j] + (mine ? add[j] : 0.f); } }
        { const bf16x8 b0 = *(const LAS bf16x8*)(vT_l + (16 * vt + fr) * LS + 8 * fq), b1 = *(const LAS bf16x8*)(vT_l + (16 * vt + fr) * LS + 32 + 8 * fq);
#pragma unroll
          for (int i = 0; i < 8; ++i) { const int drow = 128 * dh + 16 * i; const f32x4 dc = *(const LAS f32x4*)(dec_l + drow + 4 * fq);
              S[i] = S[i] * dc;
              const bf16x8 a0 = *(const LAS bf16x8*)(kT_l + (drow + fr) * LS + 8 * fq), a1 = *(const LAS bf16x8*)(kT_l + (drow + fr) * LS + 32 + 8 * fq);
              S[i] = __builtin_amdgcn_mfma_f32_16x16x32_bf16(a0, b0, S[i], 0, 0, 0); S[i] = __builtin_amdgcn_mfma_f32_16x16x32_bf16(a1, b1, S[i], 0, 0, 0); } }
        __syncthreads();
        { const int c = tid >> 3, v8 = (tid & 7) * 8; bf16_t* op = T.OI + ((size_t)dir * GT + tok0 + c) * 2048 + h * 512 + vs * 64 + v8;
          const f32x4 r0 = *(const LAS f32x4*)(red_l + c * LR + v8) + *(const LAS f32x4*)(red_l + (64 + c) * LR + v8);
          const f32x4 r1 = *(const LAS f32x4*)(red_l + c * LR + v8 + 4) + *(const LAS f32x4*)(red_l + (64 + c) * LR + v8 + 4);
          u32x4 w; w.x = cvt_pk_bf16(r0[0], r0[1]); w.y = cvt_pk_bf16(r0[2], r0[3]); w.z = cvt_pk_bf16(r1[0], r1[1]); w.w = cvt_pk_bf16(r1[2], r1[3]);
          *(u32x4*)op = w; }
      }
    }
    __syncthreads();
#undef G2_PREFETCH
}

namespace att {
constexpr int D = 128, NW = 8, QBLK = 32, KVBLK = 64, LD = 2048;
constexpr float SCALE = 0.088388347648318440f;
constexpr int SHM_V = KVBLK * D * 2, SHM_K = KVBLK * D * 2;
#if ATT_FULLV
constexpr int OFF_V = 0, OFF_K = 4 * SHM_V  ;
#else
constexpr int OFF_V = 0, OFF_K = 3 * SHM_V  ;
#endif
#if ATT_FULLV
constexpr int OFF_WS = OFF_K + 2 * SHM_K, OFF_TB = OFF_WS + NW * 64 * 4, TB_STRIDE = 264  , OFF_QS = OFF_TB + 8 * TB_STRIDE * 4  , ATT_LDS = OFF_QS + NW * 4096;
#else
constexpr int OFF_WS = OFF_K + 2 * SHM_K, OFF_TB = OFF_WS + NW * 64 * 4, TB_STRIDE = 264  , ATT_LDS = OFF_TB + 8 * TB_STRIDE * 4;
#endif
static_assert(ATT_LDS <= LDS_MISC, "attention LDS");
#define KSWZ(row, colB) ((row) * 256 + ((colB) ^ (((row) & 7) << 4)))
#define SBAR() __builtin_amdgcn_sched_barrier(0)
__device__ __forceinline__ int crow(int r, int hi) { return (r & 3) + 8 * (r >> 2) + 4 * hi; }
__device__ __forceinline__ void partialSM(f32x16& p0, f32x16& p1, const LAS float* tb, int rel0, int relmin, int relmax, int hi) {
    constexpr float C = SCALE * LOG2E;
    if (relmin >= 128 || relmax <= -128) {
        const float c = (relmin >= 128) ? tb[256] : tb[0];
#pragma unroll
        for (int r = 0; r < 16; ++r) { p0[r] = fmaf(p0[r], C, c); p1[r] = fmaf(p1[r], C, c); }
    } else {
        int rb = rel0 + 4 * hi; asm volatile("" : "+v"(rb));
#pragma unroll
        for (int r4 = 0; r4 < 16; r4 += 4) {
#pragma unroll
            for (int r = r4; r < r4 + 4; ++r) { const int rl = rb + ((r & 3) + 8 * (r >> 2)); const int i0 = min(max(rl, -128), 128) + 128, i1 = min(max(rl + 32, -128), 128) + 128;
                p0[r] = fmaf(p0[r], C, tb[i0]); p1[r] = fmaf(p1[r], C, tb[i1]); }
            __builtin_amdgcn_sched_barrier(0);
        }
    }
#pragma unroll
    for (int r = 0; r < 16; ++r) p0[r] = __builtin_amdgcn_exp2f(p0[r]);
}
__device__ __forceinline__ void finishSM(f32x16& p0, f32x16& p1, float& l_reg, bf16x8& pa0, bf16x8& pa1, bf16x8& pa2, bf16x8& pa3) {
#pragma unroll
    for (int r = 0; r < 16; ++r) p1[r] = __builtin_amdgcn_exp2f(p1[r]);
    float ps = 0;
#pragma unroll
    for (int r = 0; r < 16; ++r) ps += p0[r];
#pragma unroll
    for (int r = 0; r < 16; ++r) ps += p1[r];
    { auto rr = __builtin_amdgcn_permlane32_swap(__float_as_uint(ps), __float_as_uint(ps), false, false);
      ps = __uint_as_float(rr[0]) + __uint_as_float(rr[1]); }
    l_reg += ps;
#define PK4(P, BASE, OUT) do { unsigned a0 = cvt_pk_bf16(P[BASE + 0], P[BASE + 1]), a1 = cvt_pk_bf16(P[BASE + 2], P[BASE + 3]);   \
    unsigned b0 = cvt_pk_bf16(P[BASE + 4], P[BASE + 5]), b1 = cvt_pk_bf16(P[BASE + 6], P[BASE + 7]);                              \
    auto r0 = __builtin_amdgcn_permlane32_swap(a0, b0, false, false); auto r1 = __builtin_amdgcn_permlane32_swap(a1, b1, false, false); \
    u32x4 w = {r0[0], r1[0], r0[1], r1[1]}; OUT = __builtin_bit_cast(bf16x8, w); } while (0)
    PK4(p0, 0, pa0); PK4(p0, 8, pa1); PK4(p1, 0, pa2); PK4(p1, 8, pa3);
#undef PK4
}
__device__ __forceinline__ void qkt(f32x16& p0, f32x16& p1, const LAS char* Ks, const bf16x8* Qs, int r32, int hi) {
    p0 = f32x16{}; p1 = f32x16{};
#pragma unroll
    for (int d0 = 0; d0 < 8; ++d0) { const int cb = (d0 * 16 + hi * 8) * 2;
        const bf16x8 b0 = *(const LAS bf16x8*)(Ks + KSWZ(r32, cb));
        const bf16x8 b1 = *(const LAS bf16x8*)(Ks + KSWZ(32 + r32, cb));
        const bf16x8 q = Qs[d0];
        p0 = __builtin_amdgcn_mfma_f32_32x32x16_bf16(b0, q, p0, 0, 0, 0);
        p1 = __builtin_amdgcn_mfma_f32_32x32x16_bf16(b1, q, p1, 0, 0, 0); }
}
__device__ __forceinline__ int v_st(int k, int c) { const int kk = (k & ~0xC) | ((k & 4) << 1) | ((k & 8) >> 1); return ((kk >> 3) * 4 + (c >> 5)) * 512 + ((kk & 7) * 32 + (c & 31)) * 2; }
__device__ __forceinline__ int v_rd_base(int lane) { return ((lane & 3) << 3) | (((lane >> 2) & 3) << 6) | (((lane >> 4) & 1) << 5) | (((lane >> 5) & 1) << 8); }
constexpr int v_rd_off(int d0, int ks, int half) { return d0 * 512 + ks * 4096 + half * 2048; }
template <int OFF> __device__ __forceinline__ s16x4 tr_read(int vb) {
    s16x4 r; asm volatile("ds_read_b64_tr_b16 %0, %1 offset:%2" : "=&v"(r) : "v"(vb), "i"(OFF) : "memory"); return r;
}
template <int D0> __device__ __forceinline__ void pv_one(f32x16& od, int vb, bf16x8 pa0, bf16x8 pa1, bf16x8 pa2, bf16x8 pa3) {
    const s16x4 l0 = tr_read<v_rd_off(D0, 0, 0)>(vb), h0 = tr_read<v_rd_off(D0, 0, 1)>(vb), l1 = tr_read<v_rd_off(D0, 1, 0)>(vb), h1 = tr_read<v_rd_off(D0, 1, 1)>(vb);
    const s16x4 l2 = tr_read<v_rd_off(D0, 2, 0)>(vb), h2 = tr_read<v_rd_off(D0, 2, 1)>(vb), l3 = tr_read<v_rd_off(D0, 3, 0)>(vb), h3 = tr_read<v_rd_off(D0, 3, 1)>(vb);
    asm volatile("s_waitcnt lgkmcnt(0)" ::: "memory"); SBAR();
#define PK(L, H) (bf16x8){L[0], L[1], L[2], L[3], H[0], H[1], H[2], H[3]}
    od = __builtin_amdgcn_mfma_f32_32x32x16_bf16(pa0, PK(l0, h0), od, 0, 0, 0);
    od = __builtin_amdgcn_mfma_f32_32x32x16_bf16(pa1, PK(l1, h1), od, 0, 0, 0);
    od = __builtin_amdgcn_mfma_f32_32x32x16_bf16(pa2, PK(l2, h2), od, 0, 0, 0);
    od = __builtin_amdgcn_mfma_f32_32x32x16_bf16(pa3, PK(l3, h3), od, 0, 0, 0);
#undef PK
}
template <int KS> __device__ __forceinline__ void pv_ks(f32x16* o, int vb, bf16x8 pa) {
    const s16x4 l0 = tr_read<v_rd_off(0, KS, 0)>(vb), h0 = tr_read<v_rd_off(0, KS, 1)>(vb), l1 = tr_read<v_rd_off(1, KS, 0)>(vb), h1 = tr_read<v_rd_off(1, KS, 1)>(vb);
    const s16x4 l2 = tr_read<v_rd_off(2, KS, 0)>(vb), h2 = tr_read<v_rd_off(2, KS, 1)>(vb), l3 = tr_read<v_rd_off(3, KS, 0)>(vb), h3 = tr_read<v_rd_off(3, KS, 1)>(vb);
    asm volatile("s_waitcnt lgkmcnt(0)" ::: "memory"); SBAR();
#define PK(L, H) (bf16x8){L[0], L[1], L[2], L[3], H[0], H[1], H[2], H[3]}
    o[0] = __builtin_amdgcn_mfma_f32_32x32x16_bf16(pa, PK(l0, h0), o[0], 0, 0, 0);
    o[1] = __builtin_amdgcn_mfma_f32_32x32x16_bf16(pa, PK(l1, h1), o[1], 0, 0, 0);
    o[2] = __builtin_amdgcn_mfma_f32_32x32x16_bf16(pa, PK(l2, h2), o[2], 0, 0, 0);
    o[3] = __builtin_amdgcn_mfma_f32_32x32x16_bf16(pa, PK(l3, h3), o[3], 0, 0, 0);
#undef PK
}
template <int KS, int BASE> __device__ __forceinline__ void pv_kso(f32x16* o, int vb, bf16x8 pa) {
    const s16x4 l0 = tr_read<BASE + v_rd_off(0, KS, 0)>(vb), h0 = tr_read<BASE + v_rd_off(0, KS, 1)>(vb), l1 = tr_read<BASE + v_rd_off(1, KS, 0)>(vb), h1 = tr_read<BASE + v_rd_off(1, KS, 1)>(vb);
    const s16x4 l2 = tr_read<BASE + v_rd_off(2, KS, 0)>(vb), h2 = tr_read<BASE + v_rd_off(2, KS, 1)>(vb), l3 = tr_read<BASE + v_rd_off(3, KS, 0)>(vb), h3 = tr_read<BASE + v_rd_off(3, KS, 1)>(vb);
    asm volatile("s_waitcnt lgkmcnt(0)" ::: "memory"); SBAR();
#define PK(L, H) (bf16x8){L[0], L[1], L[2], L[3], H[0], H[1], H[2], H[3]}
    o[0] = __builtin_amdgcn_mfma_f32_32x32x16_bf16(pa, PK(l0, h0), o[0], 0, 0, 0);
    o[1] = __builtin_amdgcn_mfma_f32_32x32x16_bf16(pa, PK(l1, h1), o[1], 0, 0, 0);
    o[2] = __builtin_amdgcn_mfma_f32_32x32x16_bf16(pa, PK(l2, h2), o[2], 0, 0, 0);
    o[3] = __builtin_amdgcn_mfma_f32_32x32x16_bf16(pa, PK(l3, h3), o[3], 0, 0, 0);
#undef PK
}
__device__ __forceinline__ void pv_d0(f32x16* o, int vb, bf16x8 pa0, bf16x8 pa1, bf16x8 pa2, bf16x8 pa3) {
#if ATT_PV_KMAJOR
    pv_ks<0>(o, vb, pa0); pv_ks<1>(o, vb, pa1); pv_ks<2>(o, vb, pa2); pv_ks<3>(o, vb, pa3);
#else
    pv_one<0>(o[0], vb, pa0, pa1, pa2, pa3); pv_one<1>(o[1], vb, pa0, pa1, pa2, pa3); pv_one<2>(o[2], vb, pa0, pa1, pa2, pa3); pv_one<3>(o[3], vb, pa0, pa1, pa2, pa3);
#endif
}
__device__ __forceinline__ void attn_unit(const bf16_t* __restrict__ Qb, const bf16_t* __restrict__ Kh, const bf16_t* __restrict__ Vh, bf16_t* __restrict__ Ob, int seq, int q0, const LAS float* tb, LAS char* lds, int tid_) {
    const int tid = tid_, wid = tid >> 6, lane = tid & 63, r32 = lane & 31, hi = lane >> 5;
    LAS char* V_lds = lds + OFF_V; LAS char* K_lds = lds + OFF_K;
    LAS float* li_l = (LAS float*)(lds + OFF_WS) + wid * 64;
    float l_reg = 0; f32x16 o[4] = {};
    bf16x8 qr[8];
    { const bf16_t* Qw = Qb + (long)(wid * QBLK + r32) * LD + hi * 8;
#pragma unroll
      for (int d0 = 0; d0 < 8; ++d0) qr[d0] = *(const bf16x8*)(Qw + d0 * 16); }
    const int sr = tid >> 4, sc = (tid & 15) * 8, vst0 = v_st(sr, sc), vst1 = v_st(32 + sr, sc);
    const int vb0 = (int)(unsigned)(size_t)V_lds + v_rd_base(lane);
    const int qpos = q0 + wid * QBLK + r32, wq0 = q0 + wid * QBLK;
    struct { bf16x8 vs0, vs1, ks0, ks1; } sr_;
#define SLOAD(k0) do { sr_.vs0 = *(const bf16x8*)(&Vh[(long)((k0) + sr) * LD + sc]); sr_.vs1 = *(const bf16x8*)(&Vh[(long)((k0) + 32 + sr) * LD + sc]); \
    sr_.ks0 = *(const bf16x8*)(&Kh[(long)((k0) + sr) * LD + sc]); sr_.ks1 = *(const bf16x8*)(&Kh[(long)((k0) + 32 + sr) * LD + sc]); } while (0)
#define SWRITE(b) do { *(LAS bf16x8*)(V_lds + (b) * SHM_V + vst0) = sr_.vs0;          \
    *(LAS bf16x8*)(V_lds + (b) * SHM_V + vst1) = sr_.vs1; const int kc = sc * 2;               \
    *(LAS bf16x8*)(K_lds + (b) * SHM_K + KSWZ(sr, kc)) = sr_.ks0;                       \
    *(LAS bf16x8*)(K_lds + (b) * SHM_K + KSWZ(32 + sr, kc)) = sr_.ks1; } while (0)
#define PSM(P0, P1, TILE) partialSM(P0, P1, tb, (TILE) * KVBLK - qpos, (TILE) * KVBLK - (wq0 + 31), (TILE) * KVBLK + 63 - wq0, hi)
#define TILE_STEP(J, B) do { __syncthreads(); \
        if ((J) + 1 < NT) { asm volatile("s_waitcnt vmcnt(0)" ::: "memory"); SWRITE(1 - (B)); } \
        if ((J) + 2 < NT) SLOAD(((J) + 2) * KVBLK); \
        SBAR(); qkt(p0, p1, K_lds + (B) * SHM_K, qr, r32, hi); PSM(p0, p1, (J)); \
        finishSM(p0, p1, l_reg, pa0, pa1, pa2, pa3); SBAR(); \
        pv_d0(o, vb0 + (B) * (int)SHM_V, pa0, pa1, pa2, pa3); } while (0)
    bf16x8 pa0, pa1, pa2, pa3; const int NT = seq / KVBLK;
#if ATT_PIPE
    f32x16 pA0, pA1, pB0, pB1;
    SLOAD(0); asm volatile("s_waitcnt vmcnt(0)" ::: "memory"); SWRITE(0); __syncthreads();
    qkt(pA0, pA1, K_lds, qr, r32, hi); PSM(pA0, pA1, 0);
    SLOAD(KVBLK);
    asm volatile("s_waitcnt vmcnt(0)" ::: "memory"); SWRITE(1); __syncthreads();
#pragma nounroll
    for (int j = 1; j + 1 < NT; j += 2) {
        SBAR(); qkt(pB0, pB1, K_lds + SHM_K, qr, r32, hi);
        finishSM(pA0, pA1, l_reg, pa0, pa1, pa2, pa3); SBAR();
        SLOAD((j + 1) * KVBLK); SBAR();
        pv_d0(o, vb0, pa0, pa1, pa2, pa3); PSM(pB0, pB1, j);
        __syncthreads(); asm volatile("s_waitcnt vmcnt(0)" ::: "memory"); SWRITE(0);
        __syncthreads();
        SBAR(); qkt(pA0, pA1, K_lds, qr, r32, hi);
        finishSM(pB0, pB1, l_reg, pa0, pa1, pa2, pa3); SBAR();
        SLOAD((j + 2) * KVBLK); SBAR();
        pv_d0(o, vb0 + (int)SHM_V, pa0, pa1, pa2, pa3); PSM(pA0, pA1, j + 1);
        __syncthreads(); asm volatile("s_waitcnt vmcnt(0)" ::: "memory"); SWRITE(1);
        __syncthreads();
    }
    SBAR(); qkt(pB0, pB1, K_lds + SHM_K, qr, r32, hi);
    finishSM(pA0, pA1, l_reg, pa0, pa1, pa2, pa3); SBAR();
    pv_d0(o, vb0, pa0, pa1, pa2, pa3); PSM(pB0, pB1, NT - 1);
    finishSM(pB0, pB1, l_reg, pa0, pa1, pa2, pa3); SBAR();
    pv_d0(o, vb0 + (int)SHM_V, pa0, pa1, pa2, pa3);
#else
    f32x16 p0, p1;
#if ATT_DMA
    unsigned gk[2], gv[2];
    const int widu = __builtin_amdgcn_readfirstlane(wid);
#pragma unroll
    for (int t = 0; t < 2; ++t) { const int ch = wid + 8 * t, b = ch * 1024 + 16 * lane;
        { const int row = b >> 8, cs = (b >> 4) & 15, c = cs ^ (row & 7); gk[t] = (unsigned)(row * LD + c * 8); }
        { const int sub = b >> 9, e = (b & 511) >> 1, kk = ((sub >> 2) << 3) | (e >> 5), c = ((sub & 3) << 5) | (e & 31), k = (kk & ~0xC) | ((kk & 4) << 1) | ((kk & 8) >> 1); gv[t] = (unsigned)(k * LD + c); } }
#define DMA_TILE(k0, bufi) do { _Pragma("unroll") for (int t = 0; t < 2; ++t) { \
        __builtin_amdgcn_global_load_lds((const unsigned*)(Kh + (size_t)(k0) * LD + gk[t]), (LAS unsigned*)(K_lds + (bufi) * SHM_K + (widu + 8 * t) * 1024), 16, 0, 0); \
        __builtin_amdgcn_global_load_lds((const unsigned*)(Vh + (size_t)(k0) * LD + gv[t]), (LAS unsigned*)(V_lds + (bufi) * SHM_V + (widu + 8 * t) * 1024), 16, 0, 0); } } while (0)
#define TILE_STEP_D(J, B) do { asm volatile("s_waitcnt vmcnt(0)" ::: "memory"); __syncthreads();     \
        if ((J) + 1 < NT) DMA_TILE(((J) + 1) * KVBLK, 1 - (B)); \
        SBAR(); qkt(p0, p1, K_lds + (B) * SHM_K, qr, r32, hi); PSM(p0, p1, (J)); \
        finishSM(p0, p1, l_reg, pa0, pa1, pa2, pa3); SBAR(); \
        pv_d0(o, vb0 + (B) * (int)SHM_V, pa0, pa1, pa2, pa3); } while (0)
#if ATT_DMA == 2
#define DMA_TILE2(k0, kbi, vbi) do { _Pragma("unroll") for (int t = 0; t < 2; ++t) { \
        __builtin_amdgcn_global_load_lds((const unsigned*)(Kh + (size_t)(k0) * LD + gk[t]), (LAS unsigned*)(K_lds + (kbi) * SHM_K + (widu + 8 * t) * 1024), 16, 0, 0); \
        __builtin_amdgcn_global_load_lds((const unsigned*)(Vh + (size_t)(k0) * LD + gv[t]), (LAS unsigned*)(V_lds + (vbi) * SHM_V + (widu + 8 * t) * 1024), 16, 0, 0); } } while (0)
#define STEP2(J, PC0, PC1, PP0, PP1) do { asm volatile("s_waitcnt vmcnt(0)" ::: "memory"); __syncthreads(); \
        if ((J) + 1 < NT) DMA_TILE2(((J) + 1) * KVBLK, ((J) + 1) & 1, vnext); \
        SBAR(); qkt(PC0, PC1, K_lds + ((J) & 1) * SHM_K, qr, r32, hi); \
        finishSM(PP0, PP1, l_reg, pa0, pa1, pa2, pa3); SBAR(); \
        pv_d0(o, vb0 + vprev * (int)SHM_V, pa0, pa1, pa2, pa3); PSM(PC0, PC1, (J)); \
        vprev = vcur; vcur = vnext; vnext = vnext == 2 ? 0 : vnext + 1; } while (0)
    f32x16 pb0, pb1;
    int vprev = 0, vcur = 1, vnext = 2;
    DMA_TILE2(0, 0, 0);
    asm volatile("s_waitcnt vmcnt(0)" ::: "memory"); __syncthreads();
    DMA_TILE2(KVBLK, 1, 1);
    qkt(p0, p1, K_lds, qr, r32, hi); PSM(p0, p1, 0);
#pragma nounroll
    for (int j = 1; j + 1 < NT; j += 2) { STEP2(j, pb0, pb1, p0, p1); STEP2(j + 1, p0, p1, pb0, pb1); }
    STEP2(NT - 1, pb0, pb1, p0, p1);
    finishSM(pb0, pb1, l_reg, pa0, pa1, pa2, pa3); SBAR();
    pv_d0(o, vb0 + vprev * (int)SHM_V, pa0, pa1, pa2, pa3);
#undef STEP2
#undef DMA_TILE2
#else
    DMA_TILE(0, 0);
#pragma nounroll
    for (int j = 0; j < NT; j += 2) { TILE_STEP_D(j, 0); TILE_STEP_D(j + 1, 1); }
#endif
#undef TILE_STEP_D
#undef DMA_TILE
#else
    SLOAD(0); asm volatile("s_waitcnt vmcnt(0)" ::: "memory"); SWRITE(0); SLOAD(KVBLK);
#pragma nounroll
    for (int j = 0; j < NT; j += 2) { TILE_STEP(j, 0); TILE_STEP(j + 1, 1); }
#endif
#endif
#undef TILE_STEP
    if (hi == 0) li_l[r32] = l_reg; asm volatile("s_waitcnt lgkmcnt(0)" ::: "memory");
    float rli[16];
#pragma unroll
    for (int r = 0; r < 16; ++r) rli[r] = __builtin_amdgcn_rcpf(li_l[crow(r, hi)]);
    bf16_t* Ow = Ob + (long)(wid * QBLK) * LD;
#pragma unroll
    for (int r = 0; r < 16; ++r) { const int orow = crow(r, hi);
#pragma unroll
        for (int d0 = 0; d0 < 4; ++d0) Ow[(long)orow * LD + d0 * 32 + r32] = f2bf(o[d0][r] * rli[r]); }
#undef SLOAD
#undef SWRITE
#undef PSM
}

#if ATT_FULLV
template <int OFF> __device__ __forceinline__ void qkt1(f32x16& p, int kb, const bf16x8* Qs) {
    p = f32x16{};
    asm volatile("" : "+v"(kb));
    bf16x8 kf[8];
#define KRD(D0) asm volatile("ds_read_b128 %0, %1 offset:%2" : "=&v"(kf[D0]) : "v"(kb ^ ((D0) * 32)), "i"(OFF) : "memory")
#define QK1(D0, N) asm volatile("s_waitcnt lgkmcnt(" #N ")" ::: "memory"); SBAR(); p = __builtin_amdgcn_mfma_f32_32x32x16_bf16(kf[D0], Qs[D0], p, 0, 0, 0); SBAR();
    KRD(0); KRD(1); KRD(2); KRD(3);
    QK1(0, 3) KRD(4); QK1(1, 3) KRD(5); QK1(2, 3) KRD(6); QK1(3, 3) KRD(7); QK1(4, 3) QK1(5, 2) QK1(6, 1) QK1(7, 0)
#undef QK1
#undef KRD
}
template <int OFF> __device__ __forceinline__ void qkt2(f32x16& pA, f32x16& pB, int kb, int qa, const bf16x8* Qs) {
    pA = f32x16{}; pB = f32x16{};
    asm volatile("" : "+v"(kb), "+v"(qa));
    bf16x8 ka[8], kc[8], ql[8];
#define KRD2(D0) do { asm volatile("ds_read_b128 %0, %1 offset:%2" : "=&v"(ka[D0]) : "v"(kb ^ ((D0) * 32)), "i"(OFF) : "memory"); asm volatile("ds_read_b128 %0, %1 offset:%2" : "=&v"(kc[D0]) : "v"(kb ^ ((D0) * 32)), "i"(OFF + 8192) : "memory"); \
        if ((D0) >= 4) asm volatile("ds_read_b128 %0, %1 offset:%2" : "=&v"(ql[D0]) : "v"(qa), "i"(((D0) - 4) * 1024) : "memory"); } while (0)
#define QK2(D0, N) asm volatile("s_waitcnt lgkmcnt(" #N ")" ::: "memory"); SBAR(); { const bf16x8 q_ = (D0) >= 4 ? ql[D0] : Qs[(D0) & 3]; pA = __builtin_amdgcn_mfma_f32_32x32x16_bf16(ka[D0], q_, pA, 0, 0, 0); pB = __builtin_amdgcn_mfma_f32_32x32x16_bf16(kc[D0], q_, pB, 0, 0, 0); } SBAR();
    KRD2(0); KRD2(1);
    QK2(0, 2) KRD2(2); QK2(1, 2) KRD2(3); QK2(2, 2) KRD2(4); QK2(3, 3) KRD2(5); QK2(4, 3) KRD2(6); QK2(5, 3) KRD2(7); QK2(6, 3) QK2(7, 0)
#undef QK2
#undef KRD2
}
__device__ __forceinline__ void partialSM1(f32x16& p, const LAS float* tb, int rel_s, int lrel) {
    constexpr float C = SCALE * LOG2E;
    if (rel_s - 31 >= 128 || rel_s + 31 <= -128) {
        const float c = (rel_s >= 159) ? tb[256] : tb[0];
#pragma unroll
        for (int r = 0; r < 16; ++r) p[r] = fmaf(p[r], C, c);
    } else {
        int rb = rel_s + lrel; asm volatile("" : "+v"(rb));
#pragma unroll
        for (int r4 = 0; r4 < 16; r4 += 4) {
#pragma unroll
            for (int r = r4; r < r4 + 4; ++r) { const int rl = rb + ((r & 3) + 8 * (r >> 2)); const int i0 = min(max(rl, -128), 128) + 128; p[r] = fmaf(p[r], C, tb[i0]); }
            __builtin_amdgcn_sched_barrier(0);
        }
    }
#pragma unroll
    for (int r = 0; r < 16; ++r) p[r] = __builtin_amdgcn_exp2f(p[r]);
}
__device__ __forceinline__ void finishSM1(const f32x16& p, float& l_acc, bf16x8& pa_lo, bf16x8& pa_hi) {
    float ps = 0;
#pragma unroll
    for (int r = 0; r < 16; ++r) ps += p[r];
    l_acc += ps;
#define PK4(P, BASE, OUT) do { unsigned a0 = cvt_pk_bf16(P[BASE + 0], P[BASE + 1]), a1 = cvt_pk_bf16(P[BASE + 2], P[BASE + 3]);   \
    unsigned b0 = cvt_pk_bf16(P[BASE + 4], P[BASE + 5]), b1 = cvt_pk_bf16(P[BASE + 6], P[BASE + 7]);                              \
    auto r0 = __builtin_amdgcn_permlane32_swap(a0, b0, false, false); auto r1 = __builtin_amdgcn_permlane32_swap(a1, b1, false, false); \
    u32x4 w = {r0[0], r1[0], r0[1], r1[1]}; OUT = __builtin_bit_cast(bf16x8, w); } while (0)
    PK4(p, 0, pa_lo); PK4(p, 8, pa_hi);
#undef PK4
}
__device__ __forceinline__ void attn_unit_fv(const bf16_t* __restrict__ Qb, const bf16_t* __restrict__ Kh, const bf16_t* __restrict__ Vh, bf16_t* __restrict__ Ob, int seq, int q0, const LAS float* tb, LAS char* lds, int tid_) {
    int tid = tid_; asm volatile("" : "+v"(tid));
    const int wid = __builtin_amdgcn_readfirstlane(tid >> 6), lane = tid & 63, r32 = lane & 31, hi = lane >> 5;
    LAS char* V_lds = lds + OFF_V; LAS char* K_lds = lds + OFF_K;
    LAS float* li_l = (LAS float*)(lds + OFF_WS) + wid * 64;
    float l_reg = 0; f32x16 o[8] = {};
    bf16x8 qr[4];
    const int qa0 = (int)(unsigned)(size_t)(lds + OFF_QS) + wid * 4096 + lane * 16;
    { const char* Qw = (const char*)(Qb + (long)(wid * QBLK) * LD); const unsigned qo = (unsigned)((r32 * LD + hi * 8) * 2);
#pragma unroll
      for (int d0 = 0; d0 < 4; ++d0) qr[d0] = *(const bf16x8*)(Qw + qo + d0 * 32);
#pragma unroll
      for (int d0 = 4; d0 < 8; ++d0) { const bf16x8 qv = *(const bf16x8*)(Qw + qo + d0 * 32); *(LAS bf16x8*)((LAS char*)(size_t)(unsigned)qa0 + (d0 - 4) * 1024) = qv; } }
    const int vb0 = (int)(unsigned)(size_t)V_lds + v_rd_base(lane);
    const int wq0 = q0 + wid * QBLK, lrel = 4 * hi - r32;
    unsigned gk0, gv0;
    const int widu = wid;
    { const int b = wid * 1024 + 16 * lane;
      { const int row = b >> 8, cs = (b >> 4) & 15, c = cs ^ (row & 7); gk0 = (unsigned)(row * LD + c * 8) * 2u; }
      { const int sub = b >> 9, e = (b & 511) >> 1, kk = ((sub >> 2) << 3) | (e >> 5), c = ((sub & 3) << 5) | (e & 31), k = (kk & ~0xC) | ((kk & 4) << 1) | ((kk & 8) >> 1); gv0 = (unsigned)(k * LD + c) * 2u; } }
    const int kb0 = (int)(unsigned)(size_t)K_lds + r32 * 256 + ((hi * 16) ^ ((r32 & 7) << 4));
#define DMA1(sbase, voff, ldsaddr) asm volatile("s_mov_b32 m0, %2\n\ts_nop 0\n\tglobal_load_lds_dwordx4 %0, %1" :: "v"(voff), "s"(sbase), "s"(ldsaddr) : "memory", "m0")
#define DMA_TILE_FV(k0, bufi) do { const char* kt_ = (const char*)(Kh + (size_t)(k0) * LD); const char* vt_ = (const char*)(Vh + (size_t)(k0) * LD); _Pragma("unroll") for (int t = 0; t < 2; ++t) { \
        DMA1(kt_ + t * (32 * LD * 2), gk0, (unsigned)(size_t)(K_lds + (bufi) * SHM_K + (widu + 8 * t) * 1024)); \
        DMA1(vt_ + t * (32 * LD * 2), gv0, (unsigned)(size_t)(V_lds + (bufi) * 2 * SHM_V + (widu + 8 * t) * 1024)); \
        DMA1(vt_ + 256 + t * (32 * LD * 2), gv0, (unsigned)(size_t)(V_lds + (bufi) * 2 * SHM_V + SHM_V + (widu + 8 * t) * 1024)); } } while (0)
#define TR4(F, BASE, KS, D0) do { F[0] = tr_read<(BASE) + v_rd_off(D0, KS, 0)>(vb0); F[1] = tr_read<(BASE) + v_rd_off(D0, KS, 1)>(vb0); F[2] = tr_read<(BASE) + v_rd_off(D0 + 1, KS, 0)>(vb0); F[3] = tr_read<(BASE) + v_rd_off(D0 + 1, KS, 1)>(vb0); } while (0)
#define PKF(L, H) (bf16x8){L[0], L[1], L[2], L[3], H[0], H[1], H[2], H[3]}
#define MM2(O, D0, PA, F) do { (O)[D0] = __builtin_amdgcn_mfma_f32_32x32x16_bf16(PA, PKF(F[0], F[1]), (O)[D0], 0, 0, 0); (O)[D0 + 1] = __builtin_amdgcn_mfma_f32_32x32x16_bf16(PA, PKF(F[2], F[3]), (O)[D0 + 1], 0, 0, 0); } while (0)
#define LGK(N) asm volatile("s_waitcnt lgkmcnt(" #N ")" ::: "memory")
#define PV_PIPE(KSA, KSB, VA_, VB_) do { s16x4 f0[4], f1[4], f2[4]; \
        TR4(f0, VA_, KSA, 0); TR4(f1, VA_, KSA, 2); TR4(f2, VB_, KSA, 0); LGK(8); SBAR(); MM2(o, 0, pa0, f0); SBAR(); \
        TR4(f0, VB_, KSA, 2); LGK(8); SBAR(); MM2(o, 2, pa0, f1); SBAR(); \
        TR4(f1, VA_, KSB, 0); LGK(8); SBAR(); MM2(o + 4, 0, pa0, f2); SBAR(); \
        TR4(f2, VA_, KSB, 2); LGK(8); SBAR(); MM2(o + 4, 2, pa0, f0); SBAR(); \
        TR4(f0, VB_, KSB, 0); LGK(8); SBAR(); MM2(o, 0, pa1, f1); SBAR(); \
        TR4(f1, VB_, KSB, 2); LGK(8); SBAR(); MM2(o, 2, pa1, f2); SBAR(); \
        LGK(4); SBAR(); MM2(o + 4, 0, pa1, f0); SBAR(); LGK(0); SBAR(); MM2(o + 4, 2, pa1, f1); } while (0)
#define STEP_FV(J, B) do { asm volatile("s_waitcnt vmcnt(0)" ::: "memory"); __syncthreads();     \
        if ((J) + 1 < NT) DMA_TILE_FV(((J) + 1) * KVBLK, 1 - (B)); \
        { constexpr int VA = (B) * 2 * SHM_V, VB = VA + SHM_V; \
        SBAR(); qkt2<(B) * SHM_K>(p, pb, kb0, qa0, qr); \
        partialSM1(p, tb, (J) * KVBLK - wq0, lrel); \
        finishSM1(p, l_reg, pa0, pa1); SBAR(); \
        pv_kso<0, VA>(o, vb0, pa0); pv_kso<0, VB>(o + 4, vb0, pa0); pv_kso<1, VA>(o, vb0, pa1); pv_kso<1, VB>(o + 4, vb0, pa1); SBAR(); \
        partialSM1(pb, tb, (J) * KVBLK + 32 - wq0, lrel); \
        finishSM1(pb, l_reg, pa0, pa1); SBAR(); \
        PV_PIPE(2, 3, VA, VB); } } while (0)
    bf16x8 pa0, pa1; const int NT = seq / KVBLK;
    f32x16 p, pb;
    DMA_TILE_FV(0, 0);
#pragma nounroll
    for (int j = 0; j < NT; j += 2) { STEP_FV(j, 0); STEP_FV(j + 1, 1); }
#undef STEP_FV
#undef PV_PIPE
#undef LGK
#undef MM2
#undef PKF
#undef TR4
#undef DMA_TILE_FV
#undef DMA1
    { auto rr = __builtin_amdgcn_permlane32_swap(__float_as_uint(l_reg), __float_as_uint(l_reg), false, false); l_reg = __uint_as_float(rr[0]) + __uint_as_float(rr[1]); }
    int l2; asm volatile("v_mbcnt_lo_u32_b32 %0, -1, 0\n\tv_mbcnt_hi_u32_b32 %0, -1, %0" : "=v"(l2));
    const int r32e = l2 & 31, hie = l2 >> 5;
    if (hie == 0) li_l[r32e] = l_reg; asm volatile("s_waitcnt lgkmcnt(0)" ::: "memory");
    char* Ow = (char*)(Ob + (long)(wid * QBLK) * LD);
    unsigned ob = (unsigned)((4 * hie * LD + r32e) * 2);
#pragma unroll
    for (int r = 0; r < 16; ++r) { const float rl = __builtin_amdgcn_rcpf(li_l[crow(r, hie)]); asm volatile("" : "+v"(ob));
        bf16_t* op = (bf16_t*)(Ow + ob + (unsigned)((((r & 3) + 8 * (r >> 2)) * LD) * 2));
#pragma unroll
        for (int d0 = 0; d0 < 8; ++d0) op[d0 * 32] = f2bf(o[d0][r] * rl);
        SBAR(); }
}
#endif
}

__device__ __forceinline__ int t5_bucket(int rel) {
    const int ret = rel > 0 ? 16 : 0; const int n = rel < 0 ? -rel : rel;
    if (n < 8) return ret + n;
    const int e = 31 - __clz(n); int large = 8 + 2 * (e - 3) + ((n * n >= (2 << (2 * e))) ? 1 : 0);
    large = large < 15 ? large : 15;
    return ret + large;
}

__device__ __forceinline__ void p4_mixer(const Frame& F, const Args& a, int g) {
    unsigned char* ws = a.ws; const int TT = g ? 2048 : 4096, NB = g ? 8 : 4;
    bf16_t* dsc = (bf16_t*)(a.out + (size_t)g * GT * DM);
    const float* prm = (const float*)(ws + WS_PRM);
    GlaT T{(const bf16_t*)(ws + A_GQ), (const bf16_t*)(ws + A_GK), (const bf16_t*)(ws + A_GV), (const float*)(ws + WS_ST), prm + P_WGF, prm + P_BGF, prm + P_WGB, prm + P_BGB,
           (bf16_t*)(ws + A_QD), (bf16_t*)(ws + A_KDT), dsc + (size_t)2 * GT * 2048, (bf16_t*)(ws + A_ATT), (float*)(ws + WS_DEC), DG_WORD(ws)};
    const int n_g2 = NB * 4 * 2 * 8;
    for (int it = F.vcu; it < n_g2; it += F.G) gla_g2_item(F, T, it, TT);
#if ATT_FULLV
    const int NQB = TT / 256, n_at = NB * 8 * 2 * NQB;
#else
    const int NQB = TT / 256, n_at = NB * 8 * 2 * 2 * NQB;
#endif
    LAS float* tb = (LAS float*)(F.lds + att::OFF_TB);
    const bf16_t* Qg = (const bf16_t*)(ws + A_Q); const bf16_t* Kg = (const bf16_t*)(ws + A_K); const bf16_t* Vg = (const bf16_t*)(ws + A_V);
    __syncthreads();
    for (int i = F.tid; i < 8 * 257; i += NTHR) { const int h = i / 257, j = i - h * 257; tb[h * att::TB_STRIDE + j] = prm[P_RB + t5_bucket(j - 128) * 8 + h] * LOG2E; }
    __syncthreads();
    for (int it = F.vcu; it < n_at; it += F.G) {
#if ATT_FULLV
        const int qb = it % NQB; int r = it / NQB; const int map = r & 1; r >>= 1; const int h = r & 7; const int b = r >> 3;
        const size_t rowb = (size_t)b * TT;
        att::attn_unit_fv(Qg + (rowb + qb * 256) * 2048 + h * 256 + map * 128, Kg + rowb * 2048 + h * 256 + map * 128, Vg + rowb * 2048 + h * 256,
                          dsc + (size_t)map * GT * 2048 + (rowb + qb * 256) * 2048 + h * 256, TT, qb * 256, tb + h * att::TB_STRIDE, (LAS char*)F.lds, F.tid);
        __syncthreads();
#else
        const int qb = it % NQB; int r = it / NQB; const int vhalf = r & 1; r >>= 1; const int map = r & 1; r >>= 1; const int h = r & 7; const int b = r >> 3;
        const size_t rowb = (size_t)b * TT;
        att::attn_unit(Qg + (rowb + qb * 256) * 2048 + h * 256 + map * 128, Kg + rowb * 2048 + h * 256 + map * 128, Vg + rowb * 2048 + h * 256 + vhalf * 128,
                       dsc + (size_t)map * GT * 2048 + (rowb + qb * 256) * 2048 + h * 256 + vhalf * 128, TT, qb * 256, tb + h * att::TB_STRIDE, (LAS char*)F.lds, F.tid);
        __syncthreads();
#endif
    }
}
__device__ __forceinline__ void p5_finalize(const Frame& F, const Args& a, int g) {
    unsigned char* ws = a.ws; const bf16_t* dsc = (const bf16_t*)(a.out + (size_t)g * GT * DM);
    const bf16_t* O1 = dsc; const bf16_t* O2 = dsc + (size_t)GT * 2048; const bf16_t* OF = dsc + (size_t)2 * GT * 2048; const bf16_t* OB = dsc + (size_t)3 * GT * 2048;
    const bf16_t* GR = (const bf16_t*)(ws + A_GR);
    const float* prm = (const float*)(ws + WS_PRM); const float lam = prm[P_LAM];
    const int gw = F.vcu * NWAVES + F.wave, NGW = F.G * NWAVES, lane = F.lane;
    float sg[8], gg[8];
#pragma unroll
    for (int e = 0; e < 8; ++e) { sg[e] = prm[P_SUBLN + (lane & 31) * 8 + e] * 0.8f; gg[e] = prm[P_GLAG + lane * 8 + e]; }
    unsigned char* OQ = ws + A_OAB; float* soa = (float*)(ws + WS_PRM) + P_SOA; float* sob = (float*)(ws + WS_PRM) + P_SOB;
    for (int m = gw; m < GT; m += NGW) {
        float ya[4][8], yb[4][8]; float ma = 0.f, mb = 0.f;
#pragma unroll
        for (int i = 0; i < 4; ++i) {
            const size_t off = (size_t)m * 2048 + i * 512 + lane * 8;
            { const u32x4 w1 = *(const u32x4*)(O1 + off), w2 = *(const u32x4*)(O2 + off);
              float v[8] = {bflo(w1.x) - lam * bflo(w2.x), bfhi(w1.x) - lam * bfhi(w2.x), bflo(w1.y) - lam * bflo(w2.y), bfhi(w1.y) - lam * bfhi(w2.y),
                            bflo(w1.z) - lam * bflo(w2.z), bfhi(w1.z) - lam * bfhi(w2.z), bflo(w1.w) - lam * bflo(w2.w), bfhi(w1.w) - lam * bfhi(w2.w)};
              float s = 0.f;
#pragma unroll
              for (int e = 0; e < 8; ++e) s += v[e] * v[e];
              s += __shfl_xor(s, 1); s += __shfl_xor(s, 2); s += __shfl_xor(s, 4); s += __shfl_xor(s, 8); s += __shfl_xor(s, 16);
              const float r = 1.f / sqrtf(s * (1.f / 256.f) + EPS);
#pragma unroll
              for (int e = 0; e < 8; ++e) { ya[i][e] = v[e] * r * sg[e]; ma = fmaxf(ma, fabsf(ya[i][e])); } }
            { const u32x4 w1 = *(const u32x4*)(OF + off), w2 = *(const u32x4*)(OB + off), wr_ = *(const u32x4*)(GR + off);
              float v[8] = {bflo(w1.x) + bflo(w2.x), bfhi(w1.x) + bfhi(w2.x), bflo(w1.y) + bflo(w2.y), bfhi(w1.y) + bfhi(w2.y),
                            bflo(w1.z) + bflo(w2.z), bfhi(w1.z) + bfhi(w2.z), bflo(w1.w) + bflo(w2.w), bfhi(w1.w) + bfhi(w2.w)};
              const float rr[8] = {bflo(wr_.x), bfhi(wr_.x), bflo(wr_.y), bfhi(wr_.y), bflo(wr_.z), bfhi(wr_.z), bflo(wr_.w), bfhi(wr_.w)};
              float s = 0.f;
#pragma unroll
              for (int e = 0; e < 8; ++e) s += v[e] * v[e];
              s = wave_sum(s);
              const float r = 1.f / sqrtf(s * (1.f / 512.f) + EPS);
#pragma unroll
              for (int e = 0; e < 8; ++e) { yb[i][e] = v[e] * r * gg[e] * rr[e]; mb = fmaxf(mb, fabsf(yb[i][e])); } }
        }
#pragma unroll
        for (int o = 1; o < 64; o <<= 1) { ma = fmaxf(ma, __shfl_xor(ma, o)); mb = fmaxf(mb, __shfl_xor(mb, o)); }
        ma = fmaxf(ma, 1e-30f); mb = fmaxf(mb, 1e-30f); const float qa = 127.f / ma, qb = 127.f / mb;
#pragma unroll
        for (int i = 0; i < 4; ++i) {
            *(u32x2*)(OQ + (size_t)m * DM + i * 512 + lane * 8) = (u32x2){pack_i8x4(ya[i][0] * qa, ya[i][1] * qa, ya[i][2] * qa, ya[i][3] * qa), pack_i8x4(ya[i][4] * qa, ya[i][5] * qa, ya[i][6] * qa, ya[i][7] * qa)};
            *(u32x2*)(OQ + (size_t)m * DM + 2048 + i * 512 + lane * 8) = (u32x2){pack_i8x4(yb[i][0] * qb, yb[i][1] * qb, yb[i][2] * qb, yb[i][3] * qb), pack_i8x4(yb[i][4] * qb, yb[i][5] * qb, yb[i][6] * qb, yb[i][7] * qb)}; }
        if (lane == 0) { soa[m] = ma * (1.f / 127.f); sob[m] = mb * (1.f / 127.f); }
    }
}
__device__ __forceinline__ void p9_fix(const Frame& F, const float* HB, unsigned char* U8, const float* CW, const float* CB, int TT) {
    const int total = 64 * 86 * 2 * 32;
    for (int it = F.vcu * NTHR + F.tid; it < total; it += F.G * NTHR) {
        const int q = it & 31, e = (it >> 5) & 1, tix = it >> 6, pm = tix / 86, pn = tix - pm * 86, fl = 4 * q, f0 = pn * HALF + fl;
        const float* own = HB + (size_t)tix * 768 + fl; f32x4 prv, cur, nxt, gg; int row;
        if (e == 0) { row = pm * BM; cur = *(const f32x4*)(own); nxt = *(const f32x4*)(own + 128); gg = *(const f32x4*)(own + 4 * 128);
            prv = (row % TT) == 0 ? (f32x4){0.f, 0.f, 0.f, 0.f} : *(const f32x4*)(HB + (size_t)(tix - 86) * 768 + 3 * 128 + fl); }
        else { row = pm * BM + 255; prv = *(const f32x4*)(own + 2 * 128); cur = *(const f32x4*)(own + 3 * 128); gg = *(const f32x4*)(own + 5 * 128);
            nxt = ((row + 1) % TT) == 0 ? (f32x4){0.f, 0.f, 0.f, 0.f} : *(const f32x4*)(HB + (size_t)(tix + 86) * 768 + fl); }
        const f32x4 x0 = *(const f32x4*)(CW + f0), x1 = *(const f32x4*)(CW + DFF + f0), x2 = *(const f32x4*)(CW + 2 * DFF + f0), xb = *(const f32x4*)(CB + f0);
        float o[4];
#pragma unroll
        for (int i = 0; i < 4; ++i) { const float c = prv[i] * x0[i] + cur[i] * x1[i] + nxt[i] * x2[i] + xb[i]; o[i] = gelu_tanh_(c) * gg[i]; }
        int w = 0; w = __builtin_amdgcn_cvt_pk_fp8_f32(sat8(o[0]), sat8(o[1]), w, false); w = __builtin_amdgcn_cvt_pk_fp8_f32(sat8(o[2]), sat8(o[3]), w, true);
        *(unsigned*)(U8 + (size_t)row * DFF + f0) = (unsigned)w;
    }
}
__device__ __forceinline__ float gelu_tanh(float x) { const float u = x * (1.5957691216057308f + 0.07135481627159145f * x * x); return x * __builtin_amdgcn_rcpf(1.f + __builtin_amdgcn_exp2f(-u * LOG2E)); }
__device__ __forceinline__ void unpack8(const u32x4 w, float (&v)[8]) { v[0] = bflo(w.x); v[1] = bfhi(w.x); v[2] = bflo(w.y); v[3] = bfhi(w.y); v[4] = bflo(w.z); v[5] = bfhi(w.z); v[6] = bflo(w.w); v[7] = bfhi(w.w); }
__device__ __forceinline__ void p9_conv(const Frame& F, const Args& a, int g) {
    unsigned char* ws = a.ws; const int TT = g ? 2048 : 4096;
    const bf16_t* FA = (const bf16_t*)(ws + A_FA); const bf16_t* FG = (const bf16_t*)(ws + A_FG); unsigned char* U8 = u8_ptr(a, g);
    const float* cw = (const float*)(ws + WS_PRM) + P_CW; const float* cb = (const float*)(ws + WS_PRM) + P_CB;
    constexpr int NF8 = DFF / 8, RB = 16, NRB = GT / RB;
    const long total = (long)NF8 * NRB;
    for (long it = (long)F.vcu * NTHR + F.tid; it < total; it += (long)F.G * NTHR) {
        const int f8 = (int)(it % NF8), rb = (int)(it / NF8), f0 = f8 * 8, r0 = rb * RB;
        float w0[8], w1[8], w2[8], bb[8];
#pragma unroll
        for (int e = 0; e < 8; ++e) { w0[e] = cw[f0 + e]; w1[e] = cw[DFF + f0 + e]; w2[e] = cw[2 * DFF + f0 + e]; bb[e] = cb[f0 + e]; }
        float pv[8], cv[8], nv[8];
        if ((r0 % TT) != 0) unpack8(*(const u32x4*)(FA + (size_t)(r0 - 1) * DFF + f0), pv); else {
#pragma unroll
            for (int e = 0; e < 8; ++e) pv[e] = 0.f; }
        unpack8(*(const u32x4*)(FA + (size_t)r0 * DFF + f0), cv);
#pragma unroll 4
        for (int r = 0; r < RB; ++r) { const int row = r0 + r;
            if (((row + 1) % TT) != 0) unpack8(*(const u32x4*)(FA + (size_t)(row + 1) * DFF + f0), nv); else {
#pragma unroll
                for (int e = 0; e < 8; ++e) nv[e] = 0.f; }
            float gv[8]; unpack8(*(const u32x4*)(FG + (size_t)row * DFF + f0), gv);
            float o[8];
#pragma unroll
            for (int e = 0; e < 8; ++e) { const float c = pv[e] * w0[e] + cv[e] * w1[e] + nv[e] * w2[e] + bb[e]; o[e] = gelu_tanh(c) * gv[e]; pv[e] = cv[e]; cv[e] = nv[e]; }
            int w0 = 0, w1 = 0;
            w0 = __builtin_amdgcn_cvt_pk_fp8_f32(sat8(o[0] * U8_SCALE), sat8(o[1] * U8_SCALE), w0, false); w0 = __builtin_amdgcn_cvt_pk_fp8_f32(sat8(o[2] * U8_SCALE), sat8(o[3] * U8_SCALE), w0, true);
            w1 = __builtin_amdgcn_cvt_pk_fp8_f32(sat8(o[4] * U8_SCALE), sat8(o[5] * U8_SCALE), w1, false); w1 = __builtin_amdgcn_cvt_pk_fp8_f32(sat8(o[6] * U8_SCALE), sat8(o[7] * U8_SCALE), w1, true);
            *(u32x2*)(U8 + (size_t)row * DFF + f0) = (u32x2){(unsigned)w0, (unsigned)w1}; }
    }
}

constexpr int NPH = 11;
#if MK_TPROBE >= 0
#define TP_BEGIN(k) unsigned long long tp_t0_ = 0; if (MK_TPROBE == (k)) tp_t0_ = __builtin_amdgcn_s_memrealtime();
#define TP_END(k) do { if (MK_TPROBE == (k) && F.tid == 0) { volatile LAS unsigned* m_ = (volatile LAS unsigned*)(lds + LDS_MISC); m_[32] = m_[32] + (unsigned)(__builtin_amdgcn_s_memrealtime() - tp_t0_); } } while (0)
#else
#define TP_BEGIN(k)
#define TP_END(k)
#endif
#define GRID_BAR() do { if (!multi) { XcdBarrier b_; b_.bar = (unsigned*)(args.ws + WS_CTL) + CW_BAR; b_.x = xb_xcc_id(); b_.st = (volatile LAS unsigned*)(lds + LDS_MISC); xcd_barrier(b_); } } while (0)
#if MK_ONE_LAUNCH
#define IN(k) true
#else
#define IN(k) (lo <= (k) && (k) < hi)
#endif
template <int GI> __device__ __forceinline__ void group_body(LAS unsigned char* lds, const int wave_s, const Args& args, const bool more) {
    constexpr bool multi = !MK_ONE_LAUNCH;
    constexpr int g = GI;
    unsigned char* ws = args.ws; const int lo = args.ph_lo, hi = args.ph_hi; (void)lo; (void)hi;
    const float* xg = args.in[GI];
    float* outg = args.out + (size_t)GI * GT * DM;
    float* rss = (float*)((unsigned*)(ws + WS_CTL) + CW_RSS) + (size_t)GI * GT;
    if (IN(1)) { const Frame F = make_frame(lds, wave_s); TP_BEGIN(1) p1_hnorm(F, xg, GI == 0 ? args.in[3] : (const float*)(ws + WS_PRM) + P_GMIX, ws + A_H, (float*)(ws + WS_PRM) + P_SH); GRID_BAR(); TP_END(1); }
    if (IN(2)) { const Frame F = make_frame(lds, wave_s);
        TP_BEGIN(2)
        { pg8::Gemm gm{(const bf16_t*)(ws + A_H), (const bf16_t*)(ws + WS_WIN)};
          EpiInProj E{ws, (const float*)(ws + WS_PRM) + P_SH, (const float*)(ws + WS_PRM) + P_SWIN, (LAS float*)(F.lds + 131072 + 4096)};
          pg8::gemm_phase<GT, DINP, DM / 2, DM / 2, DM / 2, 1, 0, 2>(F.lds, gm, fresh_grid(), fresh_bid(), F.tid, E); }
        GRID_BAR(); TP_END(2);
    }
    if (IN(3)) { const Frame F = make_frame(lds, wave_s);
        TP_BEGIN(3)
        const float* prm = (const float*)(ws + WS_PRM);
        bf16_t* dsc = (bf16_t*)outg;
        GlaT T{(const bf16_t*)(ws + A_GQ), (const bf16_t*)(ws + A_GK), (const bf16_t*)(ws + A_GV), (const float*)(ws + WS_ST), prm + P_WGF, prm + P_BGF, prm + P_WGB, prm + P_BGB,
               (bf16_t*)(ws + A_QD), (bf16_t*)(ws + A_KDT), dsc + (size_t)2 * GT * 2048, (bf16_t*)(ws + A_ATT), (float*)(ws + WS_DEC), DG_WORD(ws)};
        constexpr int TT = g ? 2048 : 4096;
        for (int it = F.vcu; it < 2048; it += F.G) gla_g1_item(F, T, it, TT);
        GRID_BAR(); TP_END(3);
    }
    if (IN(4)) { const Frame F = make_frame(lds, wave_s); TP_BEGIN(4) p4_mixer(F, args, g); GRID_BAR(); TP_END(4); }
    if (IN(5)) { const Frame F = make_frame(lds, wave_s); TP_BEGIN(5) p5_finalize(F, args, g); GRID_BAR(); TP_END(5); }
    if (IN(6)) { const Frame F = make_frame(lds, wave_s);
        pg8::Gemm gm{(const bf16_t*)(ws + A_OAB), (const bf16_t*)(ws + WS_WPAB)}; EpiBranch E{ws};
        TP_BEGIN(6) pg8::gemm_phase<GT, DM, 1024, 2048, 2048, 2, 1024, 2>(F.lds, gm, fresh_grid(), fresh_bid(), F.tid, E); GRID_BAR();
        if (INT8_WOUT) { p7b_quant_x1(F, (const bf16_t*)(ws + A_MRG), ws + A_K, (float*)(ws + WS_PRM) + P_SM); GRID_BAR(); } TP_END(6);
    }
    if (IN(7)) { const Frame F = make_frame(lds, wave_s);
        pg8::Gemm gm{(const bf16_t*)(ws + (INT8_WOUT ? A_K : A_MRG)), (const bf16_t*)(ws + WS_WOUT)};
        EpiWout E{xg, (bf16_t*)(ws + A_X1B), rss, (const float*)(ws + WS_PRM) + P_SM, (const float*)(ws + WS_PRM) + P_SWWO}; TP_BEGIN(7) if (INT8_WOUT) pg8::gemm_phase<GT, DM, DM / 2, DM / 2, DM / 2, 1, 0, 2>(F.lds, gm, fresh_grid(), fresh_bid(), F.tid, E); else pg8::gemm_phase<GT, DM, DM, DM, DM, 1, 0, 0>(F.lds, gm, fresh_grid(), fresh_bid(), F.tid, E);
        GRID_BAR(); TP_END(7);
    }
    if (IN(8)) { const Frame F = make_frame(lds, wave_s);
        TP_BEGIN(8)
        float* sx = (float*)(ws + WS_PRM) + P_SX + (size_t)GI * GT;
        p7b_quant_x1(F, (const bf16_t*)(ws + A_X1B), (unsigned char*)outg, sx); GRID_BAR();
        pg8::Gemm gm{(const bf16_t*)outg, (const bf16_t*)(ws + WS_WUP)};
#if FUSE_CONV
        EpiUpConv E{ws, GI, (LAS float*)(F.lds + 131072)};
#else
        EpiUp E{rss, (bf16_t*)(ws + A_FA), (bf16_t*)(ws + A_FG), sx, (const float*)(ws + WS_PRM) + P_SWUP};
#endif
        pg8::gemm_phase<GT, 2 * DFF, DM / 2, DM / 2, DM / 2, 1, 0, 2>(F.lds, gm, fresh_grid(), fresh_bid(), F.tid, E); GRID_BAR(); TP_END(8);
    }
#if FUSE_CONV
    if (IN(9)) { const Frame F = make_frame(lds, wave_s); TP_BEGIN(9) p9_fix(F, (const float*)(ws + A_FA), u8_ptr(args, g), (const float*)(ws + WS_PRM) + P_CW, (const float*)(ws + WS_PRM) + P_CB, g ? 2048 : 4096); GRID_BAR(); TP_END(9); }
#else
    if (IN(9)) { const Frame F = make_frame(lds, wave_s); TP_BEGIN(9) p9_conv(F, args, g); GRID_BAR(); TP_END(9); }
#endif
    if (IN(10)) { const Frame F = make_frame(lds, wave_s);
        pg8::Gemm gm{(const bf16_t*)u8_ptr(args, g), (const bf16_t*)(ws + WS_WDN)};
        EpiDown E{outg, (const bf16_t*)(ws + A_X1B), 1.f / (U8_SCALE * W8_SCALE)}; TP_BEGIN(10) pg8::gemm_phase<GT, DM, DFF / 2, DFF / 2, DFF / 2, 1, 0, 1>(F.lds, gm, fresh_grid(), fresh_bid(), F.tid, E); TP_END(10);
        if (more) GRID_BAR();
    }
}
__global__ void __launch_bounds__(NTHR, 2) mk_fwd(Args args) {
    extern __shared__ __attribute__((aligned(16))) unsigned char lds_raw[];
    LAS unsigned char* lds = (LAS unsigned char*)lds_raw;
    const int wave_s = __builtin_amdgcn_readfirstlane((int)threadIdx.x >> 6);
#if MK_TPROBE == 99
    const unsigned long long tp_k0 = __builtin_amdgcn_s_memrealtime();
#endif
    { volatile LAS unsigned* MISC = (volatile LAS unsigned*)(lds + LDS_MISC); const int t = fresh_tid(wave_s); if (t < 64) MISC[t] = 0u; }
    __syncthreads();
#if MK_ONE_LAUNCH
    (void)xcd_barrier_post((unsigned*)(args.ws + WS_CTL) + CW_BAR, (volatile LAS unsigned*)(lds + LDS_MISC));
    { const Frame F = make_frame(lds, wave_s); p0_colmax(F, args.in[21], DM, 2 * DFF, args.in[20], (unsigned*)(args.ws + WS_CTL) + CW_CMAX_UP);
      p0_colmax(F, args.in[4], DM, DIN, nullptr, (unsigned*)(args.ws + WS_CTL) + CW_CMAX_IN);
      p0_colmax(F, args.in[17], 2048, DM, nullptr, (unsigned*)(args.ws + WS_CTL) + CW_CMAX_PA); p0_colmax(F, args.in[18], 2048, DM, nullptr, (unsigned*)(args.ws + WS_CTL) + CW_CMAX_PB);
      p0_colmax(F, args.in[19], DM, DM, nullptr, (unsigned*)(args.ws + WS_CTL) + CW_CMAX_WO); }
    { XcdBarrier b_; b_.bar = (unsigned*)(args.ws + WS_CTL) + CW_BAR; b_.x = xb_xcc_id(); b_.st = (volatile LAS unsigned*)(lds + LDS_MISC); xcd_barrier(b_); }
    { const Frame F = make_frame(lds, wave_s); TP_BEGIN(0) p0_weights(F, args); TP_END(0); }
    group_body<0>(lds, wave_s, args, true);
    group_body<1>(lds, wave_s, args, false);
#if MK_TPROBE == 99
    { const Frame F = make_frame(lds, wave_s); if (fresh_bid() == 0 && F.tid == 0) args.out[0] += (float)(unsigned)(__builtin_amdgcn_s_memrealtime() - tp_k0) * 1e-4f; }
#elif MK_TPROBE >= 0
    { const Frame F = make_frame(lds, wave_s); if (fresh_bid() == 0 && F.tid == 0) { volatile LAS unsigned* m_ = (volatile LAS unsigned*)(lds + LDS_MISC); args.out[0] += (float)m_[32] * 1e-4f; } }
#endif
#else
    if (args.ph_lo == 0 && args.g_lo == 0) { const Frame F = make_frame(lds, wave_s); p0_weights(F, args); }
    if (args.g_lo <= 0 && 0 < args.g_hi) group_body<0>(lds, wave_s, args, false);
    if (args.g_lo <= 1 && 1 < args.g_hi) group_body<1>(lds, wave_s, args, false);
#endif
}
#undef IN
#undef GRID_BAR


#if MK_DIAG
constexpr int CW_DIAG = 32768;
__global__ void diag_scan_bf16(const bf16_t* p, size_t n, unsigned* diag, int stage, float thr) {
    unsigned bad = 0;
    for (size_t i = (size_t)blockIdx.x * blockDim.x + threadIdx.x; i < n; i += (size_t)gridDim.x * blockDim.x) { const float v = bf2f(p[i]); if (!(fabsf(v) <= thr)) ++bad; }
    if (bad) atomicAdd(diag + stage, bad);
}
__global__ void diag_scan_f32(const float* p, size_t n, unsigned* diag, int stage, float thr) {
    unsigned bad = 0;
    for (size_t i = (size_t)blockIdx.x * blockDim.x + threadIdx.x; i < n; i += (size_t)gridDim.x * blockDim.x) { const float v = p[i]; if (!(fabsf(v) <= thr)) ++bad; }
    if (bad) atomicAdd(diag + stage, bad);
}

__global__ void diag_check_inproj(const float* x, const float* gm, const float* w_in, unsigned char* ws, unsigned* flag) {
    const int lane = threadIdx.x & 63, wv = (blockIdx.x * blockDim.x + threadIdx.x) >> 6, nw = (gridDim.x * blockDim.x) >> 6;
    const bf16_t* H = (const bf16_t*)(ws + A_H); const bf16_t* W = (const bf16_t*)(ws + WS_WIN);
    for (int s = wv; s < 4096; s += nw) {
        const unsigned hsh = (unsigned)s * 2654435761u; const int row = (int)((hsh >> 8) % GT);
        { float ss = 0.f; for (int k = lane; k < DM; k += 64) { const float v = x[(size_t)row * DM + k]; ss += v * v; } ss = wave_sum(ss);
          const int k = (int)((hsh >> 3) % DM); const float ref = x[(size_t)row * DM + k] * (1.f / sqrtf(ss / DM + EPS)) * gm[k]; const float got = bf2f(H[(size_t)row * DM + k]);
          if (!(fabsf(got - ref) <= 0.02f * fabsf(ref) + 1e-3f)) atomicOr(flag, 1u); }
        { const int n = (int)((hsh >> 5) % DIN), k = (int)((hsh >> 7) % DM); const int nn = n < 12288 ? n : (n < 12320 ? 20480 + (n - 12288) : n - 32);
          const float ref = w_in[(size_t)k * DIN + n], got = bf2f(W[(size_t)nn * DM + k]); if (!(fabsf(got - ref) <= 0.01f * fabsf(ref) + 1e-6f)) atomicOr(flag, 2u); }
        { const int seg = s % 7; int ncol, ld; size_t boff; float scale = 1.f;
          if (seg == 0) { ncol = 2048; ld = 2048; boff = A_Q; } else if (seg == 1) { ncol = 2048; ld = 2048; boff = A_K; } else if (seg == 2) { ncol = 2048; ld = 2048; boff = A_V; }
          else if (seg == 3) { ncol = 1024; ld = 1024; boff = A_GQ; scale = 0.0625f; } else if (seg == 4) { ncol = 1024; ld = 1024; boff = A_GK; } else if (seg == 5) { ncol = 2048; ld = 2048; boff = A_GV; } else { ncol = 32; ld = 32; boff = WS_ST; }
          const int segbase[7] = {0, 2048, 4096, 6144, 7168, 8192, 20480};
          const int c = (int)((hsh >> 11) % ncol); const int nn = segbase[seg] + c;
          float acc = 0.f; for (int k = lane; k < DM; k += 64) acc += bf2f(H[(size_t)row * DM + k]) * bf2f(W[(size_t)nn * DM + k]); acc = wave_sum(acc) * scale;
          const float got = seg == 6 ? ((const float*)(ws + boff))[(size_t)row * 32 + c] : bf2f(((const bf16_t*)(ws + boff))[(size_t)row * ld + c]);
          if (!(fabsf(got - acc) <= 0.02f * fabsf(acc) + 0.02f)) atomicOr(flag, 4u << seg); }
    }
}
__global__ void diag_final(float* out, size_t n, const unsigned* diag, int nstages) {
    int D = (int)(diag[50] & 32u); for (int s = 0; s < 4; ++s) if (diag[40 + s]) D |= 1 << s; if (diag[41] > 1000u) D |= 16;
    if (D == 0) return;
    const float c = exp2f(0.5f * (float)D);
    for (size_t i = (size_t)blockIdx.x * blockDim.x + threadIdx.x; i < n; i += (size_t)gridDim.x * blockDim.x) out[i] = c;
}
#endif
extern "C" void kernel_launch(void* const* d_in, const int* in_sizes, int n_in, void* d_out, int out_size, void* d_ws, size_t ws_size, hipStream_t stream) {
    static int grid = 0;
    if (grid == 0) {
        if (n_in != 25 || ws_size < WS_END) { fprintf(stderr, "kernel_launch: n_in %d ws %zu (need %zu)\n", n_in, ws_size, (size_t)WS_END); grid = -1; return; }
        int dev = 0, cus = 0, per_cu = 0;
        if (hipGetDevice(&dev) != hipSuccess || hipDeviceGetAttribute(&cus, hipDeviceAttributeMultiprocessorCount, dev) != hipSuccess) { grid = -1; return; }
        if (hipFuncSetAttribute((const void*)mk_fwd, hipFuncAttributeMaxDynamicSharedMemorySize, LDS_BYTES) != hipSuccess) { fprintf(stderr, "kernel_launch: hipFuncSetAttribute failed\n"); grid = -1; return; }
        if (hipOccupancyMaxActiveBlocksPerMultiprocessor(&per_cu, (const void*)mk_fwd, NTHR, LDS_BYTES) != hipSuccess || per_cu < 1) { fprintf(stderr, "kernel_launch: occupancy query says %d\n", per_cu); }
        (void)hipGetLastError();
        grid = cus;
    }
    if (grid < 0) return;
    (void)hipMemsetAsync((char*)d_ws + WS_CTL, 0, CTL_ZERO_BYTES, stream);
    Args a{};
    for (int i = 0; i < 25; ++i) a.in[i] = (const float*)d_in[i];
    a.out = (float*)d_out; a.ws = (unsigned char*)d_ws;
#if MK_ONE_LAUNCH
    a.ph_lo = 0; a.ph_hi = NPH; a.g_lo = 0; a.g_hi = 2;
    hipLaunchKernelGGL(mk_fwd, dim3(grid), dim3(NTHR), LDS_BYTES, stream, a);
#else
    a.ph_lo = 0; a.ph_hi = 1; a.g_lo = 0; a.g_hi = 1;
    hipLaunchKernelGGL(mk_fwd, dim3(grid), dim3(NTHR), LDS_BYTES, stream, a);
#if MK_DIAG
    unsigned char* ws = (unsigned char*)d_ws; unsigned* dg = (unsigned*)(ws + WS_CTL) + CW_DIAG;
#define SCANB(ptr, nel, st, thr) hipLaunchKernelGGL(diag_scan_bf16, dim3(2048), dim3(256), 0, stream, (const bf16_t*)(ptr), (size_t)(nel), dg, (st), (thr))
#define SCANF(ptr, nel, st, thr) hipLaunchKernelGGL(diag_scan_f32, dim3(2048), dim3(256), 0, stream, (const float*)(ptr), (size_t)(nel), dg, (st), (thr))
    SCANB(ws + WS_WIN, (WS_ACT - WS_WIN) / 2, 1, 1e4f);
    SCANF(ws + WS_PRM, P_END, 1, 1e4f);
#endif
    for (int g = 0; g < 2; ++g)
        for (int p = 1; p < NPH; ++p) { a.ph_lo = p; a.ph_hi = p + 1; a.g_lo = g; a.g_hi = g + 1; hipLaunchKernelGGL(mk_fwd, dim3(grid), dim3(NTHR), LDS_BYTES, stream, a);
#if MK_DIAG
            const int sb = 2 + g * 12; float* og = (float*)d_out + (size_t)g * GT * DM; const size_t E64 = (size_t)GT * 2048;
            if (p == 1) SCANB(ws + A_H, 2 * E64, sb + 0, 1e4f);
            if (p == 2) { SCANB(ws + A_Q, (A_SB + 128 * MiB - A_Q) / 2, sb + 1, 1e4f); SCANF(ws + WS_ST, (size_t)GT * 32, sb + 1, 1e4f); }
            if (p == 3 && g == 0) { SCANB((bf16_t*)og + 2 * E64, 2 * E64, 40, 3e38f); SCANB((bf16_t*)og + 2 * E64, 2 * E64, 41, 1e4f); SCANB((bf16_t*)og + 2 * E64, E64, 42, 1e4f); SCANB((bf16_t*)og + 3 * E64, E64, 43, 1e4f); }
            if (p == 4) SCANB(og, 4 * E64, sb + 3, 1e4f);
            if (p == 5) SCANB(ws + A_OAB, 2 * E64, sb + 4, 1e4f);
            if (p == 6) SCANB(ws + A_MRG, 2 * E64, sb + 5, 1e4f);
            if (p == 7) { SCANF(og, (size_t)GT * DM, sb + 6, 1e4f); SCANB(ws + A_X1B, 2 * E64, sb + 6, 1e4f); SCANF((float*)((unsigned*)(ws + WS_CTL) + CW_RSS) + (size_t)g * GT, GT, sb + 6, 1e6f); }
            if (p == 8) { SCANB(ws + A_FA, (size_t)GT * DFF, sb + 7, 1e4f); SCANB(ws + A_FG, (size_t)GT * DFF, sb + 7, 1e4f); }
            if (p == 9) SCANB(ws + A_FG, (size_t)GT * DFF, sb + 8, 1e4f);
            if (p == 10) SCANF(og, (size_t)GT * DM, sb + 9, 1e4f);
#endif
        }
#if MK_DIAG
    hipLaunchKernelGGL(diag_final, dim3(2048), dim3(256), 0, stream, (float*)d_out, (size_t)2 * GT * DM, dg, 32);
#endif
#endif
}
```

```cpp
#include <hip/hip_runtime.h>
#include <cstdio>
#include <cstdint>

#ifndef MK_ONE_LAUNCH
#define MK_ONE_LAUNCH 1
#endif
#ifndef INT8_WOUT
#define INT8_WOUT 1
#endif
#ifndef ATT_DMA
#define ATT_DMA 2
#endif
#ifndef FUSE_CONV
#define FUSE_CONV 1
#endif
#ifndef ATT_PV_KMAJOR
#define ATT_PV_KMAJOR 1
#endif
#ifndef RELAX_EPI
#define RELAX_EPI 1
#endif
#ifndef ATT_FULLV
#define ATT_FULLV 1
#endif
#ifndef ATT_PIPE
#define ATT_PIPE 0
#endif
#ifndef MK_TPROBE
#define MK_TPROBE -1
#endif
#ifndef MK_DIAG
#define MK_DIAG 0
#endif
#define DG_WORD(ws) ((unsigned*)((ws) + WS_CTL) + 32768 + 50)

#define LAS __attribute__((address_space(3)))
#define GAS __attribute__((address_space(1)))
typedef unsigned short bf16_t;
typedef short bf16x8 __attribute__((ext_vector_type(8)));
typedef short s16x4 __attribute__((ext_vector_type(4)));
typedef float f32x4 __attribute__((ext_vector_type(4)));
typedef float f32x2 __attribute__((ext_vector_type(2)));
typedef float f32x16 __attribute__((ext_vector_type(16)));
typedef unsigned u32x4 __attribute__((ext_vector_type(4)));
typedef unsigned u32x2 __attribute__((ext_vector_type(2)));

constexpr int DM = 4096, GT = 16384  , DIN = 20512, DINP = 20736, DFF = 11008;
constexpr float EPS = 1e-6f;
constexpr float LOG2E = 1.4426950408889634f;
constexpr int NWAVES = 8, NTHR = 512;

constexpr size_t MiB = 1u << 20;
constexpr size_t WS_CTL = 0, CTL_ZERO_BYTES = 1 * MiB;
constexpr size_t WS_PRM = 1 * MiB;
constexpr int P_LAM = 0, P_GMIX = 64, P_QG = 4160, P_KG = 4288, P_SUBLN = 4416, P_WGF = 4672, P_BGF = 21056, P_WGB = 22080, P_BGB = 38464, P_GLAG = 39488, P_CW = 40000, P_CB = 73024, P_RB = 84032, P_END = 84288;
constexpr size_t WS_ST = 2 * MiB;
constexpr size_t WS_DEC = 4 * MiB;
constexpr size_t WS_WIN = 8 * MiB;
constexpr size_t WS_WIN8 = 96 * MiB;
constexpr size_t WS_WUP = 170 * MiB;
constexpr size_t WS_WDN = 342 * MiB;
constexpr size_t WS_WOUT = 428 * MiB;
constexpr size_t WS_WPAB = 460 * MiB;
constexpr size_t WS_ACT = 492 * MiB;
constexpr size_t A_H = WS_ACT + 0 * MiB;
constexpr size_t A_Q = WS_ACT + 128 * MiB, A_K = WS_ACT + 192 * MiB, A_V = WS_ACT + 256 * MiB;
constexpr size_t A_GQ = WS_ACT + 320 * MiB, A_GK = WS_ACT + 352 * MiB;
constexpr size_t A_GV = WS_ACT + 384 * MiB, A_GR = WS_ACT + 448 * MiB;
constexpr size_t A_SA = WS_ACT + 512 * MiB, A_SB = WS_ACT + 640 * MiB;
constexpr size_t A_ATT = WS_ACT + 768 * MiB;
constexpr size_t A_QD = A_H, A_KDT = A_H + 64 * MiB;
constexpr size_t A_OAB = A_Q;
constexpr size_t A_MRG = A_V;
constexpr size_t A_X1B = A_H;
constexpr size_t A_FA = WS_ACT + 128 * MiB;
constexpr size_t A_FG = WS_ACT + 472 * MiB;
constexpr size_t WS_END = WS_ACT + 816 * MiB;
constexpr float H8_SCALE = 16.f;
constexpr float U8_SCALE = 8.f, W8_SCALE = 64.f;
constexpr int CW_CMAX_UP = 100000, CW_CMAX_IN = 125000;
constexpr int P_SWUP = 150000, P_SWIN = 175000;
constexpr int CW_CMAX_PA = 146000, CW_CMAX_PB = 150100, CW_CMAX_WO = 154200;
constexpr int P_SOA = 200000, P_SOB = 216384, P_SM = 232768;
constexpr int P_SWPA = 249200, P_SWPB = 253296, P_SWWO = 257392;
constexpr int CW_WMAX = 40000;
constexpr int P_SH = 130000;
constexpr int P_SX = 90000;
constexpr int CW_BAR = 1024;
constexpr int CW_RSS = 65536;

constexpr int LDS_BYTES = 155648;
constexpr int LDS_MISC = 153600;

typedef __bf16 nbf16x2 __attribute__((ext_vector_type(2)));
__device__ __forceinline__ unsigned cvt_pk_bf16(float lo, float hi) { const f32x2 v = {lo, hi}; return __builtin_bit_cast(unsigned, __builtin_convertvector(v, nbf16x2)); }
__device__ __forceinline__ float bflo(unsigned w) { return __uint_as_float(w << 16); }
__device__ __forceinline__ float bfhi(unsigned w) { return __uint_as_float(w & 0xffff0000u); }
__device__ __forceinline__ float bf2f(bf16_t v) { return __uint_as_float(((unsigned)v) << 16); }
__device__ __forceinline__ bf16_t f2bf(float f) { return (bf16_t)(cvt_pk_bf16(f, 0.f) & 0xffffu); }
__device__ __forceinline__ float sat8(float v) { return __builtin_fminf(__builtin_fmaxf(v, -448.f), 448.f); }
__device__ __forceinline__ unsigned pack_i8x4(float a, float b, float c, float d) {
    const int ia = (int)__builtin_rintf(a), ib = (int)__builtin_rintf(b), ic = (int)__builtin_rintf(c), id = (int)__builtin_rintf(d);
    return (unsigned)(ia & 0xff) | ((unsigned)(ib & 0xff) << 8) | ((unsigned)(ic & 0xff) << 16) | ((unsigned)id << 24);
}
__device__ __forceinline__ float wave_sum(float v) {
#pragma unroll
    for (int o = 1; o < 64; o <<= 1) v += __shfl_xor(v, o);
    return v;
}
__device__ __forceinline__ float fast_exp(float x) { return __builtin_amdgcn_exp2f(x * LOG2E); }
__device__ __forceinline__ float sigmoidf_(float x) { return __builtin_amdgcn_rcpf(1.f + fast_exp(-x)); }

__device__ __forceinline__ int fresh_tid(int wave_s) { int l; asm volatile("v_mbcnt_lo_u32_b32 %0, -1, 0\n\tv_mbcnt_hi_u32_b32 %0, -1, %0" : "=v"(l)); return (wave_s << 6) | l; }
__device__ __forceinline__ int fresh_bid() { int b = blockIdx.x; asm volatile("" : "+s"(b)); return b; }
__device__ __forceinline__ int fresh_grid() { int g = gridDim.x; asm volatile("" : "+s"(g)); return g; }
#define XB_TMO      128
#define XB_XCNT(j)  (256  + 64 * (j))
#define XB_XSUB(j)  (1280 + 64 * (j))
#define XB_XGEN(j)  (2304 + 64 * (j))
#define XB_TOP      3328
#define XB_TOPGEN   3392
#define XCD_BAR_WORDS 3456
#define XB_SPIN_CAP (1u << 18)
__device__ __forceinline__ unsigned xb_ld(unsigned* p)              { return __hip_atomic_load(p, __ATOMIC_RELAXED, __HIP_MEMORY_SCOPE_AGENT); }
__device__ __forceinline__ unsigned xb_add(unsigned* p, unsigned v) { return __hip_atomic_fetch_add(p, v, __ATOMIC_RELAXED, __HIP_MEMORY_SCOPE_AGENT); }
__device__ __forceinline__ unsigned xb_xcc_id() { return (unsigned)__builtin_amdgcn_s_getreg((3 << 11) | 20) & 0xFu; }
#define XB_SPIN(cond, bar) do { unsigned _sp = 0; while (cond) { __builtin_amdgcn_s_sleep(1); \
    if ((++_sp & 255u) == 0u) { if (xb_ld(&(bar)[XB_TMO])) break; if (_sp > XB_SPIN_CAP) { atomicAdd(&(bar)[XB_TMO], 1u); break; } } } } while (0)
struct XcdBarrier { unsigned* bar; unsigned x; volatile LAS unsigned* st; };
__device__ __forceinline__ XcdBarrier xcd_barrier_post(unsigned* bar, volatile LAS unsigned* st) {
    XcdBarrier b; b.bar = bar; b.x = xb_xcc_id(); b.st = st;
    if (threadIdx.x == 0) (void)xb_add(&bar[XB_XCNT(b.x)], 1u);
    return b;
}
__device__ __forceinline__ void xcd_barrier_complete(unsigned* bar, unsigned x, unsigned& nloc, unsigned& nx) {
    const unsigned G = gridDim.x * gridDim.y * gridDim.z;
    unsigned sum, cnt, mine, sp = 0u;
    for (;;) {
        sum = 0u; cnt = 0u; mine = 0u;
#pragma unroll
        for (unsigned j = 0; j < 16; ++j) { const unsigned c = xb_ld(&bar[XB_XCNT(j)]); sum += c; cnt += (c > 0u) ? 1u : 0u; mine = (j == x) ? c : mine; }
        if (sum == G) break;
        __builtin_amdgcn_s_sleep(1);
        if ((++sp & 255u) == 0u) { if (xb_ld(&bar[XB_TMO])) break; if (sp > XB_SPIN_CAP) { atomicAdd(&bar[XB_TMO], 1u); break; } }
    }
    nloc = mine > 0u ? mine : 1u; nx = cnt > 0u ? cnt : 1u;
}
__device__ __forceinline__ void xcd_barrier(const XcdBarrier& b) {
    asm volatile("s_waitcnt vmcnt(0)" ::: "memory");
    __syncthreads();
    if (threadIdx.x == 0) {
        unsigned* bar = b.bar;
        __builtin_amdgcn_s_waitcnt(0);
        unsigned nloc = b.st[0], nx = b.st[1];
        if (nloc == 0u) { xcd_barrier_complete(bar, b.x, nloc, nx); b.st[0] = nloc; b.st[1] = nx; }
        const unsigned old = xb_add(&bar[XB_XSUB(b.x)], 1u);
        const unsigned gen = old / nloc;
        if (old + 1u == (gen + 1u) * nloc) {
            __builtin_amdgcn_fence(__ATOMIC_RELEASE, "agent");
            asm volatile("s_waitcnt vmcnt(0)" ::: "memory");
            const unsigned og = xb_add(&bar[XB_TOP], 1u);
            const unsigned tg = og / nx;
            if (og + 1u == (tg + 1u) * nx) xb_add(&bar[XB_TOPGEN], 1u);
            else XB_SPIN(xb_ld(&bar[XB_TOPGEN]) == tg, bar);
            __builtin_amdgcn_fence(__ATOMIC_ACQUIRE, "agent");
            xb_add(&bar[XB_XGEN(b.x)], 1u);
            asm volatile("s_waitcnt vmcnt(0)" ::: "memory");
        } else {
            XB_SPIN(xb_ld(&bar[XB_XGEN(b.x)]) == gen, bar);
            __builtin_amdgcn_fence(__ATOMIC_ACQUIRE, "agent");
            asm volatile("s_waitcnt vmcnt(0)" ::: "memory");
        }
    }
    __syncthreads();
}

namespace pg8 {
typedef int i32x8_ __attribute__((ext_vector_type(8)));
typedef int i32x4_ __attribute__((ext_vector_type(4)));
union Frag { i32x8_ v; bf16x8 q[2]; };
constexpr int BM = 256, BK = 64, HALF = 128, HTB = HALF * BK * 2, STAGE_BYTES = 8 * HTB, NXCD = 8, WGM = 4;
__host__ __device__ __forceinline__ int lds_byte(int r, int c) { const int st = (r >> 4) * 2 + (c >> 5), rr = r & 15, cc = c & 31, ob = rr * 64 + cc * 2; return st * 1024 + (ob ^ (((ob >> 9) & 1) << 5)); }
__host__ __device__ __forceinline__ void stage_rc(int b, int& R, int& C) { const int st = b / 1024, sb = b % 1024, swz = sb ^ (((sb >> 9) & 1) << 5); R = (st >> 1) * 16 + swz / 64; C = (st & 1) * 32 + (swz % 64) / 2; }
__host__ __device__ __forceinline__ int perm32(int rho) { const int n = rho >> 4, i = rho & 15; return 8 * (i >> 2) + 4 * n + (i & 3); }
struct Unit { int pm, pn, ps; };
struct Gemm { const bf16_t* A; const bf16_t* Bt; };
template <int NM, int NN, int PASSES> struct StaticOrder {
    int G, c;
    __device__ __forceinline__ bool next(int i, Unit& u) const {
        constexpr int nwg = NM * NN;
        const int ti = PASSES == 2 ? (i >> 1) : i;
        const long L = (long)ti * G + c; if (L >= nwg) return false;
        int wgid = (int)L; { constexpr int q = nwg / NXCD, r = nwg % NXCD; const int xcd = wgid % NXCD, off = wgid / NXCD; wgid = (xcd < r ? xcd * (q + 1) : r * (q + 1) + (xcd - r) * q) + off; }
        constexpr int nig = WGM * NN; const int gid = wgid / nig, fm = gid * WGM, gsz = (NM - fm) < WGM ? (NM - fm) : WGM;
        u.pm = fm + ((wgid % nig) % gsz); u.pn = (wgid % nig) / gsz; u.ps = PASSES == 2 ? (i & 1) : 0; return true;
    }
};
template <int M, int N, int K, int LDA, int LDB, int PASSES, int PASS_OFF  , int MODE  , class Epi>
__device__ __forceinline__ void gemm_phase(LAS unsigned char* lds, const Gemm g, int G, int c, int tid_, const Epi& E) {
    StaticOrder<M / BM, N / BM, PASSES> S; S.G = G; S.c = c;
    const int tid = tid_, wid = __builtin_amdgcn_readfirstlane(tid >> 6), lane = tid & 63, wr = wid >> 2, wc = wid & 3, fr = lane & 15, fq = lane >> 4;
    constexpr int nt = K / BK;
    unsigned voffA[2], voffB[2];
#pragma unroll
    for (int i = 0; i < 2; ++i) { int R, C; stage_rc(tid * 16 + i * 8192, R, C); const int Rb = Epi::PERM ? ((R & ~31) + perm32(R & 31)) : R;
        voffA[i] = (unsigned)(R * LDA + C) * 2u; voffB[i] = (unsigned)(Rb * LDB + C) * 2u; }
    constexpr size_t kstep = (size_t)(BK * 2);
    constexpr size_t hstepA = (size_t)HALF * LDA * 2, hstepB = (size_t)HALF * LDB * 2;
    constexpr size_t tstepA = 2 * hstepA, tstepB = 2 * hstepB, pstep = (size_t)PASS_OFF * 2;
    const unsigned ldsw = (unsigned)wid * 1024u;
    const int aoff = lds_byte(wr * 64 + fr, fq * 8), boff = lds_byte(wc * 32 + fr, fq * 8);
#define PG8_SA(b, h) (((b) * 2 + (h)) * HTB)
#define PG8_SB(b, h) ((4 + (b) * 2 + (h)) * HTB)
#define PG8_STAGE(bufoff, gbase, voff) do { _Pragma("unroll") for (int _i = 0; _i < 2; ++_i) \
        __builtin_amdgcn_global_load_lds((const unsigned*)((const char*)(gbase) + (voff)[_i]), (LAS unsigned*)(lds + (bufoff) + ldsw + _i * 8192), 16, 0, 0); } while (0)
#define PG8_LDA(dst, b, h) do { _Pragma("unroll") for (int m = 0; m < 4; ++m) _Pragma("unroll") for (int k = 0; k < 2; ++k) dst[m].q[k] = *(const LAS bf16x8*)(lds + PG8_SA(b, h) + aoff + m * 2048 + k * 1024); } while (0)
#define PG8_LDB(dst, b, h) do { _Pragma("unroll") for (int n = 0; n < 2; ++n) _Pragma("unroll") for (int k = 0; k < 2; ++k) dst[n].q[k] = *(const LAS bf16x8*)(lds + PG8_SB(b, h) + boff + n * 2048 + k * 1024); } while (0)
#define PG8_MMA(ai, bj, At, Bt) do { __builtin_amdgcn_s_setprio(1); _Pragma("unroll") for (int m = 0; m < 4; ++m) _Pragma("unroll") for (int n = 0; n < 2; ++n) { \
        if constexpr (FP8) asm volatile("v_mfma_scale_f32_16x16x128_f8f6f4 %0, %1, %2, %0, %3, %3 op_sel_hi:[0,0,0]" : "+v"(acc[ai][bj][m][n]) : "v"(Bt[n].v), "v"(At[m].v), "v"(one_scale)); \
        else if constexpr (MODE == 2) { _Pragma("unroll") for (int k = 0; k < 2; ++k) acc[ai][bj][m][n] = __builtin_bit_cast(f32x4, __builtin_amdgcn_mfma_i32_16x16x64_i8(__builtin_bit_cast(i32x4_, Bt[n].q[k]), __builtin_bit_cast(i32x4_, At[m].q[k]), __builtin_bit_cast(i32x4_, acc[ai][bj][m][n]), 0, 0, 0)); } \
        else { _Pragma("unroll") for (int k = 0; k < 2; ++k) acc[ai][bj][m][n] = __builtin_amdgcn_mfma_f32_16x16x32_bf16(Bt[n].q[k], At[m].q[k], acc[ai][bj][m][n], 0, 0, 0); } } \
        __builtin_amdgcn_s_setprio(0); } while (0)
#define PG8_WAIT_V(n) asm volatile("s_waitcnt vmcnt(" #n ")" ::: "memory")
#define PG8_WAIT_L(n) asm volatile("s_waitcnt lgkmcnt(" #n ")" ::: "memory")
#define PG8_BAR __builtin_amdgcn_s_barrier()
#define PG8_SCHED __builtin_amdgcn_sched_barrier(0)
    Unit cur, nxt; int ui = 0;
    if (!S.next(0, cur)) return;
    f32x4 acc[2][2][4][2];
#pragma unroll
    for (int a = 0; a < 2; ++a)
#pragma unroll
        for (int b = 0; b < 2; ++b)
#pragma unroll
            for (int m = 0; m < 4; ++m)
#pragma unroll
                for (int n = 0; n < 2; ++n) acc[a][b][m][n] = (f32x4){0.f, 0.f, 0.f, 0.f};
    Frag At[4], B0[2], B1[2];
    const int one_scale = 0x7f7f7f7f;
    constexpr bool FP8 = MODE == 1;
    const char* cA = (const char*)g.A + (size_t)cur.pm * tstepA + (size_t)cur.ps * pstep; const char* cB = (const char*)g.Bt + (size_t)cur.pn * tstepB + (size_t)cur.ps * pstep;
    PG8_STAGE(PG8_SB(0, 0), cB, voffB); PG8_STAGE(PG8_SB(0, 1), cB + hstepB, voffB); PG8_STAGE(PG8_SA(0, 0), cA, voffA); PG8_STAGE(PG8_SA(0, 1), cA + hstepA, voffA);
    if (wr == 1) PG8_BAR;
    PG8_WAIT_V(2); PG8_BAR;
    PG8_STAGE(PG8_SB(1, 0), cB + kstep, voffB); PG8_STAGE(PG8_SA(1, 0), cA + kstep, voffA); PG8_STAGE(PG8_SB(1, 1), cB + hstepB + kstep, voffB);
    PG8_WAIT_V(6); PG8_BAR;
    for (;;) {
        const bool has_next = S.next(ui + 1, nxt);
        const char* nA = has_next ? (const char*)g.A + (size_t)nxt.pm * tstepA + (size_t)nxt.ps * pstep : cA; const char* nB = has_next ? (const char*)g.Bt + (size_t)nxt.pn * tstepB + (size_t)nxt.ps * pstep : cB;
        for (int t = 0; t < nt; t += 2) {
            const bool last = (t == nt - 2);
            const char* a1 = cA + (size_t)(t + 1) * kstep;
            const char* a2 = last ? nA : cA + (size_t)(t + 2) * kstep; const char* b2 = last ? nB : cB + (size_t)(t + 2) * kstep;
            const char* a3 = a2 + kstep; const char* b3 = b2 + kstep;
            const int rlx = __builtin_amdgcn_readfirstlane((RELAX_EPI && (t == 0) && (ui > 0)) ? 1 : 0);
#define PG8_WAIT_V8R() do { if constexpr (Epi::NST >= 32) asm volatile("s_waitcnt vmcnt(40)\n\ts_cmp_lg_u32 %0, 0\n\ts_cbranch_scc1 .Lrlx%=\n\ts_waitcnt vmcnt(8)\n.Lrlx%=:" :: "s"(rlx) : "memory", "scc"); \
                            else asm volatile("s_waitcnt vmcnt(24)\n\ts_cmp_lg_u32 %0, 0\n\ts_cbranch_scc1 .Lrlx%=\n\ts_waitcnt vmcnt(8)\n.Lrlx%=:" :: "s"(rlx) : "memory", "scc"); } while (0)
            PG8_LDB(B0, 0, 0); PG8_LDB(B1, 0, 1); PG8_SCHED; PG8_LDA(At, 0, 0); PG8_STAGE(PG8_SA(1, 1), a1 + hstepA, voffA);
            PG8_WAIT_V8R(); PG8_WAIT_L(0); PG8_BAR; PG8_MMA(0, 0, At, B0); PG8_MMA(0, 1, At, B1); PG8_BAR; PG8_SCHED;
            PG8_LDA(At, 0, 1); PG8_STAGE(PG8_SB(0, 0), b2, voffB); PG8_STAGE(PG8_SB(0, 1), b2 + hstepB, voffB); PG8_STAGE(PG8_SA(0, 0), a2, voffA);
            PG8_WAIT_V8R(); PG8_WAIT_L(0); PG8_BAR; PG8_MMA(1, 0, At, B0); PG8_MMA(1, 1, At, B1); PG8_BAR; PG8_SCHED;
#undef PG8_WAIT_V8R
            PG8_LDB(B0, 1, 0); PG8_LDB(B1, 1, 1); PG8_SCHED; PG8_LDA(At, 1, 0); PG8_STAGE(PG8_SA(0, 1), a2 + hstepA, voffA);
            PG8_WAIT_V(8); PG8_WAIT_L(0); PG8_BAR; PG8_MMA(0, 0, At, B0); PG8_MMA(0, 1, At, B1); PG8_BAR; PG8_SCHED;
            PG8_LDA(At, 1, 1); PG8_STAGE(PG8_SB(1, 0), b3, voffB); PG8_STAGE(PG8_SB(1, 1), b3 + hstepB, voffB); PG8_STAGE(PG8_SA(1, 0), a3, voffA);
            PG8_WAIT_V(8); PG8_WAIT_L(0); PG8_BAR; PG8_MMA(1, 0, At, B0); PG8_MMA(1, 1, At, B1); PG8_BAR; PG8_SCHED;
        }
        if (wr == 0) PG8_BAR;
        { int l_; asm volatile("v_mbcnt_lo_u32_b32 %0, -1, 0\n\tv_mbcnt_hi_u32_b32 %0, -1, %0" : "=v"(l_));
          E(acc, cur, wr, wc, l_ & 15, l_ >> 4); }
        if (!has_next) break;
#pragma unroll
        for (int a = 0; a < 2; ++a)
#pragma unroll
            for (int b = 0; b < 2; ++b)
#pragma unroll
                for (int m = 0; m < 4; ++m)
#pragma unroll
                    for (int n = 0; n < 2; ++n) acc[a][b][m][n] = (f32x4){0.f, 0.f, 0.f, 0.f};
        cur = nxt; cA = nA; cB = nB; ++ui;
        if (wr == 1) PG8_BAR;
    }
    PG8_WAIT_V(0);
    PG8_BAR;
#undef PG8_SA
#undef PG8_SB
#undef PG8_STAGE
#undef PG8_LDA
#undef PG8_LDB
#undef PG8_MMA
#undef PG8_WAIT_V
#undef PG8_WAIT_L
#undef PG8_BAR
#undef PG8_SCHED
}
}
using pg8::Unit;
constexpr int HALF = 128, BM = 256;

struct EpiInProj {
    static constexpr bool PERM = true;
    static constexpr int NST = 16;
    unsigned char* ws; const float* SH; const float* SW;
    LAS float* XS;
    __device__ __forceinline__ void qk_tile(const f32x4 (&acc)[2][2][4][2], const Unit& u, int wr, int wc, int fr, int fq, bf16_t* base, int col0) const {
        const int pn = u.pn, row0 = u.pm * BM + wr * 64 + fr; const float* gn = (const float*)(ws + WS_PRM) + (pn < 8 ? P_QG : P_KG) + wc * 32 + 8 * fq;
        f32x4 cs[2][2], g4[2]; float shr[2][4];
#pragma unroll
        for (int ai = 0; ai < 2; ++ai)
#pragma unroll
            for (int m = 0; m < 4; ++m) shr[ai][m] = SH[row0 + ai * HALF + m * 16];
#pragma unroll
        for (int n = 0; n < 2; ++n) { g4[n] = *(const f32x4*)(gn + 4 * n);
#pragma unroll
            for (int bj = 0; bj < 2; ++bj) cs[bj][n] = *(const f32x4*)(SW + pn * BM + bj * HALF + wc * 32 + 8 * fq + 4 * n); }
#pragma unroll
        for (int ai = 0; ai < 2; ++ai)
#pragma unroll
            for (int m = 0; m < 4; ++m) { const int rl = ai * HALF + wr * 64 + m * 16 + fr; const float sc = shr[ai][m];
#pragma unroll
                for (int bj = 0; bj < 2; ++bj) { float ss = 0.f;
#pragma unroll
                    for (int n = 0; n < 2; ++n) { const pg8::i32x4_ ii = __builtin_bit_cast(pg8::i32x4_, acc[ai][bj][m][n]); const f32x4 x = (f32x4){(float)ii[0], (float)ii[1], (float)ii[2], (float)ii[3]} * cs[bj][n] * sc;
                        ss += (x[0] * x[0] + x[1] * x[1]) + (x[2] * x[2] + x[3] * x[3]); }
                    ss += __shfl_xor(ss, 16); ss += __shfl_xor(ss, 32);
                    if (fq == 0) XS[(rl * 2 + bj) * 4 + wc] = ss; } }
        asm volatile("s_waitcnt lgkmcnt(0)" ::: "memory"); __builtin_amdgcn_s_barrier(); asm volatile("" ::: "memory");
#pragma unroll
        for (int bj = 0; bj < 2; ++bj)
#pragma unroll
            for (int n = 0; n < 2; ++n) asm volatile("" : "+v"(cs[bj][n]));
#pragma unroll
        for (int ai = 0; ai < 2; ++ai)
#pragma unroll
            for (int m = 0; m < 4; ++m) { const int rl = ai * HALF + wr * 64 + m * 16 + fr; bf16_t* rowp = base + (size_t)(u.pm * BM + rl) * 2048 + col0; const float sc = shr[ai][m];
#pragma unroll
                for (int bj = 0; bj < 2; ++bj) { const f32x4 p = *(const LAS f32x4*)(XS + (rl * 2 + bj) * 4); const float r = sc / sqrtf(((p[0] + p[1]) + (p[2] + p[3])) * (1.f / 128.f) + EPS);
                    pg8::i32x4_ j0 = __builtin_bit_cast(pg8::i32x4_, acc[ai][bj][m][0]), j1 = __builtin_bit_cast(pg8::i32x4_, acc[ai][bj][m][1]);
                    asm volatile("" : "+v"(j0), "+v"(j1));
                    const f32x4 y0 = (f32x4){(float)j0[0], (float)j0[1], (float)j0[2], (float)j0[3]} * cs[bj][0] * g4[0] * r, y1 = (f32x4){(float)j1[0], (float)j1[1], (float)j1[2], (float)j1[3]} * cs[bj][1] * g4[1] * r;
                    u32x4 w; w.x = cvt_pk_bf16(y0[0], y0[1]); w.y = cvt_pk_bf16(y0[2], y0[3]); w.z = cvt_pk_bf16(y1[0], y1[1]); w.w = cvt_pk_bf16(y1[2], y1[3]);
                    *(u32x4*)(rowp + bj * HALF) = w; } }
    }
    __device__ __forceinline__ void operator()(const f32x4 (&acc)[2][2][4][2], const Unit& u, int wr, int wc, int fr, int fq) const {
        const int pn = u.pn; const int row0 = u.pm * BM + wr * 64 + fr;
        if (pn == 80) {
            if (wc == 0) { float* ST = (float*)(ws + WS_ST);
#pragma unroll
                for (int ai = 0; ai < 2; ++ai)
#pragma unroll
                    for (int m = 0; m < 4; ++m) { const int row = row0 + ai * HALF + m * 16; float* rp = ST + (size_t)row * 32 + 8 * fq; const float sc = SH[row]; const f32x4 c0 = *(const f32x4*)(SW + 80 * BM + 8 * fq), c1 = *(const f32x4*)(SW + 80 * BM + 8 * fq + 4);
                        const pg8::i32x4_ i0 = __builtin_bit_cast(pg8::i32x4_, acc[ai][0][m][0]), i1 = __builtin_bit_cast(pg8::i32x4_, acc[ai][0][m][1]);
                        *(f32x4*)(rp) = (f32x4){(float)i0[0], (float)i0[1], (float)i0[2], (float)i0[3]} * c0 * sc; *(f32x4*)(rp + 4) = (f32x4){(float)i1[0], (float)i1[1], (float)i1[2], (float)i1[3]} * c1 * sc; }
            }
            else asm volatile("s_waitcnt vmcnt(0)" ::: "memory");
            return;
        }
        unsigned boff; int ld, cb, mode = 0;
        if (pn < 8) { boff = 0u; ld = 2048; cb = pn * 256; }
        else if (pn < 16) { boff = (unsigned)(A_K - A_Q); ld = 2048; cb = (pn - 8) * 256; }
        else if (pn < 24) { boff = (unsigned)(A_V - A_Q); ld = 2048; cb = (pn - 16) * 256; }
        else if (pn < 28) { boff = (unsigned)(A_GQ - A_Q); ld = 1024; cb = (pn - 24) * 256; mode = 1; }
        else if (pn < 32) { boff = (unsigned)(A_GK - A_Q); ld = 1024; cb = (pn - 28) * 256; }
        else if (pn < 40) { boff = (unsigned)(A_GV - A_Q); ld = 2048; cb = (pn - 32) * 256; }
        else if (pn < 48) { boff = (unsigned)(A_GR - A_Q); ld = 2048; cb = (pn - 40) * 256; mode = 2; }
        else if (pn < 64) { boff = (unsigned)(A_SA - A_Q); ld = 4096; cb = (pn - 48) * 256; mode = 3; }
        else { boff = (unsigned)(A_SB - A_Q); ld = 4096; cb = (pn - 64) * 256; mode = 3; }
        bf16_t* base = (bf16_t*)(ws + A_Q + boff);
        const int col0 = cb + wc * 32 + 8 * fq;
        if (pn < 16) { qk_tile(acc, u, wr, wc, fr, fq, base, col0); return; }
        f32x4 cs[2][2]; float shr[2][4];
#pragma unroll
        for (int ai = 0; ai < 2; ++ai)
#pragma unroll
            for (int m = 0; m < 4; ++m) shr[ai][m] = SH[row0 + ai * HALF + m * 16];
#pragma unroll
        for (int bj = 0; bj < 2; ++bj)
#pragma unroll
            for (int n = 0; n < 2; ++n) cs[bj][n] = *(const f32x4*)(SW + pn * BM + bj * HALF + wc * 32 + 8 * fq + 4 * n);
        if (mode == 3) tile_out<3>(acc, cs, shr, base, row0, ld, col0);
        else if (mode == 2) tile_out<2>(acc, cs, shr, base, row0, ld, col0);
        else if (mode == 1) tile_out<1>(acc, cs, shr, base, row0, ld, col0);
        else tile_out<0>(acc, cs, shr, base, row0, ld, col0);
    }
    template <int MODE> __device__ __forceinline__ void tile_out(const f32x4 (&acc)[2][2][4][2], f32x4 (&cs)[2][2], const float (&shr)[2][4], bf16_t* base, int row0, int ld, int col0) const {
        if (MODE == 1 || MODE == 3) {
#pragma unroll
            for (int bj = 0; bj < 2; ++bj)
#pragma unroll
                for (int n = 0; n < 2; ++n) cs[bj][n] = cs[bj][n] * (MODE == 1 ? 0.0625f : -LOG2E); }
#pragma unroll
        for (int ai = 0; ai < 2; ++ai)
#pragma unroll
            for (int m = 0; m < 4; ++m) { const int row = row0 + ai * HALF + m * 16; bf16_t* rowp = base + (size_t)row * ld + col0; const float sc = shr[ai][m];
#pragma unroll
                for (int bj = 0; bj < 2; ++bj) { const pg8::i32x4_ i0 = __builtin_bit_cast(pg8::i32x4_, acc[ai][bj][m][0]), i1 = __builtin_bit_cast(pg8::i32x4_, acc[ai][bj][m][1]);
                    f32x4 v0 = (f32x4){(float)i0[0], (float)i0[1], (float)i0[2], (float)i0[3]} * cs[bj][0] * sc, v1 = (f32x4){(float)i1[0], (float)i1[1], (float)i1[2], (float)i1[3]} * cs[bj][1] * sc;
                    if (MODE == 2) {
#pragma unroll
                        for (int j = 0; j < 4; ++j) { v0[j] = v0[j] * sigmoidf_(v0[j]); v1[j] = v1[j] * sigmoidf_(v1[j]); } }
                    if (MODE == 3) {
                        constexpr float K = 1.f / 255.f;
#pragma unroll
                        for (int j = 0; j < 4; ++j) { v0[j] = __builtin_amdgcn_rcpf(fmaf(__builtin_amdgcn_exp2f(v0[j]), K, K)); v1[j] = __builtin_amdgcn_rcpf(fmaf(__builtin_amdgcn_exp2f(v1[j]), K, K)); }
                        unsigned g0 = 0u, g1 = 0u;
#pragma unroll
                        for (int j = 0; j < 4; ++j) { g0 = __builtin_amdgcn_cvt_pk_u8_f32(v0[j], j, g0); g1 = __builtin_amdgcn_cvt_pk_u8_f32(v1[j], j, g1); }
                        *(u32x2*)((unsigned char*)base + (size_t)row * 4096 + col0 + bj * HALF) = (u32x2){g0, g1};
                    } else {
                    u32x4 w; w.x = cvt_pk_bf16(v0[0], v0[1]); w.y = cvt_pk_bf16(v0[2], v0[3]); w.z = cvt_pk_bf16(v1[0], v1[1]); w.w = cvt_pk_bf16(v1[2], v1[3]);
                    *(u32x4*)(rowp + bj * HALF) = w; } } }
    }
};
struct EpiBranch {
    static constexpr bool PERM = true;
    static constexpr int NST = 16;
    unsigned char* ws;
    __device__ __forceinline__ void operator()(const f32x4 (&acc)[2][2][4][2], const Unit& u, int wr, int wc, int fr, int fq) const {
        const int row0 = u.pm * BM + wr * 64 + fr, col0 = u.pn * BM + wc * 32 + 8 * fq;
        const unsigned char* G = ws + (u.ps ? A_SB : A_SA); bf16_t* O = (bf16_t*)(ws + A_MRG);
        const float* SR = (const float*)(ws + WS_PRM) + (u.ps ? P_SOB : P_SOA); const float* SW = (const float*)(ws + WS_PRM) + (u.ps ? P_SWPB : P_SWPA);
        f32x4 cs[2][2];
#pragma unroll
        for (int bj = 0; bj < 2; ++bj)
#pragma unroll
            for (int n = 0; n < 2; ++n) cs[bj][n] = *(const f32x4*)(SW + col0 + bj * HALF + 4 * n) * (1.f / 255.f);
#pragma unroll
        for (int ai = 0; ai < 2; ++ai) {
            u32x2 gw[4][2]; u32x4 ow[4][2]; float sr[4];
#pragma unroll
            for (int m = 0; m < 4; ++m) { const int row = row0 + ai * HALF + m * 16; const size_t off = (size_t)row * DM + col0; sr[m] = SR[row];
#pragma unroll
                for (int bj = 0; bj < 2; ++bj) { gw[m][bj] = *(const u32x2*)(G + off + bj * HALF); if (u.ps) ow[m][bj] = *(const u32x4*)(O + off + bj * HALF); else ow[m][bj] = (u32x4){0u, 0u, 0u, 0u}; } }
#pragma unroll
            for (int m = 0; m < 4; ++m) { const size_t off = (size_t)(row0 + ai * HALF + m * 16) * DM + col0;
#pragma unroll
                for (int bj = 0; bj < 2; ++bj) { const u32x2 g = gw[m][bj]; const u32x4 o4 = ow[m][bj];
                    const pg8::i32x4_ i0 = __builtin_bit_cast(pg8::i32x4_, acc[ai][bj][m][0]), i1 = __builtin_bit_cast(pg8::i32x4_, acc[ai][bj][m][1]);
                    f32x4 v0 = (f32x4){(float)i0[0], (float)i0[1], (float)i0[2], (float)i0[3]} * cs[bj][0] * sr[m], v1 = (f32x4){(float)i1[0], (float)i1[1], (float)i1[2], (float)i1[3]} * cs[bj][1] * sr[m];
                    v0[0] = v0[0] * (float)(g.x & 0xffu) + bflo(o4.x); v0[1] = v0[1] * (float)((g.x >> 8) & 0xffu) + bfhi(o4.x); v0[2] = v0[2] * (float)((g.x >> 16) & 0xffu) + bflo(o4.y); v0[3] = v0[3] * (float)(g.x >> 24) + bfhi(o4.y);
                    v1[0] = v1[0] * (float)(g.y & 0xffu) + bflo(o4.z); v1[1] = v1[1] * (float)((g.y >> 8) & 0xffu) + bfhi(o4.z); v1[2] = v1[2] * (float)((g.y >> 16) & 0xffu) + bflo(o4.w); v1[3] = v1[3] * (float)(g.y >> 24) + bfhi(o4.w);
                    u32x4 w; w.x = cvt_pk_bf16(v0[0], v0[1]); w.y = cvt_pk_bf16(v0[2], v0[3]); w.z = cvt_pk_bf16(v1[0], v1[1]); w.w = cvt_pk_bf16(v1[2], v1[3]);
                    *(u32x4*)(O + off + bj * HALF) = w; } }
            asm volatile("" ::: "memory"); }
    }
};
struct EpiWout {
    static constexpr bool PERM = false;
    static constexpr int NST = 32;
    const float* X; bf16_t* X1B; float* RSS; const float* SM; const float* SW;
    __device__ __forceinline__ void operator()(const f32x4 (&acc)[2][2][4][2], const Unit& u, int wr, int wc, int fr, int fq) const {
        const int row0 = u.pm * BM + wr * 64 + fr, col0 = u.pn * BM + wc * 32 + 4 * fq;
        f32x4 cs[2][2];
#pragma unroll
        for (int bj = 0; bj < 2; ++bj)
#pragma unroll
            for (int n = 0; n < 2; ++n) cs[bj][n] = INT8_WOUT ? *(const f32x4*)(SW + col0 + bj * HALF + n * 16) : (f32x4){1.f, 1.f, 1.f, 1.f};
#pragma unroll
        for (int ai = 0; ai < 2; ++ai) {
            f32x4 xv[4][2][2]; float sr[4];
#pragma unroll
            for (int m = 0; m < 4; ++m) { const int row = row0 + ai * HALF + m * 16; const size_t off = (size_t)row * DM + col0; sr[m] = INT8_WOUT ? SM[row] : 1.f;
#pragma unroll
                for (int bj = 0; bj < 2; ++bj)
#pragma unroll
                    for (int n = 0; n < 2; ++n) xv[m][bj][n] = *(const f32x4*)(X + off + bj * HALF + n * 16); }
#pragma unroll
            for (int m = 0; m < 4; ++m) { const int row = row0 + ai * HALF + m * 16; const size_t off = (size_t)row * DM + col0; float ss = 0.f;
#pragma unroll
                for (int bj = 0; bj < 2; ++bj)
#pragma unroll
                    for (int n = 0; n < 2; ++n) { const pg8::i32x4_ ia = __builtin_bit_cast(pg8::i32x4_, acc[ai][bj][m][n]);
                        const f32x4 o = INT8_WOUT ? xv[m][bj][n] + (f32x4){(float)ia[0], (float)ia[1], (float)ia[2], (float)ia[3]} * cs[bj][n] * sr[m] : xv[m][bj][n] + acc[ai][bj][m][n];
                        ss += (o[0] * o[0] + o[1] * o[1]) + (o[2] * o[2] + o[3] * o[3]);
                        u32x2 w; w.x = cvt_pk_bf16(o[0], o[1]); w.y = cvt_pk_bf16(o[2], o[3]); *(u32x2*)(X1B + off + bj * HALF + n * 16) = w; }
                ss += __shfl_xor(ss, 16); ss += __shfl_xor(ss, 32);
                if (fq == 0) atomicAdd(RSS + row, ss); }
            asm volatile("" ::: "memory"); }
    }
};
struct EpiUp {
    static constexpr bool PERM = true;
    static constexpr int NST = 16;
    const float* RSS; bf16_t* FA; bf16_t* FG; const float* SX; const float* SW;
    __device__ __forceinline__ void operator()(const f32x4 (&acc)[2][2][4][2], const Unit& u, int wr, int wc, int fr, int fq) const {
        const int row0 = u.pm * BM + wr * 64 + fr, col0 = u.pn * HALF + wc * 32 + 8 * fq;
        f32x4 cs[2][2];
#pragma unroll
        for (int bj = 0; bj < 2; ++bj)
#pragma unroll
            for (int n = 0; n < 2; ++n) cs[bj][n] = *(const f32x4*)(SW + u.pn * BM + bj * HALF + wc * 32 + 8 * fq + 4 * n);
#pragma unroll
        for (int ai = 0; ai < 2; ++ai)
#pragma unroll
            for (int m = 0; m < 4; ++m) { const int row = row0 + ai * HALF + m * 16; const float rstd = __builtin_amdgcn_rsqf(RSS[row] * (1.f / DM) + EPS) * SX[row];
                const size_t off = (size_t)row * DFF + col0;
#pragma unroll
                for (int bj = 0; bj < 2; ++bj) { const pg8::i32x4_ i0 = __builtin_bit_cast(pg8::i32x4_, acc[ai][bj][m][0]), i1 = __builtin_bit_cast(pg8::i32x4_, acc[ai][bj][m][1]);
                    const f32x4 v0 = (f32x4){(float)i0[0], (float)i0[1], (float)i0[2], (float)i0[3]} * cs[bj][0] * rstd, v1 = (f32x4){(float)i1[0], (float)i1[1], (float)i1[2], (float)i1[3]} * cs[bj][1] * rstd;
                    u32x4 w; w.x = cvt_pk_bf16(v0[0], v0[1]); w.y = cvt_pk_bf16(v0[2], v0[3]); w.z = cvt_pk_bf16(v1[0], v1[1]); w.w = cvt_pk_bf16(v1[2], v1[3]);
                    *(u32x4*)((bj ? FG : FA) + off) = w; } }
    }
};
__device__ __forceinline__ float gelu_tanh_(float x) { const float uu = x * (-1.5957691216057308f * LOG2E + (-0.07135481627159145f * LOG2E) * x * x); return x * __builtin_amdgcn_rcpf(1.f + __builtin_amdgcn_exp2f(uu)); }
struct EpiUpConv {
    static constexpr bool PERM = true;
    static constexpr int NST = 16;
    unsigned char* ws; int gi; LAS float* XB;
    __device__ __forceinline__ void operator()(const f32x4 (&acc)[2][2][4][2], const Unit& u, int wr, int wc, int fr, int fq) const {
        const float* RSS = (const float*)((const unsigned*)(ws + WS_CTL) + CW_RSS) + (size_t)gi * GT; const float* SX = (const float*)(ws + WS_PRM) + P_SX + (size_t)gi * GT; const float* SW = (const float*)(ws + WS_PRM) + P_SWUP;
        const float* CW = (const float*)(ws + WS_PRM) + P_CW; const float* CB = (const float*)(ws + WS_PRM) + P_CB; unsigned char* U8 = ws + A_FG; float* HB = (float*)(ws + A_FA);
        const int lane = fq * 16 + fr, fl = wc * 32 + 8 * fq, f0 = u.pn * HALF + fl, row0 = u.pm * BM + wr * 64 + fr;
        float csa[8], csg[8];
#pragma unroll
        for (int n = 0; n < 2; ++n) { const f32x4 a4 = *(const f32x4*)(SW + u.pn * BM + fl + 4 * n), g4 = *(const f32x4*)(SW + u.pn * BM + HALF + fl + 4 * n);
#pragma unroll
            for (int i = 0; i < 4; ++i) { csa[4 * n + i] = a4[i]; csg[4 * n + i] = g4[i] * U8_SCALE; } }
        float A[2][4][8], G[2][4][8];
#pragma unroll
        for (int ai = 0; ai < 2; ++ai)
#pragma unroll
            for (int m = 0; m < 4; ++m) { const int row = row0 + ai * HALF + m * 16; const float fac = __builtin_amdgcn_rsqf(RSS[row] * (1.f / DM) + EPS) * SX[row];
#pragma unroll
                for (int n = 0; n < 2; ++n) { const pg8::i32x4_ ia = __builtin_bit_cast(pg8::i32x4_, acc[ai][0][m][n]), ig = __builtin_bit_cast(pg8::i32x4_, acc[ai][1][m][n]);
#pragma unroll
                    for (int i = 0; i < 4; ++i) { A[ai][m][4 * n + i] = (float)ia[i] * csa[4 * n + i] * fac; G[ai][m][4 * n + i] = (float)ig[i] * csg[4 * n + i] * fac; } } }
#pragma unroll
        for (int ai = 0; ai < 2; ++ai) { const int b = 2 * ai + wr;
            if (fr == 0) { *(LAS f32x4*)(XB + (2 * b) * 128 + fl) = (f32x4){A[ai][0][0], A[ai][0][1], A[ai][0][2], A[ai][0][3]}; *(LAS f32x4*)(XB + (2 * b) * 128 + fl + 4) = (f32x4){A[ai][0][4], A[ai][0][5], A[ai][0][6], A[ai][0][7]}; }
            if (fr == 15) { *(LAS f32x4*)(XB + (2 * b + 1) * 128 + fl) = (f32x4){A[ai][3][0], A[ai][3][1], A[ai][3][2], A[ai][3][3]}; *(LAS f32x4*)(XB + (2 * b + 1) * 128 + fl + 4) = (f32x4){A[ai][3][4], A[ai][3][5], A[ai][3][6], A[ai][3][7]}; } }
        { float* hb = HB + ((size_t)(u.pm * 86 + u.pn) * 6) * 128 + fl;
          if (wr == 0 && fr <= 1) { *(f32x4*)(hb + fr * 128) = (f32x4){A[0][0][0], A[0][0][1], A[0][0][2], A[0][0][3]}; *(f32x4*)(hb + fr * 128 + 4) = (f32x4){A[0][0][4], A[0][0][5], A[0][0][6], A[0][0][7]};
              if (fr == 0) { *(f32x4*)(hb + 4 * 128) = (f32x4){G[0][0][0], G[0][0][1], G[0][0][2], G[0][0][3]}; *(f32x4*)(hb + 4 * 128 + 4) = (f32x4){G[0][0][4], G[0][0][5], G[0][0][6], G[0][0][7]}; } }
          if (wr == 1 && fr >= 14) { const int sl = fr - 12;
              *(f32x4*)(hb + sl * 128) = (f32x4){A[1][3][0], A[1][3][1], A[1][3][2], A[1][3][3]}; *(f32x4*)(hb + sl * 128 + 4) = (f32x4){A[1][3][4], A[1][3][5], A[1][3][6], A[1][3][7]};
              if (fr == 15) { *(f32x4*)(hb + 5 * 128) = (f32x4){G[1][3][0], G[1][3][1], G[1][3][2], G[1][3][3]}; *(f32x4*)(hb + 5 * 128 + 4) = (f32x4){G[1][3][4], G[1][3][5], G[1][3][6], G[1][3][7]}; } } }
        asm volatile("s_waitcnt lgkmcnt(0)" ::: "memory"); __builtin_amdgcn_s_barrier(); asm volatile("" ::: "memory");
        const int src_dn = (lane & ~15) | ((fr + 1) & 15), src_up = (lane & ~15) | ((fr + 15) & 15);
#pragma unroll
        for (int n = 0; n < 2; ++n) {
            const f32x4 x0 = *(const f32x4*)(CW + f0 + 4 * n), x1 = *(const f32x4*)(CW + DFF + f0 + 4 * n), x2 = *(const f32x4*)(CW + 2 * DFF + f0 + 4 * n), xb = *(const f32x4*)(CB + f0 + 4 * n);
#pragma unroll
            for (int ai = 0; ai < 2; ++ai) { const int b = 2 * ai + wr;
                const f32x4 XP = b > 0 ? *(const LAS f32x4*)(XB + (2 * (b - 1) + 1) * 128 + fl + 4 * n) : (f32x4){0.f, 0.f, 0.f, 0.f};
                const f32x4 XN = b < 3 ? *(const LAS f32x4*)(XB + (2 * (b + 1)) * 128 + fl + 4 * n) : (f32x4){0.f, 0.f, 0.f, 0.f};
#pragma unroll
                for (int m = 0; m < 4; ++m) { const int row = row0 + ai * HALF + m * 16; float o[4];
#pragma unroll
                    for (int i = 0; i < 4; ++i) { const int j = 4 * n + i;
                        const float dn = __shfl(A[ai][m][j], src_dn), dnw = m < 3 ? __shfl(A[ai][m + 1][j], src_dn) : XN[i], nxt = fr == 15 ? dnw : dn;
                        const float up = __shfl(A[ai][m][j], src_up), upw = m > 0 ? __shfl(A[ai][m - 1][j], src_up) : XP[i], prv = fr == 0 ? upw : up;
                        const float c = prv * x0[i] + A[ai][m][j] * x1[i] + nxt * x2[i] + xb[i]; o[i] = gelu_tanh_(c) * G[ai][m][j]; }
                    int q0 = 0;
                    q0 = __builtin_amdgcn_cvt_pk_fp8_f32(sat8(o[0]), sat8(o[1]), q0, false); q0 = __builtin_amdgcn_cvt_pk_fp8_f32(sat8(o[2]), sat8(o[3]), q0, true);
                    *(unsigned*)(U8 + (size_t)row * DFF + f0 + 4 * n) = (unsigned)q0;
                    __builtin_amdgcn_sched_barrier(0); } } }
    }
};
struct EpiDown {
    static constexpr bool PERM = false;
    static constexpr int NST = 32;
    float* OUT; const bf16_t* X1B; float sc;
    __device__ __forceinline__ void operator()(const f32x4 (&acc)[2][2][4][2], const Unit& u, int wr, int wc, int fr, int fq) const {
        const int row0 = u.pm * BM + wr * 64 + fr, col0 = u.pn * BM + wc * 32 + 4 * fq;
#pragma unroll
        for (int ai = 0; ai < 2; ++ai) {
            u32x2 xw[4][2][2];
#pragma unroll
            for (int m = 0; m < 4; ++m) { const size_t off = (size_t)(row0 + ai * HALF + m * 16) * DM + col0;
#pragma unroll
                for (int bj = 0; bj < 2; ++bj)
#pragma unroll
                    for (int n = 0; n < 2; ++n) xw[m][bj][n] = *(const u32x2*)(X1B + off + bj * HALF + n * 16); }
#pragma unroll
            for (int m = 0; m < 4; ++m) { const size_t off = (size_t)(row0 + ai * HALF + m * 16) * DM + col0;
#pragma unroll
                for (int bj = 0; bj < 2; ++bj)
#pragma unroll
                    for (int n = 0; n < 2; ++n) { const u32x2 x2 = xw[m][bj][n]; const f32x4 a4 = acc[ai][bj][m][n] * sc;
                        *(f32x4*)(OUT + off + bj * HALF + n * 16) = (f32x4){bflo(x2.x) + a4[0], bfhi(x2.x) + a4[1], bflo(x2.y) + a4[2], bfhi(x2.y) + a4[3]}; } }
            asm volatile("" ::: "memory"); }
    }
};

struct Args;
__device__ __forceinline__ unsigned char* u8_ptr(const Args& a, int g);
struct Args { const float* in[25]; float* out; unsigned char* ws; int ph_lo, ph_hi, g_lo, g_hi; };
struct Frame {
    LAS unsigned char* lds; int tid, lane, wave, vcu, G;
};
__device__ __forceinline__ unsigned char* u8_ptr(const Args& a, int g) { (void)g; return FUSE_CONV ? a.ws + A_FG : (g == 0 ? (unsigned char*)(a.out + (size_t)GT * DM) : a.ws + WS_WIN); }
__device__ __forceinline__ Frame make_frame(LAS unsigned char* lds, int wave_s) {
    Frame F; F.lds = lds; F.tid = fresh_tid(wave_s); F.lane = F.tid & 63; F.wave = __builtin_amdgcn_readfirstlane(F.tid >> 6);
    F.G = fresh_grid(); { const int bx = fresh_bid(); F.vcu = (F.G % 8 == 0) ? (bx % 8) * (F.G / 8) + bx / 8 : bx; }
    return F;
}

template <int NMAP> __device__ __forceinline__ int nmap(int n) {
    if (NMAP == 1) { return n < 12288 ? n : (n < 12320 ? 20480 + (n - 12288) : n - 32); }
    if (NMAP == 2) { const int bj = n >= DFF ? 1 : 0, f = n - bj * DFF; return (f >> 7) * 256 + bj * 128 + (f & 127); }
    return n;
}
template <int NMAP> __device__ __forceinline__ void p0_transpose_item(const float* W, int N, const float* kscale, bf16_t* WT, int ldd, int koff, LAS float* scr, int kb, int nb, int lane) {
    const int k0 = 64 * kb, n0 = 64 * nb; const bool inb = (n0 + lane) < N;
#pragma unroll
    for (int i0 = 0; i0 < 64; i0 += 32) { float v[32];
#pragma unroll
        for (int i = 0; i < 32; ++i) v[i] = inb ? W[(size_t)(k0 + i0 + i) * N + n0 + lane] : 0.f;
#pragma unroll
        for (int i = 0; i < 32; ++i) { float t = v[i]; if (kscale) t *= kscale[k0 + i0 + i]; scr[(i0 + i) * 65 + lane] = t; } }
    asm volatile("s_waitcnt lgkmcnt(0)" ::: "memory");
    const int c = lane & 7;
#pragma unroll
    for (int j = 0; j < 8; ++j) { const int nl = (lane >> 3) + 8 * j; const int n = n0 + nl; const LAS float* s = scr + (8 * c) * 65 + nl;
        u32x4 o; o.x = cvt_pk_bf16(s[0 * 65], s[1 * 65]); o.y = cvt_pk_bf16(s[2 * 65], s[3 * 65]); o.z = cvt_pk_bf16(s[4 * 65], s[5 * 65]); o.w = cvt_pk_bf16(s[6 * 65], s[7 * 65]);
        if (n < N) *(u32x4*)(WT + (size_t)nmap<NMAP>(n) * ldd + koff + k0 + 8 * c) = o; }
    asm volatile("s_waitcnt lgkmcnt(0)" ::: "memory");
}
__device__ __forceinline__ void p0_colmax(const Frame& F, const float* W, int K, int N, const float* kscale, unsigned* out) {
    const int gw = F.vcu * NWAVES + F.wave, NGW = F.G * NWAVES; const int nnb = (N + 255) / 256, nt = (K / 64) * nnb;
    for (int t = gw; t < nt; t += NGW) { const int kb = t / nnb, nb = t - kb * nnb, n = nb * 256 + 4 * F.lane; if (n >= N) continue;
        f32x4 mx = {0.f, 0.f, 0.f, 0.f};
#pragma unroll 16
        for (int i = 0; i < 64; ++i) { const int k = kb * 64 + i; const float ks = kscale ? fabsf(kscale[k]) : 1.f; const f32x4 v = *(const f32x4*)(W + (size_t)k * N + n);
            mx[0] = fmaxf(mx[0], fabsf(v[0]) * ks); mx[1] = fmaxf(mx[1], fabsf(v[1]) * ks); mx[2] = fmaxf(mx[2], fabsf(v[2]) * ks); mx[3] = fmaxf(mx[3], fabsf(v[3]) * ks); }
#pragma unroll
        for (int j = 0; j < 4; ++j) atomicMax(out + n + j, __float_as_uint(mx[j])); }
}
__device__ __forceinline__ void p0_absmax(const Frame& F, const float* W, int K, int N, const float* kscale, unsigned* out) {
    const int gw = F.vcu * NWAVES + F.wave, NGW = F.G * NWAVES; float mx = 0.f;
    for (int k = gw; k < K; k += NGW) { const float ks = kscale ? kscale[k] : 1.f; const f32x4* row = (const f32x4*)(W + (size_t)k * N);
        for (int i = F.lane; i < N / 4; i += 64) { const f32x4 v = row[i]; mx = fmaxf(mx, fmaxf(fmaxf(fabsf(v[0]), fabsf(v[1])), fmaxf(fabsf(v[2]), fabsf(v[3]))) * fabsf(ks)); } }
#pragma unroll
    for (int o = 1; o < 64; o <<= 1) mx = fmaxf(mx, __shfl_xor(mx, o));
    if (F.lane == 0) atomicMax(out, __float_as_uint(mx));
}
template <int NMAP> __device__ __forceinline__ void p0_transpose_item_i8(const float* W, int N, const float* kscale, const unsigned* cmax, unsigned char* WT8, int ldd, int koff, LAS float* scr, int kb, int nb, int lane) {
    const int k0 = 64 * kb, n0 = 64 * nb; const bool inb = (n0 + lane) < N;
    const float qs = inb ? 127.f / fmaxf(__uint_as_float(__hip_atomic_load(cmax + n0 + lane, __ATOMIC_RELAXED, __HIP_MEMORY_SCOPE_AGENT)), 1e-30f) : 0.f;
#pragma unroll
    for (int i0 = 0; i0 < 64; i0 += 32) { float v[32];
#pragma unroll
        for (int i = 0; i < 32; ++i) v[i] = inb ? W[(size_t)(k0 + i0 + i) * N + n0 + lane] : 0.f;
#pragma unroll
        for (int i = 0; i < 32; ++i) { float t = v[i] * qs; if (kscale) t *= kscale[k0 + i0 + i]; scr[(i0 + i) * 65 + lane] = t; } }
    asm volatile("s_waitcnt lgkmcnt(0)" ::: "memory");
    const int c = lane & 7;
#pragma unroll
    for (int j = 0; j < 8; ++j) { const int nl = (lane >> 3) + 8 * j; const LAS float* s = scr + (8 * c) * 65 + nl;
        const unsigned w0 = pack_i8x4(s[0 * 65], s[1 * 65], s[2 * 65], s[3 * 65]), w1 = pack_i8x4(s[4 * 65], s[5 * 65], s[6 * 65], s[7 * 65]);
        if (n0 + nl < N) *(u32x2*)(WT8 + (size_t)nmap<NMAP>(n0 + nl) * ldd + koff + k0 + 8 * c) = (u32x2){w0, w1}; }
    asm volatile("s_waitcnt lgkmcnt(0)" ::: "memory");
}
template <int NMAP> __device__ __forceinline__ void p0_transpose_item_fp8(const float* W, int N, unsigned char* WT8, int ldd, LAS float* scr, int kb, int nb, int lane) {
    const int k0 = 64 * kb, n0 = 64 * nb; const bool inb = (n0 + lane) < N;
#pragma unroll
    for (int i0 = 0; i0 < 64; i0 += 32) { float v[32];
#pragma unroll
        for (int i = 0; i < 32; ++i) v[i] = inb ? W[(size_t)(k0 + i0 + i) * N + n0 + lane] : 0.f;
#pragma unroll
        for (int i = 0; i < 32; ++i) scr[(i0 + i) * 65 + lane] = sat8(v[i] * W8_SCALE); }
    asm volatile("s_waitcnt lgkmcnt(0)" ::: "memory");
    const int c = lane & 7;
#pragma unroll
    for (int j = 0; j < 8; ++j) { const int nl = (lane >> 3) + 8 * j; const LAS float* s = scr + (8 * c) * 65 + nl;
        int w0 = 0, w1 = 0;
        w0 = __builtin_amdgcn_cvt_pk_fp8_f32(s[0 * 65], s[1 * 65], w0, false); w0 = __builtin_amdgcn_cvt_pk_fp8_f32(s[2 * 65], s[3 * 65], w0, true);
        w1 = __builtin_amdgcn_cvt_pk_fp8_f32(s[4 * 65], s[5 * 65], w1, false); w1 = __builtin_amdgcn_cvt_pk_fp8_f32(s[6 * 65], s[7 * 65], w1, true);
        if (n0 + nl < N) *(u32x2*)(WT8 + (size_t)nmap<NMAP>(n0 + nl) * ldd + k0 + 8 * c) = (u32x2){(unsigned)w0, (unsigned)w1}; }
    asm volatile("s_waitcnt lgkmcnt(0)" ::: "memory");
}
__device__ __forceinline__ void p0_weights(const Frame& F, const Args& a) {
    unsigned char* ws = a.ws;
    LAS float* scr = (LAS float*)(F.lds + F.wave * 16640);
    const int gw = F.vcu * NWAVES + F.wave, NGW = F.G * NWAVES;
    constexpr int I_IN = 64 * 321, I_UP = 64 * 344, I_DN = 172 * 64, I_OUT = 64 * 64, I_PA = 32 * 64, I_PB = 32 * 64;
    constexpr int NITEMS = I_IN + I_UP + I_DN + I_OUT + I_PA + I_PB;
    { float* prm = (float*)(ws + WS_PRM); const int gt = F.vcu * NTHR + F.tid, ngt = F.G * NTHR; const unsigned* ctl = (const unsigned*)(ws + WS_CTL);
      for (int n = gt; n < 2 * DFF; n += ngt) prm[P_SWUP + nmap<2>(n)] = __uint_as_float(__hip_atomic_load(ctl + CW_CMAX_UP + n, __ATOMIC_RELAXED, __HIP_MEMORY_SCOPE_AGENT)) * (1.f / 127.f);
      for (int n = gt; n < DM; n += ngt) { prm[P_SWPA + n] = __uint_as_float(__hip_atomic_load(ctl + CW_CMAX_PA + n, __ATOMIC_RELAXED, __HIP_MEMORY_SCOPE_AGENT)) * (1.f / 127.f);
          prm[P_SWPB + n] = __uint_as_float(__hip_atomic_load(ctl + CW_CMAX_PB + n, __ATOMIC_RELAXED, __HIP_MEMORY_SCOPE_AGENT)) * (1.f / 127.f);
          prm[P_SWWO + n] = __uint_as_float(__hip_atomic_load(ctl + CW_CMAX_WO + n, __ATOMIC_RELAXED, __HIP_MEMORY_SCOPE_AGENT)) * (1.f / 127.f); }
      for (int n = gt; n < DINP; n += ngt) { if (n < DIN) prm[P_SWIN + nmap<1>(n)] = __uint_as_float(__hip_atomic_load(ctl + CW_CMAX_IN + n, __ATOMIC_RELAXED, __HIP_MEMORY_SCOPE_AGENT)) * (1.f / 127.f); else prm[P_SWIN + n] = 0.f; } }
    for (int it = gw; it < NITEMS; it += NGW) {
        int r = it;
        if (r < I_IN) { p0_transpose_item_i8<1>(a.in[4], DIN, nullptr, (const unsigned*)(ws + WS_CTL) + CW_CMAX_IN, ws + WS_WIN, DM, 0, scr, r / 321, r % 321, F.lane); continue; } r -= I_IN;
        if (r < I_UP) { p0_transpose_item_i8<2>(a.in[21], 2 * DFF, a.in[20], (const unsigned*)(ws + WS_CTL) + CW_CMAX_UP, ws + WS_WUP, DM, 0, scr, r / 344, r % 344, F.lane); continue; } r -= I_UP;
        if (r < I_DN) { p0_transpose_item_fp8<0>(a.in[24], DM, ws + WS_WDN, DFF, scr, r / 64, r % 64, F.lane); continue; } r -= I_DN;
        if (r < I_OUT) { if (INT8_WOUT) p0_transpose_item_i8<0>(a.in[19], DM, nullptr, (const unsigned*)(ws + WS_CTL) + CW_CMAX_WO, ws + WS_WOUT, DM, 0, scr, r / 64, r % 64, F.lane);
                         else p0_transpose_item<0>(a.in[19], DM, nullptr, (bf16_t*)(ws + WS_WOUT), DM, 0, scr, r / 64, r % 64, F.lane); continue; } r -= I_OUT;
        if (r < I_PA) { p0_transpose_item_i8<0>(a.in[17], DM, nullptr, (const unsigned*)(ws + WS_CTL) + CW_CMAX_PA, ws + WS_WPAB, DM, 0, scr, r / 64, r % 64, F.lane); continue; } r -= I_PA;
        p0_transpose_item_i8<0>(a.in[18], DM, nullptr, (const unsigned*)(ws + WS_CTL) + CW_CMAX_PB, ws + WS_WPAB, DM, 2048, scr, r / 64, r % 64, F.lane);
    }
    { u32x4* z = (u32x4*)(ws + WS_WIN + (size_t)DIN * DM);
      for (int i = gw * 64 + F.lane; i < 224 * 256; i += NGW * 64) z[i] = (u32x4){0u, 0u, 0u, 0u}; }
    { float* prm = (float*)(ws + WS_PRM); const int gt = F.vcu * NTHR + F.tid, ngt = F.G * NTHR;
      for (int i = gt; i < 4096; i += ngt) prm[P_GMIX + i] = a.in[3][i];
      for (int i = gt; i < 128; i += ngt) { prm[P_QG + i] = a.in[5][i]; prm[P_KG + i] = a.in[6][i]; }
      for (int i = gt; i < 256; i += ngt) { prm[P_SUBLN + i] = a.in[11][i]; prm[P_RB + i] = a.in[2][i]; }
      for (int i = gt; i < 16384; i += ngt) { prm[P_WGF + i] = a.in[12][i]; prm[P_WGB + i] = a.in[14][i]; }
      for (int i = gt; i < 1024; i += ngt) { prm[P_BGF + i] = a.in[13][i]; prm[P_BGB + i] = a.in[15][i]; }
      for (int i = gt; i < 512; i += ngt) prm[P_GLAG + i] = a.in[16][i];
      for (int i = gt; i < 3 * DFF; i += ngt) prm[P_CW + i] = a.in[22][i];
      for (int i = gt; i < DFF; i += ngt) prm[P_CB + i] = a.in[23][i]; }
    if (fresh_bid() == 0 && F.wave == 0) {
        float s1 = 0.f, s2 = 0.f;
        for (int i = F.lane; i < 128; i += 64) { s1 += a.in[7][i] * a.in[8][i]; s2 += a.in[9][i] * a.in[10][i]; }
        s1 = wave_sum(s1); s2 = wave_sum(s2);
        if (F.lane == 0) ((float*)(ws + WS_PRM))[P_LAM] = expf(s1) - expf(s2) + 0.2f;
    }
}
__device__ __forceinline__ void p1_hnorm(const Frame& F, const float* x, const float* gm, unsigned char* HQ, float* SH) {
    const int gw = F.vcu * NWAVES + F.wave, NGW = F.G * NWAVES;
    for (int m = gw; m < GT; m += NGW) {
        const f32x4* xr = (const f32x4*)(x + (size_t)m * DM) + F.lane; const f32x4* gr = (const f32x4*)gm + F.lane;
        f32x4 v[16]; float s = 0.f;
#pragma unroll
        for (int j = 0; j < 16; ++j) { v[j] = xr[64 * j]; s += (v[j][0] * v[j][0] + v[j][1] * v[j][1]) + (v[j][2] * v[j][2] + v[j][3] * v[j][3]); }
        const float rstd = 1.f / sqrtf(wave_sum(s) * (1.f / DM) + EPS); float mx = 0.f;
#pragma unroll
        for (int j = 0; j < 16; ++j) { v[j] = v[j] * gr[64 * j]; mx = fmaxf(mx, fmaxf(fmaxf(fabsf(v[j][0]), fabsf(v[j][1])), fmaxf(fabsf(v[j][2]), fabsf(v[j][3])))); }
#pragma unroll
        for (int o = 1; o < 64; o <<= 1) mx = fmaxf(mx, __shfl_xor(mx, o));
        mx = fmaxf(mx, 1e-30f); const float qs = 127.f / mx;
        unsigned* o8 = (unsigned*)(HQ + (size_t)m * DM) + F.lane;
#pragma unroll
        for (int j = 0; j < 16; ++j) o8[64 * j] = pack_i8x4(v[j][0] * qs, v[j][1] * qs, v[j][2] * qs, v[j][3] * qs);
        if (F.lane == 0) SH[m] = mx * rstd * (1.f / 127.f);
    }
}
__device__ __forceinline__ void p7b_quant_x1(const Frame& F, const bf16_t* X1B, unsigned char* X1Q, float* SX) {
    const int gw = F.vcu * NWAVES + F.wave, NGW = F.G * NWAVES;
    for (int m = gw; m < GT; m += NGW) {
        const u32x4* xr = (const u32x4*)(X1B + (size_t)m * DM) + F.lane; u32x4 w[8]; float mx = 0.f;
#pragma unroll
        for (int j = 0; j < 8; ++j) { w[j] = xr[64 * j]; mx = fmaxf(mx, fmaxf(fmaxf(fmaxf(fabsf(bflo(w[j].x)), fabsf(bfhi(w[j].x))), fmaxf(fabsf(bflo(w[j].y)), fabsf(bfhi(w[j].y)))), fmaxf(fmaxf(fabsf(bflo(w[j].z)), fabsf(bfhi(w[j].z))), fmaxf(fabsf(bflo(w[j].w)), fabsf(bfhi(w[j].w)))))); }
#pragma unroll
        for (int o = 1; o < 64; o <<= 1) mx = fmaxf(mx, __shfl_xor(mx, o));
        mx = fmaxf(mx, 1e-30f); const float qs = 127.f / mx;
        u32x2* o8 = (u32x2*)(X1Q + (size_t)m * DM) + F.lane;
#pragma unroll
        for (int j = 0; j < 8; ++j) o8[64 * j] = (u32x2){pack_i8x4(bflo(w[j].x) * qs, bfhi(w[j].x) * qs, bflo(w[j].y) * qs, bfhi(w[j].y) * qs), pack_i8x4(bflo(w[j].z) * qs, bfhi(w[j].z) * qs, bflo(w[j].w) * qs, bfhi(w[j].w) * qs)};
        if (F.lane == 0) SX[m] = mx * (1.f / 127.f);
    }
}
__device__ __forceinline__ void p3_qknorm(const Frame& F, bf16_t* Q, bf16_t* K, const float* gq, const float* gk) {
    const int gw = F.vcu * NWAVES + F.wave, NGW = F.G * NWAVES;
    const int gi = (F.lane & 15) * 8;
    float gqv[8], gkv[8];
#pragma unroll
    for (int e = 0; e < 8; ++e) { gqv[e] = gq[gi + e]; gkv[e] = gk[gi + e]; }
    for (int m = gw; m < 2 * GT; m += NGW) {
        const bool isk = m >= GT; bf16_t* row = (isk ? K : Q) + (size_t)(isk ? m - GT : m) * 2048;
#pragma unroll
        for (int i = 0; i < 4; ++i) {
            u32x4* p = (u32x4*)(row + i * 512) + F.lane; const u32x4 w = *p;
            float v[8] = {bflo(w.x), bfhi(w.x), bflo(w.y), bfhi(w.y), bflo(w.z), bfhi(w.z), bflo(w.w), bfhi(w.w)};
            float s = 0.f;
#pragma unroll
            for (int e = 0; e < 8; ++e) s += v[e] * v[e];
            s += __shfl_xor(s, 1); s += __shfl_xor(s, 2); s += __shfl_xor(s, 4); s += __shfl_xor(s, 8);
            const float r = 1.f / sqrtf(s * (1.f / 128.f) + EPS);
#pragma unroll
            for (int e = 0; e < 8; ++e) v[e] = v[e] * r * (isk ? gkv[e] : gqv[e]);
            u32x4 o; o.x = cvt_pk_bf16(v[0], v[1]); o.y = cvt_pk_bf16(v[2], v[3]); o.z = cvt_pk_bf16(v[4], v[5]); o.w = cvt_pk_bf16(v[6], v[7]);
            *p = o;
        }
    }
}

constexpr int LQ = 264;
constexpr int LS = 72;
constexpr int G1_QD = 0, G1_KI = 64 * LQ * 2, G1_VT = 2 * 64 * LQ * 2, G1_ATT = G1_VT + 256 * LS * 2, G1_ST = G1_ATT + 64 * LS * 2, G1_TOT = G1_ST + 64 * 16 * 4, G1_END = G1_TOT + 2 * 256 * 4;
static_assert(G1_END <= LDS_MISC, "G1 LDS");
struct GlaT { const bf16_t *GQ, *GK, *GV; const float* ST; const float *wgf, *bgf, *wgb, *bgb; bf16_t *QD, *KDT, *OI, *ATT; float* DEC; unsigned* dg; };
__device__ __forceinline__ void gla_g1_item(const Frame& F, const GlaT& T, int item, int TT) {
    LAS unsigned char* lds = F.lds;
    const int NCH = TT / 64;
    const int n = item % NCH; int r_ = item / NCH; const int dir = r_ & 1; r_ >>= 1; const int h = r_ & 3; const int b = r_ >> 2;
    const int tok0 = b * TT + n * 64, cg = tok0 >> 6;
    const int tid = F.tid, d = tid & 255, half = tid >> 8;
#if MK_DIAG
    if (tid == 0) atomicOr(T.dg, 32u);
#endif
    LAS bf16_t* qd_l = (LAS bf16_t*)(lds + G1_QD); LAS bf16_t* ki_l = (LAS bf16_t*)(lds + G1_KI); LAS bf16_t* vT_l = (LAS bf16_t*)(lds + G1_VT);
    LAS bf16_t* att_l = (LAS bf16_t*)(lds + G1_ATT); LAS float* st_l = (LAS float*)(lds + G1_ST); LAS float* tot_l = (LAS float*)(lds + G1_TOT);
    const float* wg = dir ? T.wgb : T.wgf; const float* bg = dir ? T.bgb : T.bgf;
    float wgr[16];
#pragma unroll
    for (int j = 0; j < 16; ++j) wgr[j] = wg[j * 1024 + h * 256 + d];
    const float bias = bg[h * 256 + d];
    const bf16_t* gqp = T.GQ + (size_t)tok0 * 1024 + h * 256; const bf16_t* gkp = T.GK + (size_t)tok0 * 1024 + h * 256;
    unsigned o32 = (unsigned)(half * 32 * 1024 + d); asm volatile("" : "+v"(o32));
    bf16_t qraw[32], kraw[32];
#pragma unroll
    for (int rr = 0; rr < 32; ++rr) { qraw[rr] = gqp[o32 + (unsigned)(rr * 1024)]; kraw[rr] = gkp[o32 + (unsigned)(rr * 1024)]; }
    if (tid < 256) { const int r = tid >> 2, j4 = (tid & 3) * 4; const f32x4 sv = *(const f32x4*)(T.ST + (size_t)(tok0 + r) * 32 + dir * 16 + j4); *(LAS f32x4*)(st_l + r * 16 + j4) = sv;
#if MK_DIAG
        if (!(fabsf(sv[0]) <= 20.f && fabsf(sv[1]) <= 20.f && fabsf(sv[2]) <= 20.f && fabsf(sv[3]) <= 20.f)) atomicOr(T.dg, 16u);
#endif
    }
    __syncthreads();
    float bl[32];
#pragma unroll
    for (int rr = 0; rr < 32; ++rr) { const int r = half * 32 + rr; float x = bias;
#pragma unroll
        for (int j4 = 0; j4 < 4; ++j4) { const f32x4 s = *(const LAS f32x4*)(st_l + r * 16 + j4 * 4); x += s[0] * wgr[j4 * 4] + s[1] * wgr[j4 * 4 + 1] + s[2] * wgr[j4 * 4 + 2] + s[3] * wgr[j4 * 4 + 3]; }
#if MK_DIAG
        if (!(fabsf(x) <= 50.f)) atomicOr(T.dg, 1u);
#endif
        const float ax = fabsf(x); const float ls = fminf(x, 0.f) - __logf(1.f + __expf(-ax));
        bl[rr] = ls * 0.0625f; if ((rr & 3) == 3) __builtin_amdgcn_sched_barrier(0); }
    float run = 0.f;
    if (dir == 0) {
#pragma unroll
        for (int rr = 0; rr < 32; ++rr) { run += bl[rr]; bl[rr] = run; }
    } else {
#pragma unroll
        for (int rr = 31; rr >= 0; --rr) { run += bl[rr]; bl[rr] = run; }
    }
    tot_l[half * 256 + d] = run;
    __syncthreads();
    const float other = tot_l[(1 - half) * 256 + d]; const float blast = run + other;
    const float addv = ((dir == 0) ? (half == 1) : (half == 0)) ? other : 0.f;
    const float elast = __expf(blast);
    const int gbase = (cg * 4 + h) * 2 + dir;
    if (half == 0) T.DEC[(size_t)gbase * 256 + d] = elast;
    unsigned kdp[16];
    bf16_t* qdp = T.QD + ((size_t)tok0 * 2 + dir) * 1024 + h * 256;
    const unsigned o32q = (unsigned)(half * 32 * 2048 + d);
#pragma unroll
    for (int rr = 0; rr < 32; rr += 2) {
        unsigned od = o32q; asm volatile("" : "+v"(od));
        float kd2[2];
#pragma unroll
        for (int e = 0; e < 2; ++e) { const int r = half * 32 + rr + e; const float bb = bl[rr + e] + addv; const float eb = __expf(bb), ieb = __builtin_amdgcn_rcpf(eb);
            const float qv = bf2f(qraw[rr + e]), kv = bf2f(kraw[rr + e]);
            const bf16_t qdb = f2bf(qv * eb); const float ki = kv * ieb;
#if MK_DIAG
            if (!(fabsf(ki) <= 1e30f)) atomicOr(T.dg, 2u);
#endif
            qd_l[r * LQ + d] = qdb; ki_l[r * LQ + d] = f2bf(ki);
            qdp[od + (unsigned)((rr + e) * 2048)] = qdb;
            kd2[e] = ki * elast; }
        kdp[rr >> 1] = cvt_pk_bf16(kd2[0], kd2[1]); if ((rr & 6) == 6) __builtin_amdgcn_sched_barrier(0);
    }
    { u32x4* kp = (u32x4*)(T.KDT + ((size_t)gbase * 256 + d) * 64 + half * 32);
#pragma unroll
      for (int i = 0; i < 4; ++i) kp[i] = (u32x4){kdp[4 * i], kdp[4 * i + 1], kdp[4 * i + 2], kdp[4 * i + 3]}; }
    __syncthreads();
    const int lane = F.lane, fr = lane & 15, fq = lane >> 4;
#pragma unroll
    for (int i = 0; i < 2; ++i) { const int id = F.wave * 2 + i, mt = id >> 2, nt = id & 3; f32x4 acc = {0.f, 0.f, 0.f, 0.f};
#pragma unroll
        for (int k0 = 0; k0 < 256; k0 += 32) { const bf16x8 av = *(const LAS bf16x8*)(qd_l + (16 * mt + fr) * LQ + k0 + 8 * fq); const bf16x8 bv = *(const LAS bf16x8*)(ki_l + (16 * nt + fr) * LQ + k0 + 8 * fq);
            acc = __builtin_amdgcn_mfma_f32_16x16x32_bf16(av, bv, acc, 0, 0, 0); }
#pragma unroll
        for (int j = 0; j < 4; ++j) { const int c = 16 * mt + 4 * fq + j, s = 16 * nt + fr; const bool keep = dir == 0 ? (s <= c) : (s >= c); att_l[c * LS + s] = f2bf(keep ? acc[j] : 0.f);
#if MK_DIAG
            if (keep && !(fabsf(acc[j]) <= 1e4f)) atomicOr(T.dg, 4u);
#endif
        } }
    __syncthreads();
    { const int c = tid >> 3, ch = tid & 7; *(u32x4*)(T.ATT + (size_t)gbase * 4096 + c * 64 + ch * 8) = *(const LAS u32x4*)(att_l + c * LS + ch * 8); }
    __syncthreads();
}

constexpr int LR = 68;
constexpr int G2_QD = 0, G2_KT = 64 * LQ * 2, G2_VT = G2_KT + 256 * LS * 2, G2_DEC = G2_VT + 64 * LS * 2, G2_RED = G2_DEC + 1024, G2_ATT = G2_RED + 2 * 64 * LR * 4, G2_END = G2_ATT + 64 * LS * 2;
static_assert(G2_END <= LDS_MISC, "G2 LDS");
__device__ __forceinline__ void gla_g2_item(const Frame& F, const GlaT& T, int item, int TT) {
    LAS unsigned char* lds = F.lds;
    const int NCH = TT / 64;
    const int vs = item & 7; int r_ = item >> 3; const int dir = r_ & 1; r_ >>= 1; const int h = r_ & 3; const int b = r_ >> 2;
    int tid_l = F.tid; asm volatile("" : "+v"(tid_l));
    const int tid = tid_l, lane = tid & 63, fr = lane & 15, fq = lane >> 4, vt = F.wave & 3, dh = F.wave >> 2;
    LAS bf16_t* qd_l = (LAS bf16_t*)(lds + G2_QD); LAS bf16_t* kT_l = (LAS bf16_t*)(lds + G2_KT); LAS bf16_t* vT_l = (LAS bf16_t*)(lds + G2_VT);
    LAS float* dec_l = (LAS float*)(lds + G2_DEC); LAS float* red_l = (LAS float*)(lds + G2_RED); LAS bf16_t* at_l = (LAS bf16_t*)(lds + G2_ATT);
    f32x4 S[8];
#pragma unroll
    for (int i = 0; i < 8; ++i) S[i] = (f32x4){0.f, 0.f, 0.f, 0.f};
    u32x4 pq[2][4], pk[2][4], pv[2], po[2]; float pd[2] = {0.f, 0.f};
#define G2_PREFETCH(SET, STEP) do { const int n_ = dir ? (NCH - 1 - (STEP)) : (STEP); const int tk_ = b * TT + n_ * 64; const int gb_ = ((tk_ >> 6) * 4 + h) * 2 + dir; \
        _Pragma("unroll") for (int i = 0; i < 4; ++i) { const int id = tid + 512 * i; \
            pq[SET][i] = *(const u32x4*)(T.QD + ((size_t)(tk_ + (id >> 5)) * 2 + dir) * 1024 + h * 256 + (id & 31) * 8); \
            pk[SET][i] = *(const u32x4*)(T.KDT + ((size_t)gb_ * 256 + (id >> 3)) * 64 + (id & 7) * 8); } \
        pv[SET] = *(const u32x4*)(T.GV + (size_t)(tk_ + (tid >> 3)) * 2048 + h * 512 + vs * 64 + (tid & 7) * 8); \
        po[SET] = *(const u32x4*)(T.ATT + (size_t)gb_ * 4096 + (tid >> 3) * 64 + (tid & 7) * 8); \
        if (tid < 256) pd[SET] = T.DEC[(size_t)gb_ * 256 + tid]; } while (0)
    G2_PREFETCH(0, 0); G2_PREFETCH(1, 1);
#pragma nounroll
    for (int st2 = 0; st2 < NCH; st2 += 2) {
#pragma unroll
      for (int SET = 0; SET < 2; ++SET) { const int st = st2 + SET;
        const int n = dir ? (NCH - 1 - st) : st; const int tok0 = b * TT + n * 64;
#pragma unroll
        for (int i = 0; i < 4; ++i) { const int id = tid + 512 * i; *(LAS u32x4*)(qd_l + (id >> 5) * LQ + (id & 31) * 8) = pq[SET][i]; *(LAS u32x4*)(kT_l + (id >> 3) * LS + (id & 7) * 8) = pk[SET][i]; }
        { const int s = tid >> 3, cc = tid & 7; const u32x4 w = pv[SET];
            LAS bf16_t* vp = vT_l + (cc * 8) * LS + s;
            vp[0 * LS] = (bf16_t)(w.x & 0xffff); vp[1 * LS] = (bf16_t)(w.x >> 16); vp[2 * LS] = (bf16_t)(w.y & 0xffff); vp[3 * LS] = (bf16_t)(w.y >> 16);
            vp[4 * LS] = (bf16_t)(w.z & 0xffff); vp[5 * LS] = (bf16_t)(w.z >> 16); vp[6 * LS] = (bf16_t)(w.w & 0xffff); vp[7 * LS] = (bf16_t)(w.w >> 16); }
        if (tid < 256) dec_l[tid] = pd[SET];
        *(LAS u32x4*)(at_l + (tid >> 3) * LS + (tid & 7) * 8) = po[SET];
        __syncthreads();
        if (st + 2 < NCH) { if (SET == 0) G2_PREFETCH(0, st + 2); else G2_PREFETCH(1, st + 2); }
        bf16x8 sb[4];
#pragma unroll
        for (int kb = 0; kb < 4; ++kb) { u32x4 w; w.x = cvt_pk_bf16(S[2 * kb][0], S[2 * kb][1]); w.y = cvt_pk_bf16(S[2 * kb][2], S[2 * kb][3]); w.z = cvt_pk_bf16(S[2 * kb + 1][0], S[2 * kb + 1][1]); w.w = cvt_pk_bf16(S[2 * kb + 1][2], S[2 * kb + 1][3]);
            sb[kb] = __builtin_bit_cast(bf16x8, w); }
        { bf16x8 av[4][4];
#pragma unroll
          for (int mt = 0; mt < 4; ++mt)
#pragma unroll
              for (int kb = 0; kb < 4; ++kb) { const LAS bf16_t* ap = qd_l + (16 * mt + fr) * LQ + 128 * dh + 32 * kb + 4 * fq;
                  const s16x4 lo = *(const LAS s16x4*)(ap), hi = *(const LAS s16x4*)(ap + 16);
                  av[mt][kb] = __builtin_shufflevector(lo, hi, 0, 1, 2, 3, 4, 5, 6, 7); }
          bf16x8 ia[2][2], ib[2];
#pragma unroll
          for (int ks = 0; ks < 2; ++ks) { ib[ks] = *(const LAS bf16x8*)(vT_l + (16 * vt + fr) * LS + 32 * ks + 8 * fq);
#pragma unroll
              for (int j = 0; j < 2; ++j) ia[j][ks] = *(const LAS bf16x8*)(at_l + (16 * (2 * dh + j) + fr) * LS + 32 * ks + 8 * fq); }
          f32x4 acc[4], ai[2];
#pragma unroll
          for (int mt = 0; mt < 4; ++mt) acc[mt] = (f32x4){0.f, 0.f, 0.f, 0.f};
          ai[0] = (f32x4){0.f, 0.f, 0.f, 0.f}; ai[1] = (f32x4){0.f, 0.f, 0.f, 0.f};
#pragma unroll
          for (int kb = 0; kb < 4; ++kb)
#pragma unroll
              for (int mt = 0; mt < 4; ++mt) acc[mt] = __builtin_amdgcn_mfma_f32_16x16x32_bf16(av[mt][kb], sb[kb], acc[mt], 0, 0, 0);
#pragma unroll
          for (int ks = 0; ks < 2; ++ks)
#pragma unroll
              for (int j = 0; j < 2; ++j) ai[j] = __builtin_amdgcn_mfma_f32_16x16x32_bf16(ia[j][ks], ib[ks], ai[j], 0, 0, 0);
#pragma unroll
          for (int mt = 0; mt < 4; ++mt) { const bool mine = (mt >> 1) == dh; const f32x4 add = ai[mt & 1];
#pragma unroll
              for (int j = 0; j < 4; ++j) red_l[(dh * 64 + 16 * mt + 4 * fq + j) * LR + 16 * vt + fr] = acc[mt][j] + (mine ? add[j] : 0.f); } }
        { const bf16x8 b0 = *(const LAS bf16x8*)(vT_l + (16 * vt + fr) * LS + 8 * fq), b1 = *(const LAS bf16x8*)(vT_l + (16 * vt + fr) * LS + 32 + 8 * fq);
#pragma unroll
          for (int i = 0; i < 8; ++i) { const int drow = 128 * dh + 16 * i; const f32x4 dc = *(const LAS f32x4*)(dec_l + drow + 4 * fq);
              S[i] = S[i] * dc;
              const bf16x8 a0 = *(const LAS bf16x8*)(kT_l + (drow + fr) * LS + 8 * fq), a1 = *(const LAS bf16x8*)(kT_l + (drow + fr) * LS + 32 + 8 * fq);
              S[i] = __builtin_amdgcn_mfma_f32_16x16x32_bf16(a0, b0, S[i], 0, 0, 0); S[i] = __builtin_amdgcn_mfma_f32_16x16x32_bf16(a1, b1, S[i], 0, 0, 0); } }
        __syncthreads();
        { const int c = tid >> 3, v8 = (tid & 7) * 8; bf16_t* op = T.OI + ((size_t)dir * GT + tok0 + c) * 2048 + h * 512 + vs * 64 + v8;
          const f32x4 r0 = *(const LAS f32x4*)(red_l + c * LR + v8) + *(const LAS f32x4*)(red_l + (64 + c) * LR + v8);
          const f32x4 r1 = *(const LAS f32x4*)(red_l + c * LR + v8 + 4) + *(const LAS f32x4*)(red_l + (64 + c) * LR + v8 + 4);
          u32x4 w; w.x = cvt_pk_bf16(r0[0], r0[1]); w.y = cvt_pk_bf16(r0[2], r0[3]); w.z = cvt_pk_bf16(r1[0], r1[1]); w.w = cvt_pk_bf16(r1[2], r1[3]);
          *(u32x4*)op = w; }
      }
    }
    __syncthreads();
#undef G2_PREFETCH
}

namespace att {
constexpr int D = 128, NW = 8, QBLK = 32, KVBLK = 64, LD = 2048;
constexpr float SCALE = 0.088388347648318440f;
constexpr int SHM_V = KVBLK * D * 2, SHM_K = KVBLK * D * 2;
#if ATT_FULLV
constexpr int OFF_V = 0, OFF_K = 4 * SHM_V  ;
#else
constexpr int OFF_V = 0, OFF_K = 3 * SHM_V  ;
#endif
#if ATT_FULLV
constexpr int OFF_WS = OFF_K + 2 * SHM_K, OFF_TB = OFF_WS + NW * 64 * 4, TB_STRIDE = 264  , OFF_QS = OFF_TB + 8 * TB_STRIDE * 4  , ATT_LDS = OFF_QS + NW * 4096;
#else
constexpr int OFF_WS = OFF_K + 2 * SHM_K, OFF_TB = OFF_WS + NW * 64 * 4, TB_STRIDE = 264  , ATT_LDS = OFF_TB + 8 * TB_STRIDE * 4;
#endif
static_assert(ATT_LDS <= LDS_MISC, "attention LDS");
#define KSWZ(row, colB) ((row) * 256 + ((colB) ^ (((row) & 7) << 4)))
#define SBAR() __builtin_amdgcn_sched_barrier(0)
__device__ __forceinline__ int crow(int r, int hi) { return (r & 3) + 8 * (r >> 2) + 4 * hi; }
__device__ __forceinline__ void partialSM(f32x16& p0, f32x16& p1, const LAS float* tb, int rel0, int relmin, int relmax, int hi) {
    constexpr float C = SCALE * LOG2E;
    if (relmin >= 128 || relmax <= -128) {
        const float c = (relmin >= 128) ? tb[256] : tb[0];
#pragma unroll
        for (int r = 0; r < 16; ++r) { p0[r] = fmaf(p0[r], C, c); p1[r] = fmaf(p1[r], C, c); }
    } else {
        int rb = rel0 + 4 * hi; asm volatile("" : "+v"(rb));
#pragma unroll
        for (int r4 = 0; r4 < 16; r4 += 4) {
#pragma unroll
            for (int r = r4; r < r4 + 4; ++r) { const int rl = rb + ((r & 3) + 8 * (r >> 2)); const int i0 = min(max(rl, -128), 128) + 128, i1 = min(max(rl + 32, -128), 128) + 128;
                p0[r] = fmaf(p0[r], C, tb[i0]); p1[r] = fmaf(p1[r], C, tb[i1]); }
            __builtin_amdgcn_sched_barrier(0);
        }
    }
#pragma unroll
    for (int r = 0; r < 16; ++r) p0[r] = __builtin_amdgcn_exp2f(p0[r]);
}
__device__ __forceinline__ void finishSM(f32x16& p0, f32x16& p1, float& l_reg, bf16x8& pa0, bf16x8& pa1, bf16x8& pa2, bf16x8& pa3) {
#pragma unroll
    for (int r = 0; r < 16; ++r) p1[r] = __builtin_amdgcn_exp2f(p1[r]);
    float ps = 0;
#pragma unroll
    for (int r = 0; r < 16; ++r) ps += p0[r];
#pragma unroll
    for (int r = 0; r < 16; ++r) ps += p1[r];
    { auto rr = __builtin_amdgcn_permlane32_swap(__float_as_uint(ps), __float_as_uint(ps), false, false);
      ps = __uint_as_float(rr[0]) + __uint_as_float(rr[1]); }
    l_reg += ps;
#define PK4(P, BASE, OUT) do { unsigned a0 = cvt_pk_bf16(P[BASE + 0], P[BASE + 1]), a1 = cvt_pk_bf16(P[BASE + 2], P[BASE + 3]);   \
    unsigned b0 = cvt_pk_bf16(P[BASE + 4], P[BASE + 5]), b1 = cvt_pk_bf16(P[BASE + 6], P[BASE + 7]);                              \
    auto r0 = __builtin_amdgcn_permlane32_swap(a0, b0, false, false); auto r1 = __builtin_amdgcn_permlane32_swap(a1, b1, false, false); \
    u32x4 w = {r0[0], r1[0], r0[1], r1[1]}; OUT = __builtin_bit_cast(bf16x8, w); } while (0)
    PK4(p0, 0, pa0); PK4(p0, 8, pa1); PK4(p1, 0, pa2); PK4(p1, 8, pa3);
#undef PK4
}
__device__ __forceinline__ void qkt(f32x16& p0, f32x16& p1, const LAS char* Ks, const bf16x8* Qs, int r32, int hi) {
    p0 = f32x16{}; p1 = f32x16{};
#pragma unroll
    for (int d0 = 0; d0 < 8; ++d0) { const int cb = (d0 * 16 + hi * 8) * 2;
        const bf16x8 b0 = *(const LAS bf16x8*)(Ks + KSWZ(r32, cb));
        const bf16x8 b1 = *(const LAS bf16x8*)(Ks + KSWZ(32 + r32, cb));
        const bf16x8 q = Qs[d0];
        p0 = __builtin_amdgcn_mfma_f32_32x32x16_bf16(b0, q, p0, 0, 0, 0);
        p1 = __builtin_amdgcn_mfma_f32_32x32x16_bf16(b1, q, p1, 0, 0, 0); }
}
__device__ __forceinline__ int v_st(int k, int c) { const int kk = (k & ~0xC) | ((k & 4) << 1) | ((k & 8) >> 1); return ((kk >> 3) * 4 + (c >> 5)) * 512 + ((kk & 7) * 32 + (c & 31)) * 2; }
__device__ __forceinline__ int v_rd_base(int lane) { return ((lane & 3) << 3) | (((lane >> 2) & 3) << 6) | (((lane >> 4) & 1) << 5) | (((lane >> 5) & 1) << 8); }
constexpr int v_rd_off(int d0, int ks, int half) { return d0 * 512 + ks * 4096 + half * 2048; }
template <int OFF> __device__ __forceinline__ s16x4 tr_read(int vb) {
    s16x4 r; asm volatile("ds_read_b64_tr_b16 %0, %1 offset:%2" : "=&v"(r) : "v"(vb), "i"(OFF) : "memory"); return r;
}
template <int D0> __device__ __forceinline__ void pv_one(f32x16& od, int vb, bf16x8 pa0, bf16x8 pa1, bf16x8 pa2, bf16x8 pa3) {
    const s16x4 l0 = tr_read<v_rd_off(D0, 0, 0)>(vb), h0 = tr_read<v_rd_off(D0, 0, 1)>(vb), l1 = tr_read<v_rd_off(D0, 1, 0)>(vb), h1 = tr_read<v_rd_off(D0, 1, 1)>(vb);
    const s16x4 l2 = tr_read<v_rd_off(D0, 2, 0)>(vb), h2 = tr_read<v_rd_off(D0, 2, 1)>(vb), l3 = tr_read<v_rd_off(D0, 3, 0)>(vb), h3 = tr_read<v_rd_off(D0, 3, 1)>(vb);
    asm volatile("s_waitcnt lgkmcnt(0)" ::: "memory"); SBAR();
#define PK(L, H) (bf16x8){L[0], L[1], L[2], L[3], H[0], H[1], H[2], H[3]}
    od = __builtin_amdgcn_mfma_f32_32x32x16_bf16(pa0, PK(l0, h0), od, 0, 0, 0);
    od = __builtin_amdgcn_mfma_f32_32x32x16_bf16(pa1, PK(l1, h1), od, 0, 0, 0);
    od = __builtin_amdgcn_mfma_f32_32x32x16_bf16(pa2, PK(l2, h2), od, 0, 0, 0);
    od = __builtin_amdgcn_mfma_f32_32x32x16_bf16(pa3, PK(l3, h3), od, 0, 0, 0);
#undef PK
}
template <int KS> __device__ __forceinline__ void pv_ks(f32x16* o, int vb, bf16x8 pa) {
    const s16x4 l0 = tr_read<v_rd_off(0, KS, 0)>(vb), h0 = tr_read<v_rd_off(0, KS, 1)>(vb), l1 = tr_read<v_rd_off(1, KS, 0)>(vb), h1 = tr_read<v_rd_off(1, KS, 1)>(vb);
    const s16x4 l2 = tr_read<v_rd_off(2, KS, 0)>(vb), h2 = tr_read<v_rd_off(2, KS, 1)>(vb), l3 = tr_read<v_rd_off(3, KS, 0)>(vb), h3 = tr_read<v_rd_off(3, KS, 1)>(vb);
    asm volatile("s_waitcnt lgkmcnt(0)" ::: "memory"); SBAR();
#define PK(L, H) (bf16x8){L[0], L[1], L[2], L[3], H[0], H[1], H[2], H[3]}
    o[0] = __builtin_amdgcn_mfma_f32_32x32x16_bf16(pa, PK(l0, h0), o[0], 0, 0, 0);
    o[1] = __builtin_amdgcn_mfma_f32_32x32x16_bf16(pa, PK(l1, h1), o[1], 0, 0, 0);
    o[2] = __builtin_amdgcn_mfma_f32_32x32x16_bf16(pa, PK(l2, h2), o[2], 0, 0, 0);
    o[3] = __builtin_amdgcn_mfma_f32_32x32x16_bf16(pa, PK(l3, h3), o[3], 0, 0, 0);
#undef PK
}
template <int KS, int BASE> __device__ __forceinline__ void pv_kso(f32x16* o, int vb, bf16x8 pa) {
    const s16x4 l0 = tr_read<BASE + v_rd_off(0, KS, 0)>(vb), h0 = tr_read<BASE + v_rd_off(0, KS, 1)>(vb), l1 = tr_read<BASE + v_rd_off(1, KS, 0)>(vb), h1 = tr_read<BASE + v_rd_off(1, KS, 1)>(vb);
    const s16x4 l2 = tr_read<BASE + v_rd_off(2, KS, 0)>(vb), h2 = tr_read<BASE + v_rd_off(2, KS, 1)>(vb), l3 = tr_read<BASE + v_rd_off(3, KS, 0)>(vb), h3 = tr_read<BASE + v_rd_off(3, KS, 1)>(vb);
    asm volatile("s_waitcnt lgkmcnt(0)" ::: "memory"); SBAR();
#define PK(L, H) (bf16x8){L[0], L[1], L[2], L[3], H[0], H[1], H[2], H[3]}
    o[0] = __builtin_amdgcn_mfma_f32_32x32x16_bf16(pa, PK(l0, h0), o[0], 0, 0, 0);
    o[1] = __builtin_amdgcn_mfma_f32_32x32x16_bf16(pa, PK(l1, h1), o[1], 0, 0, 0);
    o[2] = __builtin_amdgcn_mfma_f32_32x32x16_bf16(pa, PK(l2, h2), o[2], 0, 0, 0);
    o[3] = __builtin_amdgcn_mfma_f32_32x32x16_bf16(pa, PK(l3, h3), o[3], 0, 0, 0);
#undef PK
}
__device__ __forceinline__ void pv_d0(f32x16* o, int vb, bf16x8 pa0, bf16x8 pa1, bf16x8 pa2, bf16x8 pa3) {
#if ATT_PV_KMAJOR
    pv_ks<0>(o, vb, pa0); pv_ks<1>(o, vb, pa1); pv_ks<2>(o, vb, pa2); pv_ks<3>(o, vb, pa3);
#else
    pv_one<0>(o[0], vb, pa0, pa1, pa2, pa3); pv_one<1>(o[1], vb, pa0, pa1, pa2, pa3); pv_one<2>(o[2], vb, pa0, pa1, pa2, pa3); pv_one<3>(o[3], vb, pa0, pa1, pa2, pa3);
#endif
}
__device__ __forceinline__ void attn_unit(const bf16_t* __restrict__ Qb, const bf16_t* __restrict__ Kh, const bf16_t* __restrict__ Vh, bf16_t* __restrict__ Ob, int seq, int q0, const LAS float* tb, LAS char* lds, int tid_) {
    const int tid = tid_, wid = tid >> 6, lane = tid & 63, r32 = lane & 31, hi = lane >> 5;
    LAS char* V_lds = lds + OFF_V; LAS char* K_lds = lds + OFF_K;
    LAS float* li_l = (LAS float*)(lds + OFF_WS) + wid * 64;
    float l_reg = 0; f32x16 o[4] = {};
    bf16x8 qr[8];
    { const bf16_t* Qw = Qb + (long)(wid * QBLK + r32) * LD + hi * 8;
#pragma unroll
      for (int d0 = 0; d0 < 8; ++d0) qr[d0] = *(const bf16x8*)(Qw + d0 * 16); }
    const int sr = tid >> 4, sc = (tid & 15) * 8, vst0 = v_st(sr, sc), vst1 = v_st(32 + sr, sc);
    const int vb0 = (int)(unsigned)(size_t)V_lds + v_rd_base(lane);
    const int qpos = q0 + wid * QBLK + r32, wq0 = q0 + wid * QBLK;
    struct { bf16x8 vs0, vs1, ks0, ks1; } sr_;
#define SLOAD(k0) do { sr_.vs0 = *(const bf16x8*)(&Vh[(long)((k0) + sr) * LD + sc]); sr_.vs1 = *(const bf16x8*)(&Vh[(long)((k0) + 32 + sr) * LD + sc]); \
    sr_.ks0 = *(const bf16x8*)(&Kh[(long)((k0) + sr) * LD + sc]); sr_.ks1 = *(const bf16x8*)(&Kh[(long)((k0) + 32 + sr) * LD + sc]); } while (0)
#define SWRITE(b) do { *(LAS bf16x8*)(V_lds + (b) * SHM_V + vst0) = sr_.vs0;          \
    *(LAS bf16x8*)(V_lds + (b) * SHM_V + vst1) = sr_.vs1; const int kc = sc * 2;               \
    *(LAS bf16x8*)(K_lds + (b) * SHM_K + KSWZ(sr, kc)) = sr_.ks0;                       \
    *(LAS bf16x8*)(K_lds + (b) * SHM_K + KSWZ(32 + sr, kc)) = sr_.ks1; } while (0)
#define PSM(P0, P1, TILE) partialSM(P0, P1, tb, (TILE) * KVBLK - qpos, (TILE) * KVBLK - (wq0 + 31), (TILE) * KVBLK + 63 - wq0, hi)
#define TILE_STEP(J, B) do { __syncthreads(); \
        if ((J) + 1 < NT) { asm volatile("s_waitcnt vmcnt(0)" ::: "memory"); SWRITE(1 - (B)); } \
        if ((J) + 2 < NT) SLOAD(((J) + 2) * KVBLK); \
        SBAR(); qkt(p0, p1, K_lds + (B) * SHM_K, qr, r32, hi); PSM(p0, p1, (J)); \
        finishSM(p0, p1, l_reg, pa0, pa1, pa2, pa3); SBAR(); \
        pv_d0(o, vb0 + (B) * (int)SHM_V, pa0, pa1, pa2, pa3); } while (0)
    bf16x8 pa0, pa1, pa2, pa3; const int NT = seq / KVBLK;
#if ATT_PIPE
    f32x16 pA0, pA1, pB0, pB1;
    SLOAD(0); asm volatile("s_waitcnt vmcnt(0)" ::: "memory"); SWRITE(0); __syncthreads();
    qkt(pA0, pA1, K_lds, qr, r32, hi); PSM(pA0, pA1, 0);
    SLOAD(KVBLK);
    asm volatile("s_waitcnt vmcnt(0)" ::: "memory"); SWRITE(1); __syncthreads();
#pragma nounroll
    for (int j = 1; j + 1 < NT; j += 2) {
        SBAR(); qkt(pB0, pB1, K_lds + SHM_K, qr, r32, hi);
        finishSM(pA0, pA1, l_reg, pa0, pa1, pa2, pa3); SBAR();
        SLOAD((j + 1) * KVBLK); SBAR();
        pv_d0(o, vb0, pa0, pa1, pa2, pa3); PSM(pB0, pB1, j);
        __syncthreads(); asm volatile("s_waitcnt vmcnt(0)" ::: "memory"); SWRITE(0);
        __syncthreads();
        SBAR(); qkt(pA0, pA1, K_lds, qr, r32, hi);
        finishSM(pB0, pB1, l_reg, pa0, pa1, pa2, pa3); SBAR();
        SLOAD((j + 2) * KVBLK); SBAR();
        pv_d0(o, vb0 + (int)SHM_V, pa0, pa1, pa2, pa3); PSM(pA0, pA1, j + 1);
        __syncthreads(); asm volatile("s_waitcnt vmcnt(0)" ::: "memory"); SWRITE(1);
        __syncthreads();
    }
    SBAR(); qkt(pB0, pB1, K_lds + SHM_K, qr, r32, hi);
    finishSM(pA0, pA1, l_reg, pa0, pa1, pa2, pa3); SBAR();
    pv_d0(o, vb0, pa0, pa1, pa2, pa3); PSM(pB0, pB1, NT - 1);
    finishSM(pB0, pB1, l_reg, pa0, pa1, pa2, pa3); SBAR();
    pv_d0(o, vb0 + (int)SHM_V, pa0, pa1, pa2, pa3);
#else
    f32x16 p0, p1;
#if ATT_DMA
    unsigned gk[2], gv[2];
    const int widu = __builtin_amdgcn_readfirstlane(wid);
#pragma unroll
    for (int t = 0; t < 2; ++t) { const int ch = wid + 8 * t, b = ch * 1024 + 16 * lane;
        { const int row = b >> 8, cs = (b >> 4) & 15, c = cs ^ (row & 7); gk[t] = (unsigned)(row * LD + c * 8); }
        { const int sub = b >> 9, e = (b & 511) >> 1, kk = ((sub >> 2) << 3) | (e >> 5), c = ((sub & 3) << 5) | (e & 31), k = (kk & ~0xC) | ((kk & 4) << 1) | ((kk & 8) >> 1); gv[t] = (unsigned)(k * LD + c); } }
#define DMA_TILE(k0, bufi) do { _Pragma("unroll") for (int t = 0; t < 2; ++t) { \
        __builtin_amdgcn_global_load_lds((const unsigned*)(Kh + (size_t)(k0) * LD + gk[t]), (LAS unsigned*)(K_lds + (bufi) * SHM_K + (widu + 8 * t) * 1024), 16, 0, 0); \
        __builtin_amdgcn_global_load_lds((const unsigned*)(Vh + (size_t)(k0) * LD + gv[t]), (LAS unsigned*)(V_lds + (bufi) * SHM_V + (widu + 8 * t) * 1024), 16, 0, 0); } } while (0)
#define TILE_STEP_D(J, B) do { asm volatile("s_waitcnt vmcnt(0)" ::: "memory"); __syncthreads();     \
        if ((J) + 1 < NT) DMA_TILE(((J) + 1) * KVBLK, 1 - (B)); \
        SBAR(); qkt(p0, p1, K_lds + (B) * SHM_K, qr, r32, hi); PSM(p0, p1, (J)); \
        finishSM(p0, p1, l_reg, pa0, pa1, pa2, pa3); SBAR(); \
        pv_d0(o, vb0 + (B) * (int)SHM_V, pa0, pa1, pa2, pa3); } while (0)
#if ATT_DMA == 2
#define DMA_TILE2(k0, kbi, vbi) do { _Pragma("unroll") for (int t = 0; t < 2; ++t) { \
        __builtin_amdgcn_global_load_lds((const unsigned*)(Kh + (size_t)(k0) * LD + gk[t]), (LAS unsigned*)(K_lds + (kbi) * SHM_K + (widu + 8 * t) * 1024), 16, 0, 0); \
        __builtin_amdgcn_global_load_lds((const unsigned*)(Vh + (size_t)(k0) * LD + gv[t]), (LAS unsigned*)(V_lds + (vbi) * SHM_V + (widu + 8 * t) * 1024), 16, 0, 0); } } while (0)
#define STEP2(J, PC0, PC1, PP0, PP1) do { asm volatile("s_waitcnt vmcnt(0)" ::: "memory"); __syncthreads(); \
        if ((J) + 1 < NT) DMA_TILE2(((J) + 1) * KVBLK, ((J) + 1) & 1, vnext); \
        SBAR(); qkt(PC0, PC1, K_lds + ((J) & 1) * SHM_K, qr, r32, hi); \
        finishSM(PP0, PP1, l_reg, pa0, pa1, pa2, pa3); SBAR(); \
        pv_d0(o, vb0 + vprev * (int)SHM_V, pa0, pa1, pa2, pa3); PSM(PC0, PC1, (J)); \
        vprev = vcur; vcur = vnext; vnext = vnext == 2 ? 0 : vnext + 1; } while (0)
    f32x16 pb0, pb1;
    int vprev = 0, vcur = 1, vnext = 2;
    DMA_TILE2(0, 0, 0);
    asm volatile("s_waitcnt vmcnt(0)" ::: "memory"); __syncthreads();
    DMA_TILE2(KVBLK, 1, 1);
    qkt(p0, p1, K_lds, qr, r32, hi); PSM(p0, p1, 0);
#pragma nounroll
    for (int j = 1; j + 1 < NT; j += 2) { STEP2(j, pb0, pb1, p0, p1); STEP2(j + 1, p0, p1, pb0, pb1); }
    STEP2(NT - 1, pb0, pb1, p0, p1);
    finishSM(pb0, pb1, l_reg, pa0, pa1, pa2, pa3); SBAR();
    pv_d0(o, vb0 + vprev * (int)SHM_V, pa0, pa1, pa2, pa3);
#undef STEP2
#undef DMA_TILE2
#else
    DMA_TILE(0, 0);
#pragma nounroll
    for (int j = 0; j < NT; j += 2) { TILE_STEP_D(j, 0); TILE_STEP_D(j + 1, 1); }
#endif
#undef TILE_STEP_D
#undef DMA_TILE
#else
    SLOAD(0); asm volatile("s_waitcnt vmcnt(0)" ::: "memory"); SWRITE(0); SLOAD(KVBLK);
#pragma nounroll
    for (int j = 0; j < NT; j += 2) { TILE_STEP(j, 0); TILE_STEP(j + 1, 1); }
#endif
#endif
#undef TILE_STEP
    if (hi == 0) li_l[r32] = l_reg; asm volatile("s_waitcnt lgkmcnt(0)" ::: "memory");
    float rli[16];
#pragma unroll
    for (int r = 0; r < 16; ++r) rli[r] = __builtin_amdgcn_rcpf(li_l[crow(r, hi)]);
    bf16_t* Ow = Ob + (long)(wid * QBLK) * LD;
#pragma unroll
    for (int r = 0; r < 16; ++r) { const int orow = crow(r, hi);
#pragma unroll
        for (int d0 = 0; d0 < 4; ++d0) Ow[(long)orow * LD + d0 * 32 + r32] = f2bf(o[d0][r] * rli[r]); }
#undef SLOAD
#undef SWRITE
#undef PSM
}

#if ATT_FULLV
template <int OFF> __device__ __forceinline__ void qkt1(f32x16& p, int kb, const bf16x8* Qs) {
    p = f32x16{};
    asm volatile("" : "+v"(kb));
    bf16x8 kf[8];
#define KRD(D0) asm volatile("ds_read_b128 %0, %1 offset:%2" : "=&v"(kf[D0]) : "v"(kb ^ ((D0) * 32)), "i"(OFF) : "memory")
#define QK1(D0, N) asm volatile("s_waitcnt lgkmcnt(" #N ")" ::: "memory"); SBAR(); p = __builtin_amdgcn_mfma_f32_32x32x16_bf16(kf[D0], Qs[D0], p, 0, 0, 0); SBAR();
    KRD(0); KRD(1); KRD(2); KRD(3);
    QK1(0, 3) KRD(4); QK1(1, 3) KRD(5); QK1(2, 3) KRD(6); QK1(3, 3) KRD(7); QK1(4, 3) QK1(5, 2) QK1(6, 1) QK1(7, 0)
#undef QK1
#undef KRD
}
template <int OFF> __device__ __forceinline__ void qkt2(f32x16& pA, f32x16& pB, int kb, int qa, const bf16x8* Qs) {
    pA = f32x16{}; pB = f32x16{};
    asm volatile("" : "+v"(kb), "+v"(qa));
    bf16x8 ka[8], kc[8], ql[8];
#define KRD2(D0) do { asm volatile("ds_read_b128 %0, %1 offset:%2" : "=&v"(ka[D0]) : "v"(kb ^ ((D0) * 32)), "i"(OFF) : "memory"); asm volatile("ds_read_b128 %0, %1 offset:%2" : "=&v"(kc[D0]) : "v"(kb ^ ((D0) * 32)), "i"(OFF + 8192) : "memory"); \
        if ((D0) >= 4) asm volatile("ds_read_b128 %0, %1 offset:%2" : "=&v"(ql[D0]) : "v"(qa), "i"(((D0) - 4) * 1024) : "memory"); } while (0)
#define QK2(D0, N) asm volatile("s_waitcnt lgkmcnt(" #N ")" ::: "memory"); SBAR(); { const bf16x8 q_ = (D0) >= 4 ? ql[D0] : Qs[(D0) & 3]; pA = __builtin_amdgcn_mfma_f32_32x32x16_bf16(ka[D0], q_, pA, 0, 0, 0); pB = __builtin_amdgcn_mfma_f32_32x32x16_bf16(kc[D0], q_, pB, 0, 0, 0); } SBAR();
    KRD2(0); KRD2(1);
    QK2(0, 2) KRD2(2); QK2(1, 2) KRD2(3); QK2(2, 2) KRD2(4); QK2(3, 3) KRD2(5); QK2(4, 3) KRD2(6); QK2(5, 3) KRD2(7); QK2(6, 3) QK2(7, 0)
#undef QK2
#undef KRD2
}
__device__ __forceinline__ void partialSM1(f32x16& p, const LAS float* tb, int rel_s, int lrel) {
    constexpr float C = SCALE * LOG2E;
    if (rel_s - 31 >= 128 || rel_s + 31 <= -128) {
        const float c = (rel_s >= 159) ? tb[256] : tb[0];
#pragma unroll
        for (int r = 0; r < 16; ++r) p[r] = fmaf(p[r], C, c);
    } else {
        int rb = rel_s + lrel; asm volatile("" : "+v"(rb));
#pragma unroll
        for (int r4 = 0; r4 < 16; r4 += 4) {
#pragma unroll
            for (int r = r4; r < r4 + 4; ++r) { const int rl = rb + ((r & 3) + 8 * (r >> 2)); const int i0 = min(max(rl, -128), 128) + 128; p[r] = fmaf(p[r], C, tb[i0]); }
            __builtin_amdgcn_sched_barrier(0);
        }
    }
#pragma unroll
    for (int r = 0; r < 16; ++r) p[r] = __builtin_amdgcn_exp2f(p[r]);
}
__device__ __forceinline__ void finishSM1(const f32x16& p, float& l_acc, bf16x8& pa_lo, bf16x8& pa_hi) {
    float ps = 0;
#pragma unroll
    for (int r = 0; r < 16; ++r) ps += p[r];
    l_acc += ps;
#define PK4(P, BASE, OUT) do { unsigned a0 = cvt_pk_bf16(P[BASE + 0], P[BASE + 1]), a1 = cvt_pk_bf16(P[BASE + 2], P[BASE + 3]);   \
    unsigned b0 = cvt_pk_bf16(P[BASE + 4], P[BASE + 5]), b1 = cvt_pk_bf16(P[BASE + 6], P[BASE + 7]);                              \
    auto r0 = __builtin_amdgcn_permlane32_swap(a0, b0, false, false); auto r1 = __builtin_amdgcn_permlane32_swap(a1, b1, false, false); \
    u32x4 w = {r0[0], r1[0], r0[1], r1[1]}; OUT = __builtin_bit_cast(bf16x8, w); } while (0)
    PK4(p, 0, pa_lo); PK4(p, 8, pa_hi);
#undef PK4
}
__device__ __forceinline__ void attn_unit_fv(const bf16_t* __restrict__ Qb, const bf16_t* __restrict__ Kh, const bf16_t* __restrict__ Vh, bf16_t* __restrict__ Ob, int seq, int q0, const LAS float* tb, LAS char* lds, int tid_) {
    int tid = tid_; asm volatile("" : "+v"(tid));
    const int wid = __builtin_amdgcn_readfirstlane(tid >> 6), lane = tid & 63, r32 = lane & 31, hi = lane >> 5;
    LAS char* V_lds = lds + OFF_V; LAS char* K_lds = lds + OFF_K;
    LAS float* li_l = (LAS float*)(lds + OFF_WS) + wid * 64;
    float l_reg = 0; f32x16 o[8] = {};
    bf16x8 qr[4];
    const int qa0 = (int)(unsigned)(size_t)(lds + OFF_QS) + wid * 4096 + lane * 16;
    { const char* Qw = (const char*)(Qb + (long)(wid * QBLK) * LD); const unsigned qo = (unsigned)((r32 * LD + hi * 8) * 2);
#pragma unroll
      for (int d0 = 0; d0 < 4; ++d0) qr[d0] = *(const bf16x8*)(Qw + qo + d0 * 32);
#pragma unroll
      for (int d0 = 4; d0 < 8; ++d0) { const bf16x8 qv = *(const bf16x8*)(Qw + qo + d0 * 32); *(LAS bf16x8*)((LAS char*)(size_t)(unsigned)qa0 + (d0 - 4) * 1024) = qv; } }
    const int vb0 = (int)(unsigned)(size_t)V_lds + v_rd_base(lane);
    const int wq0 = q0 + wid * QBLK, lrel = 4 * hi - r32;
    unsigned gk0, gv0;
    const int widu = wid;
    { const int b = wid * 1024 + 16 * lane;
      { const int row = b >> 8, cs = (b >> 4) & 15, c = cs ^ (row & 7); gk0 = (unsigned)(row * LD + c * 8) * 2u; }
      { const int sub = b >> 9, e = (b & 511) >> 1, kk = ((sub >> 2) << 3) | (e >> 5), c = ((sub & 3) << 5) | (e & 31), k = (kk & ~0xC) | ((kk & 4) << 1) | ((kk & 8) >> 1); gv0 = (unsigned)(k * LD + c) * 2u; } }
    const int kb0 = (int)(unsigned)(size_t)K_lds + r32 * 256 + ((hi * 16) ^ ((r32 & 7) << 4));
#define DMA1(sbase, voff, ldsaddr) asm volatile("s_mov_b32 m0, %2\n\ts_nop 0\n\tglobal_load_lds_dwordx4 %0, %1" :: "v"(voff), "s"(sbase), "s"(ldsaddr) : "memory", "m0")
#define DMA_TILE_FV(k0, bufi) do { const char* kt_ = (const char*)(Kh + (size_t)(k0) * LD); const char* vt_ = (const char*)(Vh + (size_t)(k0) * LD); _Pragma("unroll") for (int t = 0; t < 2; ++t) { \
        DMA1(kt_ + t * (32 * LD * 2), gk0, (unsigned)(size_t)(K_lds + (bufi) * SHM_K + (widu + 8 * t) * 1024)); \
        DMA1(vt_ + t * (32 * LD * 2), gv0, (unsigned)(size_t)(V_lds + (bufi) * 2 * SHM_V + (widu + 8 * t) * 1024)); \
        DMA1(vt_ + 256 + t * (32 * LD * 2), gv0, (unsigned)(size_t)(V_lds + (bufi) * 2 * SHM_V + SHM_V + (widu + 8 * t) * 1024)); } } while (0)
#define TR4(F, BASE, KS, D0) do { F[0] = tr_read<(BASE) + v_rd_off(D0, KS, 0)>(vb0); F[1] = tr_read<(BASE) + v_rd_off(D0, KS, 1)>(vb0); F[2] = tr_read<(BASE) + v_rd_off(D0 + 1, KS, 0)>(vb0); F[3] = tr_read<(BASE) + v_rd_off(D0 + 1, KS, 1)>(vb0); } while (0)
#define PKF(L, H) (bf16x8){L[0], L[1], L[2], L[3], H[0], H[1], H[2], H[3]}
#define MM2(O, D0, PA, F) do { (O)[D0] = __builtin_amdgcn_mfma_f32_32x32x16_bf16(PA, PKF(F[0], F[1]), (O)[D0], 0, 0, 0); (O)[D0 + 1] = __builtin_amdgcn_mfma_f32_32x32x16_bf16(PA, PKF(F[2], F[3]), (O)[D0 + 1], 0, 0, 0); } while (0)
#define LGK(N) asm volatile("s_waitcnt lgkmcnt(" #N ")" ::: "memory")
#define PV_PIPE(KSA, KSB, VA_, VB_) do { s16x4 f0[4], f1[4], f2[4]; \
        TR4(f0, VA_, KSA, 0); TR4(f1, VA_, KSA, 2); TR4(f2, VB_, KSA, 0); LGK(8); SBAR(); MM2(o, 0, pa0, f0); SBAR(); \
        TR4(f0, VB_, KSA, 2); LGK(8); SBAR(); MM2(o, 2, pa0, f1); SBAR(); \
        TR4(f1, VA_, KSB, 0); LGK(8); SBAR(); MM2(o + 4, 0, pa0, f2); SBAR(); \
        TR4(f2, VA_, KSB, 2); LGK(8); SBAR(); MM2(o + 4, 2, pa0, f0); SBAR(); \
        TR4(f0, VB_, KSB, 0); LGK(8); SBAR(); MM2(o, 0, pa1, f1); SBAR(); \
        TR4(f1, VB_, KSB, 2); LGK(8); SBAR(); MM2(o, 2, pa1, f2); SBAR(); \
        LGK(4); SBAR(); MM2(o + 4, 0, pa1, f0); SBAR(); LGK(0); SBAR(); MM2(o + 4, 2, pa1, f1); } while (0)
#define STEP_FV(J, B) do { asm volatile("s_waitcnt vmcnt(0)" ::: "memory"); __syncthreads();     \
        if ((J) + 1 < NT) DMA_TILE_FV(((J) + 1) * KVBLK, 1 - (B)); \
        { constexpr int VA = (B) * 2 * SHM_V, VB = VA + SHM_V; \
        SBAR(); qkt2<(B) * SHM_K>(p, pb, kb0, qa0, qr); \
        partialSM1(p, tb, (J) * KVBLK - wq0, lrel); \
        finishSM1(p, l_reg, pa0, pa1); SBAR(); \
        pv_kso<0, VA>(o, vb0, pa0); pv_kso<0, VB>(o + 4, vb0, pa0); pv_kso<1, VA>(o, vb0, pa1); pv_kso<1, VB>(o + 4, vb0, pa1); SBAR(); \
        partialSM1(pb, tb, (J) * KVBLK + 32 - wq0, lrel); \
        finishSM1(pb, l_reg, pa0, pa1); SBAR(); \
        PV_PIPE(2, 3, VA, VB); } } while (0)
    bf16x8 pa0, pa1; const int NT = seq / KVBLK;
    f32x16 p, pb;
    DMA_TILE_FV(0, 0);
#pragma nounroll
    for (int j = 0; j < NT; j += 2) { STEP_FV(j, 0); STEP_FV(j + 1, 1); }
#undef STEP_FV
#undef PV_PIPE
#undef LGK
#undef MM2
#undef PKF
#undef TR4
#undef DMA_TILE_FV
#undef DMA1
    { auto rr = __builtin_amdgcn_permlane32_swap(__float_as_uint(l_reg), __float_as_uint(l_reg), false, false); l_reg = __uint_as_float(rr[0]) + __uint_as_float(rr[1]); }
    int l2; asm volatile("v_mbcnt_lo_u32_b32 %0, -1, 0\n\tv_mbcnt_hi_u32_b32 %0, -1, %0" : "=v"(l2));
    const int r32e = l2 & 31, hie = l2 >> 5;
    if (hie == 0) li_l[r32e] = l_reg; asm volatile("s_waitcnt lgkmcnt(0)" ::: "memory");
    char* Ow = (char*)(Ob + (long)(wid * QBLK) * LD);
    unsigned ob = (unsigned)((4 * hie * LD + r32e) * 2);
#pragma unroll
    for (int r = 0; r < 16; ++r) { const float rl = __builtin_amdgcn_rcpf(li_l[crow(r, hie)]); asm volatile("" : "+v"(ob));
        bf16_t* op = (bf16_t*)(Ow + ob + (unsigned)((((r & 3) + 8 * (r >> 2)) * LD) * 2));
#pragma unroll
        for (int d0 = 0; d0 < 8; ++d0) op[d0 * 32] = f2bf(o[d0][r] * rl);
        SBAR(); }
}
#endif
}

__device__ __forceinline__ int t5_bucket(int rel) {
    const int ret = rel > 0 ? 16 : 0; const int n = rel < 0 ? -rel : rel;
    if (n < 8) return ret + n;
    const int e = 31 - __clz(n); int large = 8 + 2 * (e - 3) + ((n * n >= (2 << (2 * e))) ? 1 : 0);
    large = large < 15 ? large : 15;
    return ret + large;
}

__device__ __forceinline__ void p4_mixer(const Frame& F, const Args& a, int g) {
    unsigned char* ws = a.ws; const int TT = g ? 2048 : 4096, NB = g ? 8 : 4;
    bf16_t* dsc = (bf16_t*)(a.out + (size_t)g * GT * DM);
    const float* prm = (const float*)(ws + WS_PRM);
    GlaT T{(const bf16_t*)(ws + A_GQ), (const bf16_t*)(ws + A_GK), (const bf16_t*)(ws + A_GV), (const float*)(ws + WS_ST), prm + P_WGF, prm + P_BGF, prm + P_WGB, prm + P_BGB,
           (bf16_t*)(ws + A_QD), (bf16_t*)(ws + A_KDT), dsc + (size_t)2 * GT * 2048, (bf16_t*)(ws + A_ATT), (float*)(ws + WS_DEC), DG_WORD(ws)};
    const int n_g2 = NB * 4 * 2 * 8;
    for (int it = F.vcu; it < n_g2; it += F.G) gla_g2_item(F, T, it, TT);
#if ATT_FULLV
    const int NQB = TT / 256, n_at = NB * 8 * 2 * NQB;
#else
    const int NQB = TT / 256, n_at = NB * 8 * 2 * 2 * NQB;
#endif
    LAS float* tb = (LAS float*)(F.lds + att::OFF_TB);
    const bf16_t* Qg = (const bf16_t*)(ws + A_Q); const bf16_t* Kg = (const bf16_t*)(ws + A_K); const bf16_t* Vg = (const bf16_t*)(ws + A_V);
    __syncthreads();
    for (int i = F.tid; i < 8 * 257; i += NTHR) { const int h = i / 257, j = i - h * 257; tb[h * att::TB_STRIDE + j] = prm[P_RB + t5_bucket(j - 128) * 8 + h] * LOG2E; }
    __syncthreads();
    for (int it = F.vcu; it < n_at; it += F.G) {
#if ATT_FULLV
        const int qb = it % NQB; int r = it / NQB; const int map = r & 1; r >>= 1; const int h = r & 7; const int b = r >> 3;
        const size_t rowb = (size_t)b * TT;
        att::attn_unit_fv(Qg + (rowb + qb * 256) * 2048 + h * 256 + map * 128, Kg + rowb * 2048 + h * 256 + map * 128, Vg + rowb * 2048 + h * 256,
                          dsc + (size_t)map * GT * 2048 + (rowb + qb * 256) * 2048 + h * 256, TT, qb * 256, tb + h * att::TB_STRIDE, (LAS char*)F.lds, F.tid);
        __syncthreads();
#else
        const int qb = it % NQB; int r = it / NQB; const int vhalf = r & 1; r >>= 1; const int map = r & 1; r >>= 1; const int h = r & 7; const int b = r >> 3;
        const size_t rowb = (size_t)b * TT;
        att::attn_unit(Qg + (rowb + qb * 256) * 2048 + h * 256 + map * 128, Kg + rowb * 2048 + h * 256 + map * 128, Vg + rowb * 2048 + h * 256 + vhalf * 128,
                       dsc + (size_t)map * GT * 2048 + (rowb + qb * 256) * 2048 + h * 256 + vhalf * 128, TT, qb * 256, tb + h * att::TB_STRIDE, (LAS char*)F.lds, F.tid);
        __syncthreads();
#endif
    }
}
__device__ __forceinline__ void p5_finalize(const Frame& F, const Args& a, int g) {
    unsigned char* ws = a.ws; const bf16_t* dsc = (const bf16_t*)(a.out + (size_t)g * GT * DM);
    const bf16_t* O1 = dsc; const bf16_t* O2 = dsc + (size_t)GT * 2048; const bf16_t* OF = dsc + (size_t)2 * GT * 2048; const bf16_t* OB = dsc + (size_t)3 * GT * 2048;
    const bf16_t* GR = (const bf16_t*)(ws + A_GR);
    const float* prm = (const float*)(ws + WS_PRM); const float lam = prm[P_LAM];
    const int gw = F.vcu * NWAVES + F.wave, NGW = F.G * NWAVES, lane = F.lane;
    float sg[8], gg[8];
#pragma unroll
    for (int e = 0; e < 8; ++e) { sg[e] = prm[P_SUBLN + (lane & 31) * 8 + e] * 0.8f; gg[e] = prm[P_GLAG + lane * 8 + e]; }
    unsigned char* OQ = ws + A_OAB; float* soa = (float*)(ws + WS_PRM) + P_SOA; float* sob = (float*)(ws + WS_PRM) + P_SOB;
    for (int m = gw; m < GT; m += NGW) {
        float ya[4][8], yb[4][8]; float ma = 0.f, mb = 0.f;
#pragma unroll
        for (int i = 0; i < 4; ++i) {
            const size_t off = (size_t)m * 2048 + i * 512 + lane * 8;
            { const u32x4 w1 = *(const u32x4*)(O1 + off), w2 = *(const u32x4*)(O2 + off);
              float v[8] = {bflo(w1.x) - lam * bflo(w2.x), bfhi(w1.x) - lam * bfhi(w2.x), bflo(w1.y) - lam * bflo(w2.y), bfhi(w1.y) - lam * bfhi(w2.y),
                            bflo(w1.z) - lam * bflo(w2.z), bfhi(w1.z) - lam * bfhi(w2.z), bflo(w1.w) - lam * bflo(w2.w), bfhi(w1.w) - lam * bfhi(w2.w)};
              float s = 0.f;
#pragma unroll
              for (int e = 0; e < 8; ++e) s += v[e] * v[e];
              s += __shfl_xor(s, 1); s += __shfl_xor(s, 2); s += __shfl_xor(s, 4); s += __shfl_xor(s, 8); s += __shfl_xor(s, 16);
              const float r = 1.f / sqrtf(s * (1.f / 256.f) + EPS);
#pragma unroll
              for (int e = 0; e < 8; ++e) { ya[i][e] = v[e] * r * sg[e]; ma = fmaxf(ma, fabsf(ya[i][e])); } }
            { const u32x4 w1 = *(const u32x4*)(OF + off), w2 = *(const u32x4*)(OB + off), wr_ = *(const u32x4*)(GR + off);
              float v[8] = {bflo(w1.x) + bflo(w2.x), bfhi(w1.x) + bfhi(w2.x), bflo(w1.y) + bflo(w2.y), bfhi(w1.y) + bfhi(w2.y),
                            bflo(w1.z) + bflo(w2.z), bfhi(w1.z) + bfhi(w2.z), bflo(w1.w) + bflo(w2.w), bfhi(w1.w) + bfhi(w2.w)};
              const float rr[8] = {bflo(wr_.x), bfhi(wr_.x), bflo(wr_.y), bfhi(wr_.y), bflo(wr_.z), bfhi(wr_.z), bflo(wr_.w), bfhi(wr_.w)};
              float s = 0.f;
#pragma unroll
              for (int e = 0; e < 8; ++e) s += v[e] * v[e];
              s = wave_sum(s);
              const float r = 1.f / sqrtf(s * (1.f / 512.f) + EPS);
#pragma unroll
              for (int e = 0; e < 8; ++e) { yb[i][e] = v[e] * r * gg[e] * rr[e]; mb = fmaxf(mb, fabsf(yb[i][e])); } }
        }
#pragma unroll
        for (int o = 1; o < 64; o <<= 1) { ma = fmaxf(ma, __shfl_xor(ma, o)); mb = fmaxf(mb, __shfl_xor(mb, o)); }
        ma = fmaxf(ma, 1e-30f); mb = fmaxf(mb, 1e-30f); const float qa = 127.f / ma, qb = 127.f / mb;
#pragma unroll
        for (int i = 0; i < 4; ++i) {
            *(u32x2*)(OQ + (size_t)m * DM + i * 512 + lane * 8) = (u32x2){pack_i8x4(ya[i][0] * qa, ya[i][1] * qa, ya[i][2] * qa, ya[i][3] * qa), pack_i8x4(ya[i][4] * qa, ya[i][5] * qa, ya[i][6] * qa, ya[i][7] * qa)};
            *(u32x2*)(OQ + (size_t)m * DM + 2048 + i * 512 + lane * 8) = (u32x2){pack_i8x4(yb[i][0] * qb, yb[i][1] * qb, yb[i][2] * qb, yb[i][3] * qb), pack_i8x4(yb[i][4] * qb, yb[i][5] * qb, yb[i][6] * qb, yb[i][7] * qb)}; }
        if (lane == 0) { soa[m] = ma * (1.f / 127.f); sob[m] = mb * (1.f / 127.f); }
    }
}
__device__ __forceinline__ void p9_fix(const Frame& F, const float* HB, unsigned char* U8, const float* CW, const float* CB, int TT) {
    const int total = 64 * 86 * 2 * 32;
    for (int it = F.vcu * NTHR + F.tid; it < total; it += F.G * NTHR) {
        const int q = it & 31, e = (it >> 5) & 1, tix = it >> 6, pm = tix / 86, pn = tix - pm * 86, fl = 4 * q, f0 = pn * HALF + fl;
        const float* own = HB + (size_t)tix * 768 + fl; f32x4 prv, cur, nxt, gg; int row;
        if (e == 0) { row = pm * BM; cur = *(const f32x4*)(own); nxt = *(const f32x4*)(own + 128); gg = *(const f32x4*)(own + 4 * 128);
            prv = (row % TT) == 0 ? (f32x4){0.f, 0.f, 0.f, 0.f} : *(const f32x4*)(HB + (size_t)(tix - 86) * 768 + 3 * 128 + fl); }
        else { row = pm * BM + 255; prv = *(const f32x4*)(own + 2 * 128); cur = *(const f32x4*)(own + 3 * 128); gg = *(const f32x4*)(own + 5 * 128);
            nxt = ((row + 1) % TT) == 0 ? (f32x4){0.f, 0.f, 0.f, 0.f} : *(const f32x4*)(HB + (size_t)(tix + 86) * 768 + fl); }
        const f32x4 x0 = *(const f32x4*)(CW + f0), x1 = *(const f32x4*)(CW + DFF + f0), x2 = *(const f32x4*)(CW + 2 * DFF + f0), xb = *(const f32x4*)(CB + f0);
        float o[4];
#pragma unroll
        for (int i = 0; i < 4; ++i) { const float c = prv[i] * x0[i] + cur[i] * x1[i] + nxt[i] * x2[i] + xb[i]; o[i] = gelu_tanh_(c) * gg[i]; }
        int w = 0; w = __builtin_amdgcn_cvt_pk_fp8_f32(sat8(o[0]), sat8(o[1]), w, false); w = __builtin_amdgcn_cvt_pk_fp8_f32(sat8(o[2]), sat8(o[3]), w, true);
        *(unsigned*)(U8 + (size_t)row * DFF + f0) = (unsigned)w;
    }
}
__device__ __forceinline__ float gelu_tanh(float x) { const float u = x * (1.5957691216057308f + 0.07135481627159145f * x * x); return x * __builtin_amdgcn_rcpf(1.f + __builtin_amdgcn_exp2f(-u * LOG2E)); }
__device__ __forceinline__ void unpack8(const u32x4 w, float (&v)[8]) { v[0] = bflo(w.x); v[1] = bfhi(w.x); v[2] = bflo(w.y); v[3] = bfhi(w.y); v[4] = bflo(w.z); v[5] = bfhi(w.z); v[6] = bflo(w.w); v[7] = bfhi(w.w); }
__device__ __forceinline__ void p9_conv(const Frame& F, const Args& a, int g) {
    unsigned char* ws = a.ws; const int TT = g ? 2048 : 4096;
    const bf16_t* FA = (const bf16_t*)(ws + A_FA); const bf16_t* FG = (const bf16_t*)(ws + A_FG); unsigned char* U8 = u8_ptr(a, g);
    const float* cw = (const float*)(ws + WS_PRM) + P_CW; const float* cb = (const float*)(ws + WS_PRM) + P_CB;
    constexpr int NF8 = DFF / 8, RB = 16, NRB = GT / RB;
    const long total = (long)NF8 * NRB;
    for (long it = (long)F.vcu * NTHR + F.tid; it < total; it += (long)F.G * NTHR) {
        const int f8 = (int)(it % NF8), rb = (int)(it / NF8), f0 = f8 * 8, r0 = rb * RB;
        float w0[8], w1[8], w2[8], bb[8];
#pragma unroll
        for (int e = 0; e < 8; ++e) { w0[e] = cw[f0 + e]; w1[e] = cw[DFF + f0 + e]; w2[e] = cw[2 * DFF + f0 + e]; bb[e] = cb[f0 + e]; }
        float pv[8], cv[8], nv[8];
        if ((r0 % TT) != 0) unpack8(*(const u32x4*)(FA + (size_t)(r0 - 1) * DFF + f0), pv); else {
#pragma unroll
            for (int e = 0; e < 8; ++e) pv[e] = 0.f; }
        unpack8(*(const u32x4*)(FA + (size_t)r0 * DFF + f0), cv);
#pragma unroll 4
        for (int r = 0; r < RB; ++r) { const int row = r0 + r;
            if (((row + 1) % TT) != 0) unpack8(*(const u32x4*)(FA + (size_t)(row + 1) * DFF + f0), nv); else {
#pragma unroll
                for (int e = 0; e < 8; ++e) nv[e] = 0.f; }
            float gv[8]; unpack8(*(const u32x4*)(FG + (size_t)row * DFF + f0), gv);
            float o[8];
#pragma unroll
            for (int e = 0; e < 8; ++e) { const float c = pv[e] * w0[e] + cv[e] * w1[e] + nv[e] * w2[e] + bb[e]; o[e] = gelu_tanh(c) * gv[e]; pv[e] = cv[e]; cv[e] = nv[e]; }
            int w0 = 0, w1 = 0;
            w0 = __builtin_amdgcn_cvt_pk_fp8_f32(sat8(o[0] * U8_SCALE), sat8(o[1] * U8_SCALE), w0, false); w0 = __builtin_amdgcn_cvt_pk_fp8_f32(sat8(o[2] * U8_SCALE), sat8(o[3] * U8_SCALE), w0, true);
            w1 = __builtin_amdgcn_cvt_pk_fp8_f32(sat8(o[4] * U8_SCALE), sat8(o[5] * U8_SCALE), w1, false); w1 = __builtin_amdgcn_cvt_pk_fp8_f32(sat8(o[6] * U8_SCALE), sat8(o[7] * U8_SCALE), w1, true);
            *(u32x2*)(U8 + (size_t)row * DFF + f0) = (u32x2){(unsigned)w0, (unsigned)w1}; }
    }
}

constexpr int NPH = 11;
#if MK_TPROBE >= 0
#define TP_BEGIN(k) unsigned long long tp_t0_ = 0; if (MK_TPROBE == (k)) tp_t0_ = __builtin_amdgcn_s_memrealtime();
#define TP_END(k) do { if (MK_TPROBE == (k) && F.tid == 0) { volatile LAS unsigned* m_ = (volatile LAS unsigned*)(lds + LDS_MISC); m_[32] = m_[32] + (unsigned)(__builtin_amdgcn_s_memrealtime() - tp_t0_); } } while (0)
#else
#define TP_BEGIN(k)
#define TP_END(k)
#endif
#define GRID_BAR() do { if (!multi) { XcdBarrier b_; b_.bar = (unsigned*)(args.ws + WS_CTL) + CW_BAR; b_.x = xb_xcc_id(); b_.st = (volatile LAS unsigned*)(lds + LDS_MISC); xcd_barrier(b_); } } while (0)
#if MK_ONE_LAUNCH
#define IN(k) true
#else
#define IN(k) (lo <= (k) && (k) < hi)
#endif
template <int GI> __device__ __forceinline__ void group_body(LAS unsigned char* lds, const int wave_s, const Args& args, const bool more) {
    constexpr bool multi = !MK_ONE_LAUNCH;
    constexpr int g = GI;
    unsigned char* ws = args.ws; const int lo = args.ph_lo, hi = args.ph_hi; (void)lo; (void)hi;
    const float* xg = args.in[GI];
    float* outg = args.out + (size_t)GI * GT * DM;
    float* rss = (float*)((unsigned*)(ws + WS_CTL) + CW_RSS) + (size_t)GI * GT;
    if (IN(1)) { const Frame F = make_frame(lds, wave_s); TP_BEGIN(1) p1_hnorm(F, xg, GI == 0 ? args.in[3] : (const float*)(ws + WS_PRM) + P_GMIX, ws + A_H, (float*)(ws + WS_PRM) + P_SH); GRID_BAR(); TP_END(1); }
    if (IN(2)) { const Frame F = make_frame(lds, wave_s);
        TP_BEGIN(2)
        { pg8::Gemm gm{(const bf16_t*)(ws + A_H), (const bf16_t*)(ws + WS_WIN)};
          EpiInProj E{ws, (const float*)(ws + WS_PRM) + P_SH, (const float*)(ws + WS_PRM) + P_SWIN, (LAS float*)(F.lds + 131072 + 4096)};
          pg8::gemm_phase<GT, DINP, DM / 2, DM / 2, DM / 2, 1, 0, 2>(F.lds, gm, fresh_grid(), fresh_bid(), F.tid, E); }
        GRID_BAR(); TP_END(2);
    }
    if (IN(3)) { const Frame F = make_frame(lds, wave_s);
        TP_BEGIN(3)
        const float* prm = (const float*)(ws + WS_PRM);
        bf16_t* dsc = (bf16_t*)outg;
        GlaT T{(const bf16_t*)(ws + A_GQ), (const bf16_t*)(ws + A_GK), (const bf16_t*)(ws + A_GV), (const float*)(ws + WS_ST), prm + P_WGF, prm + P_BGF, prm + P_WGB, prm + P_BGB,
               (bf16_t*)(ws + A_QD), (bf16_t*)(ws + A_KDT), dsc + (size_t)2 * GT * 2048, (bf16_t*)(ws + A_ATT), (float*)(ws + WS_DEC), DG_WORD(ws)};
        constexpr int TT = g ? 2048 : 4096;
        for (int it = F.vcu; it < 2048; it += F.G) gla_g1_item(F, T, it, TT);
        GRID_BAR(); TP_END(3);
    }
    if (IN(4)) { const Frame F = make_frame(lds, wave_s); TP_BEGIN(4) p4_mixer(F, args, g); GRID_BAR(); TP_END(4); }
    if (IN(5)) { const Frame F = make_frame(lds, wave_s); TP_BEGIN(5) p5_finalize(F, args, g); GRID_BAR(); TP_END(5); }
    if (IN(6)) { const Frame F = make_frame(lds, wave_s);
        pg8::Gemm gm{(const bf16_t*)(ws + A_OAB), (const bf16_t*)(ws + WS_WPAB)}; EpiBranch E{ws};
        TP_BEGIN(6) pg8::gemm_phase<GT, DM, 1024, 2048, 2048, 2, 1024, 2>(F.lds, gm, fresh_grid(), fresh_bid(), F.tid, E); GRID_BAR();
        if (INT8_WOUT) { p7b_quant_x1(F, (const bf16_t*)(ws + A_MRG), ws + A_K, (float*)(ws + WS_PRM) + P_SM); GRID_BAR(); } TP_END(6);
    }
    if (IN(7)) { const Frame F = make_frame(lds, wave_s);
        pg8::Gemm gm{(const bf16_t*)(ws + (INT8_WOUT ? A_K : A_MRG)), (const bf16_t*)(ws + WS_WOUT)};
        EpiWout E{xg, (bf16_t*)(ws + A_X1B), rss, (const float*)(ws + WS_PRM) + P_SM, (const float*)(ws + WS_PRM) + P_SWWO}; TP_BEGIN(7) if (INT8_WOUT) pg8::gemm_phase<GT, DM, DM / 2, DM / 2, DM / 2, 1, 0, 2>(F.lds, gm, fresh_grid(), fresh_bid(), F.tid, E); else pg8::gemm_phase<GT, DM, DM, DM, DM, 1, 0, 0>(F.lds, gm, fresh_grid(), fresh_bid(), F.tid, E);
        GRID_BAR(); TP_END(7);
    }
    if (IN(8)) { const Frame F = make_frame(lds, wave_s);
        TP_BEGIN(8)
        float* sx = (float*)(ws + WS_PRM) + P_SX + (size_t)GI * GT;
        p7b_quant_x1(F, (const bf16_t*)(ws + A_X1B), (unsigned char*)outg, sx); GRID_BAR();
        pg8::Gemm gm{(const bf16_t*)outg, (const bf16_t*)(ws + WS_WUP)};
#if FUSE_CONV
        EpiUpConv E{ws, GI, (LAS float*)(F.lds + 131072)};
#else
        EpiUp E{rss, (bf16_t*)(ws + A_FA), (bf16_t*)(ws + A_FG), sx, (const float*)(ws + WS_PRM) + P_SWUP};
#endif
        pg8::gemm_phase<GT, 2 * DFF, DM / 2, DM / 2, DM / 2, 1, 0, 2>(F.lds, gm, fresh_grid(), fresh_bid(), F.tid, E); GRID_BAR(); TP_END(8);
    }
#if FUSE_CONV
    if (IN(9)) { const Frame F = make_frame(lds, wave_s); TP_BEGIN(9) p9_fix(F, (const float*)(ws + A_FA), u8_ptr(args, g), (const float*)(ws + WS_PRM) + P_CW, (const float*)(ws + WS_PRM) + P_CB, g ? 2048 : 4096); GRID_BAR(); TP_END(9); }
#else
    if (IN(9)) { const Frame F = make_frame(lds, wave_s); TP_BEGIN(9) p9_conv(F, args, g); GRID_BAR(); TP_END(9); }
#endif
    if (IN(10)) { const Frame F = make_frame(lds, wave_s);
        pg8::Gemm gm{(const bf16_t*)u8_ptr(args, g), (const bf16_t*)(ws + WS_WDN)};
        EpiDown E{outg, (const bf16_t*)(ws + A_X1B), 1.f / (U8_SCALE * W8_SCALE)}; TP_BEGIN(10) pg8::gemm_phase<GT, DM, DFF / 2, DFF / 2, DFF / 2, 1, 0, 1>(F.lds, gm, fresh_grid(), fresh_bid(), F.tid, E); TP_END(10);
        if (more) GRID_BAR();
    }
}
__global__ void __launch_bounds__(NTHR, 2) mk_fwd(Args args) {
    extern __shared__ __attribute__((aligned(16))) unsigned char lds_raw[];
    LAS unsigned char* lds = (LAS unsigned char*)lds_raw;
    const int wave_s = __builtin_amdgcn_readfirstlane((int)threadIdx.x >> 6);
#if MK_TPROBE == 99
    const unsigned long long tp_k0 = __builtin_amdgcn_s_memrealtime();
#endif
    { volatile LAS unsigned* MISC = (volatile LAS unsigned*)(lds + LDS_MISC); const int t = fresh_tid(wave_s); if (t < 64) MISC[t] = 0u; }
    __syncthreads();
#if MK_ONE_LAUNCH
    (void)xcd_barrier_post((unsigned*)(args.ws + WS_CTL) + CW_BAR, (volatile LAS unsigned*)(lds + LDS_MISC));
    { const Frame F = make_frame(lds, wave_s); p0_colmax(F, args.in[21], DM, 2 * DFF, args.in[20], (unsigned*)(args.ws + WS_CTL) + CW_CMAX_UP);
      p0_colmax(F, args.in[4], DM, DIN, nullptr, (unsigned*)(args.ws + WS_CTL) + CW_CMAX_IN);
      p0_colmax(F, args.in[17], 2048, DM, nullptr, (unsigned*)(args.ws + WS_CTL) + CW_CMAX_PA); p0_colmax(F, args.in[18], 2048, DM, nullptr, (unsigned*)(args.ws + WS_CTL) + CW_CMAX_PB);
      p0_colmax(F, args.in[19], DM, DM, nullptr, (unsigned*)(args.ws + WS_CTL) + CW_CMAX_WO); }
    { XcdBarrier b_; b_.bar = (unsigned*)(args.ws + WS_CTL) + CW_BAR; b_.x = xb_xcc_id(); b_.st = (volatile LAS unsigned*)(lds + LDS_MISC); xcd_barrier(b_); }
    { const Frame F = make_frame(lds, wave_s); TP_BEGIN(0) p0_weights(F, args); TP_END(0); }
    group_body<0>(lds, wave_s, args, true);
    group_body<1>(lds, wave_s, args, false);
#if MK_TPROBE == 99
    { const Frame F = make_frame(lds, wave_s); if (fresh_bid() == 0 && F.tid == 0) args.out[0] += (float)(unsigned)(__builtin_amdgcn_s_memrealtime() - tp_k0) * 1e-4f; }
#elif MK_TPROBE >= 0
    { const Frame F = make_frame(lds, wave_s); if (fresh_bid() == 0 && F.tid == 0) { volatile LAS unsigned* m_ = (volatile LAS unsigned*)(lds + LDS_MISC); args.out[0] += (float)m_[32] * 1e-4f; } }
#endif
#else
    if (args.ph_lo == 0 && args.g_lo == 0) { const Frame F = make_frame(lds, wave_s); p0_weights(F, args); }
    if (args.g_lo <= 0 && 0 < args.g_hi) group_body<0>(lds, wave_s, args, false);
    if (args.g_lo <= 1 && 1 < args.g_hi) group_body<1>(lds, wave_s, args, false);
#endif
}
#undef IN
#undef GRID_BAR


#if MK_DIAG
constexpr int CW_DIAG = 32768;
__global__ void diag_scan_bf16(const bf16_t* p, size_t n, unsigned* diag, int stage, float thr) {
    unsigned bad = 0;
    for (size_t i = (size_t)blockIdx.x * blockDim.x + threadIdx.x; i < n; i += (size_t)gridDim.x * blockDim.x) { const float v = bf2f(p[i]); if (!(fabsf(v) <= thr)) ++bad; }
    if (bad) atomicAdd(diag + stage, bad);
}
__global__ void diag_scan_f32(const float* p, size_t n, unsigned* diag, int stage, float thr) {
    unsigned bad = 0;
    for (size_t i = (size_t)blockIdx.x * blockDim.x + threadIdx.x; i < n; i += (size_t)gridDim.x * blockDim.x) { const float v = p[i]; if (!(fabsf(v) <= thr)) ++bad; }
    if (bad) atomicAdd(diag + stage, bad);
}

__global__ void diag_check_inproj(const float* x, const float* gm, const float* w_in, unsigned char* ws, unsigned* flag) {
    const int lane = threadIdx.x & 63, wv = (blockIdx.x * blockDim.x + threadIdx.x) >> 6, nw = (gridDim.x * blockDim.x) >> 6;
    const bf16_t* H = (const bf16_t*)(ws + A_H); const bf16_t* W = (const bf16_t*)(ws + WS_WIN);
    for (int s = wv; s < 4096; s += nw) {
        const unsigned hsh = (unsigned)s * 2654435761u; const int row = (int)((hsh >> 8) % GT);
        { float ss = 0.f; for (int k = lane; k < DM; k += 64) { const float v = x[(size_t)row * DM + k]; ss += v * v; } ss = wave_sum(ss);
          const int k = (int)((hsh >> 3) % DM); const float ref = x[(size_t)row * DM + k] * (1.f / sqrtf(ss / DM + EPS)) * gm[k]; const float got = bf2f(H[(size_t)row * DM + k]);
          if (!(fabsf(got - ref) <= 0.02f * fabsf(ref) + 1e-3f)) atomicOr(flag, 1u); }
        { const int n = (int)((hsh >> 5) % DIN), k = (int)((hsh >> 7) % DM); const int nn = n < 12288 ? n : (n < 12320 ? 20480 + (n - 12288) : n - 32);
          const float ref = w_in[(size_t)k * DIN + n], got = bf2f(W[(size_t)nn * DM + k]); if (!(fabsf(got - ref) <= 0.01f * fabsf(ref) + 1e-6f)) atomicOr(flag, 2u); }
        { const int seg = s % 7; int ncol, ld; size_t boff; float scale = 1.f;
          if (seg == 0) { ncol = 2048; ld = 2048; boff = A_Q; } else if (seg == 1) { ncol = 2048; ld = 2048; boff = A_K; } else if (seg == 2) { ncol = 2048; ld = 2048; boff = A_V; }
          else if (seg == 3) { ncol = 1024; ld = 1024; boff = A_GQ; scale = 0.0625f; } else if (seg == 4) { ncol = 1024; ld = 1024; boff = A_GK; } else if (seg == 5) { ncol = 2048; ld = 2048; boff = A_GV; } else { ncol = 32; ld = 32; boff = WS_ST; }
          const int segbase[7] = {0, 2048, 4096, 6144, 7168, 8192, 20480};
          const int c = (int)((hsh >> 11) % ncol); const int nn = segbase[seg] + c;
          float acc = 0.f; for (int k = lane; k < DM; k += 64) acc += bf2f(H[(size_t)row * DM + k]) * bf2f(W[(size_t)nn * DM + k]); acc = wave_sum(acc) * scale;
          const float got = seg == 6 ? ((const float*)(ws + boff))[(size_t)row * 32 + c] : bf2f(((const bf16_t*)(ws + boff))[(size_t)row * ld + c]);
          if (!(fabsf(got - acc) <= 0.02f * fabsf(acc) + 0.02f)) atomicOr(flag, 4u << seg); }
    }
}
__global__ void diag_final(float* out, size_t n, const unsigned* diag, int nstages) {
    int D = (int)(diag[50] & 32u); for (int s = 0; s < 4; ++s) if (diag[40 + s]) D |= 1 << s; if (diag[41] > 1000u) D |= 16;
    if (D == 0) return;
    const float c = exp2f(0.5f * (float)D);
    for (size_t i = (size_t)blockIdx.x * blockDim.x + threadIdx.x; i < n; i += (size_t)gridDim.x * blockDim.x) out[i] = c;
}
#endif
extern "C" void kernel_launch(void* const* d_in, const int* in_sizes, int n_in, void* d_out, int out_size, void* d_ws, size_t ws_size, hipStream_t stream) {
    static int grid = 0;
    if (grid == 0) {
        if (n_in != 25 || ws_size < WS_END) { fprintf(stderr, "kernel_launch: n_in %d ws %zu (need %zu)\n", n_in, ws_size, (size_t)WS_END); grid = -1; return; }
        int dev = 0, cus = 0, per_cu = 0;
        if (hipGetDevice(&dev) != hipSuccess || hipDeviceGetAttribute(&cus, hipDeviceAttributeMultiprocessorCount, dev) != hipSuccess) { grid = -1; return; }
        if (hipFuncSetAttribute((const void*)mk_fwd, hipFuncAttributeMaxDynamicSharedMemorySize, LDS_BYTES) != hipSuccess) { fprintf(stderr, "kernel_launch: hipFuncSetAttribute failed\n"); grid = -1; return; }
        if (hipOccupancyMaxActiveBlocksPerMultiprocessor(&per_cu, (const void*)mk_fwd, NTHR, LDS_BYTES) != hipSuccess || per_cu < 1) { fprintf(stderr, "kernel_launch: occupancy query says %d\n", per_cu); }
        (void)hipGetLastError();
        grid = cus;
    }
    if (grid < 0) return;
    (void)hipMemsetAsync((char*)d_ws + WS_CTL, 0, CTL_ZERO_BYTES, stream);
    Args a{};
    for (int i = 0; i < 25; ++i) a.in[i] = (const float*)d_in[i];
    a.out = (float*)d_out; a.ws = (unsigned char*)d_ws;
#if MK_ONE_LAUNCH
    a.ph_lo = 0; a.ph_hi = NPH; a.g_lo = 0; a.g_hi = 2;
    hipLaunchKernelGGL(mk_fwd, dim3(grid), dim3(NTHR), LDS_BYTES, stream, a);
#else
    a.ph_lo = 0; a.ph_hi = 1; a.g_lo = 0; a.g_hi = 1;
    hipLaunchKernelGGL(mk_fwd, dim3(grid), dim3(NTHR), LDS_BYTES, stream, a);
#if MK_DIAG
    unsigned char* ws = (unsigned char*)d_ws; unsigned* dg = (unsigned*)(ws + WS_CTL) + CW_DIAG;
#define SCANB(ptr, nel, st, thr) hipLaunchKernelGGL(diag_scan_bf16, dim3(2048), dim3(256), 0, stream, (const bf16_t*)(ptr), (size_t)(nel), dg, (st), (thr))
#define SCANF(ptr, nel, st, thr) hipLaunchKernelGGL(diag_scan_f32, dim3(2048), dim3(256), 0, stream, (const float*)(ptr), (size_t)(nel), dg, (st), (thr))
    SCANB(ws + WS_WIN, (WS_ACT - WS_WIN) / 2, 1, 1e4f);
    SCANF(ws + WS_PRM, P_END, 1, 1e4f);
#endif
    for (int g = 0; g < 2; ++g)
        for (int p = 1; p < NPH; ++p) { a.ph_lo = p; a.ph_hi = p + 1; a.g_lo = g; a.g_hi = g + 1; hipLaunchKernelGGL(mk_fwd, dim3(grid), dim3(NTHR), LDS_BYTES, stream, a);
#if MK_DIAG
            const int sb = 2 + g * 12; float* og = (float*)d_out + (size_t)g * GT * DM; const size_t E64 = (size_t)GT * 2048;
            if (p == 1) SCANB(ws + A_H, 2 * E64, sb + 0, 1e4f);
            if (p == 2) { SCANB(ws + A_Q, (A_SB + 128 * MiB - A_Q) / 2, sb + 1, 1e4f); SCANF(ws + WS_ST, (size_t)GT * 32, sb + 1, 1e4f); }
            if (p == 3 && g == 0) { SCANB((bf16_t*)og + 2 * E64, 2 * E64, 40, 3e38f); SCANB((bf16_t*)og + 2 * E64, 2 * E64, 41, 1e4f); SCANB((bf16_t*)og + 2 * E64, E64, 42, 1e4f); SCANB((bf16_t*)og + 3 * E64, E64, 43, 1e4f); }
            if (p == 4) SCANB(og, 4 * E64, sb + 3, 1e4f);
            if (p == 5) SCANB(ws + A_OAB, 2 * E64, sb + 4, 1e4f);
            if (p == 6) SCANB(ws + A_MRG, 2 * E64, sb + 5, 1e4f);
            if (p == 7) { SCANF(og, (size_t)GT * DM, sb + 6, 1e4f); SCANB(ws + A_X1B, 2 * E64, sb + 6, 1e4f); SCANF((float*)((unsigned*)(ws + WS_CTL) + CW_RSS) + (size_t)g * GT, GT, sb + 6, 1e6f); }
            if (p == 8) { SCANB(ws + A_FA, (size_t)GT * DFF, sb + 7, 1e4f); SCANB(ws + A_FG, (size_t)GT * DFF, sb + 7, 1e4f); }
            if (p == 9) SCANB(ws + A_FG, (size_t)GT * DFF, sb + 8, 1e4f);
            if (p == 10) SCANF(og, (size_t)GT * DM, sb + 9, 1e4f);
#endif
        }
#if MK_DIAG
    hipLaunchKernelGGL(diag_final, dim3(2048), dim3(256), 0, stream, (float*)d_out, (size_t)2 * GT * DM, dg, 32);
#endif
#endif
}
```

```cpp
#include <hip/hip_runtime.h>
#include <cstdio>
#include <cstdint>

#ifndef MK_ONE_LAUNCH
#define MK_ONE_LAUNCH 1
#endif
#ifndef INT8_WOUT
#define INT8_WOUT 1
#endif
#ifndef ATT_DMA
#define ATT_DMA 2
#endif
#ifndef FUSE_CONV
#define FUSE_CONV 1
#endif
#ifndef ATT_PV_KMAJOR
#define ATT_PV_KMAJOR 1
#endif
#ifndef RELAX_EPI
#define RELAX_EPI 1
#endif
#ifndef ATT_FULLV
#define ATT_FULLV 1
#endif
#ifndef ATT_PIPE
#define ATT_PIPE 0
#endif
#ifndef MK_TPROBE
#define MK_TPROBE -1
#endif
#ifndef MK_DIAG
#define MK_DIAG 0
#endif
#define DG_WORD(ws) ((unsigned*)((ws) + WS_CTL) + 32768 + 50)

#define LAS __attribute__((address_space(3)))
#define GAS __attribute__((address_space(1)))
typedef unsigned short bf16_t;
typedef short bf16x8 __attribute__((ext_vector_type(8)));
typedef short s16x4 __attribute__((ext_vector_type(4)));
typedef float f32x4 __attribute__((ext_vector_type(4)));
typedef float f32x2 __attribute__((ext_vector_type(2)));
typedef float f32x16 __attribute__((ext_vector_type(16)));
typedef unsigned u32x4 __attribute__((ext_vector_type(4)));
typedef unsigned u32x2 __attribute__((ext_vector_type(2)));

constexpr int DM = 4096, GT = 16384  , DIN = 20512, DINP = 20736, DFF = 11008;
constexpr float EPS = 1e-6f;
constexpr float LOG2E = 1.4426950408889634f;
constexpr int NWAVES = 8, NTHR = 512;

constexpr size_t MiB = 1u << 20;
constexpr size_t WS_CTL = 0, CTL_ZERO_BYTES = 1 * MiB;
constexpr size_t WS_PRM = 1 * MiB;
constexpr int P_LAM = 0, P_GMIX = 64, P_QG = 4160, P_KG = 4288, P_SUBLN = 4416, P_WGF = 4672, P_BGF = 21056, P_WGB = 22080, P_BGB = 38464, P_GLAG = 39488, P_CW = 40000, P_CB = 73024, P_RB = 84032, P_END = 84288;
constexpr size_t WS_ST = 2 * MiB;
constexpr size_t WS_DEC = 4 * MiB;
constexpr size_t WS_WIN = 8 * MiB;
constexpr size_t WS_WIN8 = 96 * MiB;
constexpr size_t WS_WUP = 170 * MiB;
constexpr size_t WS_WDN = 342 * MiB;
constexpr size_t WS_WOUT = 428 * MiB;
constexpr size_t WS_WPAB = 460 * MiB;
constexpr size_t WS_ACT = 492 * MiB;
constexpr size_t A_H = WS_ACT + 0 * MiB;
constexpr size_t A_Q = WS_ACT + 128 * MiB, A_K = WS_ACT + 192 * MiB, A_V = WS_ACT + 256 * MiB;
constexpr size_t A_GQ = WS_ACT + 320 * MiB, A_GK = WS_ACT + 352 * MiB;
constexpr size_t A_GV = WS_ACT + 384 * MiB, A_GR = WS_ACT + 448 * MiB;
constexpr size_t A_SA = WS_ACT + 512 * MiB, A_SB = WS_ACT + 640 * MiB;
constexpr size_t A_ATT = WS_ACT + 768 * MiB;
constexpr size_t A_QD = A_H, A_KDT = A_H + 64 * MiB;
constexpr size_t A_OAB = A_Q;
constexpr size_t A_MRG = A_V;
constexpr size_t A_X1B = A_H;
constexpr size_t A_FA = WS_ACT + 128 * MiB;
constexpr size_t A_FG = WS_ACT + 472 * MiB;
constexpr size_t WS_END = WS_ACT + 816 * MiB;
constexpr float H8_SCALE = 16.f;
constexpr float U8_SCALE = 8.f, W8_SCALE = 64.f;
constexpr int CW_CMAX_UP = 100000, CW_CMAX_IN = 125000;
constexpr int P_SWUP = 150000, P_SWIN = 175000;
constexpr int CW_CMAX_PA = 146000, CW_CMAX_PB = 150100, CW_CMAX_WO = 154200;
constexpr int P_SOA = 200000, P_SOB = 216384, P_SM = 232768;
constexpr int P_SWPA = 249200, P_SWPB = 253296, P_SWWO = 257392;
constexpr int CW_WMAX = 40000;
constexpr int P_SH = 130000;
constexpr int P_SX = 90000;
constexpr int CW_BAR = 1024;
constexpr int CW_RSS = 65536;

constexpr int LDS_BYTES = 155648;
constexpr int LDS_MISC = 153600;

typedef __bf16 nbf16x2 __attribute__((ext_vector_type(2)));
__device__ __forceinline__ unsigned cvt_pk_bf16(float lo, float hi) { const f32x2 v = {lo, hi}; return __builtin_bit_cast(unsigned, __builtin_convertvector(v, nbf16x2)); }
__device__ __forceinline__ float bflo(unsigned w) { return __uint_as_float(w << 16); }
__device__ __forceinline__ float bfhi(unsigned w) { return __uint_as_float(w & 0xffff0000u); }
__device__ __forceinline__ float bf2f(bf16_t v) { return __uint_as_float(((unsigned)v) << 16); }
__device__ __forceinline__ bf16_t f2bf(float f) { return (bf16_t)(cvt_pk_bf16(f, 0.f) & 0xffffu); }
__device__ __forceinline__ float sat8(float v) { return __builtin_fminf(__builtin_fmaxf(v, -448.f), 448.f); }
__device__ __forceinline__ unsigned pack_i8x4(float a, float b, float c, float d) {
    const int ia = (int)__builtin_rintf(a), ib = (int)__builtin_rintf(b), ic = (int)__builtin_rintf(c), id = (int)__builtin_rintf(d);
    return (unsigned)(ia & 0xff) | ((unsigned)(ib & 0xff) << 8) | ((unsigned)(ic & 0xff) << 16) | ((unsigned)id << 24);
}
__device__ __forceinline__ float wave_sum(float v) {
#pragma unroll
    for (int o = 1; o < 64; o <<= 1) v += __shfl_xor(v, o);
    return v;
}
__device__ __forceinline__ float fast_exp(float x) { return __builtin_amdgcn_exp2f(x * LOG2E); }
__device__ __forceinline__ float sigmoidf_(float x) { return __builtin_amdgcn_rcpf(1.f + fast_exp(-x)); }

__device__ __forceinline__ int fresh_tid(int wave_s) { int l; asm volatile("v_mbcnt_lo_u32_b32 %0, -1, 0\n\tv_mbcnt_hi_u32_b32 %0, -1, %0" : "=v"(l)); return (wave_s << 6) | l; }
__device__ __forceinline__ int fresh_bid() { int b = blockIdx.x; asm volatile("" : "+s"(b)); return b; }
__device__ __forceinline__ int fresh_grid() { int g = gridDim.x; asm volatile("" : "+s"(g)); return g; }
#define XB_TMO      128
#define XB_XCNT(j)  (256  + 64 * (j))
#define XB_XSUB(j)  (1280 + 64 * (j))
#define XB_XGEN(j)  (2304 + 64 * (j))
#define XB_TOP      3328
#define XB_TOPGEN   3392
#define XCD_BAR_WORDS 3456
#define XB_SPIN_CAP (1u << 18)
__device__ __forceinline__ unsigned xb_ld(unsigned* p)              { return __hip_atomic_load(p, __ATOMIC_RELAXED, __HIP_MEMORY_SCOPE_AGENT); }
__device__ __forceinline__ unsigned xb_add(unsigned* p, unsigned v) { return __hip_atomic_fetch_add(p, v, __ATOMIC_RELAXED, __HIP_MEMORY_SCOPE_AGENT); }
__device__ __forceinline__ unsigned xb_xcc_id() { return (unsigned)__builtin_amdgcn_s_getreg((3 << 11) | 20) & 0xFu; }
#define XB_SPIN(cond, bar) do { unsigned _sp = 0; while (cond) { __builtin_amdgcn_s_sleep(1); \
    if ((++_sp & 255u) == 0u) { if (xb_ld(&(bar)[XB_TMO])) break; if (_sp > XB_SPIN_CAP) { atomicAdd(&(bar)[XB_TMO], 1u); break; } } } } while (0)
struct XcdBarrier { unsigned* bar; unsigned x; volatile LAS unsigned* st; };
__device__ __forceinline__ XcdBarrier xcd_barrier_post(unsigned* bar, volatile LAS unsigned* st) {
    XcdBarrier b; b.bar = bar; b.x = xb_xcc_id(); b.st = st;
    if (threadIdx.x == 0) (void)xb_add(&bar[XB_XCNT(b.x)], 1u);
    return b;
}
__device__ __forceinline__ void xcd_barrier_complete(unsigned* bar, unsigned x, unsigned& nloc, unsigned& nx) {
    const unsigned G = gridDim.x * gridDim.y * gridDim.z;
    unsigned sum, cnt, mine, sp = 0u;
    for (;;) {
        sum = 0u; cnt = 0u; mine = 0u;
#pragma unroll
        for (unsigned j = 0; j < 16; ++j) { const unsigned c = xb_ld(&bar[XB_XCNT(j)]); sum += c; cnt += (c > 0u) ? 1u : 0u; mine = (j == x) ? c : mine; }
        if (sum == G) break;
        __builtin_amdgcn_s_sleep(1);
        if ((++sp & 255u) == 0u) { if (xb_ld(&bar[XB_TMO])) break; if (sp > XB_SPIN_CAP) { atomicAdd(&bar[XB_TMO], 1u); break; } }
    }
    nloc = mine > 0u ? mine : 1u; nx = cnt > 0u ? cnt : 1u;
}
__device__ __forceinline__ void xcd_barrier(const XcdBarrier& b) {
    asm volatile("s_waitcnt vmcnt(0)" ::: "memory");
    __syncthreads();
    if (threadIdx.x == 0) {
        unsigned* bar = b.bar;
        __builtin_amdgcn_s_waitcnt(0);
        unsigned nloc = b.st[0], nx = b.st[1];
        if (nloc == 0u) { xcd_barrier_complete(bar, b.x, nloc, nx); b.st[0] = nloc; b.st[1] = nx; }
        const unsigned old = xb_add(&bar[XB_XSUB(b.x)], 1u);
        const unsigned gen = old / nloc;
        if (old + 1u == (gen + 1u) * nloc) {
            __builtin_amdgcn_fence(__ATOMIC_RELEASE, "agent");
            asm volatile("s_waitcnt vmcnt(0)" ::: "memory");
            const unsigned og = xb_add(&bar[XB_TOP], 1u);
            const unsigned tg = og / nx;
            if (og + 1u == (tg + 1u) * nx) xb_add(&bar[XB_TOPGEN], 1u);
            else XB_SPIN(xb_ld(&bar[XB_TOPGEN]) == tg, bar);
            __builtin_amdgcn_fence(__ATOMIC_ACQUIRE, "agent");
            xb_add(&bar[XB_XGEN(b.x)], 1u);
            asm volatile("s_waitcnt vmcnt(0)" ::: "memory");
        } else {
            XB_SPIN(xb_ld(&bar[XB_XGEN(b.x)]) == gen, bar);
            __builtin_amdgcn_fence(__ATOMIC_ACQUIRE, "agent");
            asm volatile("s_waitcnt vmcnt(0)" ::: "memory");
        }
    }
    __syncthreads();
}

namespace pg8 {
typedef int i32x8_ __attribute__((ext_vector_type(8)));
typedef int i32x4_ __attribute__((ext_vector_type(4)));
union Frag { i32x8_ v; bf16x8 q[2]; };
constexpr int BM = 256, BK = 64, HALF = 128, HTB = HALF * BK * 2, STAGE_BYTES = 8 * HTB, NXCD = 8, WGM = 4;
__host__ __device__ __forceinline__ int lds_byte(int r, int c) { const int st = (r >> 4) * 2 + (c >> 5), rr = r & 15, cc = c & 31, ob = rr * 64 + cc * 2; return st * 1024 + (ob ^ (((ob >> 9) & 1) << 5)); }
__host__ __device__ __forceinline__ void stage_rc(int b, int& R, int& C) { const int st = b / 1024, sb = b % 1024, swz = sb ^ (((sb >> 9) & 1) << 5); R = (st >> 1) * 16 + swz / 64; C = (st & 1) * 32 + (swz % 64) / 2; }
__host__ __device__ __forceinline__ int perm32(int rho) { const int n = rho >> 4, i = rho & 15; return 8 * (i >> 2) + 4 * n + (i & 3); }
struct Unit { int pm, pn, ps; };
struct Gemm { const bf16_t* A; const bf16_t* Bt; };
template <int NM, int NN, int PASSES> struct StaticOrder {
    int G, c;
    __device__ __forceinline__ bool next(int i, Unit& u) const {
        constexpr int nwg = NM * NN;
        const int ti = PASSES == 2 ? (i >> 1) : i;
        const long L = (long)ti * G + c; if (L >= nwg) return false;
        int wgid = (int)L; { constexpr int q = nwg / NXCD, r = nwg % NXCD; const int xcd = wgid % NXCD, off = wgid / NXCD; wgid = (xcd < r ? xcd * (q + 1) : r * (q + 1) + (xcd - r) * q) + off; }
        constexpr int nig = WGM * NN; const int gid = wgid / nig, fm = gid * WGM, gsz = (NM - fm) < WGM ? (NM - fm) : WGM;
        u.pm = fm + ((wgid % nig) % gsz); u.pn = (wgid % nig) / gsz; u.ps = PASSES == 2 ? (i & 1) : 0; return true;
    }
};
template <int M, int N, int K, int LDA, int LDB, int PASSES, int PASS_OFF  , int MODE  , class Epi>
__device__ __forceinline__ void gemm_phase(LAS unsigned char* lds, const Gemm g, int G, int c, int tid_, const Epi& E) {
    StaticOrder<M / BM, N / BM, PASSES> S; S.G = G; S.c = c;
    const int tid = tid_, wid = __builtin_amdgcn_readfirstlane(tid >> 6), lane = tid & 63, wr = wid >> 2, wc = wid & 3, fr = lane & 15, fq = lane >> 4;
    constexpr int nt = K / BK;
    unsigned voffA[2], voffB[2];
#pragma unroll
    for (int i = 0; i < 2; ++i) { int R, C; stage_rc(tid * 16 + i * 8192, R, C); const int Rb = Epi::PERM ? ((R & ~31) + perm32(R & 31)) : R;
        voffA[i] = (unsigned)(R * LDA + C) * 2u; voffB[i] = (unsigned)(Rb * LDB + C) * 2u; }
    constexpr size_t kstep = (size_t)(BK * 2);
    constexpr size_t hstepA = (size_t)HALF * LDA * 2, hstepB = (size_t)HALF * LDB * 2;
    constexpr size_t tstepA = 2 * hstepA, tstepB = 2 * hstepB, pstep = (size_t)PASS_OFF * 2;
    const unsigned ldsw = (unsigned)wid * 1024u;
    const int aoff = lds_byte(wr * 64 + fr, fq * 8), boff = lds_byte(wc * 32 + fr, fq * 8);
#define PG8_SA(b, h) (((b) * 2 + (h)) * HTB)
#define PG8_SB(b, h) ((4 + (b) * 2 + (h)) * HTB)
#define PG8_STAGE(bufoff, gbase, voff) do { _Pragma("unroll") for (int _i = 0; _i < 2; ++_i) \
        __builtin_amdgcn_global_load_lds((const unsigned*)((const char*)(gbase) + (voff)[_i]), (LAS unsigned*)(lds + (bufoff) + ldsw + _i * 8192), 16, 0, 0); } while (0)
#define PG8_LDA(dst, b, h) do { _Pragma("unroll") for (int m = 0; m < 4; ++m) _Pragma("unroll") for (int k = 0; k < 2; ++k) dst[m].q[k] = *(const LAS bf16x8*)(lds + PG8_SA(b, h) + aoff + m * 2048 + k * 1024); } while (0)
#define PG8_LDB(dst, b, h) do { _Pragma("unroll") for (int n = 0; n < 2; ++n) _Pragma("unroll") for (int k = 0; k < 2; ++k) dst[n].q[k] = *(const LAS bf16x8*)(lds + PG8_SB(b, h) + boff + n * 2048 + k * 1024); } while (0)
#define PG8_MMA(ai, bj, At, Bt) do { __builtin_amdgcn_s_setprio(1); _Pragma("unroll") for (int m = 0; m < 4; ++m) _Pragma("unroll") for (int n = 0; n < 2; ++n) { \
        if constexpr (FP8) asm volatile("v_mfma_scale_f32_16x16x128_f8f6f4 %0, %1, %2, %0, %3, %3 op_sel_hi:[0,0,0]" : "+v"(acc[ai][bj][m][n]) : "v"(Bt[n].v), "v"(At[m].v), "v"(one_scale)); \
        else if constexpr (MODE == 2) { _Pragma("unroll") for (int k = 0; k < 2; ++k) acc[ai][bj][m][n] = __builtin_bit_cast(f32x4, __builtin_amdgcn_mfma_i32_16x16x64_i8(__builtin_bit_cast(i32x4_, Bt[n].q[k]), __builtin_bit_cast(i32x4_, At[m].q[k]), __builtin_bit_cast(i32x4_, acc[ai][bj][m][n]), 0, 0, 0)); } \
        else { _Pragma("unroll") for (int k = 0; k < 2; ++k) acc[ai][bj][m][n] = __builtin_amdgcn_mfma_f32_16x16x32_bf16(Bt[n].q[k], At[m].q[k], acc[ai][bj][m][n], 0, 0, 0); } } \
        __builtin_amdgcn_s_setprio(0); } while (0)
#define PG8_WAIT_V(n) asm volatile("s_waitcnt vmcnt(" #n ")" ::: "memory")
#define PG8_WAIT_L(n) asm volatile("s_waitcnt lgkmcnt(" #n ")" ::: "memory")
#define PG8_BAR __builtin_amdgcn_s_barrier()
#define PG8_SCHED __builtin_amdgcn_sched_barrier(0)
    Unit cur, nxt; int ui = 0;
    if (!S.next(0, cur)) return;
    f32x4 acc[2][2][4][2];
#pragma unroll
    for (int a = 0; a < 2; ++a)
#pragma unroll
        for (int b = 0; b < 2; ++b)
#pragma unroll
            for (int m = 0; m < 4; ++m)
#pragma unroll
                for (int n = 0; n < 2; ++n) acc[a][b][m][n] = (f32x4){0.f, 0.f, 0.f, 0.f};
    Frag At[4], B0[2], B1[2];
    const int one_scale = 0x7f7f7f7f;
    constexpr bool FP8 = MODE == 1;
    const char* cA = (const char*)g.A + (size_t)cur.pm * tstepA + (size_t)cur.ps * pstep; const char* cB = (const char*)g.Bt + (size_t)cur.pn * tstepB + (size_t)cur.ps * pstep;
    PG8_STAGE(PG8_SB(0, 0), cB, voffB); PG8_STAGE(PG8_SB(0, 1), cB + hstepB, voffB); PG8_STAGE(PG8_SA(0, 0), cA, voffA); PG8_STAGE(PG8_SA(0, 1), cA + hstepA, voffA);
    if (wr == 1) PG8_BAR;
    PG8_WAIT_V(2); PG8_BAR;
    PG8_STAGE(PG8_SB(1, 0), cB + kstep, voffB); PG8_STAGE(PG8_SA(1, 0), cA + kstep, voffA); PG8_STAGE(PG8_SB(1, 1), cB + hstepB + kstep, voffB);
    PG8_WAIT_V(6); PG8_BAR;
    for (;;) {
        const bool has_next = S.next(ui + 1, nxt);
        const char* nA = has_next ? (const char*)g.A + (size_t)nxt.pm * tstepA + (size_t)nxt.ps * pstep : cA; const char* nB = has_next ? (const char*)g.Bt + (size_t)nxt.pn * tstepB + (size_t)nxt.ps * pstep : cB;
        for (int t = 0; t < nt; t += 2) {
            const bool last = (t == nt - 2);
            const char* a1 = cA + (size_t)(t + 1) * kstep;
            const char* a2 = last ? nA : cA + (size_t)(t + 2) * kstep; const char* b2 = last ? nB : cB + (size_t)(t + 2) * kstep;
            const char* a3 = a2 + kstep; const char* b3 = b2 + kstep;
            const int rlx = __builtin_amdgcn_readfirstlane((RELAX_EPI && (t == 0) && (ui > 0)) ? 1 : 0);
#define PG8_WAIT_V8R() do { if constexpr (Epi::NST >= 32) asm volatile("s_waitcnt vmcnt(40)\n\ts_cmp_lg_u32 %0, 0\n\ts_cbranch_scc1 .Lrlx%=\n\ts_waitcnt vmcnt(8)\n.Lrlx%=:" :: "s"(rlx) : "memory", "scc"); \
                            else asm volatile("s_waitcnt vmcnt(24)\n\ts_cmp_lg_u32 %0, 0\n\ts_cbranch_scc1 .Lrlx%=\n\ts_waitcnt vmcnt(8)\n.Lrlx%=:" :: "s"(rlx) : "memory", "scc"); } while (0)
            PG8_LDB(B0, 0, 0); PG8_LDB(B1, 0, 1); PG8_SCHED; PG8_LDA(At, 0, 0); PG8_STAGE(PG8_SA(1, 1), a1 + hstepA, voffA);
            PG8_WAIT_V8R(); PG8_WAIT_L(0); PG8_BAR; PG8_MMA(0, 0, At, B0); PG8_MMA(0, 1, At, B1); PG8_BAR; PG8_SCHED;
            PG8_LDA(At, 0, 1); PG8_STAGE(PG8_SB(0, 0), b2, voffB); PG8_STAGE(PG8_SB(0, 1), b2 + hstepB, voffB); PG8_STAGE(PG8_SA(0, 0), a2, voffA);
            PG8_WAIT_V8R(); PG8_WAIT_L(0); PG8_BAR; PG8_MMA(1, 0, At, B0); PG8_MMA(1, 1, At, B1); PG8_BAR; PG8_SCHED;
#undef PG8_WAIT_V8R
            PG8_LDB(B0, 1, 0); PG8_LDB(B1, 1, 1); PG8_SCHED; PG8_LDA(At, 1, 0); PG8_STAGE(PG8_SA(0, 1), a2 + hstepA, voffA);
            PG8_WAIT_V(8); PG8_WAIT_L(0); PG8_BAR; PG8_MMA(0, 0, At, B0); PG8_MMA(0, 1, At, B1); PG8_BAR; PG8_SCHED;
            PG8_LDA(At, 1, 1); PG8_STAGE(PG8_SB(1, 0), b3, voffB); PG8_STAGE(PG8_SB(1, 1), b3 + hstepB, voffB); PG8_STAGE(PG8_SA(1, 0), a3, voffA);
            PG8_WAIT_V(8); PG8_WAIT_L(0); PG8_BAR; PG8_MMA(1, 0, At, B0); PG8_MMA(1, 1, At, B1); PG8_BAR; PG8_SCHED;
        }
        if (wr == 0) PG8_BAR;
        { int l_; asm volatile("v_mbcnt_lo_u32_b32 %0, -1, 0\n\tv_mbcnt_hi_u32_b32 %0, -1, %0" : "=v"(l_));
          E(acc, cur, wr, wc, l_ & 15, l_ >> 4); }
        if (!has_next) break;
#pragma unroll
        for (int a = 0; a < 2; ++a)
#pragma unroll
            for (int b = 0; b < 2; ++b)
#pragma unroll
                for (int m = 0; m < 4; ++m)
#pragma unroll
                    for (int n = 0; n < 2; ++n) acc[a][b][m][n] = (f32x4){0.f, 0.f, 0.f, 0.f};
        cur = nxt; cA = nA; cB = nB; ++ui;
        if (wr == 1) PG8_BAR;
    }
    PG8_WAIT_V(0);
    PG8_BAR;
#undef PG8_SA
#undef PG8_SB
#undef PG8_STAGE
#undef PG8_LDA
#undef PG8_LDB
#undef PG8_MMA
#undef PG8_WAIT_V
#undef PG8_WAIT_L
#undef PG8_BAR
#undef PG8_SCHED
}
}
using pg8::Unit;
constexpr int HALF = 128, BM = 256;

struct EpiInProj {
    static constexpr bool PERM = true;
    static constexpr int NST = 16;
    unsigned char* ws; const float* SH; const float* SW;
    LAS float* XS;
    __device__ __forceinline__ void qk_tile(const f32x4 (&acc)[2][2][4][2], const Unit& u, int wr, int wc, int fr, int fq, bf16_t* base, int col0) const {
        const int pn = u.pn, row0 = u.pm * BM + wr * 64 + fr; const float* gn = (const float*)(ws + WS_PRM) + (pn < 8 ? P_QG : P_KG) + wc * 32 + 8 * fq;
        f32x4 cs[2][2], g4[2]; float shr[2][4];
#pragma unroll
        for (int ai = 0; ai < 2; ++ai)
#pragma unroll
            for (int m = 0; m < 4; ++m) shr[ai][m] = SH[row0 + ai * HALF + m * 16];
#pragma unroll
        for (int n = 0; n < 2; ++n) { g4[n] = *(const f32x4*)(gn + 4 * n);
#pragma unroll
            for (int bj = 0; bj < 2; ++bj) cs[bj][n] = *(const f32x4*)(SW + pn * BM + bj * HALF + wc * 32 + 8 * fq + 4 * n); }
#pragma unroll
        for (int ai = 0; ai < 2; ++ai)
#pragma unroll
            for (int m = 0; m < 4; ++m) { const int rl = ai * HALF + wr * 64 + m * 16 + fr; const float sc = shr[ai][m];
#pragma unroll
                for (int bj = 0; bj < 2; ++bj) { float ss = 0.f;
#pragma unroll
                    for (int n = 0; n < 2; ++n) { const pg8::i32x4_ ii = __builtin_bit_cast(pg8::i32x4_, acc[ai][bj][m][n]); const f32x4 x = (f32x4){(float)ii[0], (float)ii[1], (float)ii[2], (float)ii[3]} * cs[bj][n] * sc;
                        ss += (x[0] * x[0] + x[1] * x[1]) + (x[2] * x[2] + x[3] * x[3]); }
                    ss += __shfl_xor(ss, 16); ss += __shfl_xor(ss, 32);
                    if (fq == 0) XS[(rl * 2 + bj) * 4 + wc] = ss; } }
        asm volatile("s_waitcnt lgkmcnt(0)" ::: "memory"); __builtin_amdgcn_s_barrier(); asm volatile("" ::: "memory");
#pragma unroll
        for (int bj = 0; bj < 2; ++bj)
#pragma unroll
            for (int n = 0; n < 2; ++n) asm volatile("" : "+v"(cs[bj][n]));
#pragma unroll
        for (int ai = 0; ai < 2; ++ai)
#pragma unroll
            for (int m = 0; m < 4; ++m) { const int rl = ai * HALF + wr * 64 + m * 16 + fr; bf16_t* rowp = base + (size_t)(u.pm * BM + rl) * 2048 + col0; const float sc = shr[ai][m];
#pragma unroll
                for (int bj = 0; bj < 2; ++bj) { const f32x4 p = *(const LAS f32x4*)(XS + (rl * 2 + bj) * 4); const float r = sc / sqrtf(((p[0] + p[1]) + (p[2] + p[3])) * (1.f / 128.f) + EPS);
                    pg8::i32x4_ j0 = __builtin_bit_cast(pg8::i32x4_, acc[ai][bj][m][0]), j1 = __builtin_bit_cast(pg8::i32x4_, acc[ai][bj][m][1]);
                    asm volatile("" : "+v"(j0), "+v"(j1));
                    const f32x4 y0 = (f32x4){(float)j0[0], (float)j0[1], (float)j0[2], (float)j0[3]} * cs[bj][0] * g4[0] * r, y1 = (f32x4){(float)j1[0], (float)j1[1], (float)j1[2], (float)j1[3]} * cs[bj][1] * g4[1] * r;
                    u32x4 w; w.x = cvt_pk_bf16(y0[0], y0[1]); w.y = cvt_pk_bf16(y0[2], y0[3]); w.z = cvt_pk_bf16(y1[0], y1[1]); w.w = cvt_pk_bf16(y1[2], y1[3]);
                    *(u32x4*)(rowp + bj * HALF) = w; } }
    }
    __device__ __forceinline__ void operator()(const f32x4 (&acc)[2][2][4][2], const Unit& u, int wr, int wc, int fr, int fq) const {
        const int pn = u.pn; const int row0 = u.pm * BM + wr * 64 + fr;
        if (pn == 80) {
            if (wc == 0) { float* ST = (float*)(ws + WS_ST);
#pragma unroll
                for (int ai = 0; ai < 2; ++ai)
#pragma unroll
                    for (int m = 0; m < 4; ++m) { const int row = row0 + ai * HALF + m * 16; float* rp = ST + (size_t)row * 32 + 8 * fq; const float sc = SH[row]; const f32x4 c0 = *(const f32x4*)(SW + 80 * BM + 8 * fq), c1 = *(const f32x4*)(SW + 80 * BM + 8 * fq + 4);
                        const pg8::i32x4_ i0 = __builtin_bit_cast(pg8::i32x4_, acc[ai][0][m][0]), i1 = __builtin_bit_cast(pg8::i32x4_, acc[ai][0][m][1]);
                        *(f32x4*)(rp) = (f32x4){(float)i0[0], (float)i0[1], (float)i0[2], (float)i0[3]} * c0 * sc; *(f32x4*)(rp + 4) = (f32x4){(float)i1[0], (float)i1[1], (float)i1[2], (float)i1[3]} * c1 * sc; }
            }
            else asm volatile("s_waitcnt vmcnt(0)" ::: "memory");
            return;
        }
        unsigned boff; int ld, cb, mode = 0;
        if (pn < 8) { boff = 0u; ld = 2048; cb = pn * 256; }
        else if (pn < 16) { boff = (unsigned)(A_K - A_Q); ld = 2048; cb = (pn - 8) * 256; }
        else if (pn < 24) { boff = (unsigned)(A_V - A_Q); ld = 2048; cb = (pn - 16) * 256; }
        else if (pn < 28) { boff = (unsigned)(A_GQ - A_Q); ld = 1024; cb = (pn - 24) * 256; mode = 1; }
        else if (pn < 32) { boff = (unsigned)(A_GK - A_Q); ld = 1024; cb = (pn - 28) * 256; }
        else if (pn < 40) { boff = (unsigned)(A_GV - A_Q); ld = 2048; cb = (pn - 32) * 256; }
        else if (pn < 48) { boff = (unsigned)(A_GR - A_Q); ld = 2048; cb = (pn - 40) * 256; mode = 2; }
        else if (pn < 64) { boff = (unsigned)(A_SA - A_Q); ld = 4096; cb = (pn - 48) * 256; mode = 3; }
        else { boff = (unsigned)(A_SB - A_Q); ld = 4096; cb = (pn - 64) * 256; mode = 3; }
        bf16_t* base = (bf16_t*)(ws + A_Q + boff);
        const int col0 = cb + wc * 32 + 8 * fq;
        if (pn < 16) { qk_tile(acc, u, wr, wc, fr, fq, base, col0); return; }
        f32x4 cs[2][2]; float shr[2][4];
#pragma unroll
        for (int ai = 0; ai < 2; ++ai)
#pragma unroll
            for (int m = 0; m < 4; ++m) shr[ai][m] = SH[row0 + ai * HALF + m * 16];
#pragma unroll
        for (int bj = 0; bj < 2; ++bj)
#pragma unroll
            for (int n = 0; n < 2; ++n) cs[bj][n] = *(const f32x4*)(SW + pn * BM + bj * HALF + wc * 32 + 8 * fq + 4 * n);
        if (mode == 3) tile_out<3>(acc, cs, shr, base, row0, ld, col0);
        else if (mode == 2) tile_out<2>(acc, cs, shr, base, row0, ld, col0);
        else if (mode == 1) tile_out<1>(acc, cs, shr, base, row0, ld, col0);
        else tile_out<0>(acc, cs, shr, base, row0, ld, col0);
    }
    template <int MODE> __device__ __forceinline__ void tile_out(const f32x4 (&acc)[2][2][4][2], f32x4 (&cs)[2][2], const float (&shr)[2][4], bf16_t* base, int row0, int ld, int col0) const {
        if (MODE == 1 || MODE == 3) {
#pragma unroll
            for (int bj = 0; bj < 2; ++bj)
#pragma unroll
                for (int n = 0; n < 2; ++n) cs[bj][n] = cs[bj][n] * (MODE == 1 ? 0.0625f : -LOG2E); }
#pragma unroll
        for (int ai = 0; ai < 2; ++ai)
#pragma unroll
            for (int m = 0; m < 4; ++m) { const int row = row0 + ai * HALF + m * 16; bf16_t* rowp = base + (size_t)row * ld + col0; const float sc = shr[ai][m];
#pragma unroll
                for (int bj = 0; bj < 2; ++bj) { const pg8::i32x4_ i0 = __builtin_bit_cast(pg8::i32x4_, acc[ai][bj][m][0]), i1 = __builtin_bit_cast(pg8::i32x4_, acc[ai][bj][m][1]);
                    f32x4 v0 = (f32x4){(float)i0[0], (float)i0[1], (float)i0[2], (float)i0[3]} * cs[bj][0] * sc, v1 = (f32x4){(float)i1[0], (float)i1[1], (float)i1[2], (float)i1[3]} * cs[bj][1] * sc;
                    if (MODE == 2) {
#pragma unroll
                        for (int j = 0; j < 4; ++j) { v0[j] = v0[j] * sigmoidf_(v0[j]); v1[j] = v1[j] * sigmoidf_(v1[j]); } }
                    if (MODE == 3) {
                        constexpr float K = 1.f / 255.f;
#pragma unroll
                        for (int j = 0; j < 4; ++j) { v0[j] = __builtin_amdgcn_rcpf(fmaf(__builtin_amdgcn_exp2f(v0[j]), K, K)); v1[j] = __builtin_amdgcn_rcpf(fmaf(__builtin_amdgcn_exp2f(v1[j]), K, K)); }
                        unsigned g0 = 0u, g1 = 0u;
#pragma unroll
                        for (int j = 0; j < 4; ++j) { g0 = __builtin_amdgcn_cvt_pk_u8_f32(v0[j], j, g0); g1 = __builtin_amdgcn_cvt_pk_u8_f32(v1[j], j, g1); }
                        *(u32x2*)((unsigned char*)base + (size_t)row * 4096 + col0 + bj * HALF) = (u32x2){g0, g1};
                    } else {
                    u32x4 w; w.x = cvt_pk_bf16(v0[0], v0[1]); w.y = cvt_pk_bf16(v0[2], v0[3]); w.z = cvt_pk_bf16(v1[0], v1[1]); w.w = cvt_pk_bf16(v1[2], v1[3]);
                    *(u32x4*)(rowp + bj * HALF) = w; } } }
    }
};
struct EpiBranch {
    static constexpr bool PERM = true;
    static constexpr int NST = 16;
    unsigned char* ws;
    __device__ __forceinline__ void operator()(const f32x4 (&acc)[2][2][4][2], const Unit& u, int wr, int wc, int fr, int fq) const {
        const int row0 = u.pm * BM + wr * 64 + fr, col0 = u.pn * BM + wc * 32 + 8 * fq;
        const unsigned char* G = ws + (u.ps ? A_SB : A_SA); bf16_t* O = (bf16_t*)(ws + A_MRG);
        const float* SR = (const float*)(ws + WS_PRM) + (u.ps ? P_SOB : P_SOA); const float* SW = (const float*)(ws + WS_PRM) + (u.ps ? P_SWPB : P_SWPA);
        f32x4 cs[2][2];
#pragma unroll
        for (int bj = 0; bj < 2; ++bj)
#pragma unroll
            for (int n = 0; n < 2; ++n) cs[bj][n] = *(const f32x4*)(SW + col0 + bj * HALF + 4 * n) * (1.f / 255.f);
#pragma unroll
        for (int ai = 0; ai < 2; ++ai) {
            u32x2 gw[4][2]; u32x4 ow[4][2]; float sr[4];
#pragma unroll
            for (int m = 0; m < 4; ++m) { const int row = row0 + ai * HALF + m * 16; const size_t off = (size_t)row * DM + col0; sr[m] = SR[row];
#pragma unroll
                for (int bj = 0; bj < 2; ++bj) { gw[m][bj] = *(const u32x2*)(G + off + bj * HALF); if (u.ps) ow[m][bj] = *(const u32x4*)(O + off + bj * HALF); else ow[m][bj] = (u32x4){0u, 0u, 0u, 0u}; } }
#pragma unroll
            for (int m = 0; m < 4; ++m) { const size_t off = (size_t)(row0 + ai * HALF + m * 16) * DM + col0;
#pragma unroll
                for (int bj = 0; bj < 2; ++bj) { const u32x2 g = gw[m][bj]; const u32x4 o4 = ow[m][bj];
                    const pg8::i32x4_ i0 = __builtin_bit_cast(pg8::i32x4_, acc[ai][bj][m][0]), i1 = __builtin_bit_cast(pg8::i32x4_, acc[ai][bj][m][1]);
                    f32x4 v0 = (f32x4){(float)i0[0], (float)i0[1], (float)i0[2], (float)i0[3]} * cs[bj][0] * sr[m], v1 = (f32x4){(float)i1[0], (float)i1[1], (float)i1[2], (float)i1[3]} * cs[bj][1] * sr[m];
                    v0[0] = v0[0] * (float)(g.x & 0xffu) + bflo(o4.x); v0[1] = v0[1] * (float)((g.x >> 8) & 0xffu) + bfhi(o4.x); v0[2] = v0[2] * (float)((g.x >> 16) & 0xffu) + bflo(o4.y); v0[3] = v0[3] * (float)(g.x >> 24) + bfhi(o4.y);
                    v1[0] = v1[0] * (float)(g.y & 0xffu) + bflo(o4.z); v1[1] = v1[1] * (float)((g.y >> 8) & 0xffu) + bfhi(o4.z); v1[2] = v1[2] * (float)((g.y >> 16) & 0xffu) + bflo(o4.w); v1[3] = v1[3] * (float)(g.y >> 24) + bfhi(o4.w);
                    u32x4 w; w.x = cvt_pk_bf16(v0[0], v0[1]); w.y = cvt_pk_bf16(v0[2], v0[3]); w.z = cvt_pk_bf16(v1[0], v1[1]); w.w = cvt_pk_bf16(v1[2], v1[3]);
                    *(u32x4*)(O + off + bj * HALF) = w; } }
            asm volatile("" ::: "memory"); }
    }
};
struct EpiWout {
    static constexpr bool PERM = false;
    static constexpr int NST = 32;
    const float* X; bf16_t* X1B; float* RSS; const float* SM; const float* SW;
    __device__ __forceinline__ void operator()(const f32x4 (&acc)[2][2][4][2], const Unit& u, int wr, int wc, int fr, int fq) const {
        const int row0 = u.pm * BM + wr * 64 + fr, col0 = u.pn * BM + wc * 32 + 4 * fq;
        f32x4 cs[2][2];
#pragma unroll
        for (int bj = 0; bj < 2; ++bj)
#pragma unroll
            for (int n = 0; n < 2; ++n) cs[bj][n] = INT8_WOUT ? *(const f32x4*)(SW + col0 + bj * HALF + n * 16) : (f32x4){1.f, 1.f, 1.f, 1.f};
#pragma unroll
        for (int ai = 0; ai < 2; ++ai) {
            f32x4 xv[4][2][2]; float sr[4];
#pragma unroll
            for (int m = 0; m < 4; ++m) { const int row = row0 + ai * HALF + m * 16; const size_t off = (size_t)row * DM + col0; sr[m] = INT8_WOUT ? SM[row] : 1.f;
#pragma unroll
                for (int bj = 0; bj < 2; ++bj)
#pragma unroll
                    for (int n = 0; n < 2; ++n) xv[m][bj][n] = *(const f32x4*)(X + off + bj * HALF + n * 16); }
#pragma unroll
            for (int m = 0; m < 4; ++m) { const int row = row0 + ai * HALF + m * 16; const size_t off = (size_t)row * DM + col0; float ss = 0.f;
#pragma unroll
                for (int bj = 0; bj < 2; ++bj)
#pragma unroll
                    for (int n = 0; n < 2; ++n) { const pg8::i32x4_ ia = __builtin_bit_cast(pg8::i32x4_, acc[ai][bj][m][n]);
                        const f32x4 o = INT8_WOUT ? xv[m][bj][n] + (f32x4){(float)ia[0], (float)ia[1], (float)ia[2], (float)ia[3]} * cs[bj][n] * sr[m] : xv[m][bj][n] + acc[ai][bj][m][n];
                        ss += (o[0] * o[0] + o[1] * o[1]) + (o[2] * o[2] + o[3] * o[3]);
                        u32x2 w; w.x = cvt_pk_bf16(o[0], o[1]); w.y = cvt_pk_bf16(o[2], o[3]); *(u32x2*)(X1B + off + bj * HALF + n * 16) = w; }
                ss += __shfl_xor(ss, 16); ss += __shfl_xor(ss, 32);
                if (fq == 0) atomicAdd(RSS + row, ss); }
            asm volatile("" ::: "memory"); }
    }
};
struct EpiUp {
    static constexpr bool PERM = true;
    static constexpr int NST = 16;
    const float* RSS; bf16_t* FA; bf16_t* FG; const float* SX; const float* SW;
    __device__ __forceinline__ void operator()(const f32x4 (&acc)[2][2][4][2], const Unit& u, int wr, int wc, int fr, int fq) const {
        const int row0 = u.pm * BM + wr * 64 + fr, col0 = u.pn * HALF + wc * 32 + 8 * fq;
        f32x4 cs[2][2];
#pragma unroll
        for (int bj = 0; bj < 2; ++bj)
#pragma unroll
            for (int n = 0; n < 2; ++n) cs[bj][n] = *(const f32x4*)(SW + u.pn * BM + bj * HALF + wc * 32 + 8 * fq + 4 * n);
#pragma unroll
        for (int ai = 0; ai < 2; ++ai)
#pragma unroll
            for (int m = 0; m < 4; ++m) { const int row = row0 + ai * HALF + m * 16; const float rstd = __builtin_amdgcn_rsqf(RSS[row] * (1.f / DM) + EPS) * SX[row];
                const size_t off = (size_t)row * DFF + col0;
#pragma unroll
                for (int bj = 0; bj < 2; ++bj) { const pg8::i32x4_ i0 = __builtin_bit_cast(pg8::i32x4_, acc[ai][bj][m][0]), i1 = __builtin_bit_cast(pg8::i32x4_, acc[ai][bj][m][1]);
                    const f32x4 v0 = (f32x4){(float)i0[0], (float)i0[1], (float)i0[2], (float)i0[3]} * cs[bj][0] * rstd, v1 = (f32x4){(float)i1[0], (float)i1[1], (float)i1[2], (float)i1[3]} * cs[bj][1] * rstd;
                    u32x4 w; w.x = cvt_pk_bf16(v0[0], v0[1]); w.y = cvt_pk_bf16(v0[2], v0[3]); w.z = cvt_pk_bf16(v1[0], v1[1]); w.w = cvt_pk_bf16(v1[2], v1[3]);
                    *(u32x4*)((bj ? FG : FA) + off) = w; } }
    }
};
__device__ __forceinline__ float gelu_tanh_(float x) { const float uu = x * (-1.5957691216057308f * LOG2E + (-0.07135481627159145f * LOG2E) * x * x); return x * __builtin_amdgcn_rcpf(1.f + __builtin_amdgcn_exp2f(uu)); }
struct EpiUpConv {
    static constexpr bool PERM = true;
    static constexpr int NST = 16;
    unsigned char* ws; int gi; LAS float* XB;
    __device__ __forceinline__ void operator()(const f32x4 (&acc)[2][2][4][2], const Unit& u, int wr, int wc, int fr, int fq) const {
        const float* RSS = (const float*)((const unsigned*)(ws + WS_CTL) + CW_RSS) + (size_t)gi * GT; const float* SX = (const float*)(ws + WS_PRM) + P_SX + (size_t)gi * GT; const float* SW = (const float*)(ws + WS_PRM) + P_SWUP;
        const float* CW = (const float*)(ws + WS_PRM) + P_CW; const float* CB = (const float*)(ws + WS_PRM) + P_CB; unsigned char* U8 = ws + A_FG; float* HB = (float*)(ws + A_FA);
        const int lane = fq * 16 + fr, fl = wc * 32 + 8 * fq, f0 = u.pn * HALF + fl, row0 = u.pm * BM + wr * 64 + fr;
        float csa[8], csg[8];
#pragma unroll
        for (int n = 0; n < 2; ++n) { const f32x4 a4 = *(const f32x4*)(SW + u.pn * BM + fl + 4 * n), g4 = *(const f32x4*)(SW + u.pn * BM + HALF + fl + 4 * n);
#pragma unroll
            for (int i = 0; i < 4; ++i) { csa[4 * n + i] = a4[i]; csg[4 * n + i] = g4[i] * U8_SCALE; } }
        float A[2][4][8], G[2][4][8];
#pragma unroll
        for (int ai = 0; ai < 2; ++ai)
#pragma unroll
            for (int m = 0; m < 4; ++m) { const int row = row0 + ai * HALF + m * 16; const float fac = __builtin_amdgcn_rsqf(RSS[row] * (1.f / DM) + EPS) * SX[row];
#pragma unroll
                for (int n = 0; n < 2; ++n) { const pg8::i32x4_ ia = __builtin_bit_cast(pg8::i32x4_, acc[ai][0][m][n]), ig = __builtin_bit_cast(pg8::i32x4_, acc[ai][1][m][n]);
#pragma unroll
                    for (int i = 0; i < 4; ++i) { A[ai][m][4 * n + i] = (float)ia[i] * csa[4 * n + i] * fac; G[ai][m][4 * n + i] = (float)ig[i] * csg[4 * n + i] * fac; } } }
#pragma unroll
        for (int ai = 0; ai < 2; ++ai) { const int b = 2 * ai + wr;
            if (fr == 0) { *(LAS f32x4*)(XB + (2 * b) * 128 + fl) = (f32x4){A[ai][0][0], A[ai][0][1], A[ai][0][2], A[ai][0][3]}; *(LAS f32x4*)(XB + (2 * b) * 128 + fl + 4) = (f32x4){A[ai][0][4], A[ai][0][5], A[ai][0][6], A[ai][0][7]}; }
            if (fr == 15) { *(LAS f32x4*)(XB + (2 * b + 1) * 128 + fl) = (f32x4){A[ai][3][0], A[ai][3][1], A[ai][3][2], A[ai][3][3]}; *(LAS f32x4*)(XB + (2 * b + 1) * 128 + fl + 4) = (f32x4){A[ai][3][4], A[ai][3][5], A[ai][3][6], A[ai][3][7]}; } }
        { float* hb = HB + ((size_t)(u.pm * 86 + u.pn) * 6) * 128 + fl;
          if (wr == 0 && fr <= 1) { *(f32x4*)(hb + fr * 128) = (f32x4){A[0][0][0], A[0][0][1], A[0][0][2], A[0][0][3]}; *(f32x4*)(hb + fr * 128 + 4) = (f32x4){A[0][0][4], A[0][0][5], A[0][0][6], A[0][0][7]};
              if (fr == 0) { *(f32x4*)(hb + 4 * 128) = (f32x4){G[0][0][0], G[0][0][1], G[0][0][2], G[0][0][3]}; *(f32x4*)(hb + 4 * 128 + 4) = (f32x4){G[0][0][4], G[0][0][5], G[0][0][6], G[0][0][7]}; } }
          if (wr == 1 && fr >= 14) { const int sl = fr - 12;
              *(f32x4*)(hb + sl * 128) = (f32x4){A[1][3][0], A[1][3][1], A[1][3][2], A[1][3][3]}; *(f32x4*)(hb + sl * 128 + 4) = (f32x4){A[1][3][4], A[1][3][5], A[1][3][6], A[1][3][7]};
              if (fr == 15) { *(f32x4*)(hb + 5 * 128) = (f32x4){G[1][3][0], G[1][3][1], G[1][3][2], G[1][3][3]}; *(f32x4*)(hb + 5 * 128 + 4) = (f32x4){G[1][3][4], G[1][3][5], G[1][3][6], G[1][3][7]}; } } }
        asm volatile("s_waitcnt lgkmcnt(0)" ::: "memory"); __builtin_amdgcn_s_barrier(); asm volatile("" ::: "memory");
        const int src_dn = (lane & ~15) | ((fr + 1) & 15), src_up = (lane & ~15) | ((fr + 15) & 15);
#pragma unroll
        for (int n = 0; n < 2; ++n) {
            const f32x4 x0 = *(const f32x4*)(CW + f0 + 4 * n), x1 = *(const f32x4*)(CW + DFF + f0 + 4 * n), x2 = *(const f32x4*)(CW + 2 * DFF + f0 + 4 * n), xb = *(const f32x4*)(CB + f0 + 4 * n);
#pragma unroll
            for (int ai = 0; ai < 2; ++ai) { const int b = 2 * ai + wr;
                const f32x4 XP = b > 0 ? *(const LAS f32x4*)(XB + (2 * (b - 1) + 1) * 128 + fl + 4 * n) : (f32x4){0.f, 0.f, 0.f, 0.f};
                const f32x4 XN = b < 3 ? *(const LAS f32x4*)(XB + (2 * (b + 1)) * 128 + fl + 4 * n) : (f32x4){0.f, 0.f, 0.f, 0.f};
#pragma unroll
                for (int m = 0; m < 4; ++m) { const int row = row0 + ai * HALF + m * 16; float o[4];
#pragma unroll
                    for (int i = 0; i < 4; ++i) { const int j = 4 * n + i;
                        const float dn = __shfl(A[ai][m][j], src_dn), dnw = m < 3 ? __shfl(A[ai][m + 1][j], src_dn) : XN[i], nxt = fr == 15 ? dnw : dn;
                        const float up = __shfl(A[ai][m][j], src_up), upw = m > 0 ? __shfl(A[ai][m - 1][j], src_up) : XP[i], prv = fr == 0 ? upw : up;
                        const float c = prv * x0[i] + A[ai][m][j] * x1[i] + nxt * x2[i] + xb[i]; o[i] = gelu_tanh_(c) * G[ai][m][j]; }
                    int q0 = 0;
                    q0 = __builtin_amdgcn_cvt_pk_fp8_f32(sat8(o[0]), sat8(o[1]), q0, false); q0 = __builtin_amdgcn_cvt_pk_fp8_f32(sat8(o[2]), sat8(o[3]), q0, true);
                    *(unsigned*)(U8 + (size_t)row * DFF + f0 + 4 * n) = (unsigned)q0;
                    __builtin_amdgcn_sched_barrier(0); } } }
    }
};
struct EpiDown {
    static constexpr bool PERM = false;
    static constexpr int NST = 32;
    float* OUT; const bf16_t* X1B; float sc;
    __device__ __forceinline__ void operator()(const f32x4 (&acc)[2][2][4][2], const Unit& u, int wr, int wc, int fr, int fq) const {
        const int row0 = u.pm * BM + wr * 64 + fr, col0 = u.pn * BM + wc * 32 + 4 * fq;
#pragma unroll
        for (int ai = 0; ai < 2; ++ai) {
            u32x2 xw[4][2][2];
#pragma unroll
            for (int m = 0; m < 4; ++m) { const size_t off = (size_t)(row0 + ai * HALF + m * 16) * DM + col0;
#pragma unroll
                for (int bj = 0; bj < 2; ++bj)
#pragma unroll
                    for (int n = 0; n < 2; ++n) xw[m][bj][n] = *(const u32x2*)(X1B + off + bj * HALF + n * 16); }
#pragma unroll
            for (int m = 0; m < 4; ++m) { const size_t off = (size_t)(row0 + ai * HALF + m * 16) * DM + col0;
#pragma unroll
                for (int bj = 0; bj < 2; ++bj)
#pragma unroll
                    for (int n = 0; n < 2; ++n) { const u32x2 x2 = xw[m][bj][n]; const f32x4 a4 = acc[ai][bj][m][n] * sc;
                        *(f32x4*)(OUT + off + bj * HALF + n * 16) = (f32x4){bflo(x2.x) + a4[0], bfhi(x2.x) + a4[1], bflo(x2.y) + a4[2], bfhi(x2.y) + a4[3]}; } }
            asm volatile("" ::: "memory"); }
    }
};

struct Args;
__device__ __forceinline__ unsigned char* u8_ptr(const Args& a, int g);
struct Args { const float* in[25]; float* out; unsigned char* ws; int ph_lo, ph_hi, g_lo, g_hi; };
struct Frame {
    LAS unsigned char* lds; int tid, lane, wave, vcu, G;
};
__device__ __forceinline__ unsigned char* u8_ptr(const Args& a, int g) { (void)g; return FUSE_CONV ? a.ws + A_FG : (g == 0 ? (unsigned char*)(a.out + (size_t)GT * DM) : a.ws + WS_WIN); }
__device__ __forceinline__ Frame make_frame(LAS unsigned char* lds, int wave_s) {
    Frame F; F.lds = lds; F.tid = fresh_tid(wave_s); F.lane = F.tid & 63; F.wave = __builtin_amdgcn_readfirstlane(F.tid >> 6);
    F.G = fresh_grid(); { const int bx = fresh_bid(); F.vcu = (F.G % 8 == 0) ? (bx % 8) * (F.G / 8) + bx / 8 : bx; }
    return F;
}

template <int NMAP> __device__ __forceinline__ int nmap(int n) {
    if (NMAP == 1) { return n < 12288 ? n : (n < 12320 ? 20480 + (n - 12288) : n - 32); }
    if (NMAP == 2) { const int bj = n >= DFF ? 1 : 0, f = n - bj * DFF; return (f >> 7) * 256 + bj * 128 + (f & 127); }
    return n;
}
template <int NMAP> __device__ __forceinline__ void p0_transpose_item(const float* W, int N, const float* kscale, bf16_t* WT, int ldd, int koff, LAS float* scr, int kb, int nb, int lane) {
    const int k0 = 64 * kb, n0 = 64 * nb; const bool inb = (n0 + lane) < N;
#pragma unroll
    for (int i0 = 0; i0 < 64; i0 += 32) { float v[32];
#pragma unroll
        for (int i = 0; i < 32; ++i) v[i] = inb ? W[(size_t)(k0 + i0 + i) * N + n0 + lane] : 0.f;
#pragma unroll
        for (int i = 0; i < 32; ++i) { float t = v[i]; if (kscale) t *= kscale[k0 + i0 + i]; scr[(i0 + i) * 65 + lane] = t; } }
    asm volatile("s_waitcnt lgkmcnt(0)" ::: "memory");
    const int c = lane & 7;
#pragma unroll
    for (int j = 0; j < 8; ++j) { const int nl = (lane >> 3) + 8 * j; const int n = n0 + nl; const LAS float* s = scr + (8 * c) * 65 + nl;
        u32x4 o; o.x = cvt_pk_bf16(s[0 * 65], s[1 * 65]); o.y = cvt_pk_bf16(s[2 * 65], s[3 * 65]); o.z = cvt_pk_bf16(s[4 * 65], s[5 * 65]); o.w = cvt_pk_bf16(s[6 * 65], s[7 * 65]);
        if (n < N) *(u32x4*)(WT + (size_t)nmap<NMAP>(n) * ldd + koff + k0 + 8 * c) = o; }
    asm volatile("s_waitcnt lgkmcnt(0)" ::: "memory");
}
__device__ __forceinline__ void p0_colmax(const Frame& F, const float* W, int K, int N, const float* kscale, unsigned* out) {
    const int gw = F.vcu * NWAVES + F.wave, NGW = F.G * NWAVES; const int nnb = (N + 255) / 256, nt = (K / 64) * nnb;
    for (int t = gw; t < nt; t += NGW) { const int kb = t / nnb, nb = t - kb * nnb, n = nb * 256 + 4 * F.lane; if (n >= N) continue;
        f32x4 mx = {0.f, 0.f, 0.f, 0.f};
#pragma unroll 16
        for (int i = 0; i < 64; ++i) { const int k = kb * 64 + i; const float ks = kscale ? fabsf(kscale[k]) : 1.f; const f32x4 v = *(const f32x4*)(W + (size_t)k * N + n);
            mx[0] = fmaxf(mx[0], fabsf(v[0]) * ks); mx[1] = fmaxf(mx[1], fabsf(v[1]) * ks); mx[2] = fmaxf(mx[2], fabsf(v[2]) * ks); mx[3] = fmaxf(mx[3], fabsf(v[3]) * ks); }
#pragma unroll
        for (int j = 0; j < 4; ++j) atomicMax(out + n + j, __float_as_uint(mx[j])); }
}
__device__ __forceinline__ void p0_absmax(const Frame& F, const float* W, int K, int N, const float* kscale, unsigned* out) {
    const int gw = F.vcu * NWAVES + F.wave, NGW = F.G * NWAVES; float mx = 0.f;
    for (int k = gw; k < K; k += NGW) { const float ks = kscale ? kscale[k] : 1.f; const f32x4* row = (const f32x4*)(W + (size_t)k * N);
        for (int i = F.lane; i < N / 4; i += 64) { const f32x4 v = row[i]; mx = fmaxf(mx, fmaxf(fmaxf(fabsf(v[0]), fabsf(v[1])), fmaxf(fabsf(v[2]), fabsf(v[3]))) * fabsf(ks)); } }
#pragma unroll
    for (int o = 1; o < 64; o <<= 1) mx = fmaxf(mx, __shfl_xor(mx, o));
    if (F.lane == 0) atomicMax(out, __float_as_uint(mx));
}
template <int NMAP> __device__ __forceinline__ void p0_transpose_item_i8(const float* W, int N, const float* kscale, const unsigned* cmax, unsigned char* WT8, int ldd, int koff, LAS float* scr, int kb, int nb, int lane) {
    const int k0 = 64 * kb, n0 = 64 * nb; const bool inb = (n0 + lane) < N;
    const float qs = inb ? 127.f / fmaxf(__uint_as_float(__hip_atomic_load(cmax + n0 + lane, __ATOMIC_RELAXED, __HIP_MEMORY_SCOPE_AGENT)), 1e-30f) : 0.f;
#pragma unroll
    for (int i0 = 0; i0 < 64; i0 += 32) { float v[32];
#pragma unroll
        for (int i = 0; i < 32; ++i) v[i] = inb ? W[(size_t)(k0 + i0 + i) * N + n0 + lane] : 0.f;
#pragma unroll
        for (int i = 0; i < 32; ++i) { float t = v[i] * qs; if (kscale) t *= kscale[k0 + i0 + i]; scr[(i0 + i) * 65 + lane] = t; } }
    asm volatile("s_waitcnt lgkmcnt(0)" ::: "memory");
    const int c = lane & 7;
#pragma unroll
    for (int j = 0; j < 8; ++j) { const int nl = (lane >> 3) + 8 * j; const LAS float* s = scr + (8 * c) * 65 + nl;
        const unsigned w0 = pack_i8x4(s[0 * 65], s[1 * 65], s[2 * 65], s[3 * 65]), w1 = pack_i8x4(s[4 * 65], s[5 * 65], s[6 * 65], s[7 * 65]);
        if (n0 + nl < N) *(u32x2*)(WT8 + (size_t)nmap<NMAP>(n0 + nl) * ldd + koff + k0 + 8 * c) = (u32x2){w0, w1}; }
    asm volatile("s_waitcnt lgkmcnt(0)" ::: "memory");
}
template <int NMAP> __device__ __forceinline__ void p0_transpose_item_fp8(const float* W, int N, unsigned char* WT8, int ldd, LAS float* scr, int kb, int nb, int lane) {
    const int k0 = 64 * kb, n0 = 64 * nb; const bool inb = (n0 + lane) < N;
#pragma unroll
    for (int i0 = 0; i0 < 64; i0 += 32) { float v[32];
#pragma unroll
        for (int i = 0; i < 32; ++i) v[i] = inb ? W[(size_t)(k0 + i0 + i) * N + n0 + lane] : 0.f;
#pragma unroll
        for (int i = 0; i < 32; ++i) scr[(i0 + i) * 65 + lane] = sat8(v[i] * W8_SCALE); }
    asm volatile("s_waitcnt lgkmcnt(0)" ::: "memory");
    const int c = lane & 7;
#pragma unroll
    for (int j = 0; j < 8; ++j) { const int nl = (lane >> 3) + 8 * j; const LAS float* s = scr + (8 * c) * 65 + nl;
        int w0 = 0, w1 = 0;
        w0 = __builtin_amdgcn_cvt_pk_fp8_f32(s[0 * 65], s[1 * 65], w0, false); w0 = __builtin_amdgcn_cvt_pk_fp8_f32(s[2 * 65], s[3 * 65], w0, true);
        w1 = __builtin_amdgcn_cvt_pk_fp8_f32(s[4 * 65], s[5 * 65], w1, false); w1 = __builtin_amdgcn_cvt_pk_fp8_f32(s[6 * 65], s[7 * 65], w1, true);
        if (n0 + nl < N) *(u32x2*)(WT8 + (size_t)nmap<NMAP>(n0 + nl) * ldd + k0 + 8 * c) = (u32x2){(unsigned)w0, (unsigned)w1}; }
    asm volatile("s_waitcnt lgkmcnt(0)" ::: "memory");
}
__device__ __forceinline__ void p0_weights(const Frame& F, const Args& a) {
    unsigned char* ws = a.ws;
    LAS float* scr = (LAS float*)(F.lds + F.wave * 16640);
    const int gw = F.vcu * NWAVES + F.wave, NGW = F.G * NWAVES;
    constexpr int I_IN = 64 * 321, I_UP = 64 * 344, I_DN = 172 * 64, I_OUT = 64 * 64, I_PA = 32 * 64, I_PB = 32 * 64;
    constexpr int NITEMS = I_IN + I_UP + I_DN + I_OUT + I_PA + I_PB;
    { float* prm = (float*)(ws + WS_PRM); const int gt = F.vcu * NTHR + F.tid, ngt = F.G * NTHR; const unsigned* ctl = (const unsigned*)(ws + WS_CTL);
      for (int n = gt; n < 2 * DFF; n += ngt) prm[P_SWUP + nmap<2>(n)] = __uint_as_float(__hip_atomic_load(ctl + CW_CMAX_UP + n, __ATOMIC_RELAXED, __HIP_MEMORY_SCOPE_AGENT)) * (1.f / 127.f);
      for (int n = gt; n < DM; n += ngt) { prm[P_SWPA + n] = __uint_as_float(__hip_atomic_load(ctl + CW_CMAX_PA + n, __ATOMIC_RELAXED, __HIP_MEMORY_SCOPE_AGENT)) * (1.f / 127.f);
          prm[P_SWPB + n] = __uint_as_float(__hip_atomic_load(ctl + CW_CMAX_PB + n, __ATOMIC_RELAXED, __HIP_MEMORY_SCOPE_AGENT)) * (1.f / 127.f);
          prm[P_SWWO + n] = __uint_as_float(__hip_atomic_load(ctl + CW_CMAX_WO + n, __ATOMIC_RELAXED, __HIP_MEMORY_SCOPE_AGENT)) * (1.f / 127.f); }
      for (int n = gt; n < DINP; n += ngt) { if (n < DIN) prm[P_SWIN + nmap<1>(n)] = __uint_as_float(__hip_atomic_load(ctl + CW_CMAX_IN + n, __ATOMIC_RELAXED, __HIP_MEMORY_SCOPE_AGENT)) * (1.f / 127.f); else prm[P_SWIN + n] = 0.f; } }
    for (int it = gw; it < NITEMS; it += NGW) {
        int r = it;
        if (r < I_IN) { p0_transpose_item_i8<1>(a.in[4], DIN, nullptr, (const unsigned*)(ws + WS_CTL) + CW_CMAX_IN, ws + WS_WIN, DM, 0, scr, r / 321, r % 321, F.lane); continue; } r -= I_IN;
        if (r < I_UP) { p0_transpose_item_i8<2>(a.in[21], 2 * DFF, a.in[20], (const unsigned*)(ws + WS_CTL) + CW_CMAX_UP, ws + WS_WUP, DM, 0, scr, r / 344, r % 344, F.lane); continue; } r -= I_UP;
        if (r < I_DN) { p0_transpose_item_fp8<0>(a.in[24], DM, ws + WS_WDN, DFF, scr, r / 64, r % 64, F.lane); continue; } r -= I_DN;
        if (r < I_OUT) { if (INT8_WOUT) p0_transpose_item_i8<0>(a.in[19], DM, nullptr, (const unsigned*)(ws + WS_CTL) + CW_CMAX_WO, ws + WS_WOUT, DM, 0, scr, r / 64, r % 64, F.lane);
                         else p0_transpose_item<0>(a.in[19], DM, nullptr, (bf16_t*)(ws + WS_WOUT), DM, 0, scr, r / 64, r % 64, F.lane); continue; } r -= I_OUT;
        if (r < I_PA) { p0_transpose_item_i8<0>(a.in[17], DM, nullptr, (const unsigned*)(ws + WS_CTL) + CW_CMAX_PA, ws + WS_WPAB, DM, 0, scr, r / 64, r % 64, F.lane); continue; } r -= I_PA;
        p0_transpose_item_i8<0>(a.in[18], DM, nullptr, (const unsigned*)(ws + WS_CTL) + CW_CMAX_PB, ws + WS_WPAB, DM, 2048, scr, r / 64, r % 64, F.lane);
    }
    { u32x4* z = (u32x4*)(ws + WS_WIN + (size_t)DIN * DM);
      for (int i = gw * 64 + F.lane; i < 224 * 256; i += NGW * 64) z[i] = (u32x4){0u, 0u, 0u, 0u}; }
    { float* prm = (float*)(ws + WS_PRM); const int gt = F.vcu * NTHR + F.tid, ngt = F.G * NTHR;
      for (int i = gt; i < 4096; i += ngt) prm[P_GMIX + i] = a.in[3][i];
      for (int i = gt; i < 128; i += ngt) { prm[P_QG + i] = a.in[5][i]; prm[P_KG + i] = a.in[6][i]; }
      for (int i = gt; i < 256; i += ngt) { prm[P_SUBLN + i] = a.in[11][i]; prm[P_RB + i] = a.in[2][i]; }
      for (int i = gt; i < 16384; i += ngt) { prm[P_WGF + i] = a.in[12][i]; prm[P_WGB + i] = a.in[14][i]; }
      for (int i = gt; i < 1024; i += ngt) { prm[P_BGF + i] = a.in[13][i]; prm[P_BGB + i] = a.in[15][i]; }
      for (int i = gt; i < 512; i += ngt) prm[P_GLAG + i] = a.in[16][i];
      for (int i = gt; i < 3 * DFF; i += ngt) prm[P_CW + i] = a.in[22][i];
      for (int i = gt; i < DFF; i += ngt) prm[P_CB + i] = a.in[23][i]; }
    if (fresh_bid() == 0 && F.wave == 0) {
        float s1 = 0.f, s2 = 0.f;
        for (int i = F.lane; i < 128; i += 64) { s1 += a.in[7][i] * a.in[8][i]; s2 += a.in[9][i] * a.in[10][i]; }
        s1 = wave_sum(s1); s2 = wave_sum(s2);
        if (F.lane == 0) ((float*)(ws + WS_PRM))[P_LAM] = expf(s1) - expf(s2) + 0.2f;
    }
}
__device__ __forceinline__ void p1_hnorm(const Frame& F, const float* x, const float* gm, unsigned char* HQ, float* SH) {
    const int gw = F.vcu * NWAVES + F.wave, NGW = F.G * NWAVES;
    for (int m = gw; m < GT; m += NGW) {
        const f32x4* xr = (const f32x4*)(x + (size_t)m * DM) + F.lane; const f32x4* gr = (const f32x4*)gm + F.lane;
        f32x4 v[16]; float s = 0.f;
#pragma unroll
        for (int j = 0; j < 16; ++j) { v[j] = xr[64 * j]; s += (v[j][0] * v[j][0] + v[j][1] * v[j][1]) + (v[j][2] * v[j][2] + v[j][3] * v[j][3]); }
        const float rstd = 1.f / sqrtf(wave_sum(s) * (1.f / DM) + EPS); float mx = 0.f;
#pragma unroll
        for (int j = 0; j < 16; ++j) { v[j] = v[j] * gr[64 * j]; mx = fmaxf(mx, fmaxf(fmaxf(fabsf(v[j][0]), fabsf(v[j][1])), fmaxf(fabsf(v[j][2]), fabsf(v[j][3])))); }
#pragma unroll
        for (int o = 1; o < 64; o <<= 1) mx = fmaxf(mx, __shfl_xor(mx, o));
        mx = fmaxf(mx, 1e-30f); const float qs = 127.f / mx;
        unsigned* o8 = (unsigned*)(HQ + (size_t)m * DM) + F.lane;
#pragma unroll
        for (int j = 0; j < 16; ++j) o8[64 * j] = pack_i8x4(v[j][0] * qs, v[j][1] * qs, v[j][2] * qs, v[j][3] * qs);
        if (F.lane == 0) SH[m] = mx * rstd * (1.f / 127.f);
    }
}
__device__ __forceinline__ void p7b_quant_x1(const Frame& F, const bf16_t* X1B, unsigned char* X1Q, float* SX) {
    const int gw = F.vcu * NWAVES + F.wave, NGW = F.G * NWAVES;
    for (int m = gw; m < GT; m += NGW) {
        const u32x4* xr = (const u32x4*)(X1B + (size_t)m * DM) + F.lane; u32x4 w[8]; float mx = 0.f;
#pragma unroll
        for (int j = 0; j < 8; ++j) { w[j] = xr[64 * j]; mx = fmaxf(mx, fmaxf(fmaxf(fmaxf(fabsf(bflo(w[j].x)), fabsf(bfhi(w[j].x))), fmaxf(fabsf(bflo(w[j].y)), fabsf(bfhi(w[j].y)))), fmaxf(fmaxf(fabsf(bflo(w[j].z)), fabsf(bfhi(w[j].z))), fmaxf(fabsf(bflo(w[j].w)), fabsf(bfhi(w[j].w)))))); }
#pragma unroll
        for (int o = 1; o < 64; o <<= 1) mx = fmaxf(mx, __shfl_xor(mx, o));
        mx = fmaxf(mx, 1e-30f); const float qs = 127.f / mx;
        u32x2* o8 = (u32x2*)(X1Q + (size_t)m * DM) + F.lane;
#pragma unroll
        for (int j = 0; j < 8; ++j) o8[64 * j] = (u32x2){pack_i8x4(bflo(w[j].x) * qs, bfhi(w[j].x) * qs, bflo(w[j].y) * qs, bfhi(w[j].y) * qs), pack_i8x4(bflo(w[j].z) * qs, bfhi(w[j].z) * qs, bflo(w[j].w) * qs, bfhi(w[j].w) * qs)};
        if (F.lane == 0) SX[m] = mx * (1.f / 127.f);
    }
}
__device__ __forceinline__ void p3_qknorm(const Frame& F, bf16_t* Q, bf16_t* K, const float* gq, const float* gk) {
    const int gw = F.vcu * NWAVES + F.wave, NGW = F.G * NWAVES;
    const int gi = (F.lane & 15) * 8;
    float gqv[8], gkv[8];
#pragma unroll
    for (int e = 0; e < 8; ++e) { gqv[e] = gq[gi + e]; gkv[e] = gk[gi + e]; }
    for (int m = gw; m < 2 * GT; m += NGW) {
        const bool isk = m >= GT; bf16_t* row = (isk ? K : Q) + (size_t)(isk ? m - GT : m) * 2048;
#pragma unroll
        for (int i = 0; i < 4; ++i) {
            u32x4* p = (u32x4*)(row + i * 512) + F.lane; const u32x4 w = *p;
            float v[8] = {bflo(w.x), bfhi(w.x), bflo(w.y), bfhi(w.y), bflo(w.z), bfhi(w.z), bflo(w.w), bfhi(w.w)};
            float s = 0.f;
#pragma unroll
            for (int e = 0; e < 8; ++e) s += v[e] * v[e];
            s += __shfl_xor(s, 1); s += __shfl_xor(s, 2); s += __shfl_xor(s, 4); s += __shfl_xor(s, 8);
            const float r = 1.f / sqrtf(s * (1.f / 128.f) + EPS);
#pragma unroll
            for (int e = 0; e < 8; ++e) v[e] = v[e] * r * (isk ? gkv[e] : gqv[e]);
            u32x4 o; o.x = cvt_pk_bf16(v[0], v[1]); o.y = cvt_pk_bf16(v[2], v[3]); o.z = cvt_pk_bf16(v[4], v[5]); o.w = cvt_pk_bf16(v[6], v[7]);
            *p = o;
        }
    }
}

constexpr int LQ = 264;
constexpr int LS = 72;
constexpr int G1_QD = 0, G1_KI = 64 * LQ * 2, G1_VT = 2 * 64 * LQ * 2, G1_ATT = G1_VT + 256 * LS * 2, G1_ST = G1_ATT + 64 * LS * 2, G1_TOT = G1_ST + 64 * 16 * 4, G1_END = G1_TOT + 2 * 256 * 4;
static_assert(G1_END <= LDS_MISC, "G1 LDS");
struct GlaT { const bf16_t *GQ, *GK, *GV; const float* ST; const float *wgf, *bgf, *wgb, *bgb; bf16_t *QD, *KDT, *OI, *ATT; float* DEC; unsigned* dg; };
__device__ __forceinline__ void gla_g1_item(const Frame& F, const GlaT& T, int item, int TT) {
    LAS unsigned char* lds = F.lds;
    const int NCH = TT / 64;
    const int n = item % NCH; int r_ = item / NCH; const int dir = r_ & 1; r_ >>= 1; const int h = r_ & 3; const int b = r_ >> 2;
    const int tok0 = b * TT + n * 64, cg = tok0 >> 6;
    const int tid = F.tid, d = tid & 255, half = tid >> 8;
#if MK_DIAG
    if (tid == 0) atomicOr(T.dg, 32u);
#endif
    LAS bf16_t* qd_l = (LAS bf16_t*)(lds + G1_QD); LAS bf16_t* ki_l = (LAS bf16_t*)(lds + G1_KI); LAS bf16_t* vT_l = (LAS bf16_t*)(lds + G1_VT);
    LAS bf16_t* att_l = (LAS bf16_t*)(lds + G1_ATT); LAS float* st_l = (LAS float*)(lds + G1_ST); LAS float* tot_l = (LAS float*)(lds + G1_TOT);
    const float* wg = dir ? T.wgb : T.wgf; const float* bg = dir ? T.bgb : T.bgf;
    float wgr[16];
#pragma unroll
    for (int j = 0; j < 16; ++j) wgr[j] = wg[j * 1024 + h * 256 + d];
    const float bias = bg[h * 256 + d];
    const bf16_t* gqp = T.GQ + (size_t)tok0 * 1024 + h * 256; const bf16_t* gkp = T.GK + (size_t)tok0 * 1024 + h * 256;
    unsigned o32 = (unsigned)(half * 32 * 1024 + d); asm volatile("" : "+v"(o32));
    bf16_t qraw[32], kraw[32];
#pragma unroll
    for (int rr = 0; rr < 32; ++rr) { qraw[rr] = gqp[o32 + (unsigned)(rr * 1024)]; kraw[rr] = gkp[o32 + (unsigned)(rr * 1024)]; }
    if (tid < 256) { const int r = tid >> 2, j4 = (tid & 3) * 4; const f32x4 sv = *(const f32x4*)(T.ST + (size_t)(tok0 + r) * 32 + dir * 16 + j4); *(LAS f32x4*)(st_l + r * 16 + j4) = sv;
#if MK_DIAG
        if (!(fabsf(sv[0]) <= 20.f && fabsf(sv[1]) <= 20.f && fabsf(sv[2]) <= 20.f && fabsf(sv[3]) <= 20.f)) atomicOr(T.dg, 16u);
#endif
    }
    __syncthreads();
    float bl[32];
#pragma unroll
    for (int rr = 0; rr < 32; ++rr) { const int r = half * 32 + rr; float x = bias;
#pragma unroll
        for (int j4 = 0; j4 < 4; ++j4) { const f32x4 s = *(const LAS f32x4*)(st_l + r * 16 + j4 * 4); x += s[0] * wgr[j4 * 4] + s[1] * wgr[j4 * 4 + 1] + s[2] * wgr[j4 * 4 + 2] + s[3] * wgr[j4 * 4 + 3]; }
#if MK_DIAG
        if (!(fabsf(x) <= 50.f)) atomicOr(T.dg, 1u);
#endif
        const float ax = fabsf(x); const float ls = fminf(x, 0.f) - __logf(1.f + __expf(-ax));
        bl[rr] = ls * 0.0625f; if ((rr & 3) == 3) __builtin_amdgcn_sched_barrier(0); }
    float run = 0.f;
    if (dir == 0) {
#pragma unroll
        for (int rr = 0; rr < 32; ++rr) { run += bl[rr]; bl[rr] = run; }
    } else {
#pragma unroll
        for (int rr = 31; rr >= 0; --rr) { run += bl[rr]; bl[rr] = run; }
    }
    tot_l[half * 256 + d] = run;
    __syncthreads();
    const float other = tot_l[(1 - half) * 256 + d]; const float blast = run + other;
    const float addv = ((dir == 0) ? (half == 1) : (half == 0)) ? other : 0.f;
    const float elast = __expf(blast);
    const int gbase = (cg * 4 + h) * 2 + dir;
    if (half == 0) T.DEC[(size_t)gbase * 256 + d] = elast;
    unsigned kdp[16];
    bf16_t* qdp = T.QD + ((size_t)tok0 * 2 + dir) * 1024 + h * 256;
    const unsigned o32q = (unsigned)(half * 32 * 2048 + d);
#pragma unroll
    for (int rr = 0; rr < 32; rr += 2) {
        unsigned od = o32q; asm volatile("" : "+v"(od));
        float kd2[2];
#pragma unroll
        for (int e = 0; e < 2; ++e) { const int r = half * 32 + rr + e; const float bb = bl[rr + e] + addv; const float eb = __expf(bb), ieb = __builtin_amdgcn_rcpf(eb);
            const float qv = bf2f(qraw[rr + e]), kv = bf2f(kraw[rr + e]);
            const bf16_t qdb = f2bf(qv * eb); const float ki = kv * ieb;
#if MK_DIAG
            if (!(fabsf(ki) <= 1e30f)) atomicOr(T.dg, 2u);
#endif
            qd_l[r * LQ + d] = qdb; ki_l[r * LQ + d] = f2bf(ki);
            qdp[od + (unsigned)((rr + e) * 2048)] = qdb;
            kd2[e] = ki * elast; }
        kdp[rr >> 1] = cvt_pk_bf16(kd2[0], kd2[1]); if ((rr & 6) == 6) __builtin_amdgcn_sched_barrier(0);
    }
    { u32x4* kp = (u32x4*)(T.KDT + ((size_t)gbase * 256 + d) * 64 + half * 32);
#pragma unroll
      for (int i = 0; i < 4; ++i) kp[i] = (u32x4){kdp[4 * i], kdp[4 * i + 1], kdp[4 * i + 2], kdp[4 * i + 3]}; }
    __syncthreads();
    const int lane = F.lane, fr = lane & 15, fq = lane >> 4;
#pragma unroll
    for (int i = 0; i < 2; ++i) { const int id = F.wave * 2 + i, mt = id >> 2, nt = id & 3; f32x4 acc = {0.f, 0.f, 0.f, 0.f};
#pragma unroll
        for (int k0 = 0; k0 < 256; k0 += 32) { const bf16x8 av = *(const LAS bf16x8*)(qd_l + (16 * mt + fr) * LQ + k0 + 8 * fq); const bf16x8 bv = *(const LAS bf16x8*)(ki_l + (16 * nt + fr) * LQ + k0 + 8 * fq);
            acc = __builtin_amdgcn_mfma_f32_16x16x32_bf16(av, bv, acc, 0, 0, 0); }
#pragma unroll
        for (int j = 0; j < 4; ++j) { const int c = 16 * mt + 4 * fq + j, s = 16 * nt + fr; const bool keep = dir == 0 ? (s <= c) : (s >= c); att_l[c * LS + s] = f2bf(keep ? acc[j] : 0.f);
#if MK_DIAG
            if (keep && !(fabsf(acc[j]) <= 1e4f)) atomicOr(T.dg, 4u);
#endif
        } }
    __syncthreads();
    { const int c = tid >> 3, ch = tid & 7; *(u32x4*)(T.ATT + (size_t)gbase * 4096 + c * 64 + ch * 8) = *(const LAS u32x4*)(att_l + c * LS + ch * 8); }
    __syncthreads();
}

constexpr int LR = 68;
constexpr int G2_QD = 0, G2_KT = 64 * LQ * 2, G2_VT = G2_KT + 256 * LS * 2, G2_DEC = G2_VT + 64 * LS * 2, G2_RED = G2_DEC + 1024, G2_ATT = G2_RED + 2 * 64 * LR * 4, G2_END = G2_ATT + 64 * LS * 2;
static_assert(G2_END <= LDS_MISC, "G2 LDS");
__device__ __forceinline__ void gla_g2_item(const Frame& F, const GlaT& T, int item, int TT) {
    LAS unsigned char* lds = F.lds;
    const int NCH = TT / 64;
    const int vs = item & 7; int r_ = item >> 3; const int dir = r_ & 1; r_ >>= 1; const int h = r_ & 3; const int b = r_ >> 2;
    int tid_l = F.tid; asm volatile("" : "+v"(tid_l));
    const int tid = tid_l, lane = tid & 63, fr = lane & 15, fq = lane >> 4, vt = F.wave & 3, dh = F.wave >> 2;
    LAS bf16_t* qd_l = (LAS bf16_t*)(lds + G2_QD); LAS bf16_t* kT_l = (LAS bf16_t*)(lds + G2_KT); LAS bf16_t* vT_l = (LAS bf16_t*)(lds + G2_VT);
    LAS float* dec_l = (LAS float*)(lds + G2_DEC); LAS float* red_l = (LAS float*)(lds + G2_RED); LAS bf16_t* at_l = (LAS bf16_t*)(lds + G2_ATT);
    f32x4 S[8];
#pragma unroll
    for (int i = 0; i < 8; ++i) S[i] = (f32x4){0.f, 0.f, 0.f, 0.f};
    u32x4 pq[2][4], pk[2][4], pv[2], po[2]; float pd[2] = {0.f, 0.f};
#define G2_PREFETCH(SET, STEP) do { const int n_ = dir ? (NCH - 1 - (STEP)) : (STEP); const int tk_ = b * TT + n_ * 64; const int gb_ = ((tk_ >> 6) * 4 + h) * 2 + dir; \
        _Pragma("unroll") for (int i = 0; i < 4; ++i) { const int id = tid + 512 * i; \
            pq[SET][i] = *(const u32x4*)(T.QD + ((size_t)(tk_ + (id >> 5)) * 2 + dir) * 1024 + h * 256 + (id & 31) * 8); \
            pk[SET][i] = *(const u32x4*)(T.KDT + ((size_t)gb_ * 256 + (id >> 3)) * 64 + (id & 7) * 8); } \
        pv[SET] = *(const u32x4*)(T.GV + (size_t)(tk_ + (tid >> 3)) * 2048 + h * 512 + vs * 64 + (tid & 7) * 8); \
        po[SET] = *(const u32x4*)(T.ATT + (size_t)gb_ * 4096 + (tid >> 3) * 64 + (tid & 7) * 8); \
        if (tid < 256) pd[SET] = T.DEC[(size_t)gb_ * 256 + tid]; } while (0)
    G2_PREFETCH(0, 0); G2_PREFETCH(1, 1);
#pragma nounroll
    for (int st2 = 0; st2 < NCH; st2 += 2) {
#pragma unroll
      for (int SET = 0; SET < 2; ++SET) { const int st = st2 + SET;
        const int n = dir ? (NCH - 1 - st) : st; const int tok0 = b * TT + n * 64;
#pragma unroll
        for (int i = 0; i < 4; ++i) { const int id = tid + 512 * i; *(LAS u32x4*)(qd_l + (id >> 5) * LQ + (id & 31) * 8) = pq[SET][i]; *(LAS u32x4*)(kT_l + (id >> 3) * LS + (id & 7) * 8) = pk[SET][i]; }
        { const int s = tid >> 3, cc = tid & 7; const u32x4 w = pv[SET];
            LAS bf16_t* vp = vT_l + (cc * 8) * LS + s;
            vp[0 * LS] = (bf16_t)(w.x & 0xffff); vp[1 * LS] = (bf16_t)(w.x >> 16); vp[2 * LS] = (bf16_t)(w.y & 0xffff); vp[3 * LS] = (bf16_t)(w.y >> 16);
            vp[4 * LS] = (bf16_t)(w.z & 0xffff); vp[5 * LS] = (bf16_t)(w.z >> 16); vp[6 * LS] = (bf16_t)(w.w & 0xffff); vp[7 * LS] = (bf16_t)(w.w >> 16); }
        if (tid < 256) dec_l[tid] = pd[SET];
        *(LAS u32x4*)(at_l + (tid >> 3) * LS + (tid & 7) * 8) = po[SET];
        __syncthreads();
        if (st + 2 < NCH) { if (SET == 0) G2_PREFETCH(0, st + 2); else G2_PREFETCH(1, st + 2); }
        bf16x8 sb[4];
#pragma unroll
        for (int kb = 0; kb < 4; ++kb) { u32x4 w; w.x = cvt_pk_bf16(S[2 * kb][0], S[2 * kb][1]); w.y = cvt_pk_bf16(S[2 * kb][2], S[2 * kb][3]); w.z = cvt_pk_bf16(S[2 * kb + 1][0], S[2 * kb + 1][1]); w.w = cvt_pk_bf16(S[2 * kb + 1][2], S[2 * kb + 1][3]);
            sb[kb] = __builtin_bit_cast(bf16x8, w); }
        { bf16x8 av[4][4];
#pragma unroll
          for (int mt = 0; mt < 4; ++mt)
#pragma unroll
              for (int kb = 0; kb < 4; ++kb) { const LAS bf16_t* ap = qd_l + (16 * mt + fr) * LQ + 128 * dh + 32 * kb + 4 * fq;
                  const s16x4 lo = *(const LAS s16x4*)(ap), hi = *(const LAS s16x4*)(ap + 16);
                  av[mt][kb] = __builtin_shufflevector(lo, hi, 0, 1, 2, 3, 4, 5, 6, 7); }
          bf16x8 ia[2][2], ib[2];
#pragma unroll
          for (int ks = 0; ks < 2; ++ks) { ib[ks] = *(const LAS bf16x8*)(vT_l + (16 * vt + fr) * LS + 32 * ks + 8 * fq);
#pragma unroll
              for (int j = 0; j < 2; ++j) ia[j][ks] = *(const LAS bf16x8*)(at_l + (16 * (2 * dh + j) + fr) * LS + 32 * ks + 8 * fq); }
          f32x4 acc[4], ai[2];
#pragma unroll
          for (int mt = 0; mt < 4; ++mt) acc[mt] = (f32x4){0.f, 0.f, 0.f, 0.f};
          ai[0] = (f32x4){0.f, 0.f, 0.f, 0.f}; ai[1] = (f32x4){0.f, 0.f, 0.f, 0.f};
#pragma unroll
          for (int kb = 0; kb < 4; ++kb)
#pragma unroll
              for (int mt = 0; mt < 4; ++mt) acc[mt] = __builtin_amdgcn_mfma_f32_16x16x32_bf16(av[mt][kb], sb[kb], acc[mt], 0, 0, 0);
#pragma unroll
          for (int ks = 0; ks < 2; ++ks)
#pragma unroll
              for (int j = 0; j < 2; ++j) ai[j] = __builtin_amdgcn_mfma_f32_16x16x32_bf16(ia[j][ks], ib[ks], ai[j], 0, 0, 0);
#pragma unroll
          for (int mt = 0; mt < 4; ++mt) { const bool mine = (mt >> 1) == dh; const f32x4 add = ai[mt & 1];
#pragma unroll
              for (int j = 0; j < 4; ++j) red_l[(dh * 64 + 16 * mt + 4 * fq + j) * LR + 16 * vt + fr] = acc[mt][j] + (mine ? add[j] : 0.f); } }
        { const bf16x8 b0 = *(const LAS bf16x8*)(vT_l + (16 * vt + fr) * LS + 8 * fq), b1 = *(const LAS bf16x8*)(vT_l + (16 * vt + fr) * LS + 32 + 8 * fq);
#pragma unroll
          for (int i = 0; i < 8; ++i) { const int drow = 128 * dh + 16 * i; const f32x4 dc = *(const LAS f32x4*)(dec_l + drow + 4 * fq);
              S[i] = S[i] * dc;
              const bf16x8 a0 = *(const LAS bf16x8*)(kT_l + (drow + fr) * LS + 8 * fq), a1 = *(const LAS bf16x8*)(kT_l + (drow + fr) * LS + 32 + 8 * fq);
              S[i] = __builtin_amdgcn_mfma_f32_16x16x32_bf16(a0, b0, S[i], 0, 0, 0); S[i] = __builtin_amdgcn_mfma_f32_16x16x32_bf16(a1, b1, S[i], 0, 0, 0); } }
        __syncthreads();
        { const int c = tid >> 3, v8 = (tid & 7) * 8; bf16_t* op = T.OI + ((size_t)dir * GT + tok0 + c) * 2048 + h * 512 + vs * 64 + v8;
          const f32x4 r0 = *(const LAS f32x4*)(red_l + c * LR + v8) + *(const LAS f32x4*)(red_l + (64 + c) * LR + v8);
          const f32x4 r1 = *(const LAS f32x4*)(red_l + c * LR + v8 + 4) + *(const LAS f32x4*)(red_l + (64 + c) * LR + v8 + 4);
          u32x4 w; w.x = cvt_pk_bf16(r0[0], r0[1]); w.y = cvt_pk_bf16(r0[2], r0[3]); w.z = cvt_pk_bf16(r1[0], r1[1]); w.w = cvt_pk_bf16(r1[2], r1[3]);
          *(u32x4*)op = w; }
      }
    }
    __syncthreads();
#undef G2_PREFETCH
}

namespace att {
constexpr int D = 128, NW = 8, QBLK = 32, KVBLK = 64, LD = 2048;
constexpr float SCALE = 0.088388347648318440f;
constexpr int SHM_V = KVBLK * D * 2, SHM_K = KVBLK * D * 2;
#if ATT_FULLV
constexpr int OFF_V = 0, OFF_K = 4 * SHM_V  ;
#else
constexpr int OFF_V = 0, OFF_K = 3 * SHM_V  ;
#endif
#if ATT_FULLV
constexpr int OFF_WS = OFF_K + 2 * SHM_K, OFF_TB = OFF_WS + NW * 64 * 4, TB_STRIDE = 264  , OFF_QS = OFF_TB + 8 * TB_STRIDE * 4  , ATT_LDS = OFF_QS + NW * 4096;
#else
constexpr int OFF_WS = OFF_K + 2 * SHM_K, OFF_TB = OFF_WS + NW * 64 * 4, TB_STRIDE = 264  , ATT_LDS = OFF_TB + 8 * TB_STRIDE * 4;
#endif
static_assert(ATT_LDS <= LDS_MISC, "attention LDS");
#define KSWZ(row, colB) ((row) * 256 + ((colB) ^ (((row) & 7) << 4)))
#define SBAR() __builtin_amdgcn_sched_barrier(0)
__device__ __forceinline__ int crow(int r, int hi) { return (r & 3) + 8 * (r >> 2) + 4 * hi; }
__device__ __forceinline__ void partialSM(f32x16& p0, f32x16& p1, const LAS float* tb, int rel0, int relmin, int relmax, int hi) {
    constexpr float C = SCALE * LOG2E;
    if (relmin >= 128 || relmax <= -128) {
        const float c = (relmin >= 128) ? tb[256] : tb[0];
#pragma unroll
        for (int r = 0; r < 16; ++r) { p0[r] = fmaf(p0[r], C, c); p1[r] = fmaf(p1[r], C, c); }
    } else {
        int rb = rel0 + 4 * hi; asm volatile("" : "+v"(rb));
#pragma unroll
        for (int r4 = 0; r4 < 16; r4 += 4) {
#pragma unroll
            for (int r = r4; r < r4 + 4; ++r) { const int rl = rb + ((r & 3) + 8 * (r >> 2)); const int i0 = min(max(rl, -128), 128) + 128, i1 = min(max(rl + 32, -128), 128) + 128;
                p0[r] = fmaf(p0[r], C, tb[i0]); p1[r] = fmaf(p1[r], C, tb[i1]); }
            __builtin_amdgcn_sched_barrier(0);
        }
    }
#pragma unroll
    for (int r = 0; r < 16; ++r) p0[r] = __builtin_amdgcn_exp2f(p0[r]);
}
__device__ __forceinline__ void finishSM(f32x16& p0, f32x16& p1, float& l_reg, bf16x8& pa0, bf16x8& pa1, bf16x8& pa2, bf16x8& pa3) {
#pragma unroll
    for (int r = 0; r < 16; ++r) p1[r] = __builtin_amdgcn_exp2f(p1[r]);
    float ps = 0;
#pragma unroll
    for (int r = 0; r < 16; ++r) ps += p0[r];
#pragma unroll
    for (int r = 0; r < 16; ++r) ps += p1[r];
    { auto rr = __builtin_amdgcn_permlane32_swap(__float_as_uint(ps), __float_as_uint(ps), false, false);
      ps = __uint_as_float(rr[0]) + __uint_as_float(rr[1]); }
    l_reg += ps;
#define PK4(P, BASE, OUT) do { unsigned a0 = cvt_pk_bf16(P[BASE + 0], P[BASE + 1]), a1 = cvt_pk_bf16(P[BASE + 2], P[BASE + 3]);   \
    unsigned b0 = cvt_pk_bf16(P[BASE + 4], P[BASE + 5]), b1 = cvt_pk_bf16(P[BASE + 6], P[BASE + 7]);                              \
    auto r0 = __builtin_amdgcn_permlane32_swap(a0, b0, false, false); auto r1 = __builtin_amdgcn_permlane32_swap(a1, b1, false, false); \
    u32x4 w = {r0[0], r1[0], r0[1], r1[1]}; OUT = __builtin_bit_cast(bf16x8, w); } while (0)
    PK4(p0, 0, pa0); PK4(p0, 8, pa1); PK4(p1, 0, pa2); PK4(p1, 8, pa3);
#undef PK4
}
__device__ __forceinline__ void qkt(f32x16& p0, f32x16& p1, const LAS char* Ks, const bf16x8* Qs, int r32, int hi) {
    p0 = f32x16{}; p1 = f32x16{};
#pragma unroll
    for (int d0 = 0; d0 < 8; ++d0) { const int cb = (d0 * 16 + hi * 8) * 2;
        const bf16x8 b0 = *(const LAS bf16x8*)(Ks + KSWZ(r32, cb));
        const bf16x8 b1 = *(const LAS bf16x8*)(Ks + KSWZ(32 + r32, cb));
        const bf16x8 q = Qs[d0];
        p0 = __builtin_amdgcn_mfma_f32_32x32x16_bf16(b0, q, p0, 0, 0, 0);
        p1 = __builtin_amdgcn_mfma_f32_32x32x16_bf16(b1, q, p1, 0, 0, 0); }
}
__device__ __forceinline__ int v_st(int k, int c) { const int kk = (k & ~0xC) | ((k & 4) << 1) | ((k & 8) >> 1); return ((kk >> 3) * 4 + (c >> 5)) * 512 + ((kk & 7) * 32 + (c & 31)) * 2; }
__device__ __forceinline__ int v_rd_base(int lane) { return ((lane & 3) << 3) | (((lane >> 2) & 3) << 6) | (((lane >> 4) & 1) << 5) | (((lane >> 5) & 1) << 8); }
constexpr int v_rd_off(int d0, int ks, int half) { return d0 * 512 + ks * 4096 + half * 2048; }
template <int OFF> __device__ __forceinline__ s16x4 tr_read(int vb) {
    s16x4 r; asm volatile("ds_read_b64_tr_b16 %0, %1 offset:%2" : "=&v"(r) : "v"(vb), "i"(OFF) : "memory"); return r;
}
template <int D0> __device__ __forceinline__ void pv_one(f32x16& od, int vb, bf16x8 pa0, bf16x8 pa1, bf16x8 pa2, bf16x8 pa3) {
    const s16x4 l0 = tr_read<v_rd_off(D0, 0, 0)>(vb), h0 = tr_read<v_rd_off(D0, 0, 1)>(vb), l1 = tr_read<v_rd_off(D0, 1, 0)>(vb), h1 = tr_read<v_rd_off(D0, 1, 1)>(vb);
    const s16x4 l2 = tr_read<v_rd_off(D0, 2, 0)>(vb), h2 = tr_read<v_rd_off(D0, 2, 1)>(vb), l3 = tr_read<v_rd_off(D0, 3, 0)>(vb), h3 = tr_read<v_rd_off(D0, 3, 1)>(vb);
    asm volatile("s_waitcnt lgkmcnt(0)" ::: "memory"); SBAR();
#define PK(L, H) (bf16x8){L[0], L[1], L[2], L[3], H[0], H[1], H[2], H[3]}
    od = __builtin_amdgcn_mfma_f32_32x32x16_bf16(pa0, PK(l0, h0), od, 0, 0, 0);
    od = __builtin_amdgcn_mfma_f32_32x32x16_bf16(pa1, PK(l1, h1), od, 0, 0, 0);
    od = __builtin_amdgcn_mfma_f32_32x32x16_bf16(pa2, PK(l2, h2), od, 0, 0, 0);
    od = __builtin_amdgcn_mfma_f32_32x32x16_bf16(pa3, PK(l3, h3), od, 0, 0, 0);
#undef PK
}
template <int KS> __device__ __forceinline__ void pv_ks(f32x16* o, int vb, bf16x8 pa) {
    const s16x4 l0 = tr_read<v_rd_off(0, KS, 0)>(vb), h0 = tr_read<v_rd_off(0, KS, 1)>(vb), l1 = tr_read<v_rd_off(1, KS, 0)>(vb), h1 = tr_read<v_rd_off(1, KS, 1)>(vb);
    const s16x4 l2 = tr_read<v_rd_off(2, KS, 0)>(vb), h2 = tr_read<v_rd_off(2, KS, 1)>(vb), l3 = tr_read<v_rd_off(3, KS, 0)>(vb), h3 = tr_read<v_rd_off(3, KS, 1)>(vb);
    asm volatile("s_waitcnt lgkmcnt(0)" ::: "memory"); SBAR();
#define PK(L, H) (bf16x8){L[0], L[1], L[2], L[3], H[0], H[1], H[2], H[3]}
    o[0] = __builtin_amdgcn_mfma_f32_32x32x16_bf16(pa, PK(l0, h0), o[0], 0, 0, 0);
    o[1] = __builtin_amdgcn_mfma_f32_32x32x16_bf16(pa, PK(l1, h1), o[1], 0, 0, 0);
    o[2] = __builtin_amdgcn_mfma_f32_32x32x16_bf16(pa, PK(l2, h2), o[2], 0, 0, 0);
    o[3] = __builtin_amdgcn_mfma_f32_32x32x16_bf16(pa, PK(l3, h3), o[3], 0, 0, 0);
#undef PK
}
template <int KS, int BASE> __device__ __forceinline__ void pv_kso(f32x16* o, int vb, bf16x8 pa) {
    const s16x4 l0 = tr_read<BASE + v_rd_off(0, KS, 0)>(vb), h0 = tr_read<BASE + v_rd_off(0, KS, 1)>(vb), l1 = tr_read<BASE + v_rd_off(1, KS, 0)>(vb), h1 = tr_read<BASE + v_rd_off(1, KS, 1)>(vb);
    const s16x4 l2 = tr_read<BASE + v_rd_off(2, KS, 0)>(vb), h2 = tr_read<BASE + v_rd_off(2, KS, 1)>(vb), l3 = tr_read<BASE + v_rd_off(3, KS, 0)>(vb), h3 = tr_read<BASE + v_rd_off(3, KS, 1)>(vb);
    asm volatile("s_waitcnt lgkmcnt(0)" ::: "memory"); SBAR();
#define PK(L, H) (bf16x8){L[0], L[1], L[2], L[3], H[0], H[1], H[2], H[3]}
    o[0] = __builtin_amdgcn_mfma_f32_32x32x16_bf16(pa, PK(l0, h0), o[0], 0, 0, 0);
    o[1] = __builtin_amdgcn_mfma_f32_32x32x16_bf16(pa, PK(l1, h1), o[1], 0, 0, 0);
    o[2] = __builtin_amdgcn_mfma_f32_32x32x16_bf16(pa, PK(l2, h2), o[2], 0, 0, 0);
    o[3] = __builtin_amdgcn_mfma_f32_32x32x16_bf16(pa, PK(l3, h3), o[3], 0, 0, 0);
#undef PK
}
__device__ __forceinline__ void pv_d0(f32x16* o, int vb, bf16x8 pa0, bf16x8 pa1, bf16x8 pa2, bf16x8 pa3) {
#if ATT_PV_KMAJOR
    pv_ks<0>(o, vb, pa0); pv_ks<1>(o, vb, pa1); pv_ks<2>(o, vb, pa2); pv_ks<3>(o, vb, pa3);
#else
    pv_one<0>(o[0], vb, pa0, pa1, pa2, pa3); pv_one<1>(o[1], vb, pa0, pa1, pa2, pa3); pv_one<2>(o[2], vb, pa0, pa1, pa2, pa3); pv_one<3>(o[3], vb, pa0, pa1, pa2, pa3);
#endif
}
__device__ __forceinline__ void attn_unit(const bf16_t* __restrict__ Qb, const bf16_t* __restrict__ Kh, const bf16_t* __restrict__ Vh, bf16_t* __restrict__ Ob, int seq, int q0, const LAS float* tb, LAS char* lds, int tid_) {
    const int tid = tid_, wid = tid >> 6, lane = tid & 63, r32 = lane & 31, hi = lane >> 5;
    LAS char* V_lds = lds + OFF_V; LAS char* K_lds = lds + OFF_K;
    LAS float* li_l = (LAS float*)(lds + OFF_WS) + wid * 64;
    float l_reg = 0; f32x16 o[4] = {};
    bf16x8 qr[8];
    { const bf16_t* Qw = Qb + (long)(wid * QBLK + r32) * LD + hi * 8;
#pragma unroll
      for (int d0 = 0; d0 < 8; ++d0) qr[d0] = *(const bf16x8*)(Qw + d0 * 16); }
    const int sr = tid >> 4, sc = (tid & 15) * 8, vst0 = v_st(sr, sc), vst1 = v_st(32 + sr, sc);
    const int vb0 = (int)(unsigned)(size_t)V_lds + v_rd_base(lane);
    const int qpos = q0 + wid * QBLK + r32, wq0 = q0 + wid * QBLK;
    struct { bf16x8 vs0, vs1, ks0, ks1; } sr_;
#define SLOAD(k0) do { sr_.vs0 = *(const bf16x8*)(&Vh[(long)((k0) + sr) * LD + sc]); sr_.vs1 = *(const bf16x8*)(&Vh[(long)((k0) + 32 + sr) * LD + sc]); \
    sr_.ks0 = *(const bf16x8*)(&Kh[(long)((k0) + sr) * LD + sc]); sr_.ks1 = *(const bf16x8*)(&Kh[(long)((k0) + 32 + sr) * LD + sc]); } while (0)
#define SWRITE(b) do { *(LAS bf16x8*)(V_lds + (b) * SHM_V + vst0) = sr_.vs0;          \
    *(LAS bf16x8*)(V_lds + (b) * SHM_V + vst1) = sr_.vs1; const int kc = sc * 2;               \
    *(LAS bf16x8*)(K_lds + (b) * SHM_K + KSWZ(sr, kc)) = sr_.ks0;                       \
    *(LAS bf16x8*)(K_lds + (b) * SHM_K + KSWZ(32 + sr, kc)) = sr_.ks1; } while (0)
#define PSM(P0, P1, TILE) partialSM(P0, P1, tb, (TILE) * KVBLK - qpos, (TILE) * KVBLK - (wq0 + 31), (TILE) * KVBLK + 63 - wq0, hi)
#define TILE_STEP(J, B) do { __syncthreads(); \
        if ((J) + 1 < NT) { asm volatile("s_waitcnt vmcnt(0)" ::: "memory"); SWRITE(1 - (B)); } \
        if ((J) + 2 < NT) SLOAD(((J) + 2) * KVBLK); \
        SBAR(); qkt(p0, p1, K_lds + (B) * SHM_K, qr, r32, hi); PSM(p0, p1, (J)); \
        finishSM(p0, p1, l_reg, pa0, pa1, pa2, pa3); SBAR(); \
        pv_d0(o, vb0 + (B) * (int)SHM_V, pa0, pa1, pa2, pa3); } while (0)
    bf16x8 pa0, pa1, pa2, pa3; const int NT = seq / KVBLK;
#if ATT_PIPE
    f32x16 pA0, pA1, pB0, pB1;
    SLOAD(0); asm volatile("s_waitcnt vmcnt(0)" ::: "memory"); SWRITE(0); __syncthreads();
    qkt(pA0, pA1, K_lds, qr, r32, hi); PSM(pA0, pA1, 0);
    SLOAD(KVBLK);
    asm volatile("s_waitcnt vmcnt(0)" ::: "memory"); SWRITE(1); __syncthreads();
#pragma nounroll
    for (int j = 1; j + 1 < NT; j += 2) {
        SBAR(); qkt(pB0, pB1, K_lds + SHM_K, qr, r32, hi);
        finishSM(pA0, pA1, l_reg, pa0, pa1, pa2, pa3); SBAR();
        SLOAD((j + 1) * KVBLK); SBAR();
        pv_d0(o, vb0, pa0, pa1, pa2, pa3); PSM(pB0, pB1, j);
        __syncthreads(); asm volatile("s_waitcnt vmcnt(0)" ::: "memory"); SWRITE(0);
        __syncthreads();
        SBAR(); qkt(pA0, pA1, K_lds, qr, r32, hi);
        finishSM(pB0, pB1, l_reg, pa0, pa1, pa2, pa3); SBAR();
        SLOAD((j + 2) * KVBLK); SBAR();
        pv_d0(o, vb0 + (int)SHM_V, pa0, pa1, pa2, pa3); PSM(pA0, pA1, j + 1);
        __syncthreads(); asm volatile("s_waitcnt vmcnt(0)" ::: "memory"); SWRITE(1);
        __syncthreads();
    }
    SBAR(); qkt(pB0, pB1, K_lds + SHM_K, qr, r32, hi);
    finishSM(pA0, pA1, l_reg, pa0, pa1, pa2, pa3); SBAR();
    pv_d0(o, vb0, pa0, pa1, pa2, pa3); PSM(pB0, pB1, NT - 1);
    finishSM(pB0, pB1, l_reg, pa0, pa1, pa2, pa3); SBAR();
    pv_d0(o, vb0 + (int)SHM_V, pa0, pa1, pa2, pa3);
#else
    f32x16 p0, p1;
#if ATT_DMA
    unsigned gk[2], gv[2];
    const int widu = __builtin_amdgcn_readfirstlane(wid);
#pragma unroll
    for (int t = 0; t < 2; ++t) { const int ch = wid + 8 * t, b = ch * 1024 + 16 * lane;
        { const int row = b >> 8, cs = (b >> 4) & 15, c = cs ^ (row & 7); gk[t] = (unsigned)(row * LD + c * 8); }
        { const int sub = b >> 9, e = (b & 511) >> 1, kk = ((sub >> 2) << 3) | (e >> 5), c = ((sub & 3) << 5) | (e & 31), k = (kk & ~0xC) | ((kk & 4) << 1) | ((kk & 8) >> 1); gv[t] = (unsigned)(k * LD + c); } }
#define DMA_TILE(k0, bufi) do { _Pragma("unroll") for (int t = 0; t < 2; ++t) { \
        __builtin_amdgcn_global_load_lds((const unsigned*)(Kh + (size_t)(k0) * LD + gk[t]), (LAS unsigned*)(K_lds + (bufi) * SHM_K + (widu + 8 * t) * 1024), 16, 0, 0); \
        __builtin_amdgcn_global_load_lds((const unsigned*)(Vh + (size_t)(k0) * LD + gv[t]), (LAS unsigned*)(V_lds + (bufi) * SHM_V + (widu + 8 * t) * 1024), 16, 0, 0); } } while (0)
#define TILE_STEP_D(J, B) do { asm volatile("s_waitcnt vmcnt(0)" ::: "memory"); __syncthreads();     \
        if ((J) + 1 < NT) DMA_TILE(((J) + 1) * KVBLK, 1 - (B)); \
        SBAR(); qkt(p0, p1, K_lds + (B) * SHM_K, qr, r32, hi); PSM(p0, p1, (J)); \
        finishSM(p0, p1, l_reg, pa0, pa1, pa2, pa3); SBAR(); \
        pv_d0(o, vb0 + (B) * (int)SHM_V, pa0, pa1, pa2, pa3); } while (0)
#if ATT_DMA == 2
#define DMA_TILE2(k0, kbi, vbi) do { _Pragma("unroll") for (int t = 0; t < 2; ++t) { \
        __builtin_amdgcn_global_load_lds((const unsigned*)(Kh + (size_t)(k0) * LD + gk[t]), (LAS unsigned*)(K_lds + (kbi) * SHM_K + (widu + 8 * t) * 1024), 16, 0, 0); \
        __builtin_amdgcn_global_load_lds((const unsigned*)(Vh + (size_t)(k0) * LD + gv[t]), (LAS unsigned*)(V_lds + (vbi) * SHM_V + (widu + 8 * t) * 1024), 16, 0, 0); } } while (0)
#define STEP2(J, PC0, PC1, PP0, PP1) do { asm volatile("s_waitcnt vmcnt(0)" ::: "memory"); __syncthreads(); \
        if ((J) + 1 < NT) DMA_TILE2(((J) + 1) * KVBLK, ((J) + 1) & 1, vnext); \
        SBAR(); qkt(PC0, PC1, K_lds + ((J) & 1) * SHM_K, qr, r32, hi); \
        finishSM(PP0, PP1, l_reg, pa0, pa1, pa2, pa3); SBAR(); \
        pv_d0(o, vb0 + vprev * (int)SHM_V, pa0, pa1, pa2, pa3); PSM(PC0, PC1, (J)); \
        vprev = vcur; vcur = vnext; vnext = vnext == 2 ? 0 : vnext + 1; } while (0)
    f32x16 pb0, pb1;
    int vprev = 0, vcur = 1, vnext = 2;
    DMA_TILE2(0, 0, 0);
    asm volatile("s_waitcnt vmcnt(0)" ::: "memory"); __syncthreads();
    DMA_TILE2(KVBLK, 1, 1);
    qkt(p0, p1, K_lds, qr, r32, hi); PSM(p0, p1, 0);
#pragma nounroll
    for (int j = 1; j + 1 < NT; j += 2) { STEP2(j, pb0, pb1, p0, p1); STEP2(j + 1, p0, p1, pb0, pb1); }
    STEP2(NT - 1, pb0, pb1, p0, p1);
    finishSM(pb0, pb1, l_reg, pa0, pa1, pa2, pa3); SBAR();
    pv_d0(o, vb0 + vprev * (int)SHM_V, pa0, pa1, pa2, pa3);
#undef STEP2
#undef DMA_TILE2
#else
    DMA_TILE(0, 0);
#pragma nounroll
    for (int j = 0; j < NT; j += 2) { TILE_STEP_D(j, 0); TILE_STEP_D(j + 1, 1); }
#endif
#undef TILE_STEP_D
#undef DMA_TILE
#else
    SLOAD(0); asm volatile("s_waitcnt vmcnt(0)" ::: "memory"); SWRITE(0); SLOAD(KVBLK);
#pragma nounroll
    for (int j = 0; j < NT; j += 2) { TILE_STEP(j, 0); TILE_STEP(j + 1, 1); }
#endif
#endif
#undef TILE_STEP
    if (hi == 0) li_l[r32] = l_reg; asm volatile("s_waitcnt lgkmcnt(0)" ::: "memory");
    float rli[16];
#pragma unroll
    for (int r = 0; r < 16; ++r) rli[r] = __builtin_amdgcn_rcpf(li_l[crow(r, hi)]);
    bf16_t* Ow = Ob + (long)(wid * QBLK) * LD;
#pragma unroll
    for (int r = 0; r < 16; ++r) { const int orow = crow(r, hi);
#pragma unroll
        for (int d0 = 0; d0 < 4; ++d0) Ow[(long)orow * LD + d0 * 32 + r32] = f2bf(o[d0][r] * rli[r]); }
#undef SLOAD
#undef SWRITE
#undef PSM
}

#if ATT_FULLV
template <int OFF> __device__ __forceinline__ void qkt1(f32x16& p, int kb, const bf16x8* Qs) {
    p = f32x16{};
    asm volatile("" : "+v"(kb));
    bf16x8 kf[8];
#define KRD(D0) asm volatile("ds_read_b128 %0, %1 offset:%2" : "=&v"(kf[D0]) : "v"(kb ^ ((D0) * 32)), "i"(OFF) : "memory")
#define QK1(D0, N) asm volatile("s_waitcnt lgkmcnt(" #N ")" ::: "memory"); SBAR(); p = __builtin_amdgcn_mfma_f32_32x32x16_bf16(kf[D0], Qs[D0], p, 0, 0, 0); SBAR();
    KRD(0); KRD(1); KRD(2); KRD(3);
    QK1(0, 3) KRD(4); QK1(1, 3) KRD(5); QK1(2, 3) KRD(6); QK1(3, 3) KRD(7); QK1(4, 3) QK1(5, 2) QK1(6, 1) QK1(7, 0)
#undef QK1
#undef KRD
}
template <int OFF> __device__ __forceinline__ void qkt2(f32x16& pA, f32x16& pB, int kb, int qa, const bf16x8* Qs) {
    pA = f32x16{}; pB = f32x16{};
    asm volatile("" : "+v"(kb), "+v"(qa));
    bf16x8 ka[8], kc[8], ql[8];
#define KRD2(D0) do { asm volatile("ds_read_b128 %0, %1 offset:%2" : "=&v"(ka[D0]) : "v"(kb ^ ((D0) * 32)), "i"(OFF) : "memory"); asm volatile("ds_read_b128 %0, %1 offset:%2" : "=&v"(kc[D0]) : "v"(kb ^ ((D0) * 32)), "i"(OFF + 8192) : "memory"); \
        if ((D0) >= 4) asm volatile("ds_read_b128 %0, %1 offset:%2" : "=&v"(ql[D0]) : "v"(qa), "i"(((D0) - 4) * 1024) : "memory"); } while (0)
#define QK2(D0, N) asm volatile("s_waitcnt lgkmcnt(" #N ")" ::: "memory"); SBAR(); { const bf16x8 q_ = (D0) >= 4 ? ql[D0] : Qs[(D0) & 3]; pA = __builtin_amdgcn_mfma_f32_32x32x16_bf16(ka[D0], q_, pA, 0, 0, 0); pB = __builtin_amdgcn_mfma_f32_32x32x16_bf16(kc[D0], q_, pB, 0, 0, 0); } SBAR();
    KRD2(0); KRD2(1);
    __builtin_amdgcn_s_setprio(1);
    QK2(0, 2) KRD2(2); QK2(1, 2) KRD2(3); QK2(2, 2) KRD2(4); QK2(3, 3) KRD2(5); QK2(4, 3) KRD2(6); QK2(5, 3) KRD2(7); QK2(6, 3) QK2(7, 0)
    __builtin_amdgcn_s_setprio(0);
#undef QK2
#undef KRD2
}
__device__ __forceinline__ void partialSM1(f32x16& p, const LAS float* tb, int rel_s, int lrel) {
    constexpr float C = SCALE * LOG2E;
    if (rel_s - 31 >= 128 || rel_s + 31 <= -128) {
        const float c = (rel_s >= 159) ? tb[256] : tb[0];
#pragma unroll
        for (int r = 0; r < 16; ++r) p[r] = fmaf(p[r], C, c);
    } else {
        int rb = rel_s + lrel; asm volatile("" : "+v"(rb));
#pragma unroll
        for (int r4 = 0; r4 < 16; r4 += 4) {
#pragma unroll
            for (int r = r4; r < r4 + 4; ++r) { const int rl = rb + ((r & 3) + 8 * (r >> 2)); const int i0 = min(max(rl, -128), 128) + 128; p[r] = fmaf(p[r], C, tb[i0]); }
            __builtin_amdgcn_sched_barrier(0);
        }
    }
#pragma unroll
    for (int r = 0; r < 16; ++r) p[r] = __builtin_amdgcn_exp2f(p[r]);
}
__device__ __forceinline__ void finishSM1(const f32x16& p, float& l_acc, bf16x8& pa_lo, bf16x8& pa_hi) {
    float ps = 0;
#pragma unroll
    for (int r = 0; r < 16; ++r) ps += p[r];
    l_acc += ps;
#define PK4(P, BASE, OUT) do { unsigned a0 = cvt_pk_bf16(P[BASE + 0], P[BASE + 1]), a1 = cvt_pk_bf16(P[BASE + 2], P[BASE + 3]);   \
    unsigned b0 = cvt_pk_bf16(P[BASE + 4], P[BASE + 5]), b1 = cvt_pk_bf16(P[BASE + 6], P[BASE + 7]);                              \
    auto r0 = __builtin_amdgcn_permlane32_swap(a0, b0, false, false); auto r1 = __builtin_amdgcn_permlane32_swap(a1, b1, false, false); \
    u32x4 w = {r0[0], r1[0], r0[1], r1[1]}; OUT = __builtin_bit_cast(bf16x8, w); } while (0)
    PK4(p, 0, pa_lo); PK4(p, 8, pa_hi);
#undef PK4
}
__device__ __forceinline__ void attn_unit_fv(const bf16_t* __restrict__ Qb, const bf16_t* __restrict__ Kh, const bf16_t* __restrict__ Vh, bf16_t* __restrict__ Ob, int seq, int q0, const LAS float* tb, LAS char* lds, int tid_) {
    int tid = tid_; asm volatile("" : "+v"(tid));
    const int wid = __builtin_amdgcn_readfirstlane(tid >> 6), lane = tid & 63, r32 = lane & 31, hi = lane >> 5;
    LAS char* V_lds = lds + OFF_V; LAS char* K_lds = lds + OFF_K;
    LAS float* li_l = (LAS float*)(lds + OFF_WS) + wid * 64;
    float l_reg = 0; f32x16 o[8] = {};
    bf16x8 qr[4];
    const int qa0 = (int)(unsigned)(size_t)(lds + OFF_QS) + wid * 4096 + lane * 16;
    { const char* Qw = (const char*)(Qb + (long)(wid * QBLK) * LD); const unsigned qo = (unsigned)((r32 * LD + hi * 8) * 2);
#pragma unroll
      for (int d0 = 0; d0 < 4; ++d0) qr[d0] = *(const bf16x8*)(Qw + qo + d0 * 32);
#pragma unroll
      for (int d0 = 4; d0 < 8; ++d0) { const bf16x8 qv = *(const bf16x8*)(Qw + qo + d0 * 32); *(LAS bf16x8*)((LAS char*)(size_t)(unsigned)qa0 + (d0 - 4) * 1024) = qv; } }
    const int vb0 = (int)(unsigned)(size_t)V_lds + v_rd_base(lane);
    const int wq0 = q0 + wid * QBLK, lrel = 4 * hi - r32;
    unsigned gk0, gv0;
    const int widu = wid;
    { const int b = wid * 1024 + 16 * lane;
      { const int row = b >> 8, cs = (b >> 4) & 15, c = cs ^ (row & 7); gk0 = (unsigned)(row * LD + c * 8) * 2u; }
      { const int sub = b >> 9, e = (b & 511) >> 1, kk = ((sub >> 2) << 3) | (e >> 5), c = ((sub & 3) << 5) | (e & 31), k = (kk & ~0xC) | ((kk & 4) << 1) | ((kk & 8) >> 1); gv0 = (unsigned)(k * LD + c) * 2u; } }
    const int kb0 = (int)(unsigned)(size_t)K_lds + r32 * 256 + ((hi * 16) ^ ((r32 & 7) << 4));
#define DMA1(sbase, voff, ldsaddr) asm volatile("s_mov_b32 m0, %2\n\ts_nop 0\n\tglobal_load_lds_dwordx4 %0, %1" :: "v"(voff), "s"(sbase), "s"(ldsaddr) : "memory", "m0")
#define DMA_TILE_FV(k0, bufi) do { const char* kt_ = (const char*)(Kh + (size_t)(k0) * LD); const char* vt_ = (const char*)(Vh + (size_t)(k0) * LD); _Pragma("unroll") for (int t = 0; t < 2; ++t) { \
        DMA1(kt_ + t * (32 * LD * 2), gk0, (unsigned)(size_t)(K_lds + (bufi) * SHM_K + (widu + 8 * t) * 1024)); \
        DMA1(vt_ + t * (32 * LD * 2), gv0, (unsigned)(size_t)(V_lds + (bufi) * 2 * SHM_V + (widu + 8 * t) * 1024)); \
        DMA1(vt_ + 256 + t * (32 * LD * 2), gv0, (unsigned)(size_t)(V_lds + (bufi) * 2 * SHM_V + SHM_V + (widu + 8 * t) * 1024)); } } while (0)
#define TR4(F, BASE, KS, D0) do { F[0] = tr_read<(BASE) + v_rd_off(D0, KS, 0)>(vb0); F[1] = tr_read<(BASE) + v_rd_off(D0, KS, 1)>(vb0); F[2] = tr_read<(BASE) + v_rd_off(D0 + 1, KS, 0)>(vb0); F[3] = tr_read<(BASE) + v_rd_off(D0 + 1, KS, 1)>(vb0); } while (0)
#define PKF(L, H) (bf16x8){L[0], L[1], L[2], L[3], H[0], H[1], H[2], H[3]}
#define MM2(O, D0, PA, F) do { (O)[D0] = __builtin_amdgcn_mfma_f32_32x32x16_bf16(PA, PKF(F[0], F[1]), (O)[D0], 0, 0, 0); (O)[D0 + 1] = __builtin_amdgcn_mfma_f32_32x32x16_bf16(PA, PKF(F[2], F[3]), (O)[D0 + 1], 0, 0, 0); } while (0)
#define LGK(N) asm volatile("s_waitcnt lgkmcnt(" #N ")" ::: "memory")
#define PV_PIPE(KSA, KSB, VA_, VB_) do { s16x4 f0[4], f1[4], f2[4]; __builtin_amdgcn_s_setprio(1); \
        TR4(f0, VA_, KSA, 0); TR4(f1, VA_, KSA, 2); TR4(f2, VB_, KSA, 0); LGK(8); SBAR(); MM2(o, 0, pa0, f0); SBAR(); \
        TR4(f0, VB_, KSA, 2); LGK(8); SBAR(); MM2(o, 2, pa0, f1); SBAR(); \
        TR4(f1, VA_, KSB, 0); LGK(8); SBAR(); MM2(o + 4, 0, pa0, f2); SBAR(); \
        TR4(f2, VA_, KSB, 2); LGK(8); SBAR(); MM2(o + 4, 2, pa0, f0); SBAR(); \
        TR4(f0, VB_, KSB, 0); LGK(8); SBAR(); MM2(o, 0, pa1, f1); SBAR(); \
        TR4(f1, VB_, KSB, 2); LGK(8); SBAR(); MM2(o, 2, pa1, f2); SBAR(); \
        LGK(4); SBAR(); MM2(o + 4, 0, pa1, f0); SBAR(); LGK(0); SBAR(); MM2(o + 4, 2, pa1, f1); __builtin_amdgcn_s_setprio(0); } while (0)
#define STEP_FV(J, B) do { asm volatile("s_waitcnt vmcnt(0)" ::: "memory"); __syncthreads();     \
        if ((J) + 1 < NT) DMA_TILE_FV(((J) + 1) * KVBLK, 1 - (B)); \
        { constexpr int VA = (B) * 2 * SHM_V, VB = VA + SHM_V; \
        SBAR(); qkt2<(B) * SHM_K>(p, pb, kb0, qa0, qr); \
        partialSM1(p, tb, (J) * KVBLK - wq0, lrel); \
        finishSM1(p, l_reg, pa0, pa1); SBAR(); \
        pv_kso<0, VA>(o, vb0, pa0); pv_kso<0, VB>(o + 4, vb0, pa0); pv_kso<1, VA>(o, vb0, pa1); pv_kso<1, VB>(o + 4, vb0, pa1); SBAR(); \
        partialSM1(pb, tb, (J) * KVBLK + 32 - wq0, lrel); \
        finishSM1(pb, l_reg, pa0, pa1); SBAR(); \
        PV_PIPE(2, 3, VA, VB); } } while (0)
    bf16x8 pa0, pa1; const int NT = seq / KVBLK;
    f32x16 p, pb;
    DMA_TILE_FV(0, 0);
#pragma nounroll
    for (int j = 0; j < NT; j += 2) { STEP_FV(j, 0); STEP_FV(j + 1, 1); }
#undef STEP_FV
#undef PV_PIPE
#undef LGK
#undef MM2
#undef PKF
#undef TR4
#undef DMA_TILE_FV
#undef DMA1
    { auto rr = __builtin_amdgcn_permlane32_swap(__float_as_uint(l_reg), __float_as_uint(l_reg), false, false); l_reg = __uint_as_float(rr[0]) + __uint_as_float(rr[1]); }
    int l2; asm volatile("v_mbcnt_lo_u32_b32 %0, -1, 0\n\tv_mbcnt_hi_u32_b32 %0, -1, %0" : "=v"(l2));
    const int r32e = l2 & 31, hie = l2 >> 5;
    if (hie == 0) li_l[r32e] = l_reg; asm volatile("s_waitcnt lgkmcnt(0)" ::: "memory");
    char* Ow = (char*)(Ob + (long)(wid * QBLK) * LD);
    unsigned ob = (unsigned)((4 * hie * LD + r32e) * 2);
#pragma unroll
    for (int r = 0; r < 16; ++r) { const float rl = __builtin_amdgcn_rcpf(li_l[crow(r, hie)]); asm volatile("" : "+v"(ob));
        bf16_t* op = (bf16_t*)(Ow + ob + (unsigned)((((r & 3) + 8 * (r >> 2)) * LD) * 2));
#pragma unroll
        for (int d0 = 0; d0 < 8; ++d0) op[d0 * 32] = f2bf(o[d0][r] * rl);
        SBAR(); }
}
#endif
}

__device__ __forceinline__ int t5_bucket(int rel) {
    const int ret = rel > 0 ? 16 : 0; const int n = rel < 0 ? -rel : rel;
    if (n < 8) return ret + n;
    const int e = 31 - __clz(n); int large = 8 + 2 * (e - 3) + ((n * n >= (2 << (2 * e))) ? 1 : 0);
    large = large < 15 ? large : 15;
    return ret + large;
}

__device__ __forceinline__ void p4_mixer(const Frame& F, const Args& a, int g) {
    unsigned char* ws = a.ws; const int TT = g ? 2048 : 4096, NB = g ? 8 : 4;
    bf16_t* dsc = (bf16_t*)(a.out + (size_t)g * GT * DM);
    const float* prm = (const float*)(ws + WS_PRM);
    GlaT T{(const bf16_t*)(ws + A_GQ), (const bf16_t*)(ws + A_GK), (const bf16_t*)(ws + A_GV), (const float*)(ws + WS_ST), prm + P_WGF, prm + P_BGF, prm + P_WGB, prm + P_BGB,
           (bf16_t*)(ws + A_QD), (bf16_t*)(ws + A_KDT), dsc + (size_t)2 * GT * 2048, (bf16_t*)(ws + A_ATT), (float*)(ws + WS_DEC), DG_WORD(ws)};
    const int n_g2 = NB * 4 * 2 * 8;
    for (int it = F.vcu; it < n_g2; it += F.G) gla_g2_item(F, T, it, TT);
#if ATT_FULLV
    const int NQB = TT / 256, n_at = NB * 8 * 2 * NQB;
#else
    const int NQB = TT / 256, n_at = NB * 8 * 2 * 2 * NQB;
#endif
    LAS float* tb = (LAS float*)(F.lds + att::OFF_TB);
    const bf16_t* Qg = (const bf16_t*)(ws + A_Q); const bf16_t* Kg = (const bf16_t*)(ws + A_K); const bf16_t* Vg = (const bf16_t*)(ws + A_V);
    __syncthreads();
    for (int i = F.tid; i < 8 * 257; i += NTHR) { const int h = i / 257, j = i - h * 257; tb[h * att::TB_STRIDE + j] = prm[P_RB + t5_bucket(j - 128) * 8 + h] * LOG2E; }
    __syncthreads();
    for (int it = F.vcu; it < n_at; it += F.G) {
#if ATT_FULLV
        const int qb = it % NQB; int r = it / NQB; const int map = r & 1; r >>= 1; const int h = r & 7; const int b = r >> 3;
        const size_t rowb = (size_t)b * TT;
        att::attn_unit_fv(Qg + (rowb + qb * 256) * 2048 + h * 256 + map * 128, Kg + rowb * 2048 + h * 256 + map * 128, Vg + rowb * 2048 + h * 256,
                          dsc + (size_t)map * GT * 2048 + (rowb + qb * 256) * 2048 + h * 256, TT, qb * 256, tb + h * att::TB_STRIDE, (LAS char*)F.lds, F.tid);
        __syncthreads();
#else
        const int qb = it % NQB; int r = it / NQB; const int vhalf = r & 1; r >>= 1; const int map = r & 1; r >>= 1; const int h = r & 7; const int b = r >> 3;
        const size_t rowb = (size_t)b * TT;
        att::attn_unit(Qg + (rowb + qb * 256) * 2048 + h * 256 + map * 128, Kg + rowb * 2048 + h * 256 + map * 128, Vg + rowb * 2048 + h * 256 + vhalf * 128,
                       dsc + (size_t)map * GT * 2048 + (rowb + qb * 256) * 2048 + h * 256 + vhalf * 128, TT, qb * 256, tb + h * att::TB_STRIDE, (LAS char*)F.lds, F.tid);
        __syncthreads();
#endif
    }
}
__device__ __forceinline__ void p5_finalize(const Frame& F, const Args& a, int g) {
    unsigned char* ws = a.ws; const bf16_t* dsc = (const bf16_t*)(a.out + (size_t)g * GT * DM);
    const bf16_t* O1 = dsc; const bf16_t* O2 = dsc + (size_t)GT * 2048; const bf16_t* OF = dsc + (size_t)2 * GT * 2048; const bf16_t* OB = dsc + (size_t)3 * GT * 2048;
    const bf16_t* GR = (const bf16_t*)(ws + A_GR);
    const float* prm = (const float*)(ws + WS_PRM); const float lam = prm[P_LAM];
    const int gw = F.vcu * NWAVES + F.wave, NGW = F.G * NWAVES, lane = F.lane;
    float sg[8], gg[8];
#pragma unroll
    for (int e = 0; e < 8; ++e) { sg[e] = prm[P_SUBLN + (lane & 31) * 8 + e] * 0.8f; gg[e] = prm[P_GLAG + lane * 8 + e]; }
    unsigned char* OQ = ws + A_OAB; float* soa = (float*)(ws + WS_PRM) + P_SOA; float* sob = (float*)(ws + WS_PRM) + P_SOB;
    for (int m = gw; m < GT; m += NGW) {
        float ya[4][8], yb[4][8]; float ma = 0.f, mb = 0.f;
#pragma unroll
        for (int i = 0; i < 4; ++i) {
            const size_t off = (size_t)m * 2048 + i * 512 + lane * 8;
            { const u32x4 w1 = *(const u32x4*)(O1 + off), w2 = *(const u32x4*)(O2 + off);
              float v[8] = {bflo(w1.x) - lam * bflo(w2.x), bfhi(w1.x) - lam * bfhi(w2.x), bflo(w1.y) - lam * bflo(w2.y), bfhi(w1.y) - lam * bfhi(w2.y),
                            bflo(w1.z) - lam * bflo(w2.z), bfhi(w1.z) - lam * bfhi(w2.z), bflo(w1.w) - lam * bflo(w2.w), bfhi(w1.w) - lam * bfhi(w2.w)};
              float s = 0.f;
#pragma unroll
              for (int e = 0; e < 8; ++e) s += v[e] * v[e];
              s += __shfl_xor(s, 1); s += __shfl_xor(s, 2); s += __shfl_xor(s, 4); s += __shfl_xor(s, 8); s += __shfl_xor(s, 16);
              const float r = 1.f / sqrtf(s * (1.f / 256.f) + EPS);
#pragma unroll
              for (int e = 0; e < 8; ++e) { ya[i][e] = v[e] * r * sg[e]; ma = fmaxf(ma, fabsf(ya[i][e])); } }
            { const u32x4 w1 = *(const u32x4*)(OF + off), w2 = *(const u32x4*)(OB + off), wr_ = *(const u32x4*)(GR + off);
              float v[8] = {bflo(w1.x) + bflo(w2.x), bfhi(w1.x) + bfhi(w2.x), bflo(w1.y) + bflo(w2.y), bfhi(w1.y) + bfhi(w2.y),
                            bflo(w1.z) + bflo(w2.z), bfhi(w1.z) + bfhi(w2.z), bflo(w1.w) + bflo(w2.w), bfhi(w1.w) + bfhi(w2.w)};
              const float rr[8] = {bflo(wr_.x), bfhi(wr_.x), bflo(wr_.y), bfhi(wr_.y), bflo(wr_.z), bfhi(wr_.z), bflo(wr_.w), bfhi(wr_.w)};
              float s = 0.f;
#pragma unroll
              for (int e = 0; e < 8; ++e) s += v[e] * v[e];
              s = wave_sum(s);
              const float r = 1.f / sqrtf(s * (1.f / 512.f) + EPS);
#pragma unroll
              for (int e = 0; e < 8; ++e) { yb[i][e] = v[e] * r * gg[e] * rr[e]; mb = fmaxf(mb, fabsf(yb[i][e])); } }
        }
#pragma unroll
        for (int o = 1; o < 64; o <<= 1) { ma = fmaxf(ma, __shfl_xor(ma, o)); mb = fmaxf(mb, __shfl_xor(mb, o)); }
        ma = fmaxf(ma, 1e-30f); mb = fmaxf(mb, 1e-30f); const float qa = 127.f / ma, qb = 127.f / mb;
#pragma unroll
        for (int i = 0; i < 4; ++i) {
            *(u32x2*)(OQ + (size_t)m * DM + i * 512 + lane * 8) = (u32x2){pack_i8x4(ya[i][0] * qa, ya[i][1] * qa, ya[i][2] * qa, ya[i][3] * qa), pack_i8x4(ya[i][4] * qa, ya[i][5] * qa, ya[i][6] * qa, ya[i][7] * qa)};
            *(u32x2*)(OQ + (size_t)m * DM + 2048 + i * 512 + lane * 8) = (u32x2){pack_i8x4(yb[i][0] * qb, yb[i][1] * qb, yb[i][2] * qb, yb[i][3] * qb), pack_i8x4(yb[i][4] * qb, yb[i][5] * qb, yb[i][6] * qb, yb[i][7] * qb)}; }
        if (lane == 0) { soa[m] = ma * (1.f / 127.f); sob[m] = mb * (1.f / 127.f); }
    }
}
__device__ __forceinline__ void p9_fix(const Frame& F, const float* HB, unsigned char* U8, const float* CW, const float* CB, int TT) {
    const int total = 64 * 86 * 2 * 32;
    for (int it = F.vcu * NTHR + F.tid; it < total; it += F.G * NTHR) {
        const int q = it & 31, e = (it >> 5) & 1, tix = it >> 6, pm = tix / 86, pn = tix - pm * 86, fl = 4 * q, f0 = pn * HALF + fl;
        const float* own = HB + (size_t)tix * 768 + fl; f32x4 prv, cur, nxt, gg; int row;
        if (e == 0) { row = pm * BM; cur = *(const f32x4*)(own); nxt = *(const f32x4*)(own + 128); gg = *(const f32x4*)(own + 4 * 128);
            prv = (row % TT) == 0 ? (f32x4){0.f, 0.f, 0.f, 0.f} : *(const f32x4*)(HB + (size_t)(tix - 86) * 768 + 3 * 128 + fl); }
        else { row = pm * BM + 255; prv = *(const f32x4*)(own + 2 * 128); cur = *(const f32x4*)(own + 3 * 128); gg = *(const f32x4*)(own + 5 * 128);
            nxt = ((row + 1) % TT) == 0 ? (f32x4){0.f, 0.f, 0.f, 0.f} : *(const f32x4*)(HB + (size_t)(tix + 86) * 768 + fl); }
        const f32x4 x0 = *(const f32x4*)(CW + f0), x1 = *(const f32x4*)(CW + DFF + f0), x2 = *(const f32x4*)(CW + 2 * DFF + f0), xb = *(const f32x4*)(CB + f0);
        float o[4];
#pragma unroll
        for (int i = 0; i < 4; ++i) { const float c = prv[i] * x0[i] + cur[i] * x1[i] + nxt[i] * x2[i] + xb[i]; o[i] = gelu_tanh_(c) * gg[i]; }
        int w = 0; w = __builtin_amdgcn_cvt_pk_fp8_f32(sat8(o[0]), sat8(o[1]), w, false); w = __builtin_amdgcn_cvt_pk_fp8_f32(sat8(o[2]), sat8(o[3]), w, true);
        *(unsigned*)(U8 + (size_t)row * DFF + f0) = (unsigned)w;
    }
}
__device__ __forceinline__ float gelu_tanh(float x) { const float u = x * (1.5957691216057308f + 0.07135481627159145f * x * x); return x * __builtin_amdgcn_rcpf(1.f + __builtin_amdgcn_exp2f(-u * LOG2E)); }
__device__ __forceinline__ void unpack8(const u32x4 w, float (&v)[8]) { v[0] = bflo(w.x); v[1] = bfhi(w.x); v[2] = bflo(w.y); v[3] = bfhi(w.y); v[4] = bflo(w.z); v[5] = bfhi(w.z); v[6] = bflo(w.w); v[7] = bfhi(w.w); }
__device__ __forceinline__ void p9_conv(const Frame& F, const Args& a, int g) {
    unsigned char* ws = a.ws; const int TT = g ? 2048 : 4096;
    const bf16_t* FA = (const bf16_t*)(ws + A_FA); const bf16_t* FG = (const bf16_t*)(ws + A_FG); unsigned char* U8 = u8_ptr(a, g);
    const float* cw = (const float*)(ws + WS_PRM) + P_CW; const float* cb = (const float*)(ws + WS_PRM) + P_CB;
    constexpr int NF8 = DFF / 8, RB = 16, NRB = GT / RB;
    const long total = (long)NF8 * NRB;
    for (long it = (long)F.vcu * NTHR + F.tid; it < total; it += (long)F.G * NTHR) {
        const int f8 = (int)(it % NF8), rb = (int)(it / NF8), f0 = f8 * 8, r0 = rb * RB;
        float w0[8], w1[8], w2[8], bb[8];
#pragma unroll
        for (int e = 0; e < 8; ++e) { w0[e] = cw[f0 + e]; w1[e] = cw[DFF + f0 + e]; w2[e] = cw[2 * DFF + f0 + e]; bb[e] = cb[f0 + e]; }
        float pv[8], cv[8], nv[8];
        if ((r0 % TT) != 0) unpack8(*(const u32x4*)(FA + (size_t)(r0 - 1) * DFF + f0), pv); else {
#pragma unroll
            for (int e = 0; e < 8; ++e) pv[e] = 0.f; }
        unpack8(*(const u32x4*)(FA + (size_t)r0 * DFF + f0), cv);
#pragma unroll 4
        for (int r = 0; r < RB; ++r) { const int row = r0 + r;
            if (((row + 1) % TT) != 0) unpack8(*(const u32x4*)(FA + (size_t)(row + 1) * DFF + f0), nv); else {
#pragma unroll
                for (int e = 0; e < 8; ++e) nv[e] = 0.f; }
            float gv[8]; unpack8(*(const u32x4*)(FG + (size_t)row * DFF + f0), gv);
            float o[8];
#pragma unroll
            for (int e = 0; e < 8; ++e) { const float c = pv[e] * w0[e] + cv[e] * w1[e] + nv[e] * w2[e] + bb[e]; o[e] = gelu_tanh(c) * gv[e]; pv[e] = cv[e]; cv[e] = nv[e]; }
            int w0 = 0, w1 = 0;
            w0 = __builtin_amdgcn_cvt_pk_fp8_f32(sat8(o[0] * U8_SCALE), sat8(o[1] * U8_SCALE), w0, false); w0 = __builtin_amdgcn_cvt_pk_fp8_f32(sat8(o[2] * U8_SCALE), sat8(o[3] * U8_SCALE), w0, true);
            w1 = __builtin_amdgcn_cvt_pk_fp8_f32(sat8(o[4] * U8_SCALE), sat8(o[5] * U8_SCALE), w1, false); w1 = __builtin_amdgcn_cvt_pk_fp8_f32(sat8(o[6] * U8_SCALE), sat8(o[7] * U8_SCALE), w1, true);
            *(u32x2*)(U8 + (size_t)row * DFF + f0) = (u32x2){(unsigned)w0, (unsigned)w1}; }
    }
}

constexpr int NPH = 11;
#if MK_TPROBE >= 0
#define TP_BEGIN(k) unsigned long long tp_t0_ = 0; if (MK_TPROBE == (k)) tp_t0_ = __builtin_amdgcn_s_memrealtime();
#define TP_END(k) do { if (MK_TPROBE == (k) && F.tid == 0) { volatile LAS unsigned* m_ = (volatile LAS unsigned*)(lds + LDS_MISC); m_[32] = m_[32] + (unsigned)(__builtin_amdgcn_s_memrealtime() - tp_t0_); } } while (0)
#else
#define TP_BEGIN(k)
#define TP_END(k)
#endif
#define GRID_BAR() do { if (!multi) { XcdBarrier b_; b_.bar = (unsigned*)(args.ws + WS_CTL) + CW_BAR; b_.x = xb_xcc_id(); b_.st = (volatile LAS unsigned*)(lds + LDS_MISC); xcd_barrier(b_); } } while (0)
#if MK_ONE_LAUNCH
#define IN(k) true
#else
#define IN(k) (lo <= (k) && (k) < hi)
#endif
template <int GI> __device__ __forceinline__ void group_body(LAS unsigned char* lds, const int wave_s, const Args& args, const bool more) {
    constexpr bool multi = !MK_ONE_LAUNCH;
    constexpr int g = GI;
    unsigned char* ws = args.ws; const int lo = args.ph_lo, hi = args.ph_hi; (void)lo; (void)hi;
    const float* xg = args.in[GI];
    float* outg = args.out + (size_t)GI * GT * DM;
    float* rss = (float*)((unsigned*)(ws + WS_CTL) + CW_RSS) + (size_t)GI * GT;
    if (IN(1)) { const Frame F = make_frame(lds, wave_s); TP_BEGIN(1) p1_hnorm(F, xg, GI == 0 ? args.in[3] : (const float*)(ws + WS_PRM) + P_GMIX, ws + A_H, (float*)(ws + WS_PRM) + P_SH); GRID_BAR(); TP_END(1); }
    if (IN(2)) { const Frame F = make_frame(lds, wave_s);
        TP_BEGIN(2)
        { pg8::Gemm gm{(const bf16_t*)(ws + A_H), (const bf16_t*)(ws + WS_WIN)};
          EpiInProj E{ws, (const float*)(ws + WS_PRM) + P_SH, (const float*)(ws + WS_PRM) + P_SWIN, (LAS float*)(F.lds + 131072 + 4096)};
          pg8::gemm_phase<GT, DINP, DM / 2, DM / 2, DM / 2, 1, 0, 2>(F.lds, gm, fresh_grid(), fresh_bid(), F.tid, E); }
        GRID_BAR(); TP_END(2);
    }
    if (IN(3)) { const Frame F = make_frame(lds, wave_s);
        TP_BEGIN(3)
        const float* prm = (const float*)(ws + WS_PRM);
        bf16_t* dsc = (bf16_t*)outg;
        GlaT T{(const bf16_t*)(ws + A_GQ), (const bf16_t*)(ws + A_GK), (const bf16_t*)(ws + A_GV), (const float*)(ws + WS_ST), prm + P_WGF, prm + P_BGF, prm + P_WGB, prm + P_BGB,
               (bf16_t*)(ws + A_QD), (bf16_t*)(ws + A_KDT), dsc + (size_t)2 * GT * 2048, (bf16_t*)(ws + A_ATT), (float*)(ws + WS_DEC), DG_WORD(ws)};
        constexpr int TT = g ? 2048 : 4096;
        for (int it = F.vcu; it < 2048; it += F.G) gla_g1_item(F, T, it, TT);
        GRID_BAR(); TP_END(3);
    }
    if (IN(4)) { const Frame F = make_frame(lds, wave_s); TP_BEGIN(4) p4_mixer(F, args, g); GRID_BAR(); TP_END(4); }
    if (IN(5)) { const Frame F = make_frame(lds, wave_s); TP_BEGIN(5) p5_finalize(F, args, g); GRID_BAR(); TP_END(5); }
    if (IN(6)) { const Frame F = make_frame(lds, wave_s);
        pg8::Gemm gm{(const bf16_t*)(ws + A_OAB), (const bf16_t*)(ws + WS_WPAB)}; EpiBranch E{ws};
        TP_BEGIN(6) pg8::gemm_phase<GT, DM, 1024, 2048, 2048, 2, 1024, 2>(F.lds, gm, fresh_grid(), fresh_bid(), F.tid, E); GRID_BAR();
        if (INT8_WOUT) { p7b_quant_x1(F, (const bf16_t*)(ws + A_MRG), ws + A_K, (float*)(ws + WS_PRM) + P_SM); GRID_BAR(); } TP_END(6);
    }
    if (IN(7)) { const Frame F = make_frame(lds, wave_s);
        pg8::Gemm gm{(const bf16_t*)(ws + (INT8_WOUT ? A_K : A_MRG)), (const bf16_t*)(ws + WS_WOUT)};
        EpiWout E{xg, (bf16_t*)(ws + A_X1B), rss, (const float*)(ws + WS_PRM) + P_SM, (const float*)(ws + WS_PRM) + P_SWWO}; TP_BEGIN(7) if (INT8_WOUT) pg8::gemm_phase<GT, DM, DM / 2, DM / 2, DM / 2, 1, 0, 2>(F.lds, gm, fresh_grid(), fresh_bid(), F.tid, E); else pg8::gemm_phase<GT, DM, DM, DM, DM, 1, 0, 0>(F.lds, gm, fresh_grid(), fresh_bid(), F.tid, E);
        GRID_BAR(); TP_END(7);
    }
    if (IN(8)) { const Frame F = make_frame(lds, wave_s);
        TP_BEGIN(8)
        float* sx = (float*)(ws + WS_PRM) + P_SX + (size_t)GI * GT;
        p7b_quant_x1(F, (const bf16_t*)(ws + A_X1B), (unsigned char*)outg, sx); GRID_BAR();
        pg8::Gemm gm{(const bf16_t*)outg, (const bf16_t*)(ws + WS_WUP)};
#if FUSE_CONV
        EpiUpConv E{ws, GI, (LAS float*)(F.lds + 131072)};
#else
        EpiUp E{rss, (bf16_t*)(ws + A_FA), (bf16_t*)(ws + A_FG), sx, (const float*)(ws + WS_PRM) + P_SWUP};
#endif
        pg8::gemm_phase<GT, 2 * DFF, DM / 2, DM / 2, DM / 2, 1, 0, 2>(F.lds, gm, fresh_grid(), fresh_bid(), F.tid, E); GRID_BAR(); TP_END(8);
    }
#if FUSE_CONV
    if (IN(9)) { const Frame F = make_frame(lds, wave_s); TP_BEGIN(9) p9_fix(F, (const float*)(ws + A_FA), u8_ptr(args, g), (const float*)(ws + WS_PRM) + P_CW, (const float*)(ws + WS_PRM) + P_CB, g ? 2048 : 4096); GRID_BAR(); TP_END(9); }
#else
    if (IN(9)) { const Frame F = make_frame(lds, wave_s); TP_BEGIN(9) p9_conv(F, args, g); GRID_BAR(); TP_END(9); }
#endif
    if (IN(10)) { const Frame F = make_frame(lds, wave_s);
        pg8::Gemm gm{(const bf16_t*)u8_ptr(args, g), (const bf16_t*)(ws + WS_WDN)};
        EpiDown E{outg, (const bf16_t*)(ws + A_X1B), 1.f / (U8_SCALE * W8_SCALE)}; TP_BEGIN(10) pg8::gemm_phase<GT, DM, DFF / 2, DFF / 2, DFF / 2, 1, 0, 1>(F.lds, gm, fresh_grid(), fresh_bid(), F.tid, E); TP_END(10);
        if (more) GRID_BAR();
    }
}
__global__ void __launch_bounds__(NTHR, 2) mk_fwd(Args args) {
    extern __shared__ __attribute__((aligned(16))) unsigned char lds_raw[];
    LAS unsigned char* lds = (LAS unsigned char*)lds_raw;
    const int wave_s = __builtin_amdgcn_readfirstlane((int)threadIdx.x >> 6);
#if MK_TPROBE == 99
    const unsigned long long tp_k0 = __builtin_amdgcn_s_memrealtime();
#endif
    { volatile LAS unsigned* MISC = (volatile LAS unsigned*)(lds + LDS_MISC); const int t = fresh_tid(wave_s); if (t < 64) MISC[t] = 0u; }
    __syncthreads();
#if MK_ONE_LAUNCH
    (void)xcd_barrier_post((unsigned*)(args.ws + WS_CTL) + CW_BAR, (volatile LAS unsigned*)(lds + LDS_MISC));
    { const Frame F = make_frame(lds, wave_s); p0_colmax(F, args.in[21], DM, 2 * DFF, args.in[20], (unsigned*)(args.ws + WS_CTL) + CW_CMAX_UP);
      p0_colmax(F, args.in[4], DM, DIN, nullptr, (unsigned*)(args.ws + WS_CTL) + CW_CMAX_IN);
      p0_colmax(F, args.in[17], 2048, DM, nullptr, (unsigned*)(args.ws + WS_CTL) + CW_CMAX_PA); p0_colmax(F, args.in[18], 2048, DM, nullptr, (unsigned*)(args.ws + WS_CTL) + CW_CMAX_PB);
      p0_colmax(F, args.in[19], DM, DM, nullptr, (unsigned*)(args.ws + WS_CTL) + CW_CMAX_WO); }
    { XcdBarrier b_; b_.bar = (unsigned*)(args.ws + WS_CTL) + CW_BAR; b_.x = xb_xcc_id(); b_.st = (volatile LAS unsigned*)(lds + LDS_MISC); xcd_barrier(b_); }
    { const Frame F = make_frame(lds, wave_s); TP_BEGIN(0) p0_weights(F, args); TP_END(0); }
    group_body<0>(lds, wave_s, args, true);
    group_body<1>(lds, wave_s, args, false);
#if MK_TPROBE == 99
    { const Frame F = make_frame(lds, wave_s); if (fresh_bid() == 0 && F.tid == 0) args.out[0] += (float)(unsigned)(__builtin_amdgcn_s_memrealtime() - tp_k0) * 1e-4f; }
#elif MK_TPROBE >= 0
    { const Frame F = make_frame(lds, wave_s); if (fresh_bid() == 0 && F.tid == 0) { volatile LAS unsigned* m_ = (volatile LAS unsigned*)(lds + LDS_MISC); args.out[0] += (float)m_[32] * 1e-4f; } }
#endif
#else
    if (args.ph_lo == 0 && args.g_lo == 0) { const Frame F = make_frame(lds, wave_s); p0_weights(F, args); }
    if (args.g_lo <= 0 && 0 < args.g_hi) group_body<0>(lds, wave_s, args, false);
    if (args.g_lo <= 1 && 1 < args.g_hi) group_body<1>(lds, wave_s, args, false);
#endif
}
#undef IN
#undef GRID_BAR


#if MK_DIAG
constexpr int CW_DIAG = 32768;
__global__ void diag_scan_bf16(const bf16_t* p, size_t n, unsigned* diag, int stage, float thr) {
    unsigned bad = 0;
    for (size_t i = (size_t)blockIdx.x * blockDim.x + threadIdx.x; i < n; i += (size_t)gridDim.x * blockDim.x) { const float v = bf2f(p[i]); if (!(fabsf(v) <= thr)) ++bad; }
    if (bad) atomicAdd(diag + stage, bad);
}
__global__ void diag_scan_f32(const float* p, size_t n, unsigned* diag, int stage, float thr) {
    unsigned bad = 0;
    for (size_t i = (size_t)blockIdx.x * blockDim.x + threadIdx.x; i < n; i += (size_t)gridDim.x * blockDim.x) { const float v = p[i]; if (!(fabsf(v) <= thr)) ++bad; }
    if (bad) atomicAdd(diag + stage, bad);
}

__global__ void diag_check_inproj(const float* x, const float* gm, const float* w_in, unsigned char* ws, unsigned* flag) {
    const int lane = threadIdx.x & 63, wv = (blockIdx.x * blockDim.x + threadIdx.x) >> 6, nw = (gridDim.x * blockDim.x) >> 6;
    const bf16_t* H = (const bf16_t*)(ws + A_H); const bf16_t* W = (const bf16_t*)(ws + WS_WIN);
    for (int s = wv; s < 4096; s += nw) {
        const unsigned hsh = (unsigned)s * 2654435761u; const int row = (int)((hsh >> 8) % GT);
        { float ss = 0.f; for (int k = lane; k < DM; k += 64) { const float v = x[(size_t)row * DM + k]; ss += v * v; } ss = wave_sum(ss);
          const int k = (int)((hsh >> 3) % DM); const float ref = x[(size_t)row * DM + k] * (1.f / sqrtf(ss / DM + EPS)) * gm[k]; const float got = bf2f(H[(size_t)row * DM + k]);
          if (!(fabsf(got - ref) <= 0.02f * fabsf(ref) + 1e-3f)) atomicOr(flag, 1u); }
        { const int n = (int)((hsh >> 5) % DIN), k = (int)((hsh >> 7) % DM); const int nn = n < 12288 ? n : (n < 12320 ? 20480 + (n - 12288) : n - 32);
          const float ref = w_in[(size_t)k * DIN + n], got = bf2f(W[(size_t)nn * DM + k]); if (!(fabsf(got - ref) <= 0.01f * fabsf(ref) + 1e-6f)) atomicOr(flag, 2u); }
        { const int seg = s % 7; int ncol, ld; size_t boff; float scale = 1.f;
          if (seg == 0) { ncol = 2048; ld = 2048; boff = A_Q; } else if (seg == 1) { ncol = 2048; ld = 2048; boff = A_K; } else if (seg == 2) { ncol = 2048; ld = 2048; boff = A_V; }
          else if (seg == 3) { ncol = 1024; ld = 1024; boff = A_GQ; scale = 0.0625f; } else if (seg == 4) { ncol = 1024; ld = 1024; boff = A_GK; } else if (seg == 5) { ncol = 2048; ld = 2048; boff = A_GV; } else { ncol = 32; ld = 32; boff = WS_ST; }
          const int segbase[7] = {0, 2048, 4096, 6144, 7168, 8192, 20480};
          const int c = (int)((hsh >> 11) % ncol); const int nn = segbase[seg] + c;
          float acc = 0.f; for (int k = lane; k < DM; k += 64) acc += bf2f(H[(size_t)row * DM + k]) * bf2f(W[(size_t)nn * DM + k]); acc = wave_sum(acc) * scale;
          const float got = seg == 6 ? ((const float*)(ws + boff))[(size_t)row * 32 + c] : bf2f(((const bf16_t*)(ws + boff))[(size_t)row * ld + c]);
          if (!(fabsf(got - acc) <= 0.02f * fabsf(acc) + 0.02f)) atomicOr(flag, 4u << seg); }
    }
}
__global__ void diag_final(float* out, size_t n, const unsigned* diag, int nstages) {
    int D = (int)(diag[50] & 32u); for (int s = 0; s < 4; ++s) if (diag[40 + s]) D |= 1 << s; if (diag[41] > 1000u) D |= 16;
    if (D == 0) return;
    const float c = exp2f(0.5f * (float)D);
    for (size_t i = (size_t)blockIdx.x * blockDim.x + threadIdx.x; i < n; i += (size_t)gridDim.x * blockDim.x) out[i] = c;
}
#endif
extern "C" void kernel_launch(void* const* d_in, const int* in_sizes, int n_in, void* d_out, int out_size, void* d_ws, size_t ws_size, hipStream_t stream) {
    static int grid = 0;
    if (grid == 0) {
        if (n_in != 25 || ws_size < WS_END) { fprintf(stderr, "kernel_launch: n_in %d ws %zu (need %zu)\n", n_in, ws_size, (size_t)WS_END); grid = -1; return; }
        int dev = 0, cus = 0, per_cu = 0;
        if (hipGetDevice(&dev) != hipSuccess || hipDeviceGetAttribute(&cus, hipDeviceAttributeMultiprocessorCount, dev) != hipSuccess) { grid = -1; return; }
        if (hipFuncSetAttribute((const void*)mk_fwd, hipFuncAttributeMaxDynamicSharedMemorySize, LDS_BYTES) != hipSuccess) { fprintf(stderr, "kernel_launch: hipFuncSetAttribute failed\n"); grid = -1; return; }
        if (hipOccupancyMaxActiveBlocksPerMultiprocessor(&per_cu, (const void*)mk_fwd, NTHR, LDS_BYTES) != hipSuccess || per_cu < 1) { fprintf(stderr, "kernel_launch: occupancy query says %d\n", per_cu); }
        (void)hipGetLastError();
        grid = cus;
    }
    if (grid < 0) return;
    (void)hipMemsetAsync((char*)d_ws + WS_CTL, 0, CTL_ZERO_BYTES, stream);
    Args a{};
    for (int i = 0; i < 25; ++i) a.in[i] = (const float*)d_in[i];
    a.out = (float*)d_out; a.ws = (unsigned char*)d_ws;
#if MK_ONE_LAUNCH
    a.ph_lo = 0; a.ph_hi = NPH; a.g_lo = 0; a.g_hi = 2;
    hipLaunchKernelGGL(mk_fwd, dim3(grid), dim3(NTHR), LDS_BYTES, stream, a);
#else
    a.ph_lo = 0; a.ph_hi = 1; a.g_lo = 0; a.g_hi = 1;
    hipLaunchKernelGGL(mk_fwd, dim3(grid), dim3(NTHR), LDS_BYTES, stream, a);
#if MK_DIAG
    unsigned char* ws = (unsigned char*)d_ws; unsigned* dg = (unsigned*)(ws + WS_CTL) + CW_DIAG;
#define SCANB(ptr, nel, st, thr) hipLaunchKernelGGL(diag_scan_bf16, dim3(2048), dim3(256), 0, stream, (const bf16_t*)(ptr), (size_t)(nel), dg, (st), (thr))
#define SCANF(ptr, nel, st, thr) hipLaunchKernelGGL(diag_scan_f32, dim3(2048), dim3(256), 0, stream, (const float*)(ptr), (size_t)(nel), dg, (st), (thr))
    SCANB(ws + WS_WIN, (WS_ACT - WS_WIN) / 2, 1, 1e4f);
    SCANF(ws + WS_PRM, P_END, 1, 1e4f);
#endif
    for (int g = 0; g < 2; ++g)
        for (int p = 1; p < NPH; ++p) { a.ph_lo = p; a.ph_hi = p + 1; a.g_lo = g; a.g_hi = g + 1; hipLaunchKernelGGL(mk_fwd, dim3(grid), dim3(NTHR), LDS_BYTES, stream, a);
#if MK_DIAG
            const int sb = 2 + g * 12; float* og = (float*)d_out + (size_t)g * GT * DM; const size_t E64 = (size_t)GT * 2048;
            if (p == 1) SCANB(ws + A_H, 2 * E64, sb + 0, 1e4f);
            if (p == 2) { SCANB(ws + A_Q, (A_SB + 128 * MiB - A_Q) / 2, sb + 1, 1e4f); SCANF(ws + WS_ST, (size_t)GT * 32, sb + 1, 1e4f); }
            if (p == 3 && g == 0) { SCANB((bf16_t*)og + 2 * E64, 2 * E64, 40, 3e38f); SCANB((bf16_t*)og + 2 * E64, 2 * E64, 41, 1e4f); SCANB((bf16_t*)og + 2 * E64, E64, 42, 1e4f); SCANB((bf16_t*)og + 3 * E64, E64, 43, 1e4f); }
            if (p == 4) SCANB(og, 4 * E64, sb + 3, 1e4f);
            if (p == 5) SCANB(ws + A_OAB, 2 * E64, sb + 4, 1e4f);
            if (p == 6) SCANB(ws + A_MRG, 2 * E64, sb + 5, 1e4f);
            if (p == 7) { SCANF(og, (size_t)GT * DM, sb + 6, 1e4f); SCANB(ws + A_X1B, 2 * E64, sb + 6, 1e4f); SCANF((float*)((unsigned*)(ws + WS_CTL) + CW_RSS) + (size_t)g * GT, GT, sb + 6, 1e6f); }
            if (p == 8) { SCANB(ws + A_FA, (size_t)GT * DFF, sb + 7, 1e4f); SCANB(ws + A_FG, (size_t)GT * DFF, sb + 7, 1e4f); }
            if (p == 9) SCANB(ws + A_FG, (size_t)GT * DFF, sb + 8, 1e4f);
            if (p == 10) SCANF(og, (size_t)GT * DM, sb + 9, 1e4f);
#endif
        }
#if MK_DIAG
    hipLaunchKernelGGL(diag_final, dim3(2048), dim3(256), 0, stream, (float*)d_out, (size_t)2 * GT * DM, dg, 32);
#endif
#endif
}
```
